# Optimizing an MI355X kernel written in HIP

```python
import math
import jax
import jax.numpy as jnp
from jax import lax
import numpy as np

D_MODEL = 1024
BATCH = 32
SEQ = 2048
DEPTH = 2

CTX_LEN = 256
GRID_W = 64

GLA_HEADS = 6
GLA_DK = 32
GLA_DV = 64
GLA_GATE_RANK = 16
GLA_TAU = 16.0
GLA_CHUNK = 64
NAT_HEADS = 4
NAT_DH = 64
NAT_WIN_R = 8
NAT_WIN_C = 16
RW_HEADS = 6
RW_DH = 64
RW_DECAY_RANK = 64
RW_A_RANK = 64
RW_GATE_RANK = 128
RW_GN_EPS = 64e-5
RW_DECAY_SCALE = math.exp(-0.5)

ROPE_BASE = 10000.0
LN_EPS = 1e-5

GLA_QK = GLA_HEADS * GLA_DK
GLA_V = GLA_HEADS * GLA_DV
NAT_W = NAT_HEADS * NAT_DH
RW_W = RW_HEADS * RW_DH
MIX_WIDTH = GLA_V + NAT_W + RW_W
FFN_HIDDEN = ((8 * D_MODEL + 3 * 256 - 1) // (3 * 256)) * 256

GLA_SIZES = (GLA_QK, GLA_QK, GLA_V, GLA_V, 2 * GLA_GATE_RANK)
NAT_SIZES = (NAT_W, NAT_W, NAT_W)
RW_SIZES = (RW_W, RW_W, RW_W, 2 * RW_DECAY_RANK, 2 * RW_A_RANK, RW_GATE_RANK)
GLA_COLS = 2 * GLA_QK + 2 * GLA_V + 2 * GLA_GATE_RANK
NAT_COLS = 3 * NAT_W
RW_COLS = 3 * RW_W + 2 * RW_DECAY_RANK + 2 * RW_A_RANK + RW_GATE_RANK
IN_COLS = GLA_COLS + NAT_COLS + RW_COLS

kernel_name = 'hybrid_gla_natten_rwkv7_dit_block'


def split_cols(t, sizes):
    return jnp.split(t, [int(s) for s in np.cumsum(sizes)[:-1]], axis=-1)


def layer_norm(x, w, b):
    xf = x.astype(jnp.float32)
    mu = jnp.mean(xf, axis=-1, keepdims=True)
    var = jnp.mean(jnp.square(xf - mu), axis=-1, keepdims=True)
    return (xf - mu) * lax.rsqrt(var + LN_EPS) * w.astype(jnp.float32) + b.astype(jnp.float32)


def rms_norm(x, w):
    xf = x.astype(jnp.float32)
    return xf * lax.rsqrt(jnp.mean(jnp.square(xf), axis=-1, keepdims=True) + LN_EPS) * w.astype(jnp.float32)


def group_norm_heads(x, w, b):
    xf = x.astype(jnp.float32)
    mu = jnp.mean(xf, axis=-1, keepdims=True)
    var = jnp.mean(jnp.square(xf - mu), axis=-1, keepdims=True)
    y = (xf - mu) * lax.rsqrt(var + RW_GN_EPS)
    return y * w.reshape(RW_HEADS, RW_DH).astype(jnp.float32) + b.reshape(RW_HEADS, RW_DH).astype(jnp.float32)


def ada_modulation(cvec, w_mod, b_mod):
    m = jax.nn.silu(cvec) @ w_mod + b_mod
    return jnp.split(m, 6, axis=-1)


def axial_rope_tables(n_tok, dim):
    t = jnp.arange(n_tok, dtype=jnp.int32)
    row = (t // GRID_W).astype(jnp.float32)
    col = (t % GRID_W).astype(jnp.float32)
    n_freq = dim // 4
    inv = ROPE_BASE ** (-jnp.arange(n_freq, dtype=jnp.float32) / n_freq)
    ang = jnp.concatenate([row[:, None] * inv, col[:, None] * inv], axis=-1)
    return jnp.cos(ang), jnp.sin(ang)


def apply_rope(x, cos, sin):
    xf = x.astype(jnp.float32)
    x1, x2 = xf[..., 0::2], xf[..., 1::2]
    c, s = cos[:, None, :], sin[:, None, :]
    return jnp.stack([x1 * c - x2 * s, x1 * s + x2 * c], axis=-1).reshape(x.shape)


def gla_chunked(q, k, v, logd, s0, with_out=True):
    B, H, L, DK = q.shape
    DV = v.shape[-1]
    C = GLA_CHUNK
    N = L // C
    q, k, v = (t.astype(jnp.float32).reshape(B, H, N, C, t.shape[-1]) for t in (q, k, v))
    b = jnp.cumsum(logd.astype(jnp.float32).reshape(B, H, N, C, DK), axis=3)
    b_last = b[:, :, :, -1]
    chunk_kv = jnp.einsum('bhnck,bhncv->bhnkv', k * jnp.exp(b_last[:, :, :, None] - b), v)

    def step(S, inp):
        dec, kv = inp
        return dec[..., None] * S + kv, S

    s_final, s_start = lax.scan(step, s0, (jnp.moveaxis(jnp.exp(b_last), 2, 0), jnp.moveaxis(chunk_kv, 2, 0)))
    if not with_out:
        return None, s_final
    q_e = q * jnp.exp(b)
    k_e = k * jnp.exp(-b)
    lower = jnp.tril(jnp.ones((C, C), dtype=bool))
    att = jnp.where(lower, jnp.einsum('bhnik,bhnjk->bhnij', q_e, k_e), 0.0)
    o = (jnp.einsum('bhnij,bhnjv->bhniv', att, v)
         + jnp.einsum('bhnik,bhnkv->bhniv', q_e, jnp.moveaxis(s_start, 0, 2)))
    return o.reshape(B, H, L, DV), s_final


def gla_two_way(q, k, v, logd2, s0f, s0b, with_out=True):
    of, sf = gla_chunked(q, k, v, logd2[0], s0f, with_out)
    rev = lambda t: jnp.flip(t, axis=2)
    ob, sb = gla_chunked(rev(q), rev(k), rev(v), rev(logd2[1]), s0b, with_out)
    o = of + rev(ob) if with_out else None
    return o, sf, sb


def gla_group(parts_l, parts_c, gate_up, gate_b, norm_w, rope, ctx_out):
    def prep(parts, rope_tab):
        q, k, v, g, dn = parts
        B, L, _ = q.shape
        q = q.reshape(B, L, GLA_HEADS, GLA_DK)
        k = k.reshape(B, L, GLA_HEADS, GLA_DK)
        if rope_tab is not None:
            q = apply_rope(q, *rope_tab)
            k = apply_rope(k, *rope_tab)
        z = jnp.einsum('blgr,grk->gblk', dn.reshape(B, L, 2, GLA_GATE_RANK), gate_up) + gate_b[:, None, None, :]
        logd = jax.nn.log_sigmoid(z.astype(jnp.float32)) / GLA_TAU
        logd = logd.reshape(2, B, L, GLA_HEADS, GLA_DK).transpose(0, 1, 3, 2, 4)
        bhld = lambda t: jnp.swapaxes(t, 1, 2)
        return (bhld(q) * GLA_DK ** -0.5, bhld(k), bhld(v.reshape(B, L, GLA_HEADS, GLA_DV)), logd, g)

    def readout(o, g):
        o = jnp.swapaxes(o, 1, 2)
        B, L = o.shape[:2]
        gate = jax.nn.silu(g.reshape(B, L, GLA_HEADS, GLA_DV).astype(jnp.float32))
        return (rms_norm(o, norm_w) * gate).reshape(B, L, GLA_V)

    qc, kc, vc, dc, gc = prep(parts_c, None)
    s0 = jnp.zeros((qc.shape[0], GLA_HEADS, GLA_DK, GLA_DV), jnp.float32)
    oc, sf, sb = gla_two_way(qc, kc, vc, dc, s0, s0, ctx_out)
    ql, kl, vl, dl, gl = prep(parts_l, rope)
    ol, _, _ = gla_two_way(ql, kl, vl, dl, sf, sb)
    return readout(ol, gl), (readout(oc, gc) if ctx_out else None)


def nat_group(parts_l, parts_c, rpb, ctx_out):
    ql, kl, vl = (t.reshape(t.shape[0], t.shape[1], NAT_HEADS, NAT_DH) for t in parts_l)
    qc, kc, vc = (t.reshape(t.shape[0], t.shape[1], NAT_HEADS, NAT_DH) for t in parts_c)
    B, L = ql.shape[:2]
    R = L // GRID_W
    KR = min(NAT_WIN_R, R)
    KC = NAT_WIN_C
    scale = NAT_DH ** -0.5
    r_idx = jnp.arange(R)
    rows = jnp.clip(r_idx - KR // 2, 0, R - KR)[:, None] + jnp.arange(KR)[None, :]
    cq = jnp.arange(GRID_W)
    col0 = jnp.clip(cq - KC // 2, 0, GRID_W - KC)
    in_win = (cq[None, :] >= col0[:, None]) & (cq[None, :] < col0[:, None] + KC)
    dr = rows - r_idx[:, None] + NAT_WIN_R - 1
    dc = jnp.clip(cq[None, :] - cq[:, None], -(KC - 1), KC - 1) + KC - 1
    bias = rpb[:, dr][:, :, :, dc].transpose(0, 1, 3, 2, 4)

    qg = ql.reshape(B, R, GRID_W, NAT_HEADS, NAT_DH)
    kg = kl.reshape(B, R, GRID_W, NAT_HEADS, NAT_DH)[:, rows]
    vg = vl.reshape(B, R, GRID_W, NAT_HEADS, NAT_DH)[:, rows]
    s_loc = jnp.einsum('brqhd,brkwhd->bhrqkw', qg, kg).astype(jnp.float32) * scale + bias
    s_loc = jnp.where(in_win[:, None, :], s_loc, -jnp.inf)
    s_ctx = jnp.einsum('brqhd,bchd->bhrqc', qg, kc).astype(jnp.float32) * scale
    n_loc = KR * GRID_W
    s = jnp.concatenate([s_loc.reshape(B, NAT_HEADS, R, GRID_W, n_loc), s_ctx], axis=-1)
    p = jax.nn.softmax(s, axis=-1)
    p_loc = p[..., :n_loc].reshape(B, NAT_HEADS, R, GRID_W, KR, GRID_W)
    o = (jnp.einsum('bhrqkw,brkwhd->brqhd', p_loc, vg.astype(jnp.float32))
         + jnp.einsum('bhrqc,bchd->brqhd', p[..., n_loc:], vc.astype(jnp.float32)))
    out_l = o.reshape(B, L, NAT_W)
    if not ctx_out:
        return out_l, None
    sc = jnp.einsum('bihd,bjhd->bhij', qc, kc).astype(jnp.float32) * scale
    oc = jnp.einsum('bhij,bjhd->bihd', jax.nn.softmax(sc, axis=-1), vc.astype(jnp.float32))
    return out_l, oc.reshape(B, qc.shape[1], NAT_W)


def centred_shift(y, mu):
    pad = jnp.pad(y, ((0, 0), (1, 1), (0, 0)))
    return y + (0.5 * (pad[:, :-2] + pad[:, 2:]) - y) * mu


def rwkv7_scan(r, w, k, v, kk, a, s0):
    def step(S, inp):
        r_t, w_t, k_t, v_t, kk_t, a_t = inp
        sa = jnp.einsum('bhvk,bhk->bhv', S, -kk_t)
        S = (S * w_t[:, :, None, :] + sa[..., None] * (kk_t * a_t)[:, :, None, :]
             + v_t[..., None] * k_t[:, :, None, :])
        return S, jnp.einsum('bhvk,bhk->bhv', S, r_t)

    s_final, o = lax.scan(step, s0, tuple(jnp.moveaxis(t, 1, 0) for t in (r, w, k, v, kk, a)))
    return jnp.moveaxis(o, 0, 1), s_final


def rwkv_group(P_l, P_c, mu, w0, wd2, a0, wa2, wg2, k_k, k_a, r_k, gn_w, gn_b, ctx_out):
    def heads(t):
        return t.reshape(t.shape[:-1] + (RW_HEADS, RW_DH)).astype(jnp.float32)

    def prep(P):
        y = centred_shift(P, mu)
        r, k, v, dd, ad, gd = split_cols(y, RW_SIZES)
        B, L, _ = r.shape
        d = w0[:, None, None] + jnp.einsum('blgr,grc->gblc', jnp.tanh(dd.reshape(B, L, 2, RW_DECAY_RANK)), wd2)
        w = jnp.exp(-RW_DECAY_SCALE * jax.nn.sigmoid(d.astype(jnp.float32)))
        a = jax.nn.sigmoid((a0[:, None, None] + jnp.einsum('blgr,grc->gblc', ad.reshape(B, L, 2, RW_A_RANK), wa2)).astype(jnp.float32))
        g = jax.nn.sigmoid(gd) @ wg2
        kk = heads(k * k_k)
        kk = kk * lax.rsqrt(jnp.sum(kk * kk, axis=-1, keepdims=True) + 1e-12)
        kmod = k[None].astype(jnp.float32) * (1.0 + (a - 1.0) * k_a)
        return heads(r), heads(w), heads(kmod), heads(v), kk, heads(a), g

    def two_way(st, s0f, s0b):
        r, w, k, v, kk, a, _ = st
        of, sf = rwkv7_scan(r, w[0], k[0], v, kk, a[0], s0f)
        rev = lambda t: jnp.flip(t, axis=1)
        ob, sb = rwkv7_scan(rev(r), rev(w[1]), rev(k[1]), rev(v), rev(kk), rev(a[1]), s0b)
        return of + rev(ob), sf, sb

    def readout(o, st):
        r, _, k, v, _, _, g = st
        B, L = o.shape[:2]
        rk = r_k.reshape(RW_HEADS, RW_DH).astype(jnp.float32)
        bonus = jnp.sum(r[None] * k * rk, axis=-1, keepdims=True).sum(0) * v
        return (group_norm_heads(o, gn_w, gn_b) + bonus).reshape(B, L, RW_W) * g

    st_c = prep(P_c)
    s0 = jnp.zeros((P_c.shape[0], RW_HEADS, RW_DH, RW_DH), jnp.float32)
    oc, sf, sb = two_way(st_c, s0, s0)
    st_l = prep(P_l)
    ol, _, _ = two_way(st_l, sf, sb)
    return readout(ol, st_l), (readout(oc, st_c) if ctx_out else None)


def swiglu(h, w13, w2):
    gte, up = jnp.split(h @ w13, 2, axis=-1)
    return (jax.nn.silu(gte) * up) @ w2


def token_mixers(P, Pc, p, rope, ctx_out):
    gl_, nl_, rl_ = split_cols(P, (GLA_COLS, NAT_COLS, RW_COLS))
    gc_, nc_, rc_ = split_cols(Pc, (GLA_COLS, NAT_COLS, RW_COLS))
    a_l, a_c = gla_group(split_cols(gl_, GLA_SIZES), split_cols(gc_, GLA_SIZES),
                         p['gla_gate_up'], p['gla_gate_b'], p['gla_norm_w'], rope, ctx_out)
    b_l, b_c = nat_group(split_cols(nl_, NAT_SIZES), split_cols(nc_, NAT_SIZES), p['nat_rpb'], ctx_out)
    c_l, c_c = rwkv_group(rl_, rc_, p['rw_mu'], p['rw_w0'], p['rw_wd2'], p['rw_a0'], p['rw_wa2'], p['rw_wg2'],
                          p['rw_k_k'], p['rw_k_a'], p['rw_r_k'], p['rw_gn_w'], p['rw_gn_b'], ctx_out)
    y_l = jnp.concatenate([a_l, b_l, c_l], axis=-1)
    y_c = jnp.concatenate([a_c, b_c, c_c], axis=-1) if ctx_out else None
    return y_l, y_c


def hybrid_layer(xl, xc, c, c_ctx, p, rope, last):
    dt = xl.dtype
    alpha = (2.0 * DEPTH) ** 0.25
    ctx_out = not last
    ml = [m[:, None, :] for m in ada_modulation(c, p['w_mod'], p['b_mod'])]
    mc = ada_modulation(c_ctx, p['w_mod'], p['b_mod'])
    P = (xl * (1.0 + ml[1]) + ml[0]) @ p['w_in']
    Pc = (xc * (1.0 + mc[1]) + mc[0]) @ p['w_in']
    y_l, y_c = token_mixers(P, Pc, p, rope, ctx_out)
    xl = layer_norm(alpha * xl + ml[2] * (y_l.astype(dt) @ p['w_out']), p['ln1_w'], p['ln1_b']).astype(dt)
    f_l = swiglu(xl * (1.0 + ml[4]) + ml[3], p['ffn_w13'], p['ffn_w2'])
    xl = layer_norm(alpha * xl + ml[5] * f_l, p['ln2_w'], p['ln2_b']).astype(dt)
    if ctx_out:
        xc = layer_norm(alpha * xc + mc[2] * (y_c.astype(dt) @ p['w_out']), p['ln1_w'], p['ln1_b']).astype(dt)
        f_c = swiglu(xc * (1.0 + mc[4]) + mc[3], p['ffn_w13'], p['ffn_w2'])
        xc = layer_norm(alpha * xc + mc[5] * f_c, p['ln2_w'], p['ln2_b']).astype(dt)
    return xl, xc


def setup_inputs(seed: int = 0) -> dict:
    key = jax.random.key(seed)
    ks = jax.random.split(key, 40)
    f32 = jnp.float32
    D = D_MODEL
    beta = (8.0 * DEPTH) ** -0.25

    def nrm(k, shape, s):
        return jax.random.normal(k, shape, f32) * s

    return {
        'x': nrm(ks[0], (BATCH, SEQ, D), 1.0),
        'c': nrm(ks[1], (BATCH, D), 1.0),
        'ctx': nrm(ks[2], (BATCH, CTX_LEN, D), 1.0),
        'c_ctx': nrm(ks[3], (D,), 1.0),
        'w_mod': nrm(ks[4], (DEPTH, D, 6 * D), 0.5 * D ** -0.5),
        'b_mod': nrm(ks[5], (DEPTH, 6 * D), 0.02),
        'w_in': nrm(ks[6], (DEPTH, D, IN_COLS), D ** -0.5),
        'gla_gate_up': nrm(ks[7], (DEPTH, 2, GLA_GATE_RANK, GLA_QK), GLA_GATE_RANK ** -0.5),
        'gla_gate_b': nrm(ks[8], (DEPTH, 2, GLA_QK), 0.5),
        'gla_norm_w': 1.0 + nrm(ks[9], (DEPTH, GLA_DV), 0.02),
        'nat_rpb': nrm(ks[10], (DEPTH, NAT_HEADS, 2 * NAT_WIN_R - 1, 2 * NAT_WIN_C - 1), 0.02),
        'rw_mu': jax.random.uniform(ks[11], (DEPTH, RW_COLS), f32),
        'rw_w0': jax.random.uniform(ks[12], (DEPTH, 2, RW_W), f32, -3.0, 1.0),
        'rw_wd2': nrm(ks[13], (DEPTH, 2, RW_DECAY_RANK, RW_W), 0.5 * RW_DECAY_RANK ** -0.5),
        'rw_a0': nrm(ks[14], (DEPTH, 2, RW_W), 0.1),
        'rw_wa2': nrm(ks[15], (DEPTH, 2, RW_A_RANK, RW_W), 0.5 * RW_A_RANK ** -0.5),
        'rw_wg2': nrm(ks[16], (DEPTH, RW_GATE_RANK, RW_W), RW_GATE_RANK ** -0.5),
        'rw_k_k': 0.85 + nrm(ks[17], (DEPTH, RW_W), 0.02),
        'rw_k_a': 1.0 + nrm(ks[18], (DEPTH, RW_W), 0.02),
        'rw_r_k': nrm(ks[19], (DEPTH, RW_W), 0.1),
        'rw_gn_w': 1.0 + nrm(ks[20], (DEPTH, RW_W), 0.02),
        'rw_gn_b': nrm(ks[21], (DEPTH, RW_W), 0.02),
        'w_out': nrm(ks[22], (DEPTH, MIX_WIDTH, D), beta * MIX_WIDTH ** -0.5),
        'ln1_w': 1.0 + nrm(ks[23], (DEPTH, D), 0.02),
        'ln1_b': nrm(ks[24], (DEPTH, D), 0.02),
        'ffn_w13': nrm(ks[25], (DEPTH, D, 2 * FFN_HIDDEN), D ** -0.5),
        'ffn_w2': nrm(ks[26], (DEPTH, FFN_HIDDEN, D), beta * FFN_HIDDEN ** -0.5),
        'ln2_w': 1.0 + nrm(ks[27], (DEPTH, D), 0.02),
        'ln2_b': nrm(ks[28], (DEPTH, D), 0.02),
    }


def reference(x, c, ctx, c_ctx, w_mod, b_mod, w_in, gla_gate_up, gla_gate_b, gla_norm_w, nat_rpb,
              rw_mu, rw_w0, rw_wd2, rw_a0, rw_wa2, rw_wg2, rw_k_k, rw_k_a, rw_r_k, rw_gn_w, rw_gn_b,
              w_out, ln1_w, ln1_b, ffn_w13, ffn_w2, ln2_w, ln2_b):
    rope = axial_rope_tables(x.shape[1], GLA_DK)
    xl, xc = x, ctx
    for i in range(DEPTH):
        p = dict(w_mod=w_mod[i], b_mod=b_mod[i], w_in=w_in[i], gla_gate_up=gla_gate_up[i], gla_gate_b=gla_gate_b[i],
                 gla_norm_w=gla_norm_w[i], nat_rpb=nat_rpb[i], rw_mu=rw_mu[i], rw_w0=rw_w0[i], rw_wd2=rw_wd2[i],
                 rw_a0=rw_a0[i], rw_wa2=rw_wa2[i], rw_wg2=rw_wg2[i], rw_k_k=rw_k_k[i], rw_k_a=rw_k_a[i],
                 rw_r_k=rw_r_k[i], rw_gn_w=rw_gn_w[i], rw_gn_b=rw_gn_b[i], w_out=w_out[i], ln1_w=ln1_w[i],
                 ln1_b=ln1_b[i], ffn_w13=ffn_w13[i], ffn_w2=ffn_w2[i], ln2_w=ln2_w[i], ln2_b=ln2_b[i])
        xl, xc = hybrid_layer(xl, xc, c, c_ctx, p, rope, i == DEPTH - 1)
    return xl
```

```cpp
#include <hip/hip_runtime.h>
#include <hip/hip_cooperative_groups.h>
#include <cstdio>
#include <cstdint>
namespace cg = cooperative_groups;
namespace pg8 {
#define PG8_LAS __attribute__((address_space(3)))
typedef unsigned short bf16_t;
typedef short bf16x8 __attribute__((ext_vector_type(8)));
typedef float f32x4 __attribute__((ext_vector_type(4)));
typedef unsigned u32x4 __attribute__((ext_vector_type(4)));
constexpr int BM = 256, BK = 64, HALF = 128, HTB = HALF * BK * 2  , STAGE_BYTES = 8 * HTB, NXCD = 8, WGM = 8;

__host__ __device__ __forceinline__ int lds_byte(int r, int c) { const int st = (r >> 4) * 2 + (c >> 5), rr = r & 15, cc = c & 31, ob = rr * 64 + cc * 2; return st * 1024 + (ob ^ (((ob >> 9) & 1) << 5)); }
__host__ __device__ __forceinline__ void stage_rc(int b, int& R, int& C) { const int st = b / 1024, sb = b % 1024, swz = sb ^ (((sb >> 9) & 1) << 5); R = (st >> 1) * 16 + swz / 64; C = (st & 1) * 32 + (swz % 64) / 2; }
__host__ __device__ __forceinline__ int perm32(int rho) { const int n = rho >> 4, i = rho & 15; return 8 * (i >> 2) + 4 * n + (i & 3); }

struct Unit { int pm, pn; };
struct Gemm { const bf16_t* A; const bf16_t* Bt; int M, N, K; };

struct StaticOrder {
    int nM, nN, nwg, G, c;
    __host__ __device__ void init(int M, int N, int G_, int c_) { nM = M / BM; nN = N / BM; nwg = nM * nN; G = G_; c = c_; }
    __host__ __device__ bool next(int i, Unit& u) const {
        const long L = (long)i * G + c; if (L >= nwg) return false;
        int wgid = (int)L; { const int q = nwg / NXCD, r = nwg % NXCD, xcd = wgid % NXCD, off = wgid / NXCD; wgid = (xcd < r ? xcd * (q + 1) : r * (q + 1) + (xcd - r) * q) + off; }
        const int nig = WGM * nN, gid = wgid / nig, fm = gid * WGM, gsz = (nM - fm) < WGM ? (nM - fm) : WGM;
        u.pm = fm + ((wgid % nig) % gsz); u.pn = (wgid % nig) / gsz; return true;
    }
    __device__ __forceinline__ void a_ready(const Unit&) const {}
    __device__ __forceinline__ void done(const Unit&) const {}
};
__device__ __forceinline__ unsigned cvtpk(float lo, float hi) { typedef float v2f __attribute__((ext_vector_type(2))); typedef __bf16 v2b __attribute__((ext_vector_type(2))); v2f v = {lo, hi}; v2b b = __builtin_convertvector(v, v2b); return __builtin_bit_cast(unsigned, b); }
__device__ __forceinline__ float sigm(float x) { return 1.0f / (1.0f + __expf(-x)); }
struct EpiStoreBf16 {
    static constexpr bool PERM = true, AFTER_DRAIN = false;
    bf16_t* O; int ldc;
    __device__ __forceinline__ void operator()(const f32x4 (&acc)[2][2][4][2], const Unit& u, int wr, int wc, int fr, int fq) const {
        const int row0 = u.pm * BM + wr * 64 + fr, col0 = u.pn * BM + wc * 32 + 8 * fq;
#pragma unroll
        for (int ai = 0; ai < 2; ++ai)
#pragma unroll
            for (int m = 0; m < 4; ++m) { bf16_t* rowp = O + (size_t)(row0 + ai * HALF + m * 16) * ldc + col0;
#pragma unroll
                for (int bj = 0; bj < 2; ++bj) { const f32x4 v0 = acc[ai][bj][m][0], v1 = acc[ai][bj][m][1];
                    u32x4 w; w.x = cvtpk(v0[0], v0[1]); w.y = cvtpk(v0[2], v0[3]); w.z = cvtpk(v1[0], v1[1]); w.w = cvtpk(v1[2], v1[3]);
                    *(u32x4*)(rowp + bj * HALF) = w; } }
    }
};
struct EpiLora {
    static constexpr bool PERM = true, AFTER_DRAIN = false;
    bf16_t* O; const float* w0; const float* a0;
    __device__ __forceinline__ void operator()(const f32x4 (&acc)[2][2][4][2], const Unit& u, int wr, int wc, int fr, int fq) const {
        const int row0 = u.pm * BM + wr * 64 + fr;
#pragma unroll
        for (int bj = 0; bj < 2; ++bj) {
            const int cb = u.pn * 2 + bj;
            if (cb < 15) {
                const int c0 = cb * 128 + wc * 32 + 8 * fq;
                if (cb >= 12) {
#pragma unroll
                    for (int ai = 0; ai < 2; ++ai)
#pragma unroll
                        for (int m = 0; m < 4; ++m) { const f32x4 v0 = acc[ai][bj][m][0], v1 = acc[ai][bj][m][1];
                            u32x4 w; w.x = cvtpk(v0[0], v0[1]); w.y = cvtpk(v0[2], v0[3]); w.z = cvtpk(v1[0], v1[1]); w.w = cvtpk(v1[2], v1[3]);
                            *(u32x4*)(O + (size_t)(row0 + ai * HALF + m * 16) * 1920 + c0) = w; }
                } else {
                    const int kind = wc >> 1, g = cb / 6, h = cb % 6;
                    const float* a0v = a0; const float* w0v = w0; asm volatile("" : "+s"(a0v), "+s"(w0v));
                    const float* bp = (kind ? a0v : w0v) + g * 384 + h * 64 + (wc & 1) * 32 + 8 * fq;
                    const f32x4 b0 = *(const f32x4*)bp, b1 = *(const f32x4*)(bp + 4);
                    const float mul = kind == 0 ? 0.60653065971263342f : 1.f;
#pragma unroll
                    for (int ai = 0; ai < 2; ++ai)
#pragma unroll
                        for (int m = 0; m < 4; ++m) { const f32x4 v0 = acc[ai][bj][m][0] + b0, v1 = acc[ai][bj][m][1] + b1;
                            u32x4 w; w.x = cvtpk(mul * sigm(v0[0]), mul * sigm(v0[1])); w.y = cvtpk(mul * sigm(v0[2]), mul * sigm(v0[3]));
                            w.z = cvtpk(mul * sigm(v1[0]), mul * sigm(v1[1])); w.w = cvtpk(mul * sigm(v1[2]), mul * sigm(v1[3]));
                            *(u32x4*)(O + (size_t)(row0 + ai * HALF + m * 16) * 1920 + c0) = w; }
                }
            }
        }
    }
};
struct EpiRes {
    static constexpr bool PERM = true, AFTER_DRAIN = false;
    const float* xl; const float* xc; float* ol; float* oc; const float* mod; int gofs;
    __device__ __forceinline__ void operator()(const f32x4 (&acc)[2][2][4][2], const Unit& u, int wr, int wc, int fr, int fq) const {
        const bool lat = u.pm < 256; const int bi = lat ? (u.pm >> 3) : 32;
        const size_t rbase = (size_t)(lat ? u.pm : u.pm - 256) * BM;
        const float* xlv = xl; const float* xcv = xc; float* olv = ol; float* ocv = oc; asm volatile("" : "+s"(xlv), "+s"(xcv), "+s"(olv), "+s"(ocv));
        const float* xin = (lat ? xlv : xcv) + rbase * 1024; float* out = (lat ? olv : ocv) + rbase * 1024;
        const float* gp = mod + (size_t)bi * 6144 + gofs;
        const int col0 = u.pn * BM + wc * 32 + 8 * fq, row0 = wr * 64 + fr;
#pragma unroll
        for (int bj = 0; bj < 2; ++bj)
#pragma unroll
            for (int n = 0; n < 2; ++n) { const int c = col0 + bj * HALF + 4 * n; const f32x4 gt = *(const f32x4*)(gp + c);
#pragma unroll
                for (int ai = 0; ai < 2; ++ai)
#pragma unroll
                    for (int m = 0; m < 4; ++m) { const size_t o = (size_t)(row0 + ai * HALF + m * 16) * 1024 + c;
                        const f32x4 xv = *(const f32x4*)(xin + o); const f32x4 a = acc[ai][bj][m][n];
                        f32x4 r; r[0] = 1.41421356237f * xv[0] + gt[0] * a[0]; r[1] = 1.41421356237f * xv[1] + gt[1] * a[1]; r[2] = 1.41421356237f * xv[2] + gt[2] * a[2]; r[3] = 1.41421356237f * xv[3] + gt[3] * a[3];
                        *(f32x4*)(out + o) = r; } }
    }
};
struct EpiSwiglu {
    static constexpr bool PERM = true, AFTER_DRAIN = false;
    bf16_t* O;
    __device__ __forceinline__ void operator()(const f32x4 (&acc)[2][2][4][2], const Unit& u, int wr, int wc, int fr, int fq) const {
        const int row0 = u.pm * BM + wr * 64 + fr, col0 = u.pn * HALF + wc * 32 + 8 * fq;
#pragma unroll
        for (int ai = 0; ai < 2; ++ai)
#pragma unroll
            for (int m = 0; m < 4; ++m) { float v[8];
#pragma unroll
                for (int i = 0; i < 8; ++i) { const float g = acc[ai][0][m][i >> 2][i & 3], up = acc[ai][1][m][i >> 2][i & 3]; v[i] = g * sigm(g) * up; }
                u32x4 w; w.x = cvtpk(v[0], v[1]); w.y = cvtpk(v[2], v[3]); w.z = cvtpk(v[4], v[5]); w.w = cvtpk(v[6], v[7]);
                *(u32x4*)(O + (size_t)(row0 + ai * HALF + m * 16) * 2816 + col0) = w; }
    }
};
struct EpiAny {
    static constexpr bool PERM = true, AFTER_DRAIN = false;
    int mode; EpiStoreBf16 e0; EpiLora e1; EpiRes e2; EpiSwiglu e3;
    __device__ __forceinline__ void operator()(const f32x4 (&acc)[2][2][4][2], const Unit& u, int wr, int wc, int fr, int fq) const {
        if (mode == 0) e0(acc, u, wr, wc, fr, fq); else if (mode == 1) e1(acc, u, wr, wc, fr, fq); else if (mode == 2) e2(acc, u, wr, wc, fr, fq); else e3(acc, u, wr, wc, fr, fq);
    }
};
template <class Epi, class Sched, bool ALIGN_EPI = false, bool SP2 = false>
__device__ __forceinline__ void gemm_phase(PG8_LAS unsigned char* lds, const Gemm g, const Sched& S, const Epi& E, const int tid) {
    const int wid = __builtin_amdgcn_readfirstlane(tid >> 6), lane = tid & 63, wr = wid >> 2, wc = wid & 3, fr = lane & 15, fq = lane >> 4;
    const int K = g.K, nt = K / BK;
    unsigned voffA[2], voffB[2];
#pragma unroll
    for (int i = 0; i < 2; ++i) { int R, C; stage_rc(tid * 16 + i * 8192, R, C); const int Rb = Epi::PERM ? ((R & ~31) + perm32(R & 31)) : R;
        voffA[i] = (unsigned)(R * K + C) * 2u; voffB[i] = (unsigned)(Rb * K + C) * 2u; }
    const size_t kstep = (size_t)(BK * 2);
    const size_t hstep = (size_t)HALF * K * 2;
    const size_t tstep = 2 * hstep;
    const unsigned ldsw = (unsigned)wid * 1024u;
    const int aoff = lds_byte(wr * 64 + fr, fq * 8), boff = lds_byte(wc * 32 + fr, fq * 8);
#define PG8_SA(b, h) (((b) * 2 + (h)) * HTB)
#define PG8_SB(b, h) ((4 + (b) * 2 + (h)) * HTB)
#define PG8_STAGE(bufoff, gbase, voff) do { _Pragma("unroll") for (int _i = 0; _i < 2; ++_i) \
        __builtin_amdgcn_global_load_lds((const unsigned*)((const char*)(gbase) + (voff)[_i]), (PG8_LAS unsigned*)(lds + (bufoff) + ldsw + _i * 8192), 16, 0, 0); } while (0)
#define PG8_LDA(dst, b, h) do { _Pragma("unroll") for (int m = 0; m < 4; ++m) _Pragma("unroll") for (int k = 0; k < 2; ++k) dst[m][k] = *(const PG8_LAS bf16x8*)(lds + PG8_SA(b, h) + aoff + m * 2048 + k * 1024); } while (0)
#define PG8_LDB(dst, b, h) do { _Pragma("unroll") for (int n = 0; n < 2; ++n) _Pragma("unroll") for (int k = 0; k < 2; ++k) dst[n][k] = *(const PG8_LAS bf16x8*)(lds + PG8_SB(b, h) + boff + n * 2048 + k * 1024); } while (0)
#define PG8_MMA(ai, bj, At, Bt) do { __builtin_amdgcn_s_setprio(1); _Pragma("unroll") for (int m = 0; m < 4; ++m) _Pragma("unroll") for (int n = 0; n < 2; ++n) _Pragma("unroll") for (int k = 0; k < 2; ++k) \
        acc[ai][bj][m][n] = __builtin_amdgcn_mfma_f32_16x16x32_bf16(Bt[n][k], At[m][k], acc[ai][bj][m][n], 0, 0, 0); __builtin_amdgcn_s_setprio(0); } while (0)
#define PG8_WAIT_V(n) asm volatile("s_waitcnt vmcnt(" #n ")" ::: "memory")
#define PG8_WAIT_L(n) asm volatile("s_waitcnt lgkmcnt(" #n ")" ::: "memory")
#define PG8_BAR __builtin_amdgcn_s_barrier()
#define PG8_SCHED __builtin_amdgcn_sched_barrier(0)
    Unit cur, nxt; int ui = 0;
    if (!S.next(0, cur)) return;
    f32x4 acc[2][2][4][2];
#pragma unroll
    for (int a = 0; a < 2; ++a)
#pragma unroll
        for (int b = 0; b < 2; ++b)
#pragma unroll
            for (int m = 0; m < 4; ++m)
#pragma unroll
                for (int n = 0; n < 2; ++n) acc[a][b][m][n] = (f32x4){0.f, 0.f, 0.f, 0.f};
    bf16x8 At[4][2], B0[2][2], B1[2][2];
    const char* cA = (const char*)g.A + (size_t)cur.pm * tstep; const char* cB = (const char*)g.Bt + (size_t)cur.pn * tstep;
    S.a_ready(cur);
    if constexpr (SP2) {
        PG8_STAGE(PG8_SB(0, 0), cB, voffB); PG8_STAGE(PG8_SB(0, 1), cB + hstep, voffB); PG8_STAGE(PG8_SA(0, 0), cA, voffA); PG8_STAGE(PG8_SA(0, 1), cA + hstep, voffA);
        if (wr == 1) PG8_BAR;
        PG8_WAIT_V(2); PG8_BAR;
        PG8_STAGE(PG8_SB(1, 0), cB + kstep, voffB); PG8_STAGE(PG8_SA(1, 0), cA + kstep, voffA); PG8_STAGE(PG8_SB(1, 1), cB + hstep + kstep, voffB);
        PG8_WAIT_V(6); PG8_BAR;
    } else {
        PG8_STAGE(PG8_SB(0, 0), cB, voffB); PG8_STAGE(PG8_SA(0, 0), cA, voffA); PG8_STAGE(PG8_SB(0, 1), cB + hstep, voffB); PG8_STAGE(PG8_SA(0, 1), cA + hstep, voffA);
        if (wr == 1) PG8_BAR;
        PG8_WAIT_V(4); PG8_BAR;
        PG8_STAGE(PG8_SB(1, 0), cB + kstep, voffB); PG8_STAGE(PG8_SA(1, 0), cA + kstep, voffA); PG8_STAGE(PG8_SB(1, 1), cB + hstep + kstep, voffB);
        PG8_WAIT_V(6); PG8_BAR;
    }
    for (;;) {
        const bool has_next = S.next(ui + 1, nxt);
        const char* nA = has_next ? (const char*)g.A + (size_t)nxt.pm * tstep : cA; const char* nB = has_next ? (const char*)g.Bt + (size_t)nxt.pn * tstep : cB;
        for (int t = 0; t < nt; t += 2) {
            const bool last = (t == nt - 2);
            const char* a1 = cA + (size_t)(t + 1) * kstep;
            const char* a2 = last ? nA : cA + (size_t)(t + 2) * kstep; const char* b2 = last ? nB : cB + (size_t)(t + 2) * kstep;
            const char* a3 = a2 + kstep; const char* b3 = b2 + kstep;
            if (last && has_next) S.a_ready(nxt);
            if constexpr (SP2) {
            PG8_LDB(B0, 0, 0); PG8_LDB(B1, 0, 1); PG8_SCHED; PG8_LDA(At, 0, 0); PG8_STAGE(PG8_SA(1, 1), a1 + hstep, voffA);
            PG8_WAIT_V(8); PG8_WAIT_L(0); PG8_BAR; PG8_MMA(0, 0, At, B0); PG8_MMA(0, 1, At, B1); PG8_BAR; PG8_SCHED;
            PG8_LDA(At, 0, 1); PG8_STAGE(PG8_SB(0, 0), b2, voffB); PG8_STAGE(PG8_SB(0, 1), b2 + hstep, voffB); PG8_STAGE(PG8_SA(0, 0), a2, voffA);
            PG8_WAIT_V(8); PG8_WAIT_L(0); PG8_BAR; PG8_MMA(1, 0, At, B0); PG8_MMA(1, 1, At, B1); PG8_BAR; PG8_SCHED;
            PG8_LDB(B0, 1, 0); PG8_LDB(B1, 1, 1); PG8_SCHED; PG8_LDA(At, 1, 0); PG8_STAGE(PG8_SA(0, 1), a2 + hstep, voffA);
            PG8_WAIT_V(8); PG8_WAIT_L(0); PG8_BAR; PG8_MMA(0, 0, At, B0); PG8_MMA(0, 1, At, B1); PG8_BAR; PG8_SCHED;
            PG8_LDA(At, 1, 1); PG8_STAGE(PG8_SB(1, 0), b3, voffB); PG8_STAGE(PG8_SB(1, 1), b3 + hstep, voffB); PG8_STAGE(PG8_SA(1, 0), a3, voffA);
            PG8_WAIT_V(8); PG8_WAIT_L(0); PG8_BAR; PG8_MMA(1, 0, At, B0); PG8_MMA(1, 1, At, B1); PG8_BAR; PG8_SCHED;
            } else {
            PG8_LDB(B0, 0, 0); PG8_SCHED; PG8_LDA(At, 0, 0); PG8_STAGE(PG8_SA(1, 1), a1 + hstep, voffA);
            PG8_WAIT_L(8); PG8_BAR; PG8_WAIT_L(0); PG8_MMA(0, 0, At, B0); PG8_BAR; PG8_SCHED;
            PG8_LDB(B1, 0, 1); PG8_STAGE(PG8_SB(0, 0), b2, voffB);
            PG8_BAR; PG8_WAIT_L(0); PG8_MMA(0, 1, At, B1); PG8_BAR;
            PG8_LDA(At, 0, 1); PG8_STAGE(PG8_SA(0, 0), a2, voffA);
            PG8_BAR; PG8_WAIT_L(0); PG8_MMA(1, 0, At, B0); PG8_BAR; PG8_SCHED;
            PG8_STAGE(PG8_SB(0, 1), b2 + hstep, voffB);
            PG8_WAIT_V(6); PG8_BAR; PG8_MMA(1, 1, At, B1); PG8_BAR;
            PG8_LDB(B0, 1, 0); PG8_SCHED; PG8_LDA(At, 1, 0); PG8_STAGE(PG8_SA(0, 1), a2 + hstep, voffA);
            PG8_WAIT_L(8); PG8_BAR; PG8_WAIT_L(0); PG8_MMA(0, 0, At, B0); PG8_BAR; PG8_SCHED;
            PG8_LDB(B1, 1, 1); PG8_STAGE(PG8_SB(1, 0), b3, voffB);
            PG8_BAR; PG8_WAIT_L(0); PG8_MMA(0, 1, At, B1); PG8_BAR;
            PG8_LDA(At, 1, 1); PG8_STAGE(PG8_SA(1, 0), a3, voffA);
            PG8_BAR; PG8_WAIT_L(0); PG8_MMA(1, 0, At, B0); PG8_BAR; PG8_SCHED;
            PG8_STAGE(PG8_SB(1, 1), b3 + hstep, voffB);
            PG8_WAIT_V(6); PG8_BAR; PG8_MMA(1, 1, At, B1); PG8_BAR;
            }
        }
        if constexpr (ALIGN_EPI) { if (wr == 0) PG8_BAR; }
        if constexpr (!Epi::AFTER_DRAIN) { E(acc, cur, wr, wc, fr, fq); S.done(cur); }
        if (!has_next) break;
#pragma unroll
        for (int a = 0; a < 2; ++a)
#pragma unroll
            for (int b = 0; b < 2; ++b)
#pragma unroll
                for (int m = 0; m < 4; ++m)
#pragma unroll
                    for (int n = 0; n < 2; ++n) acc[a][b][m][n] = (f32x4){0.f, 0.f, 0.f, 0.f};
        cur = nxt; cA = nA; cB = nB; ++ui;
        if constexpr (ALIGN_EPI) { if (wr == 1) PG8_BAR; }
    }
    PG8_WAIT_V(0);
    if constexpr (!ALIGN_EPI) { if (wr == 0) PG8_BAR; }
    PG8_BAR;
    if constexpr (Epi::AFTER_DRAIN) { E.fused(acc, cur, wr, wc, fr, fq, lds, wid, lane); S.done(cur); }
#undef PG8_SA
#undef PG8_SB
#undef PG8_STAGE
#undef PG8_LDA
#undef PG8_LDB
#undef PG8_MMA
#undef PG8_WAIT_V
#undef PG8_WAIT_L
#undef PG8_BAR
#undef PG8_SCHED
}
}

#define DI __device__ __forceinline__
#define LAS __attribute__((address_space(3)))
using pg8::bf16_t; using pg8::bf16x8; using pg8::f32x4; using pg8::u32x4; using pg8::cvtpk; using pg8::sigm;
typedef float f32x2 __attribute__((ext_vector_type(2)));
typedef unsigned u32x2 __attribute__((ext_vector_type(2)));

#ifndef MIXMASK
#define MIXMASK 3
#endif
#ifndef ROLEMASK
#define ROLEMASK 15
#endif
#ifndef PHMASK
#define PHMASK 0xffff
#endif
constexpr int NTHR = 512, NWAVE = 8, LDS_BYTES = 147456;
constexpr int D = 1024, NB = 32, SL = 2048, CL = 256, ML = NB * SL, MC = NB * CL, MT = ML + MC;
constexpr int INC = 3488, PLD = 3584, FH = 2816, LOLD = 1920;
constexpr int C_GQ = 0, C_GK = 192, C_GV = 384, C_GG = 768, C_GDN = 1152;
constexpr int C_NQ = 1184, C_NK = 1440, C_NV = 1696;
constexpr int C_RW = 1952;
constexpr size_t OFF_WIN = 0, OFF_WOUT = 7340032, OFF_W13 = 9437184, OFF_W2 = 20971520, OFF_BT2 = 26738688, WLB = 28311552;
constexpr size_t WS_MOD = 2 * WLB, WS_ROPE = WS_MOD + 1622016, WS_BON = WS_ROPE + 262144, WS_VT = WS_BON + 3538944, WS_AY = WS_VT + 37748736,
                 WS_PB = WS_AY + 150994944, WS_LO = WS_PB + 528482304, WS_END = WS_LO + 283115520;

struct Params { const float* in[29]; float* out; unsigned char* ws; };
enum { I_X = 0, I_C, I_CTX, I_CCTX, I_WMOD, I_BMOD, I_WIN, I_GUP, I_GB, I_GNW, I_RPB, I_MU, I_W0, I_WD2, I_A0, I_WA2, I_WG2, I_KK, I_KA, I_RK, I_GNWT, I_GNB,
       I_WOUT, I_LN1W, I_LN1B, I_W13, I_W2, I_LN2W, I_LN2B };

DI const float* pin(const Params& p, int i) { asm volatile("" : "+s"(i)); return p.in[i]; }
DI float bf2f(bf16_t h) { return __uint_as_float(((unsigned)h) << 16); }
DI float bflo(unsigned u) { return __uint_as_float(u << 16); }
DI float bfhi(unsigned u) { return __uint_as_float(u & 0xffff0000u); }
DI bf16_t f2bf(float f) { return (bf16_t)(cvtpk(f, 0.f) & 0xffffu); }
DI float wave_sum(float v) {
#pragma unroll
    for (int o = 1; o < 64; o <<= 1) v += __shfl_xor(v, o);
    return v;
}
DI void load8(const bf16_t* p, float* o) { const u32x4 u = *(const u32x4*)p; o[0] = bflo(u.x); o[1] = bfhi(u.x); o[2] = bflo(u.y); o[3] = bfhi(u.y); o[4] = bflo(u.z); o[5] = bfhi(u.z); o[6] = bflo(u.w); o[7] = bfhi(u.w); }
DI void load16(const bf16_t* p, float (&o)[16]) { load8(p, &o[0]); load8(p + 8, &o[8]); }
DI void shift16(const bf16_t* prow, bool hasm, bool hasp, const float* mu, float (&y)[16]) {
    float c0[16], cm[16], cp[16];
    load16(prow, c0);
    if (hasm) load16(prow - PLD, cm); else {
#pragma unroll
        for (int j = 0; j < 16; ++j) cm[j] = 0.f; }
    if (hasp) load16(prow + PLD, cp); else {
#pragma unroll
        for (int j = 0; j < 16; ++j) cp[j] = 0.f; }
#pragma unroll
    for (int j = 0; j < 16; ++j) y[j] = c0[j] + (0.5f * (cm[j] + cp[j]) - c0[j]) * mu[j];
}
DI void step_row(int s, int g, int b, int& row, int& ts, int& Ls) {
    if (s < CL) { ts = g ? (CL - 1 - s) : s; row = ML + b * CL + ts; Ls = CL; }
    else { const int u = s - CL; ts = g ? (SL - 1 - u) : u; row = b * SL + ts; Ls = SL; }
}

DI void transpose_item(const float* W, int N, bf16_t* WT, int Kd, size_t dst_row0, int k0, int n0, LAS float* scr, int lane) {
#pragma unroll 8
    for (int i = 0; i < 32; ++i) { const int kk = 2 * i + (lane >> 5); scr[kk * 33 + (lane & 31)] = W[(size_t)(k0 + kk) * N + n0 + (lane & 31)]; }
    asm volatile("s_waitcnt lgkmcnt(0)" ::: "memory");
    const int c = lane & 7;
#pragma unroll
    for (int j = 0; j < 4; ++j) { const int n = (lane >> 3) + 8 * j; const LAS float* s = scr + (8 * c) * 33 + n;
        u32x4 o; o.x = cvtpk(s[0 * 33], s[1 * 33]); o.y = cvtpk(s[2 * 33], s[3 * 33]); o.z = cvtpk(s[4 * 33], s[5 * 33]); o.w = cvtpk(s[6 * 33], s[7 * 33]);
        *(u32x4*)(WT + (dst_row0 + n) * Kd + k0 + 8 * c) = o; }
    asm volatile("s_waitcnt lgkmcnt(0)" ::: "memory");
}

DI void phase_prologue(const Params& p, LAS unsigned char* lds, int tid, int lane, int wave) {
    unsigned char* ws = p.ws;
    float* MOD = (float*)(ws + WS_MOD);
    {
        LAS float* sc = (LAS float*)lds;
        LAS float* part = (LAS float*)(lds + 135168);
        for (int i = tid; i < 33 * 1024; i += NTHR) { const int bi = i >> 10, k = i & 1023; const float cv = bi < 32 ? pin(p, I_C)[bi * 1024 + k] : pin(p, I_CCTX)[k]; sc[k * 33 + bi] = cv * sigm(cv); }
        __syncthreads();
        for (int u = blockIdx.x; u < 192; u += gridDim.x) {
            const int l = u / 96, n0 = (u % 96) * 64;
            float acc[33];
#pragma unroll
            for (int bi = 0; bi < 33; ++bi) acc[bi] = 0.f;
            const float* wp = pin(p, I_WMOD) + (size_t)l * 1024 * 6144 + n0 + lane;
#pragma unroll 4
            for (int kk = 0; kk < 128; ++kk) { const int k = wave * 128 + kk; const float w = wp[(size_t)k * 6144];
#pragma unroll
                for (int bi = 0; bi < 33; ++bi) acc[bi] += sc[k * 33 + bi] * w; }
            for (int w = 0; w < NWAVE; ++w) {
                if (wave == w) {
#pragma unroll
                    for (int bi = 0; bi < 33; ++bi) { if (w == 0) part[bi * 64 + lane] = acc[bi]; else part[bi * 64 + lane] += acc[bi]; } }
                __syncthreads();
            }
            for (int i = tid; i < 33 * 64; i += NTHR) { const int bi = i >> 6, n = i & 63; MOD[(size_t)(l * 33 + bi) * 6144 + n0 + n] = part[i] + pin(p, I_BMOD)[l * 6144 + n0 + n]; }
            __syncthreads();
        }
        __syncthreads();
    }
    const int gw = blockIdx.x * NWAVE + wave, NGW = gridDim.x * NWAVE;
    const int gt = blockIdx.x * NTHR + tid, NGT = gridDim.x * NTHR;
    {
        LAS float* scr = (LAS float*)(lds + wave * 8448);
        constexpr int IT_IN = 16 * 109, IT_OUT = 16 * 32, IT_13 = 16 * 176, IT_2 = 44 * 32, IT_L = IT_IN + IT_OUT + IT_13 + IT_2;
        for (int it = gw; it < 2 * IT_L; it += NGW) {
            const int l = it / IT_L; int r = it % IT_L;
            unsigned char* wl = ws + (size_t)l * WLB;
            if (r < IT_IN) { const int kb = r / 109, nb = r % 109;
                transpose_item(pin(p, I_WIN) + (size_t)l * 1024 * INC, INC, (bf16_t*)(wl + OFF_WIN), 1024, (size_t)nb * 32, kb * 64, nb * 32, scr, lane); continue; }
            r -= IT_IN;
            if (r < IT_OUT) { const int kb = r / 32, nb = r % 32;
                transpose_item(pin(p, I_WOUT) + (size_t)l * 1024 * 1024, 1024, (bf16_t*)(wl + OFF_WOUT), 1024, (size_t)nb * 32, kb * 64, nb * 32, scr, lane); continue; }
            r -= IT_OUT;
            if (r < IT_13) { const int kb = r / 176, nb = r % 176; const int n0 = nb * 32;
                const int j = n0 < FH ? n0 : n0 - FH; const size_t drow = (size_t)(256 * (j / 128) + (n0 < FH ? 0 : 128) + (j % 128));
                transpose_item(pin(p, I_W13) + (size_t)l * 1024 * 2 * FH, 2 * FH, (bf16_t*)(wl + OFF_W13), 1024, drow, kb * 64, n0, scr, lane); continue; }
            r -= IT_13;
            { const int kb = r / 32, nb = r % 32;
                transpose_item(pin(p, I_W2) + (size_t)l * FH * 1024, 1024, (bf16_t*)(wl + OFF_W2), FH, (size_t)nb * 32, kb * 64, nb * 32, scr, lane); }
        }
    }
    for (int i = gt; i < 2 * 96 * 1024; i += NGT) { const int l = i / (96 * 1024), r = i % (96 * 1024); ((bf16_t*)(ws + (size_t)l * WLB + OFF_WIN))[(size_t)INC * 1024 + r] = 0; }
    for (int i = gt; i < 2 * 2048 * 384; i += NGT) {
        const int l = i / (2048 * 384), r = i % (2048 * 384), n = r / 384, k = r % 384;
        float v = 0.f;
        if (n < 1536) { const int g = n / 768, h = (n % 768) / 128, which = (n % 128) / 64, ch = n % 64, c = h * 64 + ch;
            const int kb = which ? 128 + 64 * g : 64 * g;
            if (k >= kb && k < kb + 64) v = (which ? pin(p, I_WA2) : pin(p, I_WD2))[((size_t)(l * 2 + g) * 64 + (k - kb)) * 384 + c]; }
        else if (n < 1920) { if (k >= 256) v = pin(p, I_WG2)[((size_t)l * 128 + (k - 256)) * 384 + (n - 1536)]; }
        ((bf16_t*)(ws + (size_t)l * WLB + OFF_BT2))[r] = f2bf(v);
    }
    for (int i = gt; i < SL * 16; i += NGT) { const int t = i >> 4, pi = i & 15; const float pos = (float)(pi < 8 ? (t >> 6) : (t & 63));
        const float inv = powf(10000.0f, -(float)(pi & 7) * 0.125f); const float ang = pos * inv;
        float* rt = (float*)(ws + WS_ROPE) + (size_t)i * 2; rt[0] = cosf(ang); rt[1] = sinf(ang); }
}

DI void phase_modulate0(const Params& p, int lane, int wave) {
    const int gw = blockIdx.x * NWAVE + wave, NGW = gridDim.x * NWAVE;
    const float* MOD = (const float*)(p.ws + WS_MOD); bf16_t* A = (bf16_t*)(p.ws + WS_AY);
    for (int row = gw; row < MT; row += NGW) {
        const float* src = row < ML ? pin(p, I_X) + (size_t)row * D : pin(p, I_CTX) + (size_t)(row - ML) * D;
        const int bi = row < ML ? (row >> 11) : 32; const float* md = MOD + (size_t)bi * 6144;
#pragma unroll
        for (int j = 0; j < 4; ++j) { const int c = 4 * (lane + 64 * j); const f32x4 v = *(const f32x4*)(src + c), sh = *(const f32x4*)(md + c), sc = *(const f32x4*)(md + 1024 + c);
            u32x2 o; o.x = cvtpk(v[0] * (1.f + sc[0]) + sh[0], v[1] * (1.f + sc[1]) + sh[1]); o.y = cvtpk(v[2] * (1.f + sc[2]) + sh[2], v[3] * (1.f + sc[3]) + sh[3]);
            *(u32x2*)(A + (size_t)row * D + c) = o; }
    }
}
DI void phase_ln(const Params& p, int lane, int wave, int nrows, const float* lnw, const float* lnb, const float* modl, int sh_ofs, int sc_ofs, bool write_x, bool write_A) {
    const int gw = blockIdx.x * NWAVE + wave, NGW = gridDim.x * NWAVE;
    bf16_t* A = (bf16_t*)(p.ws + WS_AY); float* tc = (float*)(p.ws + WS_VT);
    for (int row = gw; row < nrows; row += NGW) {
        const bool lat = row < ML;
        float* t = lat ? p.out + (size_t)row * D : tc + (size_t)(row - ML) * D;
        const int bi = lat ? (row >> 11) : 32;
        f32x4 v[4]; float s = 0.f;
#pragma unroll
        for (int j = 0; j < 4; ++j) { v[j] = *(const f32x4*)(t + 4 * (lane + 64 * j)); s += (v[j][0] + v[j][1]) + (v[j][2] + v[j][3]); }
        const float mean = wave_sum(s) * (1.f / D); float s2 = 0.f;
#pragma unroll
        for (int j = 0; j < 4; ++j) { v[j] = v[j] - mean; s2 += (v[j][0] * v[j][0] + v[j][1] * v[j][1]) + (v[j][2] * v[j][2] + v[j][3] * v[j][3]); }
        const float rstd = rsqrtf(wave_sum(s2) * (1.f / D) + 1e-5f);
        const float* md = modl + (size_t)bi * 6144;
#pragma unroll
        for (int j = 0; j < 4; ++j) { const int c = 4 * (lane + 64 * j); const f32x4 w = *(const f32x4*)(lnw + c), b = *(const f32x4*)(lnb + c);
            f32x4 y; y[0] = v[j][0] * rstd * w[0] + b[0]; y[1] = v[j][1] * rstd * w[1] + b[1]; y[2] = v[j][2] * rstd * w[2] + b[2]; y[3] = v[j][3] * rstd * w[3] + b[3];
            if (write_x && lat) *(f32x4*)(t + c) = y;
            else if (write_x) *(f32x4*)(t + c) = y;
            if (write_A) { const f32x4 sh = *(const f32x4*)(md + sh_ofs + c), sc = *(const f32x4*)(md + sc_ofs + c);
                u32x2 o; o.x = cvtpk(y[0] * (1.f + sc[0]) + sh[0], y[1] * (1.f + sc[1]) + sh[1]); o.y = cvtpk(y[2] * (1.f + sc[2]) + sh[2], y[3] * (1.f + sc[3]) + sh[3]);
                *(u32x2*)(A + (size_t)row * D + c) = o; } }
    }
}

DI void phase_prep(const Params& p, int l, LAS unsigned char* lds, int lane, int wave) {
    const int gw = blockIdx.x * NWAVE + wave, NGW = gridDim.x * NWAVE;
    const bf16_t* PB = (const bf16_t*)(p.ws + WS_PB); bf16_t* A2 = (bf16_t*)(p.ws + WS_AY); bf16_t* VT = (bf16_t*)(p.ws + WS_VT);
    const float* mu = pin(p, I_MU) + (size_t)l * 1536 + 1152;
    for (int row = gw; row < MT; row += NGW) {
        const bool lat = row < ML; const int t = lat ? (row & (SL - 1)) : ((row - ML) & (CL - 1)); const int Ls = lat ? SL : CL;
        const bf16_t* pr = PB + (size_t)row * PLD + C_RW + 1152;
#pragma unroll
        for (int i = 0; i < 6; ++i) { const int j = lane + 64 * i;
            const float c0 = bf2f(pr[j]); const float cm = t > 0 ? bf2f(pr[j - PLD]) : 0.f; const float cp = t < Ls - 1 ? bf2f(pr[j + PLD]) : 0.f;
            const float y = c0 + (0.5f * (cm + cp) - c0) * mu[j];
            float o;
            if (i < 2) o = 1.f - 2.f / (1.f + __expf(2.f * y)); else if (i < 4) o = y; else o = sigm(y);
            A2[(size_t)row * 384 + j] = f2bf(o); }
    }
    LAS bf16_t* tile = (LAS bf16_t*)(lds + wave * 8448);
    for (int it = gw; it < NB * 4 * 36; it += NGW) {
        const int tb = it % 36, h = (it / 36) & 3, b = it / 144;
        const int row0 = tb < 32 ? b * SL + tb * 64 : ML + b * CL + (tb - 32) * 64; const int tk0 = tb * 64;
        const bf16_t* src = PB + (size_t)row0 * PLD + C_NV + h * 64 + lane;
#pragma unroll 8
        for (int i = 0; i < 64; ++i) tile[i * 66 + lane] = src[(size_t)i * PLD];
        asm volatile("s_waitcnt vmcnt(0) lgkmcnt(0)" ::: "memory");
        bf16_t* dst = VT + ((size_t)(b * 4 + h) * 64) * 2304 + tk0 + lane;
#pragma unroll 8
        for (int d = 0; d < 64; ++d) dst[(size_t)d * 2304] = tile[lane * 66 + d];
        asm volatile("s_waitcnt lgkmcnt(0)" ::: "memory");
    }
}

#define MFMA16(a, b, c) __builtin_amdgcn_mfma_f32_16x16x32_bf16((a), (b), (c), 0, 0, 0)
DI void nat_unit(const Params& p, int l, int id, bool isctx, int lane) {
    const bf16_t* PB = (const bf16_t*)(p.ws + WS_PB); const bf16_t* VT = (const bf16_t*)(p.ws + WS_VT); bf16_t* AY = (bf16_t*)(p.ws + WS_AY);
    const int l15 = lane & 15, g = lane >> 4;
    int b, h, r = 0, qt, qrow;
    if (!isctx) { qt = id & 3; r = (id >> 2) & 31; h = (id >> 7) & 3; b = id >> 9; qrow = b * SL + r * 64 + 16 * qt + l15; }
    else { qt = id & 15; h = (id >> 4) & 3; b = id >> 6; qrow = ML + b * CL + 16 * qt + l15; }
    const bf16_t* qp = PB + (size_t)qrow * PLD + C_NQ + h * 64 + 8 * g;
    const bf16x8 qf0 = *(const bf16x8*)qp, qf1 = *(const bf16x8*)(qp + 32);
    const int rs = min(max(r - 4, 0), 24);
    int ct_lo = 0, nct = 0;
    if (!isctx) { const int lo = min(max(16 * qt - 8, 0), 48), hi = min(max(16 * qt + 7, 0), 48) + 16; ct_lo = lo >> 4; nct = ((hi - 1) >> 4) - ct_lo + 1; }
    const int nloc = 8 * nct, npairs = nloc / 2 + 8;
    const int qc = 16 * qt + l15, cs = min(max(qc - 8, 0), 48);
    float m = -1e30f, lsum = 0.f;
    f32x4 oacc[4];
#pragma unroll
    for (int dt = 0; dt < 4; ++dt) oacc[dt] = (f32x4){0.f, 0.f, 0.f, 0.f};
    const bf16_t* vt = VT + ((size_t)(b * 4 + h) * 64) * 2304;
    const float* rp = pin(p, I_RPB) + (size_t)((l * 4 + h) * 15) * 31;
    for (int pi = 0; pi < npairs; ++pi) {
        f32x4 s[2]; int tkb[2];
#pragma unroll
        for (int e = 0; e < 2; ++e) {
            const int ti = 2 * pi + e;
            int tk, keyrow, kr = 0, ct = 0; const bool local = ti < nloc;
            if (local) { kr = ti / nct; ct = ct_lo + ti % nct; tk = (rs + kr) * 64 + 16 * ct; keyrow = b * SL + tk; }
            else { const int j = (ti - nloc) * 16; tk = SL + j; keyrow = ML + b * CL + j; }
            const bf16_t* kp = PB + (size_t)(keyrow + l15) * PLD + C_NK + h * 64 + 8 * g;
            const bf16x8 k0 = *(const bf16x8*)kp, k1 = *(const bf16x8*)(kp + 32);
            f32x4 a = (f32x4){0.f, 0.f, 0.f, 0.f};
            a = MFMA16(k0, qf0, a); a = MFMA16(k1, qf1, a);
#pragma unroll
            for (int rg = 0; rg < 4; ++rg) {
                float sv = a[rg] * 0.125f;
                if (local) { const int kc = 16 * ct + 4 * g + rg; const bool vis = (kc >= cs) && (kc < cs + 16);
                    const int dc = min(max(kc - qc + 15, 0), 30), dr = rs + kr - r + 7;
                    sv += rp[dr * 31 + dc]; sv = vis ? sv : -1e30f; }
                s[e][rg] = sv; }
            tkb[e] = tk;
        }
        float tmax = fmaxf(fmaxf(fmaxf(s[0][0], s[0][1]), fmaxf(s[0][2], s[0][3])), fmaxf(fmaxf(s[1][0], s[1][1]), fmaxf(s[1][2], s[1][3])));
        tmax = fmaxf(tmax, __shfl_xor(tmax, 16)); tmax = fmaxf(tmax, __shfl_xor(tmax, 32));
        const float mn = fmaxf(m, tmax), corr = __expf(m - mn); m = mn;
        float pv[8]; float ps = 0.f;
#pragma unroll
        for (int i = 0; i < 8; ++i) { const float sv = s[i >> 2][i & 3]; pv[i] = sv > -1e29f ? __expf(sv - mn) : 0.f; ps += pv[i]; }
        lsum = lsum * corr + ps;
        u32x4 pk; pk.x = cvtpk(pv[0], pv[1]); pk.y = cvtpk(pv[2], pv[3]); pk.z = cvtpk(pv[4], pv[5]); pk.w = cvtpk(pv[6], pv[7]);
        const bf16x8 pf = __builtin_bit_cast(bf16x8, pk);
#pragma unroll
        for (int dt = 0; dt < 4; ++dt) {
            const bf16_t* vp = vt + (size_t)(16 * dt + l15) * 2304 + 4 * g;
            const u32x2 va = *(const u32x2*)(vp + tkb[0]), vb = *(const u32x2*)(vp + tkb[1]);
            u32x4 vv; vv.x = va.x; vv.y = va.y; vv.z = vb.x; vv.w = vb.y;
            oacc[dt] = oacc[dt] * corr;
            oacc[dt] = MFMA16(__builtin_bit_cast(bf16x8, vv), pf, oacc[dt]);
        }
    }
    lsum += __shfl_xor(lsum, 16); lsum += __shfl_xor(lsum, 32);
    const float inv = 1.0f / lsum;
    bf16_t* yp = AY + (size_t)qrow * D + 768 + h * 64 + 4 * g;
#pragma unroll
    for (int dt = 0; dt < 4; ++dt) { u32x2 o; o.x = cvtpk(oacc[dt][0] * inv, oacc[dt][1] * inv); o.y = cvtpk(oacc[dt][2] * inv, oacc[dt][3] * inv); *(u32x2*)(yp + 16 * dt) = o; }
}

constexpr int RW_STEP = 384, RW_BUF = 16 * RW_STEP, GL_STEP = 160, GL_BUF = 16 * GL_STEP, NCHUNK = (CL + SL) / 16;
DI void rwkv_produce(const Params& p, int l, int item, int c, LAS float* buf, int lane) {
    const int g = item & 1, h = (item >> 1) % 6, b = item / 12;
    const int ti = lane >> 2, cg = lane & 3;
    int row, ts, Ls; step_row(16 * c + ti, g, b, row, ts, Ls);
    const bool hasm = ts > 0, hasp = ts < Ls - 1;
    const bf16_t* PB = (const bf16_t*)(p.ws + WS_PB);
    const bf16_t* pr = PB + (size_t)row * PLD + C_RW + h * 64 + 16 * cg;
    const int cofs = h * 64 + 16 * cg;
    const float* mu = pin(p, I_MU) + (size_t)l * 1536 + cofs;
    float r[16], k[16], v[16], cst[16];
#pragma unroll
    for (int j = 0; j < 16; ++j) cst[j] = mu[j];
    shift16(pr, hasm, hasp, cst, r);
#pragma unroll
    for (int j = 0; j < 16; ++j) cst[j] = mu[384 + j];
    shift16(pr + 384, hasm, hasp, cst, k);
#pragma unroll
    for (int j = 0; j < 16; ++j) cst[j] = mu[768 + j];
    shift16(pr + 768, hasm, hasp, cst, v);
    const bf16_t* lo = (const bf16_t*)(p.ws + WS_LO) + (size_t)row * LOLD + (g * 6 + h) * 128 + 16 * cg;
    float lw[16], a[16];
    load16(lo, lw); load16(lo + 64, a);
    const float* kkc = pin(p, I_KK) + (size_t)l * 384 + cofs; const float* kac = pin(p, I_KA) + (size_t)l * 384 + cofs; const float* rkc = pin(p, I_RK) + (size_t)l * 384 + cofs;
    float kkv[16]; float ss = 0.f;
#pragma unroll
    for (int j = 0; j < 16; ++j) { kkv[j] = k[j] * kkc[j]; ss += kkv[j] * kkv[j]; }
    ss += __shfl_xor(ss, 1); ss += __shfl_xor(ss, 2);
    const float inv = rsqrtf(ss + 1e-12f);
    float bon = 0.f;
    LAS float* o = buf + ti * RW_STEP + 16 * cg;
#pragma unroll
    for (int j4 = 0; j4 < 4; ++j4) {
        f32x4 w4, b4, km4, r4, kk4, v4;
#pragma unroll
        for (int jj = 0; jj < 4; ++jj) { const int j = 4 * j4 + jj;
            const float kkn = kkv[j] * inv, aj = a[j];
            const float km = k[j] * (1.f + (aj - 1.f) * kac[j]);
            w4[jj] = __expf(-lw[j]); b4[jj] = kkn * aj; km4[jj] = km; r4[jj] = r[j]; kk4[jj] = kkn; v4[jj] = v[j];
            bon += r[j] * km * rkc[j]; }
        *(LAS f32x4*)(o + 0 * 64 + 4 * j4) = w4; *(LAS f32x4*)(o + 1 * 64 + 4 * j4) = b4; *(LAS f32x4*)(o + 2 * 64 + 4 * j4) = km4;
        *(LAS f32x4*)(o + 3 * 64 + 4 * j4) = r4; *(LAS f32x4*)(o + 4 * 64 + 4 * j4) = kk4; *(LAS f32x4*)(o + 5 * 64 + 4 * j4) = v4;
    }
    bon += __shfl_xor(bon, 1); bon += __shfl_xor(bon, 2);
    if (cg == 0) ((float*)(p.ws + WS_BON))[(size_t)row * 12 + g * 6 + h] = bon;
}
DI void rwkv_scan_chunk(const Params& p, int item, int c, const LAS float* buf, f32x2 (&S)[32], int lane) {
    const int g = item & 1, h = (item >> 1) % 6, b = item / 12;
    float* LOf = (float*)(p.ws + WS_LO);
    for (int st = 0; st < 16; ++st) {
        const LAS f32x4* W = (const LAS f32x4*)(buf + st * RW_STEP);
        f32x2 sacc[4];
#pragma unroll
        for (int i = 0; i < 4; ++i) sacc[i] = (f32x2){0.f, 0.f};
#pragma unroll
        for (int i = 0; i < 16; ++i) { if ((i & 3) == 0) asm volatile("" : "+v"(sacc[0]), "+v"(sacc[1]), "+v"(sacc[2]), "+v"(sacc[3]) :: "memory"); const f32x4 kq = W[64 + i];
            sacc[(2 * i) & 3] += S[2 * i] * (f32x2){kq[0], kq[1]}; sacc[(2 * i + 1) & 3] += S[2 * i + 1] * (f32x2){kq[2], kq[3]}; }
        const f32x2 st2 = (sacc[0] + sacc[1]) + (sacc[2] + sacc[3]);
        const float sa = -(st2[0] + st2[1]);
        const float vv = buf[st * RW_STEP + 320 + lane];
        const f32x2 sa2 = (f32x2){sa, sa}, vv2 = (f32x2){vv, vv};
        f32x2 oacc[4];
#pragma unroll
        for (int i = 0; i < 4; ++i) oacc[i] = (f32x2){0.f, 0.f};
#pragma unroll
        for (int i = 0; i < 16; ++i) { if ((i & 1) == 0) asm volatile("" : "+v"(oacc[0]), "+v"(oacc[1]), "+v"(oacc[2]), "+v"(oacc[3]) :: "memory"); const f32x4 w4 = W[i], b4 = W[16 + i], km4 = W[32 + i], r4 = W[48 + i];
            f32x2 t0 = vv2 * (f32x2){km4[0], km4[1]}; t0 = sa2 * (f32x2){b4[0], b4[1]} + t0; S[2 * i] = S[2 * i] * (f32x2){w4[0], w4[1]} + t0;
            f32x2 t1 = vv2 * (f32x2){km4[2], km4[3]}; t1 = sa2 * (f32x2){b4[2], b4[3]} + t1; S[2 * i + 1] = S[2 * i + 1] * (f32x2){w4[2], w4[3]} + t1;
            oacc[(2 * i) & 3] += S[2 * i] * (f32x2){r4[0], r4[1]}; oacc[(2 * i + 1) & 3] += S[2 * i + 1] * (f32x2){r4[2], r4[3]}; }
        const f32x2 o2 = (oacc[0] + oacc[1]) + (oacc[2] + oacc[3]);
        int row, ts, Ls; step_row(16 * c + st, g, b, row, ts, Ls);
        LOf[(size_t)row * (LOLD / 2) + (g * 6 + h) * 64 + lane] = o2[0] + o2[1];
    }
}
DI void gla_produce(const Params& p, int l, int item, int c, LAS float* buf, const LAS float* GU, int lane) {
    const int g = item & 1, h = (item >> 1) % 6, b = item / 12;
    const int ti = lane >> 2, cg = lane & 3;
    int row, ts, Ls; step_row(16 * c + ti, g, b, row, ts, Ls);
    const bf16_t* pr = (const bf16_t*)(p.ws + WS_PB) + (size_t)row * PLD;
    float q[8], k[8], v[16], dn[16];
    load8(pr + C_GQ + h * 32 + 8 * cg, q); load8(pr + C_GK + h * 32 + 8 * cg, k); load16(pr + C_GV + h * 64 + 16 * cg, v); load16(pr + C_GDN + 16 * g, dn);
    const float* gb = pin(p, I_GB) + (size_t)(l * 2 + g) * 192 + h * 32 + 8 * cg;
    float al[8];
#pragma unroll
    for (int j = 0; j < 8; ++j) { float z = gb[j];
#pragma unroll
        for (int rr = 0; rr < 16; ++rr) z += dn[rr] * GU[rr * 32 + 8 * cg + j];
        const float ls = fminf(z, 0.f) - __logf(1.f + __expf(-fabsf(z)));
        al[j] = __expf(ls * 0.0625f); }
    if (Ls == SL) {
        const float* rt = (const float*)(p.ws + WS_ROPE) + (size_t)(ts * 16 + 4 * cg) * 2;
#pragma unroll
        for (int jj = 0; jj < 4; ++jj) { const float cc = rt[2 * jj], sn = rt[2 * jj + 1];
            const float q1 = q[2 * jj], q2 = q[2 * jj + 1]; q[2 * jj] = q1 * cc - q2 * sn; q[2 * jj + 1] = q1 * sn + q2 * cc;
            const float k1 = k[2 * jj], k2 = k[2 * jj + 1]; k[2 * jj] = k1 * cc - k2 * sn; k[2 * jj + 1] = k1 * sn + k2 * cc; }
    }
    LAS float* o = buf + ti * GL_STEP;
#pragma unroll
    for (int j4 = 0; j4 < 2; ++j4) {
        *(LAS f32x4*)(o + 8 * cg + 4 * j4) = (f32x4){al[4 * j4], al[4 * j4 + 1], al[4 * j4 + 2], al[4 * j4 + 3]};
        *(LAS f32x4*)(o + 32 + 8 * cg + 4 * j4) = (f32x4){k[4 * j4], k[4 * j4 + 1], k[4 * j4 + 2], k[4 * j4 + 3]};
        *(LAS f32x4*)(o + 64 + 8 * cg + 4 * j4) = (f32x4){q[4 * j4], q[4 * j4 + 1], q[4 * j4 + 2], q[4 * j4 + 3]} * 0.17677669529663687f; }
#pragma unroll
    for (int j4 = 0; j4 < 4; ++j4) *(LAS f32x4*)(o + 96 + 16 * cg + 4 * j4) = (f32x4){v[4 * j4], v[4 * j4 + 1], v[4 * j4 + 2], v[4 * j4 + 3]};
}
DI void gla_scan_chunk(const Params& p, int item, int c, const LAS float* buf, f32x2 (&S)[16], int lane) {
    const int g = item & 1, h = (item >> 1) % 6, b = item / 12;
    bf16_t* AY = (bf16_t*)(p.ws + WS_AY);
    for (int st = 0; st < 16; ++st) {
        const LAS f32x4* W = (const LAS f32x4*)(buf + st * GL_STEP);
        const float vv = buf[st * GL_STEP + 96 + lane]; const f32x2 vv2 = (f32x2){vv, vv};
        f32x2 oacc[4];
#pragma unroll
        for (int i = 0; i < 4; ++i) oacc[i] = (f32x2){0.f, 0.f};
#pragma unroll
        for (int i = 0; i < 8; ++i) { if ((i & 1) == 0) asm volatile("" : "+v"(oacc[0]), "+v"(oacc[1]), "+v"(oacc[2]), "+v"(oacc[3]) :: "memory"); const f32x4 a4 = W[i], k4 = W[8 + i], q4 = W[16 + i];
            S[2 * i] = S[2 * i] * (f32x2){a4[0], a4[1]} + vv2 * (f32x2){k4[0], k4[1]}; S[2 * i + 1] = S[2 * i + 1] * (f32x2){a4[2], a4[3]} + vv2 * (f32x2){k4[2], k4[3]};
            oacc[(2 * i) & 3] += S[2 * i] * (f32x2){q4[0], q4[1]}; oacc[(2 * i + 1) & 3] += S[2 * i + 1] * (f32x2){q4[2], q4[3]}; }
        const f32x2 o2 = (oacc[0] + oacc[1]) + (oacc[2] + oacc[3]);
        int row, ts, Ls; step_row(16 * c + st, g, b, row, ts, Ls);
        AY[(size_t)row * D + g * 384 + h * 64 + lane] = f2bf(o2[0] + o2[1]);
    }
}
DI void scan_unit(const Params& p, int l, int su, LAS unsigned char* lds, int tid, int lane, int wave) {
    LAS float* RWB = (LAS float*)lds; LAS float* GLB = (LAS float*)(lds + 98304); LAS float* GUB = (LAS float*)(lds + 139264);
    const int slot = wave & 1, item = 2 * su + slot;
    for (int i = tid; i < 2 * 512; i += NTHR) { const int sl = i >> 9, rr = (i >> 5) & 15, ch = i & 31; const int it = 2 * su + sl, gg = it & 1, hh = (it >> 1) % 6;
        GUB[i] = pin(p, I_GUP)[((size_t)(l * 2 + gg) * 16 + rr) * 192 + hh * 32 + ch]; }
    __syncthreads();
    const int role = wave >> 1;
    if ((ROLEMASK & 1) && role == 0) {
        f32x2 S[32];
#pragma unroll
        for (int i = 0; i < 32; ++i) S[i] = (f32x2){0.f, 0.f};
        __syncthreads();
        for (int c = 0; c < NCHUNK; ++c) { rwkv_scan_chunk(p, item, c, RWB + (slot * 2 + (c & 1)) * RW_BUF, S, lane); __syncthreads(); }
    } else if ((ROLEMASK & 2) && role == 1) {
        f32x2 Sg[16];
#pragma unroll
        for (int i = 0; i < 16; ++i) Sg[i] = (f32x2){0.f, 0.f};
        __syncthreads();
        for (int c = 0; c < NCHUNK; ++c) { gla_scan_chunk(p, item, c, GLB + (slot * 2 + (c & 1)) * GL_BUF, Sg, lane); __syncthreads(); }
    } else if ((ROLEMASK & 4) && role == 2) {
        rwkv_produce(p, l, item, 0, RWB + (slot * 2 + 0) * RW_BUF, lane);
        __syncthreads();
        for (int c = 0; c < NCHUNK; ++c) { if (c + 1 < NCHUNK) rwkv_produce(p, l, item, c + 1, RWB + (slot * 2 + ((c + 1) & 1)) * RW_BUF, lane); __syncthreads(); }
    } else if (ROLEMASK & 8) {
        gla_produce(p, l, item, 0, GLB + (slot * 2 + 0) * GL_BUF, GUB + slot * 512, lane);
        __syncthreads();
        for (int c = 0; c < NCHUNK; ++c) { if (c + 1 < NCHUNK) gla_produce(p, l, item, c + 1, GLB + (slot * 2 + ((c + 1) & 1)) * GL_BUF, GUB + slot * 512, lane); __syncthreads(); }
    }
}
DI void phase_mixers(const Params& p, int l, LAS unsigned char* lds, int tid, int lane, int wave) {
    const int G = gridDim.x, bx = blockIdx.x;
    const int nscan = G >= 224 ? 192 : G;
    const int nnat = NB * 4 * 32 * 4, nnatc = l == 0 ? NB * 4 * 16 : 0;
    if constexpr (MIXMASK & 1) { if (bx < nscan) for (int su = bx; su < 192; su += nscan) scan_unit(p, l, su, lds, tid, lane, wave); }
    int w0, nw;
    if (G >= 224) { if (bx < 192) return; w0 = (bx - 192) * NWAVE + wave; nw = (G - 192) * NWAVE; }
    else { w0 = bx * NWAVE + wave; nw = G * NWAVE; }
    if constexpr (MIXMASK & 2) for (int id = w0; id < nnat + nnatc; id += nw) { if (id < nnat) nat_unit(p, l, id, false, lane); else nat_unit(p, l, id - nnat, true, lane); }
}

DI void phase_readout(const Params& p, int l, int nrows, int lane, int wave) {
    const int gw = blockIdx.x * NWAVE + wave, NGW = gridDim.x * NWAVE;
    const bf16_t* PB = (const bf16_t*)(p.ws + WS_PB); bf16_t* AY = (bf16_t*)(p.ws + WS_AY);
    const float* LOf = (const float*)(p.ws + WS_LO); const bf16_t* LOb = (const bf16_t*)(p.ws + WS_LO); const float* BON = (const float*)(p.ws + WS_BON);
    const float nw = pin(p, I_GNW)[l * 64 + lane];
    const float* gnw = pin(p, I_GNWT) + l * 384; const float* gnb = pin(p, I_GNB) + l * 384;
    const float* mu = pin(p, I_MU) + (size_t)l * 1536 + 768;
    for (int row = gw; row < nrows; row += NGW) {
        const bool lat = row < ML; const int t = lat ? (row & (SL - 1)) : ((row - ML) & (CL - 1)); const int Ls = lat ? SL : CL;
        const bf16_t* pr = PB + (size_t)row * PLD; bf16_t* yr = AY + (size_t)row * D;
        float og[6], gg[6], nat[4], orw[6], vv[6], gate[6], bon[6];
#pragma unroll
        for (int h = 0; h < 6; ++h) { og[h] = bf2f(yr[h * 64 + lane]) + bf2f(yr[384 + h * 64 + lane]); gg[h] = bf2f(pr[C_GG + h * 64 + lane]);
            orw[h] = LOf[(size_t)row * (LOLD / 2) + h * 64 + lane] + LOf[(size_t)row * (LOLD / 2) + (6 + h) * 64 + lane];
            const int cv = C_RW + 768 + h * 64 + lane; const float c0 = bf2f(pr[cv]); const float cm = t > 0 ? bf2f(pr[cv - PLD]) : 0.f; const float cp = t < Ls - 1 ? bf2f(pr[cv + PLD]) : 0.f;
            vv[h] = c0 + (0.5f * (cm + cp) - c0) * mu[h * 64 + lane];
            gate[h] = bf2f(LOb[(size_t)row * LOLD + 1536 + h * 64 + lane]);
            bon[h] = BON[(size_t)row * 12 + h] + BON[(size_t)row * 12 + 6 + h]; }
#pragma unroll
        for (int h = 0; h < 4; ++h) nat[h] = bf2f(yr[768 + h * 64 + lane]);
        float yg[6], yrw[6];
#pragma unroll
        for (int h = 0; h < 6; ++h) {
            const float ss = wave_sum(og[h] * og[h]);
            yg[h] = og[h] * rsqrtf(ss * (1.f / 64.f) + 1e-5f) * nw * (gg[h] * sigm(gg[h]));
            const float mean = wave_sum(orw[h]) * (1.f / 64.f); const float dlt = orw[h] - mean; const float var = wave_sum(dlt * dlt) * (1.f / 64.f);
            const float gn = dlt * rsqrtf(var + 64e-5f) * gnw[h * 64 + lane] + gnb[h * 64 + lane];
            yrw[h] = (gn + bon[h] * vv[h]) * gate[h]; }
        asm volatile("s_waitcnt vmcnt(0)" ::: "memory");
#pragma unroll
        for (int h = 0; h < 6; ++h) { yr[h * 64 + lane] = f2bf(yg[h]); yr[640 + h * 64 + lane] = f2bf(yrw[h]); }
#pragma unroll
        for (int h = 0; h < 4; ++h) yr[384 + h * 64 + lane] = f2bf(nat[h]);
    }
}

DI void run_step(const Params& p, const int step, LAS unsigned char* lds, int tid, int lane, int wave) {
    const int G = gridDim.x, bx = blockIdx.x;
    unsigned char* ws = p.ws;
    const float* MOD = (const float*)(ws + WS_MOD);
    float* TC = (float*)(ws + WS_VT);
    {
        const int l = step < 2 ? 0 : (step - 2) / 10, st = step < 2 ? -1 : (step - 2) % 10;
        unsigned char* wl = ws + (size_t)l * WLB;
        const float* modl = MOD + (size_t)l * 33 * 6144;
        const int Mff = l == 0 ? MT : ML;
        if (st == 0 || st == 2 || st == 5 || st == 7 || st == 8) {
            const bf16_t* gA = (const bf16_t*)(ws + WS_AY); const bf16_t* gB; int gM = Mff, gN = 1024, gK = 1024, mode = 2;
            bf16_t* eO = (bf16_t*)(ws + WS_PB); const float* ex = (const float*)p.out; const float* exc = (const float*)TC; int gofs = 2 * 1024;
            if (st == 0) { gB = (const bf16_t*)(wl + OFF_WIN); gM = MT; gN = PLD; mode = 0; }
            else if (st == 2) { gB = (const bf16_t*)(wl + OFF_BT2); gM = MT; gN = 2048; gK = 384; mode = 1; eO = (bf16_t*)(ws + WS_LO); }
            else if (st == 5) { gB = (const bf16_t*)(wl + OFF_WOUT); if (l == 0) { ex = pin(p, I_X); exc = pin(p, I_CTX); } }
            else if (st == 7) { gB = (const bf16_t*)(wl + OFF_W13); gN = 2 * FH; mode = 3; }
            else { gA = (const bf16_t*)(ws + WS_PB); gB = (const bf16_t*)(wl + OFF_W2); gK = FH; gofs = 5 * 1024; }
            asm volatile("" : "+s"(gK), "+s"(gM), "+s"(gN), "+s"(mode));
            const pg8::Gemm g{gA, gB, gM, gN, gK};
            const pg8::EpiAny E{mode, pg8::EpiStoreBf16{eO, PLD}, pg8::EpiLora{eO, pin(p, I_W0) + (size_t)l * 768, pin(p, I_A0) + (size_t)l * 768},
                                pg8::EpiRes{ex, exc, p.out, TC, modl, gofs}, pg8::EpiSwiglu{eO}};
            pg8::StaticOrder S; S.init(g.M, g.N, G, bx);
            pg8::gemm_phase<pg8::EpiAny, pg8::StaticOrder, true, true>(lds, g, S, E, tid);
        }
#ifndef ONLYGEMM
        else if (step == 0) phase_prologue(p, lds, tid, lane, wave);
        else if (step == 1) phase_modulate0(p, lane, wave);
        else if (st == 1) phase_prep(p, l, lds, lane, wave);
        else if (st == 3) phase_mixers(p, l, lds, tid, lane, wave);
        else if (st == 4) phase_readout(p, l, Mff, lane, wave);
        else if (st == 6) phase_ln(p, lane, wave, Mff, pin(p, I_LN1W) + l * 1024, pin(p, I_LN1B) + l * 1024, modl, 3 * 1024, 4 * 1024, true, true);
        else {
            if (l == 0) phase_ln(p, lane, wave, MT, pin(p, I_LN2W), pin(p, I_LN2B), MOD + (size_t)33 * 6144, 0, 1024, true, true);
            else phase_ln(p, lane, wave, ML, pin(p, I_LN2W) + 1024, pin(p, I_LN2B) + 1024, modl, 0, 1024, true, false);
        }
#endif
    }
}
#ifdef MULTI_LAUNCH
template <int STEP> __global__ void __launch_bounds__(NTHR, 2) k_step(Params p) {
    extern __shared__ __attribute__((aligned(16))) unsigned char smem[];
    const int tid = threadIdx.x, lane = tid & 63, wave = __builtin_amdgcn_readfirstlane(tid >> 6);
    run_step(p, STEP, (LAS unsigned char*)smem, tid, lane, wave);
}
template <int STEP> static void launch_steps(const Params& p, int grid, hipStream_t stream) {
    static bool attr_done = false;
    if (!attr_done) { (void)hipFuncSetAttribute((const void*)k_step<STEP>, hipFuncAttributeMaxDynamicSharedMemorySize, LDS_BYTES); attr_done = true; }
    hipLaunchKernelGGL(k_step<STEP>, dim3(grid), dim3(NTHR), LDS_BYTES, stream, p);
    if constexpr (STEP + 1 < 22) launch_steps<STEP + 1>(p, grid, stream);
}
#else
__global__ void __launch_bounds__(NTHR, 2) hybrid_fwd(Params p) {
    extern __shared__ __attribute__((aligned(16))) unsigned char smem[];
    LAS unsigned char* lds = (LAS unsigned char*)smem;
    cg::grid_group grid = cg::this_grid();
    const int wave0 = __builtin_amdgcn_readfirstlane((int)threadIdx.x >> 6);
#pragma unroll 1
    for (int step = 0; step < 22; ++step) {
        unsigned msk = ~0u; int wave_ = wave0;
        asm volatile("" : "+s"(msk), "+s"(wave_));
        const int lane_ = (int)__builtin_amdgcn_mbcnt_hi(msk, __builtin_amdgcn_mbcnt_lo(msk, 0u));
        const int tid_ = wave_ * 64 + lane_;
        run_step(p, step, lds, tid_, lane_, wave_);
        if (step != 21) grid.sync();
    }
}
#endif

extern "C" void kernel_launch(void* const* d_in, const int* in_sizes, int n_in, void* d_out, int out_size, void* d_ws, size_t ws_size, hipStream_t stream) {
    static int grid = 0;
    if (grid == 0) {
        int dev = 0, cus = 0, per_cu = 0;
        if (n_in != 29 || ws_size < WS_END) { fprintf(stderr, "kernel_launch: unexpected n_in %d / ws_size %zu (need %zu)\n", n_in, ws_size, (size_t)WS_END); }
        hipGetDevice(&dev);
        hipDeviceGetAttribute(&cus, hipDeviceAttributeMultiprocessorCount, dev);
#ifndef MULTI_LAUNCH
        if (hipFuncSetAttribute((const void*)hybrid_fwd, hipFuncAttributeMaxDynamicSharedMemorySize, LDS_BYTES) != hipSuccess) fprintf(stderr, "kernel_launch: hipFuncSetAttribute failed\n");
        if (hipOccupancyMaxActiveBlocksPerMultiprocessor(&per_cu, (const void*)hybrid_fwd, NTHR, LDS_BYTES) != hipSuccess || per_cu < 1) { fprintf(stderr, "kernel_launch: occupancy query gave %d\n", per_cu); per_cu = 1; }
#endif
        (void)hipGetLastError();
        grid = cus > 0 ? cus : 256;
    }
    Params p{};
    for (int i = 0; i < 29; ++i) p.in[i] = (const float*)d_in[i];
    p.out = (float*)d_out; p.ws = (unsigned char*)d_ws;
#ifdef MULTI_LAUNCH
    launch_steps<0>(p, grid, stream);
#else
    void* args[] = {&p};
    hipError_t e = hipLaunchCooperativeKernel((const void*)hybrid_fwd, dim3(grid), dim3(NTHR), args, LDS_BYTES, stream);
    if (e != hipSuccess) fprintf(stderr, "kernel_launch: cooperative launch failed: %s (grid %d)\n", hipGetErrorString(e), grid);
#endif
}
```

```cpp
#include <hip/hip_runtime.h>
#include <hip/hip_cooperative_groups.h>
#include <cstdio>
#include <cstdint>
namespace cg = cooperative_groups;
namespace pg8 {
#define PG8_LAS __attribute__((address_space(3)))
typedef unsigned short bf16_t;
typedef short bf16x8 __attribute__((ext_vector_type(8)));
typedef float f32x4 __attribute__((ext_vector_type(4)));
typedef unsigned u32x4 __attribute__((ext_vector_type(4)));
constexpr int BM = 256, BK = 64, HALF = 128, HTB = HALF * BK * 2  , STAGE_BYTES = 8 * HTB, NXCD = 8, WGM = 8;

__host__ __device__ __forceinline__ int lds_byte(int r, int c) { const int st = (r >> 4) * 2 + (c >> 5), rr = r & 15, cc = c & 31, ob = rr * 64 + cc * 2; return st * 1024 + (ob ^ (((ob >> 9) & 1) << 5)); }
__host__ __device__ __forceinline__ void stage_rc(int b, int& R, int& C) { const int st = b / 1024, sb = b % 1024, swz = sb ^ (((sb >> 9) & 1) << 5); R = (st >> 1) * 16 + swz / 64; C = (st & 1) * 32 + (swz % 64) / 2; }
__host__ __device__ __forceinline__ int perm32(int rho) { const int n = rho >> 4, i = rho & 15; return 8 * (i >> 2) + 4 * n + (i & 3); }

struct Unit { int pm, pn; };
struct Gemm { const bf16_t* A; const bf16_t* Bt; int M, N, K; };

struct StaticOrder {
    int nM, nN, nwg, G, c;
    __host__ __device__ void init(int M, int N, int G_, int c_) { nM = M / BM; nN = N / BM; nwg = nM * nN; G = G_; c = c_; }
    __host__ __device__ bool next(int i, Unit& u) const {
        const long L = (long)i * G + c; if (L >= nwg) return false;
        int wgid = (int)L; { const int q = nwg / NXCD, r = nwg % NXCD, xcd = wgid % NXCD, off = wgid / NXCD; wgid = (xcd < r ? xcd * (q + 1) : r * (q + 1) + (xcd - r) * q) + off; }
        const int nig = WGM * nN, gid = wgid / nig, fm = gid * WGM, gsz = (nM - fm) < WGM ? (nM - fm) : WGM;
        u.pm = fm + ((wgid % nig) % gsz); u.pn = (wgid % nig) / gsz; return true;
    }
    __device__ __forceinline__ void a_ready(const Unit&) const {}
    __device__ __forceinline__ void done(const Unit&) const {}
};
__device__ __forceinline__ unsigned cvtpk(float lo, float hi) { typedef float v2f __attribute__((ext_vector_type(2))); typedef __bf16 v2b __attribute__((ext_vector_type(2))); v2f v = {lo, hi}; v2b b = __builtin_convertvector(v, v2b); return __builtin_bit_cast(unsigned, b); }
__device__ __forceinline__ float sigm(float x) { return 1.0f / (1.0f + __expf(-x)); }
struct EpiStoreBf16 {
    static constexpr bool PERM = true, AFTER_DRAIN = false;
    bf16_t* O; int ldc;
    __device__ __forceinline__ void operator()(const f32x4 (&acc)[2][2][4][2], const Unit& u, int wr, int wc, int fr, int fq) const {
        const int row0 = u.pm * BM + wr * 64 + fr, col0 = u.pn * BM + wc * 32 + 8 * fq;
#pragma unroll
        for (int ai = 0; ai < 2; ++ai)
#pragma unroll
            for (int m = 0; m < 4; ++m) { bf16_t* rowp = O + (size_t)(row0 + ai * HALF + m * 16) * ldc + col0;
#pragma unroll
                for (int bj = 0; bj < 2; ++bj) { const f32x4 v0 = acc[ai][bj][m][0], v1 = acc[ai][bj][m][1];
                    u32x4 w; w.x = cvtpk(v0[0], v0[1]); w.y = cvtpk(v0[2], v0[3]); w.z = cvtpk(v1[0], v1[1]); w.w = cvtpk(v1[2], v1[3]);
                    *(u32x4*)(rowp + bj * HALF) = w; } }
    }
};
struct EpiLora {
    static constexpr bool PERM = true, AFTER_DRAIN = false;
    bf16_t* O; const float* w0; const float* a0;
    __device__ __forceinline__ void operator()(const f32x4 (&acc)[2][2][4][2], const Unit& u, int wr, int wc, int fr, int fq) const {
        const int row0 = u.pm * BM + wr * 64 + fr;
#pragma unroll
        for (int bj = 0; bj < 2; ++bj) {
            const int cb = u.pn * 2 + bj;
            if (cb < 15) {
                const int c0 = cb * 128 + wc * 32 + 8 * fq;
                if (cb >= 12) {
#pragma unroll
                    for (int ai = 0; ai < 2; ++ai)
#pragma unroll
                        for (int m = 0; m < 4; ++m) { const f32x4 v0 = acc[ai][bj][m][0], v1 = acc[ai][bj][m][1];
                            u32x4 w; w.x = cvtpk(v0[0], v0[1]); w.y = cvtpk(v0[2], v0[3]); w.z = cvtpk(v1[0], v1[1]); w.w = cvtpk(v1[2], v1[3]);
                            *(u32x4*)(O + (size_t)(row0 + ai * HALF + m * 16) * 1920 + c0) = w; }
                } else {
                    const int kind = wc >> 1, g = cb / 6, h = cb % 6;
                    const float* a0v = a0; const float* w0v = w0; asm volatile("" : "+s"(a0v), "+s"(w0v));
                    const float* bp = (kind ? a0v : w0v) + g * 384 + h * 64 + (wc & 1) * 32 + 8 * fq;
                    const f32x4 b0 = *(const f32x4*)bp, b1 = *(const f32x4*)(bp + 4);
                    const float mul = kind == 0 ? 0.60653065971263342f : 1.f;
#pragma unroll
                    for (int ai = 0; ai < 2; ++ai)
#pragma unroll
                        for (int m = 0; m < 4; ++m) { const f32x4 v0 = acc[ai][bj][m][0] + b0, v1 = acc[ai][bj][m][1] + b1;
                            u32x4 w; w.x = cvtpk(mul * sigm(v0[0]), mul * sigm(v0[1])); w.y = cvtpk(mul * sigm(v0[2]), mul * sigm(v0[3]));
                            w.z = cvtpk(mul * sigm(v1[0]), mul * sigm(v1[1])); w.w = cvtpk(mul * sigm(v1[2]), mul * sigm(v1[3]));
                            *(u32x4*)(O + (size_t)(row0 + ai * HALF + m * 16) * 1920 + c0) = w; }
                }
            }
        }
    }
};
struct EpiRes {
    static constexpr bool PERM = true, AFTER_DRAIN = false;
    const float* xl; const float* xc; float* ol; float* oc; const float* mod; int gofs;
    __device__ __forceinline__ void operator()(const f32x4 (&acc)[2][2][4][2], const Unit& u, int wr, int wc, int fr, int fq) const {
        const bool lat = u.pm < 256; const int bi = lat ? (u.pm >> 3) : 32;
        const size_t rbase = (size_t)(lat ? u.pm : u.pm - 256) * BM;
        const float* xlv = xl; const float* xcv = xc; float* olv = ol; float* ocv = oc; asm volatile("" : "+s"(xlv), "+s"(xcv), "+s"(olv), "+s"(ocv));
        const float* xin = (lat ? xlv : xcv) + rbase * 1024; float* out = (lat ? olv : ocv) + rbase * 1024;
        const float* gp = mod + (size_t)bi * 6144 + gofs;
        const int col0 = u.pn * BM + wc * 32 + 8 * fq, row0 = wr * 64 + fr;
#pragma unroll
        for (int bj = 0; bj < 2; ++bj)
#pragma unroll
            for (int n = 0; n < 2; ++n) { const int c = col0 + bj * HALF + 4 * n; const f32x4 gt = *(const f32x4*)(gp + c);
#pragma unroll
                for (int ai = 0; ai < 2; ++ai)
#pragma unroll
                    for (int m = 0; m < 4; ++m) { const size_t o = (size_t)(row0 + ai * HALF + m * 16) * 1024 + c;
                        const f32x4 xv = *(const f32x4*)(xin + o); const f32x4 a = acc[ai][bj][m][n];
                        f32x4 r; r[0] = 1.41421356237f * xv[0] + gt[0] * a[0]; r[1] = 1.41421356237f * xv[1] + gt[1] * a[1]; r[2] = 1.41421356237f * xv[2] + gt[2] * a[2]; r[3] = 1.41421356237f * xv[3] + gt[3] * a[3];
                        *(f32x4*)(out + o) = r; } }
    }
};
struct EpiSwiglu {
    static constexpr bool PERM = true, AFTER_DRAIN = false;
    bf16_t* O;
    __device__ __forceinline__ void operator()(const f32x4 (&acc)[2][2][4][2], const Unit& u, int wr, int wc, int fr, int fq) const {
        const int row0 = u.pm * BM + wr * 64 + fr, col0 = u.pn * HALF + wc * 32 + 8 * fq;
#pragma unroll
        for (int ai = 0; ai < 2; ++ai)
#pragma unroll
            for (int m = 0; m < 4; ++m) { float v[8];
#pragma unroll
                for (int i = 0; i < 8; ++i) { const float g = acc[ai][0][m][i >> 2][i & 3], up = acc[ai][1][m][i >> 2][i & 3]; v[i] = g * sigm(g) * up; }
                u32x4 w; w.x = cvtpk(v[0], v[1]); w.y = cvtpk(v[2], v[3]); w.z = cvtpk(v[4], v[5]); w.w = cvtpk(v[6], v[7]);
                *(u32x4*)(O + (size_t)(row0 + ai * HALF + m * 16) * 2816 + col0) = w; }
    }
};
struct EpiAny {
    static constexpr bool PERM = true, AFTER_DRAIN = false;
    int mode; EpiStoreBf16 e0; EpiLora e1; EpiRes e2; EpiSwiglu e3;
    __device__ __forceinline__ void operator()(const f32x4 (&acc)[2][2][4][2], const Unit& u, int wr, int wc, int fr, int fq) const {
        if (mode == 0) e0(acc, u, wr, wc, fr, fq); else if (mode == 1) e1(acc, u, wr, wc, fr, fq); else if (mode == 2) e2(acc, u, wr, wc, fr, fq); else e3(acc, u, wr, wc, fr, fq);
    }
};
template <class Epi, class Sched, bool ALIGN_EPI = false, bool SP2 = false>
__device__ __forceinline__ void gemm_phase(PG8_LAS unsigned char* lds, const Gemm g, const Sched& S, const Epi& E, const int tid) {
    const int wid = __builtin_amdgcn_readfirstlane(tid >> 6), lane = tid & 63, wr = wid >> 2, wc = wid & 3, fr = lane & 15, fq = lane >> 4;
    const int K = g.K, nt = K / BK;
    unsigned voffA[2], voffB[2];
#pragma unroll
    for (int i = 0; i < 2; ++i) { int R, C; stage_rc(tid * 16 + i * 8192, R, C); const int Rb = Epi::PERM ? ((R & ~31) + perm32(R & 31)) : R;
        voffA[i] = (unsigned)(R * K + C) * 2u; voffB[i] = (unsigned)(Rb * K + C) * 2u; }
    const size_t kstep = (size_t)(BK * 2);
    const size_t hstep = (size_t)HALF * K * 2;
    const size_t tstep = 2 * hstep;
    const unsigned ldsw = (unsigned)wid * 1024u;
    const int aoff = lds_byte(wr * 64 + fr, fq * 8), boff = lds_byte(wc * 32 + fr, fq * 8);
#define PG8_SA(b, h) (((b) * 2 + (h)) * HTB)
#define PG8_SB(b, h) ((4 + (b) * 2 + (h)) * HTB)
#define PG8_STAGE(bufoff, gbase, voff) do { _Pragma("unroll") for (int _i = 0; _i < 2; ++_i) \
        __builtin_amdgcn_global_load_lds((const unsigned*)((const char*)(gbase) + (voff)[_i]), (PG8_LAS unsigned*)(lds + (bufoff) + ldsw + _i * 8192), 16, 0, 0); } while (0)
#define PG8_LDA(dst, b, h) do { _Pragma("unroll") for (int m = 0; m < 4; ++m) _Pragma("unroll") for (int k = 0; k < 2; ++k) dst[m][k] = *(const PG8_LAS bf16x8*)(lds + PG8_SA(b, h) + aoff + m * 2048 + k * 1024); } while (0)
#define PG8_LDB(dst, b, h) do { _Pragma("unroll") for (int n = 0; n < 2; ++n) _Pragma("unroll") for (int k = 0; k < 2; ++k) dst[n][k] = *(const PG8_LAS bf16x8*)(lds + PG8_SB(b, h) + boff + n * 2048 + k * 1024); } while (0)
#define PG8_MMA(ai, bj, At, Bt) do { __builtin_amdgcn_s_setprio(1); _Pragma("unroll") for (int m = 0; m < 4; ++m) _Pragma("unroll") for (int n = 0; n < 2; ++n) _Pragma("unroll") for (int k = 0; k < 2; ++k) \
        acc[ai][bj][m][n] = __builtin_amdgcn_mfma_f32_16x16x32_bf16(Bt[n][k], At[m][k], acc[ai][bj][m][n], 0, 0, 0); __builtin_amdgcn_s_setprio(0); } while (0)
#define PG8_WAIT_V(n) asm volatile("s_waitcnt vmcnt(" #n ")" ::: "memory")
#define PG8_WAIT_L(n) asm volatile("s_waitcnt lgkmcnt(" #n ")" ::: "memory")
#define PG8_BAR __builtin_amdgcn_s_barrier()
#define PG8_SCHED __builtin_amdgcn_sched_barrier(0)
    Unit cur, nxt; int ui = 0;
    if (!S.next(0, cur)) return;
    f32x4 acc[2][2][4][2];
#pragma unroll
    for (int a = 0; a < 2; ++a)
#pragma unroll
        for (int b = 0; b < 2; ++b)
#pragma unroll
            for (int m = 0; m < 4; ++m)
#pragma unroll
                for (int n = 0; n < 2; ++n) acc[a][b][m][n] = (f32x4){0.f, 0.f, 0.f, 0.f};
    bf16x8 At[4][2], B0[2][2], B1[2][2];
    const char* cA = (const char*)g.A + (size_t)cur.pm * tstep; const char* cB = (const char*)g.Bt + (size_t)cur.pn * tstep;
    S.a_ready(cur);
    if constexpr (SP2) {
        PG8_STAGE(PG8_SB(0, 0), cB, voffB); PG8_STAGE(PG8_SB(0, 1), cB + hstep, voffB); PG8_STAGE(PG8_SA(0, 0), cA, voffA); PG8_STAGE(PG8_SA(0, 1), cA + hstep, voffA);
        if (wr == 1) PG8_BAR;
        PG8_WAIT_V(2); PG8_BAR;
        PG8_STAGE(PG8_SB(1, 0), cB + kstep, voffB); PG8_STAGE(PG8_SA(1, 0), cA + kstep, voffA); PG8_STAGE(PG8_SB(1, 1), cB + hstep + kstep, voffB);
        PG8_WAIT_V(6); PG8_BAR;
    } else {
        PG8_STAGE(PG8_SB(0, 0), cB, voffB); PG8_STAGE(PG8_SA(0, 0), cA, voffA); PG8_STAGE(PG8_SB(0, 1), cB + hstep, voffB); PG8_STAGE(PG8_SA(0, 1), cA + hstep, voffA);
        if (wr == 1) PG8_BAR;
        PG8_WAIT_V(4); PG8_BAR;
        PG8_STAGE(PG8_SB(1, 0), cB + kstep, voffB); PG8_STAGE(PG8_SA(1, 0), cA + kstep, voffA); PG8_STAGE(PG8_SB(1, 1), cB + hstep + kstep, voffB);
        PG8_WAIT_V(6); PG8_BAR;
    }
    for (;;) {
        const bool has_next = S.next(ui + 1, nxt);
        const char* nA = has_next ? (const char*)g.A + (size_t)nxt.pm * tstep : cA; const char* nB = has_next ? (const char*)g.Bt + (size_t)nxt.pn * tstep : cB;
        for (int t = 0; t < nt; t += 2) {
            const bool last = (t == nt - 2);
            const char* a1 = cA + (size_t)(t + 1) * kstep;
            const char* a2 = last ? nA : cA + (size_t)(t + 2) * kstep; const char* b2 = last ? nB : cB + (size_t)(t + 2) * kstep;
            const char* a3 = a2 + kstep; const char* b3 = b2 + kstep;
            if (last && has_next) S.a_ready(nxt);
            if constexpr (SP2) {
            PG8_LDB(B0, 0, 0); PG8_LDB(B1, 0, 1); PG8_SCHED; PG8_LDA(At, 0, 0); PG8_STAGE(PG8_SA(1, 1), a1 + hstep, voffA);
            PG8_WAIT_V(8); PG8_WAIT_L(0); PG8_BAR; PG8_MMA(0, 0, At, B0); PG8_MMA(0, 1, At, B1); PG8_BAR; PG8_SCHED;
            PG8_LDA(At, 0, 1); PG8_STAGE(PG8_SB(0, 0), b2, voffB); PG8_STAGE(PG8_SB(0, 1), b2 + hstep, voffB); PG8_STAGE(PG8_SA(0, 0), a2, voffA);
            PG8_WAIT_V(8); PG8_WAIT_L(0); PG8_BAR; PG8_MMA(1, 0, At, B0); PG8_MMA(1, 1, At, B1); PG8_BAR; PG8_SCHED;
            PG8_LDB(B0, 1, 0); PG8_LDB(B1, 1, 1); PG8_SCHED; PG8_LDA(At, 1, 0); PG8_STAGE(PG8_SA(0, 1), a2 + hstep, voffA);
            PG8_WAIT_V(8); PG8_WAIT_L(0); PG8_BAR; PG8_MMA(0, 0, At, B0); PG8_MMA(0, 1, At, B1); PG8_BAR; PG8_SCHED;
            PG8_LDA(At, 1, 1); PG8_STAGE(PG8_SB(1, 0), b3, voffB); PG8_STAGE(PG8_SB(1, 1), b3 + hstep, voffB); PG8_STAGE(PG8_SA(1, 0), a3, voffA);
            PG8_WAIT_V(8); PG8_WAIT_L(0); PG8_BAR; PG8_MMA(1, 0, At, B0); PG8_MMA(1, 1, At, B1); PG8_BAR; PG8_SCHED;
            } else {
            PG8_LDB(B0, 0, 0); PG8_SCHED; PG8_LDA(At, 0, 0); PG8_STAGE(PG8_SA(1, 1), a1 + hstep, voffA);
            PG8_WAIT_L(8); PG8_BAR; PG8_WAIT_L(0); PG8_MMA(0, 0, At, B0); PG8_BAR; PG8_SCHED;
            PG8_LDB(B1, 0, 1); PG8_STAGE(PG8_SB(0, 0), b2, voffB);
            PG8_BAR; PG8_WAIT_L(0); PG8_MMA(0, 1, At, B1); PG8_BAR;
            PG8_LDA(At, 0, 1); PG8_STAGE(PG8_SA(0, 0), a2, voffA);
            PG8_BAR; PG8_WAIT_L(0); PG8_MMA(1, 0, At, B0); PG8_BAR; PG8_SCHED;
            PG8_STAGE(PG8_SB(0, 1), b2 + hstep, voffB);
            PG8_WAIT_V(6); PG8_BAR; PG8_MMA(1, 1, At, B1); PG8_BAR;
            PG8_LDB(B0, 1, 0); PG8_SCHED; PG8_LDA(At, 1, 0); PG8_STAGE(PG8_SA(0, 1), a2 + hstep, voffA);
            PG8_WAIT_L(8); PG8_BAR; PG8_WAIT_L(0); PG8_MMA(0, 0, At, B0); PG8_BAR; PG8_SCHED;
            PG8_LDB(B1, 1, 1); PG8_STAGE(PG8_SB(1, 0), b3, voffB);
            PG8_BAR; PG8_WAIT_L(0); PG8_MMA(0, 1, At, B1); PG8_BAR;
            PG8_LDA(At, 1, 1); PG8_STAGE(PG8_SA(1, 0), a3, voffA);
            PG8_BAR; PG8_WAIT_L(0); PG8_MMA(1, 0, At, B0); PG8_BAR; PG8_SCHED;
            PG8_STAGE(PG8_SB(1, 1), b3 + hstep, voffB);
            PG8_WAIT_V(6); PG8_BAR; PG8_MMA(1, 1, At, B1); PG8_BAR;
            }
        }
        if constexpr (ALIGN_EPI) { if (wr == 0) PG8_BAR; }
        if constexpr (!Epi::AFTER_DRAIN) { E(acc, cur, wr, wc, fr, fq); S.done(cur); }
        if (!has_next) break;
#pragma unroll
        for (int a = 0; a < 2; ++a)
#pragma unroll
            for (int b = 0; b < 2; ++b)
#pragma unroll
                for (int m = 0; m < 4; ++m)
#pragma unroll
                    for (int n = 0; n < 2; ++n) acc[a][b][m][n] = (f32x4){0.f, 0.f, 0.f, 0.f};
        cur = nxt; cA = nA; cB = nB; ++ui;
        if constexpr (ALIGN_EPI) { if (wr == 1) PG8_BAR; }
    }
    PG8_WAIT_V(0);
    if constexpr (!ALIGN_EPI) { if (wr == 0) PG8_BAR; }
    PG8_BAR;
    if constexpr (Epi::AFTER_DRAIN) { E.fused(acc, cur, wr, wc, fr, fq, lds, wid, lane); S.done(cur); }
#undef PG8_SA
#undef PG8_SB
#undef PG8_STAGE
#undef PG8_LDA
#undef PG8_LDB
#undef PG8_MMA
#undef PG8_WAIT_V
#undef PG8_WAIT_L
#undef PG8_BAR
#undef PG8_SCHED
}
}

#define DI __device__ __forceinline__
#define LAS __attribute__((address_space(3)))
using pg8::bf16_t; using pg8::bf16x8; using pg8::f32x4; using pg8::u32x4; using pg8::cvtpk; using pg8::sigm;
typedef float f32x2 __attribute__((ext_vector_type(2)));
typedef unsigned u32x2 __attribute__((ext_vector_type(2)));

#ifndef MIXMASK
#define MIXMASK 3
#endif
#ifndef ROLEMASK
#define ROLEMASK 15
#endif
#ifndef PHMASK
#define PHMASK 0xffff
#endif
constexpr int NTHR = 512, NWAVE = 8, LDS_BYTES = 147456;
constexpr int D = 1024, NB = 32, SL = 2048, CL = 256, ML = NB * SL, MC = NB * CL, MT = ML + MC;
constexpr int INC = 3488, PLD = 3584, FH = 2816, LOLD = 1920;
constexpr int C_GQ = 0, C_GK = 192, C_GV = 384, C_GG = 768, C_GDN = 1152;
constexpr int C_NQ = 1184, C_NK = 1440, C_NV = 1696;
constexpr int C_RW = 1952;
constexpr size_t OFF_WIN = 0, OFF_WOUT = 7340032, OFF_W13 = 9437184, OFF_W2 = 20971520, OFF_BT2 = 26738688, WLB = 28311552;
constexpr size_t WS_MOD = 2 * WLB, WS_ROPE = WS_MOD + 1622016, WS_BON = WS_ROPE + 262144, WS_VT = WS_BON + 3538944, WS_AY = WS_VT + 37748736,
                 WS_PB = WS_AY + 150994944, WS_LO = WS_PB + 528482304, WS_END = WS_LO + 283115520;

struct Params { const float* in[29]; float* out; unsigned char* ws; };
enum { I_X = 0, I_C, I_CTX, I_CCTX, I_WMOD, I_BMOD, I_WIN, I_GUP, I_GB, I_GNW, I_RPB, I_MU, I_W0, I_WD2, I_A0, I_WA2, I_WG2, I_KK, I_KA, I_RK, I_GNWT, I_GNB,
       I_WOUT, I_LN1W, I_LN1B, I_W13, I_W2, I_LN2W, I_LN2B };

DI const float* pin(const Params& p, int i) { asm volatile("" : "+s"(i)); return p.in[i]; }
DI float bf2f(bf16_t h) { return __uint_as_float(((unsigned)h) << 16); }
DI float bflo(unsigned u) { return __uint_as_float(u << 16); }
DI float bfhi(unsigned u) { return __uint_as_float(u & 0xffff0000u); }
DI bf16_t f2bf(float f) { return (bf16_t)(cvtpk(f, 0.f) & 0xffffu); }
DI float shx(float v, int m, int lane) { return __int_as_float(__builtin_amdgcn_ds_bpermute((lane ^ m) << 2, __float_as_int(v))); }
DI float wave_sum(float v, int lane) {
#pragma unroll
    for (int o = 1; o < 64; o <<= 1) v += shx(v, o, lane);
    return v;
}
DI void load8(const bf16_t* p, float* o) { const u32x4 u = *(const u32x4*)p; o[0] = bflo(u.x); o[1] = bfhi(u.x); o[2] = bflo(u.y); o[3] = bfhi(u.y); o[4] = bflo(u.z); o[5] = bfhi(u.z); o[6] = bflo(u.w); o[7] = bfhi(u.w); }
DI void load16(const bf16_t* p, float (&o)[16]) { load8(p, &o[0]); load8(p + 8, &o[8]); }
DI void shift16(const bf16_t* prow, bool hasm, bool hasp, const float* mu, float (&y)[16]) {
    float c0[16], cm[16], cp[16];
    load16(prow, c0);
    if (hasm) load16(prow - PLD, cm); else {
#pragma unroll
        for (int j = 0; j < 16; ++j) cm[j] = 0.f; }
    if (hasp) load16(prow + PLD, cp); else {
#pragma unroll
        for (int j = 0; j < 16; ++j) cp[j] = 0.f; }
#pragma unroll
    for (int j = 0; j < 16; ++j) y[j] = c0[j] + (0.5f * (cm[j] + cp[j]) - c0[j]) * mu[j];
}
DI void step_row(int s, int g, int b, int& row, int& ts, int& Ls) {
    if (s < CL) { ts = g ? (CL - 1 - s) : s; row = ML + b * CL + ts; Ls = CL; }
    else { const int u = s - CL; ts = g ? (SL - 1 - u) : u; row = b * SL + ts; Ls = SL; }
}

DI void transpose_item(const float* W, int N, bf16_t* WT, int Kd, size_t dst_row0, int k0, int n0, LAS float* scr, int lane) {
#pragma unroll 8
    for (int i = 0; i < 32; ++i) { const int kk = 2 * i + (lane >> 5); scr[kk * 33 + (lane & 31)] = W[(size_t)(k0 + kk) * N + n0 + (lane & 31)]; }
    asm volatile("s_waitcnt lgkmcnt(0)" ::: "memory");
    const int c = lane & 7;
#pragma unroll
    for (int j = 0; j < 4; ++j) { const int n = (lane >> 3) + 8 * j; const LAS float* s = scr + (8 * c) * 33 + n;
        u32x4 o; o.x = cvtpk(s[0 * 33], s[1 * 33]); o.y = cvtpk(s[2 * 33], s[3 * 33]); o.z = cvtpk(s[4 * 33], s[5 * 33]); o.w = cvtpk(s[6 * 33], s[7 * 33]);
        *(u32x4*)(WT + (dst_row0 + n) * Kd + k0 + 8 * c) = o; }
    asm volatile("s_waitcnt lgkmcnt(0)" ::: "memory");
}

DI void phase_prologue(const Params& p, LAS unsigned char* lds, int tid, int lane, int wave) {
    unsigned char* ws = p.ws;
    float* MOD = (float*)(ws + WS_MOD);
    {
        LAS float* sc = (LAS float*)lds;
        LAS float* part = (LAS float*)(lds + 135168);
        for (int i = tid; i < 33 * 1024; i += NTHR) { const int bi = i >> 10, k = i & 1023; const float cv = bi < 32 ? pin(p, I_C)[bi * 1024 + k] : pin(p, I_CCTX)[k]; sc[k * 33 + bi] = cv * sigm(cv); }
        __syncthreads();
        for (int u = blockIdx.x; u < 192; u += gridDim.x) {
            const int l = u / 96, n0 = (u % 96) * 64;
            float acc[33];
#pragma unroll
            for (int bi = 0; bi < 33; ++bi) acc[bi] = 0.f;
            const float* wp = pin(p, I_WMOD) + (size_t)l * 1024 * 6144 + n0 + lane;
#pragma unroll 4
            for (int kk = 0; kk < 128; ++kk) { const int k = wave * 128 + kk; const float w = wp[(size_t)k * 6144];
#pragma unroll
                for (int bi = 0; bi < 33; ++bi) acc[bi] += sc[k * 33 + bi] * w; }
            for (int w = 0; w < NWAVE; ++w) {
                if (wave == w) {
#pragma unroll
                    for (int bi = 0; bi < 33; ++bi) { if (w == 0) part[bi * 64 + lane] = acc[bi]; else part[bi * 64 + lane] += acc[bi]; } }
                __syncthreads();
            }
            for (int i = tid; i < 33 * 64; i += NTHR) { const int bi = i >> 6, n = i & 63; MOD[(size_t)(l * 33 + bi) * 6144 + n0 + n] = part[i] + pin(p, I_BMOD)[l * 6144 + n0 + n]; }
            __syncthreads();
        }
        __syncthreads();
    }
    const int gw = blockIdx.x * NWAVE + wave, NGW = gridDim.x * NWAVE;
    const int gt = blockIdx.x * NTHR + tid, NGT = gridDim.x * NTHR;
    {
        LAS float* scr = (LAS float*)(lds + wave * 8448);
        constexpr int IT_IN = 16 * 109, IT_OUT = 16 * 32, IT_13 = 16 * 176, IT_2 = 44 * 32, IT_L = IT_IN + IT_OUT + IT_13 + IT_2;
        for (int it = gw; it < 2 * IT_L; it += NGW) {
            const int l = it / IT_L; int r = it % IT_L;
            unsigned char* wl = ws + (size_t)l * WLB;
            if (r < IT_IN) { const int kb = r / 109, nb = r % 109;
                transpose_item(pin(p, I_WIN) + (size_t)l * 1024 * INC, INC, (bf16_t*)(wl + OFF_WIN), 1024, (size_t)nb * 32, kb * 64, nb * 32, scr, lane); continue; }
            r -= IT_IN;
            if (r < IT_OUT) { const int kb = r / 32, nb = r % 32;
                transpose_item(pin(p, I_WOUT) + (size_t)l * 1024 * 1024, 1024, (bf16_t*)(wl + OFF_WOUT), 1024, (size_t)nb * 32, kb * 64, nb * 32, scr, lane); continue; }
            r -= IT_OUT;
            if (r < IT_13) { const int kb = r / 176, nb = r % 176; const int n0 = nb * 32;
                const int j = n0 < FH ? n0 : n0 - FH; const size_t drow = (size_t)(256 * (j / 128) + (n0 < FH ? 0 : 128) + (j % 128));
                transpose_item(pin(p, I_W13) + (size_t)l * 1024 * 2 * FH, 2 * FH, (bf16_t*)(wl + OFF_W13), 1024, drow, kb * 64, n0, scr, lane); continue; }
            r -= IT_13;
            { const int kb = r / 32, nb = r % 32;
                transpose_item(pin(p, I_W2) + (size_t)l * FH * 1024, 1024, (bf16_t*)(wl + OFF_W2), FH, (size_t)nb * 32, kb * 64, nb * 32, scr, lane); }
        }
    }
    for (int i = gt; i < 2 * 96 * 1024; i += NGT) { const int l = i / (96 * 1024), r = i % (96 * 1024); ((bf16_t*)(ws + (size_t)l * WLB + OFF_WIN))[(size_t)INC * 1024 + r] = 0; }
    for (int i = gt; i < 2 * 2048 * 384; i += NGT) {
        const int l = i / (2048 * 384), r = i % (2048 * 384), n = r / 384, k = r % 384;
        float v = 0.f;
        if (n < 1536) { const int g = n / 768, h = (n % 768) / 128, which = (n % 128) / 64, ch = n % 64, c = h * 64 + ch;
            const int kb = which ? 128 + 64 * g : 64 * g;
            if (k >= kb && k < kb + 64) v = (which ? pin(p, I_WA2) : pin(p, I_WD2))[((size_t)(l * 2 + g) * 64 + (k - kb)) * 384 + c]; }
        else if (n < 1920) { if (k >= 256) v = pin(p, I_WG2)[((size_t)l * 128 + (k - 256)) * 384 + (n - 1536)]; }
        ((bf16_t*)(ws + (size_t)l * WLB + OFF_BT2))[r] = f2bf(v);
    }
    for (int i = gt; i < SL * 16; i += NGT) { const int t = i >> 4, pi = i & 15; const float pos = (float)(pi < 8 ? (t >> 6) : (t & 63));
        const float inv = powf(10000.0f, -(float)(pi & 7) * 0.125f); const float ang = pos * inv;
        float* rt = (float*)(ws + WS_ROPE) + (size_t)i * 2; rt[0] = cosf(ang); rt[1] = sinf(ang); }
}

DI void phase_modulate0(const Params& p, int lane, int wave) {
    const int gw = blockIdx.x * NWAVE + wave, NGW = gridDim.x * NWAVE;
    const float* MOD = (const float*)(p.ws + WS_MOD); bf16_t* A = (bf16_t*)(p.ws + WS_AY);
    for (int row = gw; row < MT; row += NGW) {
        const float* src = row < ML ? pin(p, I_X) + (size_t)row * D : pin(p, I_CTX) + (size_t)(row - ML) * D;
        const int bi = row < ML ? (row >> 11) : 32; const float* md = MOD + (size_t)bi * 6144;
#pragma unroll
        for (int j = 0; j < 4; ++j) { const int c = 4 * (lane + 64 * j); const f32x4 v = *(const f32x4*)(src + c), sh = *(const f32x4*)(md + c), sc = *(const f32x4*)(md + 1024 + c);
            u32x2 o; o.x = cvtpk(v[0] * (1.f + sc[0]) + sh[0], v[1] * (1.f + sc[1]) + sh[1]); o.y = cvtpk(v[2] * (1.f + sc[2]) + sh[2], v[3] * (1.f + sc[3]) + sh[3]);
            *(u32x2*)(A + (size_t)row * D + c) = o; }
    }
}
DI void phase_ln(const Params& p, int lane, int wave, int nrows, const float* lnw, const float* lnb, const float* modl, int sh_ofs, int sc_ofs, bool write_x, bool write_A) {
    const int gw = blockIdx.x * NWAVE + wave, NGW = gridDim.x * NWAVE;
    bf16_t* A = (bf16_t*)(p.ws + WS_AY); float* tc = (float*)(p.ws + WS_VT);
    for (int row = gw; row < nrows; row += NGW) {
        const bool lat = row < ML;
        float* t = lat ? p.out + (size_t)row * D : tc + (size_t)(row - ML) * D;
        const int bi = lat ? (row >> 11) : 32;
        f32x4 v[4]; float s = 0.f;
#pragma unroll
        for (int j = 0; j < 4; ++j) { v[j] = *(const f32x4*)(t + 4 * (lane + 64 * j)); s += (v[j][0] + v[j][1]) + (v[j][2] + v[j][3]); }
        const float mean = wave_sum(s, lane) * (1.f / D); float s2 = 0.f;
#pragma unroll
        for (int j = 0; j < 4; ++j) { v[j] = v[j] - mean; s2 += (v[j][0] * v[j][0] + v[j][1] * v[j][1]) + (v[j][2] * v[j][2] + v[j][3] * v[j][3]); }
        const float rstd = rsqrtf(wave_sum(s2, lane) * (1.f / D) + 1e-5f);
        const float* md = modl + (size_t)bi * 6144;
#pragma unroll
        for (int j = 0; j < 4; ++j) { const int c = 4 * (lane + 64 * j); const f32x4 w = *(const f32x4*)(lnw + c), b = *(const f32x4*)(lnb + c);
            f32x4 y; y[0] = v[j][0] * rstd * w[0] + b[0]; y[1] = v[j][1] * rstd * w[1] + b[1]; y[2] = v[j][2] * rstd * w[2] + b[2]; y[3] = v[j][3] * rstd * w[3] + b[3];
            if (write_x && lat) *(f32x4*)(t + c) = y;
            else if (write_x) *(f32x4*)(t + c) = y;
            if (write_A) { const f32x4 sh = *(const f32x4*)(md + sh_ofs + c), sc = *(const f32x4*)(md + sc_ofs + c);
                u32x2 o; o.x = cvtpk(y[0] * (1.f + sc[0]) + sh[0], y[1] * (1.f + sc[1]) + sh[1]); o.y = cvtpk(y[2] * (1.f + sc[2]) + sh[2], y[3] * (1.f + sc[3]) + sh[3]);
                *(u32x2*)(A + (size_t)row * D + c) = o; } }
    }
}

DI void phase_prep(const Params& p, int l, LAS unsigned char* lds, int lane, int wave) {
    const int gw = blockIdx.x * NWAVE + wave, NGW = gridDim.x * NWAVE;
    const bf16_t* PB = (const bf16_t*)(p.ws + WS_PB); bf16_t* A2 = (bf16_t*)(p.ws + WS_AY); bf16_t* VT = (bf16_t*)(p.ws + WS_VT);
    const float* mu = pin(p, I_MU) + (size_t)l * 1536 + 1152;
    for (int row = gw; row < MT; row += NGW) {
        const bool lat = row < ML; const int t = lat ? (row & (SL - 1)) : ((row - ML) & (CL - 1)); const int Ls = lat ? SL : CL;
        const bf16_t* pr = PB + (size_t)row * PLD + C_RW + 1152;
#pragma unroll
        for (int i = 0; i < 6; ++i) { const int j = lane + 64 * i;
            const float c0 = bf2f(pr[j]); const float cm = t > 0 ? bf2f(pr[j - PLD]) : 0.f; const float cp = t < Ls - 1 ? bf2f(pr[j + PLD]) : 0.f;
            const float y = c0 + (0.5f * (cm + cp) - c0) * mu[j];
            float o;
            if (i < 2) o = 1.f - 2.f / (1.f + __expf(2.f * y)); else if (i < 4) o = y; else o = sigm(y);
            A2[(size_t)row * 384 + j] = f2bf(o); }
    }
    LAS bf16_t* tile = (LAS bf16_t*)(lds + wave * 8448);
    for (int it = gw; it < NB * 4 * 36; it += NGW) {
        const int tb = it % 36, h = (it / 36) & 3, b = it / 144;
        const int row0 = tb < 32 ? b * SL + tb * 64 : ML + b * CL + (tb - 32) * 64; const int tk0 = tb * 64;
        const bf16_t* src = PB + (size_t)row0 * PLD + C_NV + h * 64 + lane;
#pragma unroll 8
        for (int i = 0; i < 64; ++i) tile[i * 66 + lane] = src[(size_t)i * PLD];
        asm volatile("s_waitcnt vmcnt(0) lgkmcnt(0)" ::: "memory");
        bf16_t* dst = VT + ((size_t)(b * 4 + h) * 64) * 2304 + tk0 + lane;
#pragma unroll 8
        for (int d = 0; d < 64; ++d) dst[(size_t)d * 2304] = tile[lane * 66 + d];
        asm volatile("s_waitcnt lgkmcnt(0)" ::: "memory");
    }
}

#define MFMA16(a, b, c) __builtin_amdgcn_mfma_f32_16x16x32_bf16((a), (b), (c), 0, 0, 0)
struct NatPair { bf16x8 k[2][2]; u32x2 v[4][2]; };
DI void nat_tile(int ti, int nloc, int nct, int ct_lo, int rs, int b, int& tk, int& keyrow, int& kr, int& ct) {
    kr = 0; ct = 0;
    if (ti < nloc) { kr = ti / nct; ct = ct_lo + ti % nct; tk = (rs + kr) * 64 + 16 * ct; keyrow = b * SL + tk; }
    else { const int j = (ti - nloc) * 16; tk = SL + j; keyrow = ML + b * CL + j; }
}
DI void nat_unit(const Params& p, int l, int id, bool isctx, int lane) {
    const bf16_t* PB = (const bf16_t*)(p.ws + WS_PB); const bf16_t* VT = (const bf16_t*)(p.ws + WS_VT); bf16_t* AY = (bf16_t*)(p.ws + WS_AY);
    const int l15 = lane & 15, g = lane >> 4;
    int b, h, r = 0, qt, qrow;
    if (!isctx) { qt = id & 3; r = (id >> 2) & 31; h = (id >> 7) & 3; b = id >> 9; qrow = b * SL + r * 64 + 16 * qt + l15; }
    else { qt = id & 15; h = (id >> 4) & 3; b = id >> 6; qrow = ML + b * CL + 16 * qt + l15; }
    const bf16_t* qp = PB + (size_t)qrow * PLD + C_NQ + h * 64 + 8 * g;
    const bf16x8 qf0 = *(const bf16x8*)qp, qf1 = *(const bf16x8*)(qp + 32);
    const int rs = min(max(r - 4, 0), 24);
    int ct_lo = 0, nct = 1;
    if (!isctx) { const int lo = min(max(16 * qt - 8, 0), 48), hi = min(max(16 * qt + 7, 0), 48) + 16; ct_lo = lo >> 4; nct = ((hi - 1) >> 4) - ct_lo + 1; }
    const int nloc = isctx ? 0 : 8 * nct, npairs = nloc / 2 + 8;
    const int qc = 16 * qt + l15, cs = min(max(qc - 8, 0), 48);
    float m = -1e30f, lsum = 0.f;
    f32x4 oacc[4];
#pragma unroll
    for (int dt = 0; dt < 4; ++dt) oacc[dt] = (f32x4){0.f, 0.f, 0.f, 0.f};
    const bf16_t* vt = VT + ((size_t)(b * 4 + h) * 64 + l15) * 2304 + 4 * g;
    const bf16_t* kbase = PB + (size_t)l15 * PLD + C_NK + h * 64 + 8 * g;
    const float* rp = pin(p, I_RPB) + (size_t)((l * 4 + h) * 15) * 31;
    NatPair ring[4];
#define NAT_ISSUE(slot, pi_) do { _Pragma("unroll") for (int e = 0; e < 2; ++e) { int tk, keyrow, kr, ct; nat_tile(2 * (pi_) + e, nloc, nct, ct_lo, rs, b, tk, keyrow, kr, ct); \
        const bf16_t* kp = kbase + (size_t)keyrow * PLD; ring[slot].k[e][0] = *(const bf16x8*)kp; ring[slot].k[e][1] = *(const bf16x8*)(kp + 32); \
        _Pragma("unroll") for (int dt = 0; dt < 4; ++dt) ring[slot].v[dt][e] = *(const u32x2*)(vt + (size_t)(16 * dt) * 2304 + tk); } } while (0)
#pragma unroll
    for (int j = 0; j < 4; ++j) NAT_ISSUE(j, j);
    for (int pi0 = 0; pi0 < npairs; pi0 += 4) {
#pragma unroll
        for (int j = 0; j < 4; ++j) {
            const int pi = pi0 + j;
            f32x4 s[2];
#pragma unroll
            for (int e = 0; e < 2; ++e) {
                int tk, keyrow, kr, ct; nat_tile(2 * pi + e, nloc, nct, ct_lo, rs, b, tk, keyrow, kr, ct);
                const bool local = 2 * pi + e < nloc;
                f32x4 a = (f32x4){0.f, 0.f, 0.f, 0.f};
                a = MFMA16(ring[j].k[e][0], qf0, a); a = MFMA16(ring[j].k[e][1], qf1, a);
#pragma unroll
                for (int rg = 0; rg < 4; ++rg) {
                    float sv = a[rg] * 0.125f;
                    if (local) { const int kc = 16 * ct + 4 * g + rg; const bool vis = (kc >= cs) && (kc < cs + 16);
                        const int dc = min(max(kc - qc + 15, 0), 30), dr = rs + kr - r + 7;
                        sv += rp[dr * 31 + dc]; sv = vis ? sv : -1e30f; }
                    s[e][rg] = sv; }
            }
            float tmax = fmaxf(fmaxf(fmaxf(s[0][0], s[0][1]), fmaxf(s[0][2], s[0][3])), fmaxf(fmaxf(s[1][0], s[1][1]), fmaxf(s[1][2], s[1][3])));
            tmax = fmaxf(tmax, shx(tmax, 16, lane)); tmax = fmaxf(tmax, shx(tmax, 32, lane));
            const float mn = fmaxf(m, tmax), corr = __expf(m - mn); m = mn;
            float pv[8]; float ps = 0.f;
#pragma unroll
            for (int i = 0; i < 8; ++i) { const float sv = s[i >> 2][i & 3]; pv[i] = sv > -1e29f ? __expf(sv - mn) : 0.f; ps += pv[i]; }
            lsum = lsum * corr + ps;
            u32x4 pk; pk.x = cvtpk(pv[0], pv[1]); pk.y = cvtpk(pv[2], pv[3]); pk.z = cvtpk(pv[4], pv[5]); pk.w = cvtpk(pv[6], pv[7]);
            const bf16x8 pf = __builtin_bit_cast(bf16x8, pk);
#pragma unroll
            for (int dt = 0; dt < 4; ++dt) {
                u32x4 vv; vv.x = ring[j].v[dt][0].x; vv.y = ring[j].v[dt][0].y; vv.z = ring[j].v[dt][1].x; vv.w = ring[j].v[dt][1].y;
                oacc[dt] = oacc[dt] * corr;
                oacc[dt] = MFMA16(__builtin_bit_cast(bf16x8, vv), pf, oacc[dt]);
            }
            if (pi + 4 < npairs) NAT_ISSUE(j, pi + 4);
        }
    }
#undef NAT_ISSUE
    lsum += shx(lsum, 16, lane); lsum += shx(lsum, 32, lane);
    const float inv = 1.0f / lsum;
    bf16_t* yp = AY + (size_t)qrow * D + 768 + h * 64 + 4 * g;
#pragma unroll
    for (int dt = 0; dt < 4; ++dt) { u32x2 o; o.x = cvtpk(oacc[dt][0] * inv, oacc[dt][1] * inv); o.y = cvtpk(oacc[dt][2] * inv, oacc[dt][3] * inv); *(u32x2*)(yp + 16 * dt) = o; }
}

constexpr int RW_STEP = 384, RW_BUF = 16 * RW_STEP, GL_STEP = 160, GL_BUF = 16 * GL_STEP, NCHUNK = (CL + SL) / 16;
struct RwRaw { u32x4 d[3][3][2]; u32x4 lo[4]; };
DI void rwkv_load(const Params& p, int item, int c, RwRaw& R, int lane) {
    const int g = item & 1, h = (item >> 1) % 6, b = item / 12;
    const int ti = lane >> 2, cg = lane & 3;
    int row, ts, Ls; step_row(16 * c + ti, g, b, row, ts, Ls);
    const int rm = ts > 0 ? row - 1 : row, rp = ts < Ls - 1 ? row + 1 : row;
    const bf16_t* PB = (const bf16_t*)(p.ws + WS_PB) + C_RW + h * 64 + 16 * cg;
    const bf16_t* p0 = PB + (size_t)row * PLD; const bf16_t* pm = PB + (size_t)rm * PLD; const bf16_t* pp = PB + (size_t)rp * PLD;
#pragma unroll
    for (int a = 0; a < 3; ++a)
#pragma unroll
        for (int hf = 0; hf < 2; ++hf) { R.d[a][0][hf] = *(const u32x4*)(pm + a * 384 + 8 * hf); R.d[a][1][hf] = *(const u32x4*)(p0 + a * 384 + 8 * hf); R.d[a][2][hf] = *(const u32x4*)(pp + a * 384 + 8 * hf); }
    const bf16_t* lo = (const bf16_t*)(p.ws + WS_LO) + (size_t)row * LOLD + (g * 6 + h) * 128 + 16 * cg;
    R.lo[0] = *(const u32x4*)lo; R.lo[1] = *(const u32x4*)(lo + 8); R.lo[2] = *(const u32x4*)(lo + 64); R.lo[3] = *(const u32x4*)(lo + 72);
}
DI void cvt8(const u32x4 u, float* o) { o[0] = bflo(u.x); o[1] = bfhi(u.x); o[2] = bflo(u.y); o[3] = bfhi(u.y); o[4] = bflo(u.z); o[5] = bfhi(u.z); o[6] = bflo(u.w); o[7] = bfhi(u.w); }
DI void rwkv_compute(const Params& p, int item, int c, const RwRaw& R, LAS float* buf, const LAS float* CST, int lane) {
    const int g = item & 1, h = (item >> 1) % 6, b = item / 12;
    const int ti = lane >> 2, cg = lane & 3;
    int row, ts, Ls; step_row(16 * c + ti, g, b, row, ts, Ls);
    const float mm = ts > 0 ? 0.5f : 0.f, mp = ts < Ls - 1 ? 0.5f : 0.f;
    float y[3][16];
#pragma unroll
    for (int a = 0; a < 3; ++a) {
        float c0[16], cm[16], cp[16];
        cvt8(R.d[a][0][0], &cm[0]); cvt8(R.d[a][0][1], &cm[8]); cvt8(R.d[a][1][0], &c0[0]); cvt8(R.d[a][1][1], &c0[8]); cvt8(R.d[a][2][0], &cp[0]); cvt8(R.d[a][2][1], &cp[8]);
#pragma unroll
        for (int j4 = 0; j4 < 4; ++j4) { const f32x4 mu = *(const LAS f32x4*)(CST + a * 64 + 16 * cg + 4 * j4);
#pragma unroll
            for (int jj = 0; jj < 4; ++jj) { const int j = 4 * j4 + jj; y[a][j] = c0[j] + ((mm * cm[j] + mp * cp[j]) - c0[j]) * mu[jj]; } }
    }
    float lw[16], a[16];
    cvt8(R.lo[0], &lw[0]); cvt8(R.lo[1], &lw[8]); cvt8(R.lo[2], &a[0]); cvt8(R.lo[3], &a[8]);
    float kkv[16]; float ss = 0.f;
#pragma unroll
    for (int j4 = 0; j4 < 4; ++j4) { const f32x4 kc = *(const LAS f32x4*)(CST + 3 * 64 + 16 * cg + 4 * j4);
#pragma unroll
        for (int jj = 0; jj < 4; ++jj) { const int j = 4 * j4 + jj; kkv[j] = y[1][j] * kc[jj]; ss += kkv[j] * kkv[j]; } }
    ss += shx(ss, 1, lane); ss += shx(ss, 2, lane);
    const float inv = rsqrtf(ss + 1e-12f);
    float bon = 0.f;
    LAS float* o = buf + ti * RW_STEP + 16 * cg;
#pragma unroll
    for (int j4 = 0; j4 < 4; ++j4) {
        const f32x4 kac = *(const LAS f32x4*)(CST + 4 * 64 + 16 * cg + 4 * j4), rkc = *(const LAS f32x4*)(CST + 5 * 64 + 16 * cg + 4 * j4);
        f32x4 w4, b4, km4, r4, kk4, v4;
#pragma unroll
        for (int jj = 0; jj < 4; ++jj) { const int j = 4 * j4 + jj;
            const float kkn = kkv[j] * inv, aj = a[j];
            const float km = y[1][j] * (1.f + (aj - 1.f) * kac[jj]);
            w4[jj] = __expf(-lw[j]); b4[jj] = kkn * aj; km4[jj] = km; r4[jj] = y[0][j]; kk4[jj] = kkn; v4[jj] = y[2][j];
            bon += y[0][j] * km * rkc[jj]; }
        *(LAS f32x4*)(o + 0 * 64 + 4 * j4) = w4; *(LAS f32x4*)(o + 1 * 64 + 4 * j4) = b4; *(LAS f32x4*)(o + 2 * 64 + 4 * j4) = km4;
        *(LAS f32x4*)(o + 3 * 64 + 4 * j4) = r4; *(LAS f32x4*)(o + 4 * 64 + 4 * j4) = kk4; *(LAS f32x4*)(o + 5 * 64 + 4 * j4) = v4;
    }
    bon += shx(bon, 1, lane); bon += shx(bon, 2, lane);
    if (cg == 0) ((float*)(p.ws + WS_BON))[(size_t)row * 12 + g * 6 + h] = bon;
}
DI void rwkv_scan_chunk(const Params& p, int item, int c, const LAS float* buf, f32x2 (&S)[32], int lane, bool dry = false) {
    const int g = item & 1, h = (item >> 1) % 6, b = item / 12;
    float* LOf = (float*)(p.ws + WS_LO);
    f32x4 KK[16];
#pragma unroll
    for (int i = 0; i < 16; ++i) KK[i] = ((const LAS f32x4*)buf)[64 + i];
    float vv = buf[320 + lane];
    for (int st = 0; st < 16; ++st) {
        const LAS f32x4* W = (const LAS f32x4*)(buf + st * RW_STEP);
        const LAS f32x4* Wn = (const LAS f32x4*)(buf + (st < 15 ? st + 1 : st) * RW_STEP);
        f32x4 U[2][8];
#pragma unroll
        for (int j = 0; j < 2; ++j) { U[0][4 * j] = W[j]; U[0][4 * j + 1] = W[16 + j]; U[0][4 * j + 2] = W[32 + j]; U[0][4 * j + 3] = W[48 + j]; }
        f32x2 sacc[4];
#pragma unroll
        for (int i = 0; i < 4; ++i) sacc[i] = (f32x2){0.f, 0.f};
#pragma unroll
        for (int i = 0; i < 16; ++i) { sacc[(2 * i) & 3] += S[2 * i] * (f32x2){KK[i][0], KK[i][1]}; sacc[(2 * i + 1) & 3] += S[2 * i + 1] * (f32x2){KK[i][2], KK[i][3]}; }
        const f32x2 st2 = (sacc[0] + sacc[1]) + (sacc[2] + sacc[3]);
        const float sa = -(st2[0] + st2[1]);
        const f32x2 sa2 = (f32x2){sa, sa}, vv2 = (f32x2){vv, vv};
        f32x2 oacc[4];
#pragma unroll
        for (int i = 0; i < 4; ++i) oacc[i] = (f32x2){0.f, 0.f};
        asm volatile("" : "+v"(oacc[0]), "+v"(oacc[1]) :: "memory");
#pragma unroll
        for (int gi = 0; gi < 8; ++gi) {
            const int cu = gi & 1, nx = cu ^ 1;
            if (gi < 7) {
#pragma unroll
                for (int j = 0; j < 2; ++j) { const int i = 2 * (gi + 1) + j; U[nx][4 * j] = W[i]; U[nx][4 * j + 1] = W[16 + i]; U[nx][4 * j + 2] = W[32 + i]; U[nx][4 * j + 3] = W[48 + i]; }
            }
            if (gi >= 4) {
#pragma unroll
                for (int j = 0; j < 4; ++j) KK[4 * (gi - 4) + j] = Wn[64 + 4 * (gi - 4) + j];
            }
#pragma unroll
            for (int j = 0; j < 2; ++j) { const int i = 2 * gi + j; const f32x4 w4 = U[cu][4 * j], b4 = U[cu][4 * j + 1], km4 = U[cu][4 * j + 2], r4 = U[cu][4 * j + 3];
                f32x2 t0 = vv2 * (f32x2){km4[0], km4[1]}; t0 = sa2 * (f32x2){b4[0], b4[1]} + t0; S[2 * i] = S[2 * i] * (f32x2){w4[0], w4[1]} + t0;
                f32x2 t1 = vv2 * (f32x2){km4[2], km4[3]}; t1 = sa2 * (f32x2){b4[2], b4[3]} + t1; S[2 * i + 1] = S[2 * i + 1] * (f32x2){w4[2], w4[3]} + t1;
                oacc[(2 * i) & 3] += S[2 * i] * (f32x2){r4[0], r4[1]}; oacc[(2 * i + 1) & 3] += S[2 * i + 1] * (f32x2){r4[2], r4[3]}; }
            asm volatile("" : "+v"(oacc[0]), "+v"(oacc[1]), "+v"(oacc[2]), "+v"(oacc[3]) :: "memory");
        }
        vv = buf[(st < 15 ? st + 1 : st) * RW_STEP + 320 + lane];
        const f32x2 o2 = (oacc[0] + oacc[1]) + (oacc[2] + oacc[3]);
        int row, ts, Ls; step_row(16 * c + st, g, b, row, ts, Ls);
        { const float ov = o2[0] + o2[1]; if (!dry || ov == 1.2345e37f) LOf[(size_t)row * (LOLD / 2) + (g * 6 + h) * 64 + lane] = ov; }
    }
}
struct GlRaw { u32x4 q, k, v[2], dn[2]; f32x4 rt[2]; };
DI void gla_load(const Params& p, int item, int c, GlRaw& R, int lane) {
    const int g = item & 1, h = (item >> 1) % 6, b = item / 12;
    const int ti = lane >> 2, cg = lane & 3;
    int row, ts, Ls; step_row(16 * c + ti, g, b, row, ts, Ls);
    const bf16_t* pr = (const bf16_t*)(p.ws + WS_PB) + (size_t)row * PLD;
    R.q = *(const u32x4*)(pr + C_GQ + h * 32 + 8 * cg); R.k = *(const u32x4*)(pr + C_GK + h * 32 + 8 * cg);
    R.v[0] = *(const u32x4*)(pr + C_GV + h * 64 + 16 * cg); R.v[1] = *(const u32x4*)(pr + C_GV + h * 64 + 16 * cg + 8);
    R.dn[0] = *(const u32x4*)(pr + C_GDN + 16 * g); R.dn[1] = *(const u32x4*)(pr + C_GDN + 16 * g + 8);
    const float* rt = (const float*)(p.ws + WS_ROPE) + (size_t)((Ls == SL ? ts : 0) * 16 + 4 * cg) * 2;
    R.rt[0] = *(const f32x4*)rt; R.rt[1] = *(const f32x4*)(rt + 4);
}
DI void gla_compute(const Params& p, int item, int c, const GlRaw& R, LAS float* buf, const LAS float* GU, int lane) {
    const int g = item & 1, b = item / 12;
    const int ti = lane >> 2, cg = lane & 3;
    int row, ts, Ls; step_row(16 * c + ti, g, b, row, ts, Ls);
    float q[8], k[8], v[16], dn[16];
    cvt8(R.q, q); cvt8(R.k, k); cvt8(R.v[0], &v[0]); cvt8(R.v[1], &v[8]); cvt8(R.dn[0], &dn[0]); cvt8(R.dn[1], &dn[8]);
    float al[8];
    {
        f32x4 z0 = *(const LAS f32x4*)(GU + 512 + 8 * cg), z1 = *(const LAS f32x4*)(GU + 512 + 8 * cg + 4);
#pragma unroll
        for (int rr = 0; rr < 16; ++rr) {
            if ((rr & 3) == 0) asm volatile("" : "+v"(z0), "+v"(z1) :: "memory");
            const f32x4 g0 = *(const LAS f32x4*)(GU + rr * 32 + 8 * cg), g1 = *(const LAS f32x4*)(GU + rr * 32 + 8 * cg + 4);
            z0 = z0 + g0 * dn[rr]; z1 = z1 + g1 * dn[rr]; }
#pragma unroll
        for (int j = 0; j < 8; ++j) { const float z = j < 4 ? z0[j & 3] : z1[j & 3];
            const float ls = fminf(z, 0.f) - __logf(1.f + __expf(-fabsf(z)));
            al[j] = __expf(ls * 0.0625f); }
    }
    if (Ls == SL) {
#pragma unroll
        for (int jj = 0; jj < 4; ++jj) { const float cc = R.rt[jj >> 1][2 * (jj & 1)], sn = R.rt[jj >> 1][2 * (jj & 1) + 1];
            const float q1 = q[2 * jj], q2 = q[2 * jj + 1]; q[2 * jj] = q1 * cc - q2 * sn; q[2 * jj + 1] = q1 * sn + q2 * cc;
            const float k1 = k[2 * jj], k2 = k[2 * jj + 1]; k[2 * jj] = k1 * cc - k2 * sn; k[2 * jj + 1] = k1 * sn + k2 * cc; }
    }
    LAS float* o = buf + ti * GL_STEP;
#pragma unroll
    for (int j4 = 0; j4 < 2; ++j4) {
        *(LAS f32x4*)(o + 8 * cg + 4 * j4) = (f32x4){al[4 * j4], al[4 * j4 + 1], al[4 * j4 + 2], al[4 * j4 + 3]};
        *(LAS f32x4*)(o + 32 + 8 * cg + 4 * j4) = (f32x4){k[4 * j4], k[4 * j4 + 1], k[4 * j4 + 2], k[4 * j4 + 3]};
        *(LAS f32x4*)(o + 64 + 8 * cg + 4 * j4) = (f32x4){q[4 * j4], q[4 * j4 + 1], q[4 * j4 + 2], q[4 * j4 + 3]} * 0.17677669529663687f; }
#pragma unroll
    for (int j4 = 0; j4 < 4; ++j4) *(LAS f32x4*)(o + 96 + 16 * cg + 4 * j4) = (f32x4){v[4 * j4], v[4 * j4 + 1], v[4 * j4 + 2], v[4 * j4 + 3]};
}
DI void gla_scan_chunk(const Params& p, int item, int c, const LAS float* buf, f32x2 (&S)[16], int lane, bool dry = false) {
    const int g = item & 1, h = (item >> 1) % 6, b = item / 12;
    bf16_t* AY = (bf16_t*)(p.ws + WS_AY);
    f32x4 U[2][12];
#pragma unroll
    for (int j = 0; j < 4; ++j) { U[0][3 * j] = ((const LAS f32x4*)buf)[j]; U[0][3 * j + 1] = ((const LAS f32x4*)buf)[8 + j]; U[0][3 * j + 2] = ((const LAS f32x4*)buf)[16 + j]; }
    float vv = buf[96 + lane];
    for (int st = 0; st < 16; ++st) {
        const LAS f32x4* W = (const LAS f32x4*)(buf + st * GL_STEP);
        const LAS float* bn = buf + (st < 15 ? st + 1 : st) * GL_STEP;
        const LAS f32x4* Wn = (const LAS f32x4*)bn;
        const f32x2 vv2 = (f32x2){vv, vv};
        f32x2 oacc[4];
#pragma unroll
        for (int i = 0; i < 4; ++i) oacc[i] = (f32x2){0.f, 0.f};
#pragma unroll
        for (int gi = 0; gi < 2; ++gi) {
            const int cu = gi, nx = gi ^ 1;
#pragma unroll
            for (int j = 0; j < 4; ++j) { const LAS f32x4* Wx = gi == 0 ? W : Wn; const int i = gi == 0 ? 4 + j : j;
                U[nx][3 * j] = Wx[i]; U[nx][3 * j + 1] = Wx[8 + i]; U[nx][3 * j + 2] = Wx[16 + i]; }
            if (gi == 1) vv = bn[96 + lane];
#pragma unroll
            for (int j = 0; j < 4; ++j) { const int i = 4 * gi + j; const f32x4 a4 = U[cu][3 * j], k4 = U[cu][3 * j + 1], q4 = U[cu][3 * j + 2];
                S[2 * i] = S[2 * i] * (f32x2){a4[0], a4[1]} + vv2 * (f32x2){k4[0], k4[1]}; S[2 * i + 1] = S[2 * i + 1] * (f32x2){a4[2], a4[3]} + vv2 * (f32x2){k4[2], k4[3]};
                oacc[(2 * i) & 3] += S[2 * i] * (f32x2){q4[0], q4[1]}; oacc[(2 * i + 1) & 3] += S[2 * i + 1] * (f32x2){q4[2], q4[3]}; }
            asm volatile("" : "+v"(oacc[0]), "+v"(oacc[1]), "+v"(oacc[2]), "+v"(oacc[3]) :: "memory");
        }
        const f32x2 o2 = (oacc[0] + oacc[1]) + (oacc[2] + oacc[3]);
        int row, ts, Ls; step_row(16 * c + st, g, b, row, ts, Ls);
        { const float ov = o2[0] + o2[1]; if (!dry || ov == 1.2345e37f) AY[(size_t)row * D + g * 384 + h * 64 + lane] = f2bf(ov); }
    }
}
DI void scan_unit(const Params& p, int l, int su, LAS unsigned char* lds, int tid, int lane, int wave, bool dry = false) {
    LAS float* RWB = (LAS float*)lds; LAS float* GLB = (LAS float*)(lds + 98304); LAS float* GUB = (LAS float*)(lds + 139264); LAS float* CSB = (LAS float*)(lds + 143616);
    const int slot = wave & 1, item = 2 * su + slot;
    for (int i = tid; i < 2 * 544; i += NTHR) { const int sl = i / 544, r = i % 544; const int it = 2 * su + sl, gg = it & 1, hh = (it >> 1) % 6;
        GUB[i] = r < 512 ? pin(p, I_GUP)[((size_t)(l * 2 + gg) * 16 + (r >> 5)) * 192 + hh * 32 + (r & 31)] : pin(p, I_GB)[(size_t)(l * 2 + gg) * 192 + hh * 32 + (r - 512)]; }
    for (int i = tid; i < 2 * 384; i += NTHR) { const int sl = i / 384, r = i % 384, a = r >> 6, ch = r & 63; const int it = 2 * su + sl, hh = (it >> 1) % 6;
        float v;
        if (a < 3) v = pin(p, I_MU)[(size_t)l * 1536 + a * 384 + hh * 64 + ch];
        else v = (a == 3 ? pin(p, I_KK) : (a == 4 ? pin(p, I_KA) : pin(p, I_RK)))[(size_t)l * 384 + hh * 64 + ch];
        CSB[i] = v; }
    __syncthreads();
    const int role = wave >> 1;
    if ((ROLEMASK & 1) && role == 0) {
        asm volatile("" : "+v"(lane));
        f32x2 S[32];
#pragma unroll
        for (int i = 0; i < 32; ++i) S[i] = (f32x2){0.f, 0.f};
        __syncthreads();
        for (int c = 0; c < NCHUNK; ++c) { rwkv_scan_chunk(p, item, c, RWB + (slot * 2 + (c & 1)) * RW_BUF, S, lane, dry); __syncthreads(); }
    } else if ((ROLEMASK & 2) && role == 1) {
        asm volatile("" : "+v"(lane));
        f32x2 Sg[16];
#pragma unroll
        for (int i = 0; i < 16; ++i) Sg[i] = (f32x2){0.f, 0.f};
        __syncthreads();
        for (int c = 0; c < NCHUNK; ++c) { gla_scan_chunk(p, item, c, GLB + (slot * 2 + (c & 1)) * GL_BUF, Sg, lane, dry); __syncthreads(); }
    } else if ((ROLEMASK & 4) && role == 2) {
        asm volatile("" : "+v"(lane));
        RwRaw R; rwkv_load(p, item, 0, R, lane);
        rwkv_compute(p, item, 0, R, RWB + (slot * 2 + 0) * RW_BUF, CSB + slot * 384, lane);
        rwkv_load(p, item, 1, R, lane);
        __syncthreads();
        for (int c = 0; c < NCHUNK; ++c) {
            if (c + 1 < NCHUNK) { rwkv_compute(p, item, c + 1, R, RWB + (slot * 2 + ((c + 1) & 1)) * RW_BUF, CSB + slot * 384, lane); if (c + 2 < NCHUNK) rwkv_load(p, item, c + 2, R, lane); }
            __syncthreads(); }
    } else if (ROLEMASK & 8) {
        asm volatile("" : "+v"(lane));
        GlRaw R; gla_load(p, item, 0, R, lane);
        gla_compute(p, item, 0, R, GLB + (slot * 2 + 0) * GL_BUF, GUB + slot * 544, lane);
        gla_load(p, item, 1, R, lane);
        __syncthreads();
        for (int c = 0; c < NCHUNK; ++c) {
            if (c + 1 < NCHUNK) { gla_compute(p, item, c + 1, R, GLB + (slot * 2 + ((c + 1) & 1)) * GL_BUF, GUB + slot * 544, lane); if (c + 2 < NCHUNK) gla_load(p, item, c + 2, R, lane); }
            __syncthreads(); }
    }
}
DI void phase_mixers(const Params& p, int l, LAS unsigned char* lds, int tid, int lane, int wave, bool dry = false) {
    const int G = gridDim.x, bx = blockIdx.x;
    const int nscan = G >= 224 ? 192 : G;
    const int nnat = NB * 4 * 32 * 4, nnatc = l == 0 ? NB * 4 * 16 : 0;
    if constexpr (MIXMASK & 1) { if (bx < nscan) for (int su = bx; su < 192; su += nscan) scan_unit(p, l, su, lds, tid, lane, wave, dry); }
    int w0, nw;
    if (G >= 224) { if (bx < 192) return; w0 = (bx - 192) * NWAVE + wave; nw = (G - 192) * NWAVE; }
    else { w0 = bx * NWAVE + wave; nw = G * NWAVE; }
    if constexpr (MIXMASK & 2) for (int id = w0; id < nnat + nnatc; id += nw) { if (id < nnat) nat_unit(p, l, id, false, lane); else nat_unit(p, l, id - nnat, true, lane); }
}

DI void phase_readout(const Params& p, int l, int nrows, int lane, int wave) {
    const int gw = blockIdx.x * NWAVE + wave, NGW = gridDim.x * NWAVE;
    const bf16_t* PB = (const bf16_t*)(p.ws + WS_PB); bf16_t* AY = (bf16_t*)(p.ws + WS_AY);
    const float* LOf = (const float*)(p.ws + WS_LO); const bf16_t* LOb = (const bf16_t*)(p.ws + WS_LO); const float* BON = (const float*)(p.ws + WS_BON);
    const float nw = pin(p, I_GNW)[l * 64 + lane];
    const float* gnw = pin(p, I_GNWT) + l * 384; const float* gnb = pin(p, I_GNB) + l * 384;
    const float* mu = pin(p, I_MU) + (size_t)l * 1536 + 768;
    for (int row = gw; row < nrows; row += NGW) {
        const bool lat = row < ML; const int t = lat ? (row & (SL - 1)) : ((row - ML) & (CL - 1)); const int Ls = lat ? SL : CL;
        const bf16_t* pr = PB + (size_t)row * PLD; bf16_t* yr = AY + (size_t)row * D;
        float og[6], gg[6], nat[4], orw[6], vv[6], gate[6], bon[6];
#pragma unroll
        for (int h = 0; h < 6; ++h) { og[h] = bf2f(yr[h * 64 + lane]) + bf2f(yr[384 + h * 64 + lane]); gg[h] = bf2f(pr[C_GG + h * 64 + lane]);
            orw[h] = LOf[(size_t)row * (LOLD / 2) + h * 64 + lane] + LOf[(size_t)row * (LOLD / 2) + (6 + h) * 64 + lane];
            const int cv = C_RW + 768 + h * 64 + lane; const float c0 = bf2f(pr[cv]); const float cm = t > 0 ? bf2f(pr[cv - PLD]) : 0.f; const float cp = t < Ls - 1 ? bf2f(pr[cv + PLD]) : 0.f;
            vv[h] = c0 + (0.5f * (cm + cp) - c0) * mu[h * 64 + lane];
            gate[h] = bf2f(LOb[(size_t)row * LOLD + 1536 + h * 64 + lane]);
            bon[h] = BON[(size_t)row * 12 + h] + BON[(size_t)row * 12 + 6 + h]; }
#pragma unroll
        for (int h = 0; h < 4; ++h) nat[h] = bf2f(yr[768 + h * 64 + lane]);
        float yg[6], yrw[6];
#pragma unroll
        for (int h = 0; h < 6; ++h) {
            const float ss = wave_sum(og[h] * og[h], lane);
            yg[h] = og[h] * rsqrtf(ss * (1.f / 64.f) + 1e-5f) * nw * (gg[h] * sigm(gg[h]));
            const float mean = wave_sum(orw[h], lane) * (1.f / 64.f); const float dlt = orw[h] - mean; const float var = wave_sum(dlt * dlt, lane) * (1.f / 64.f);
            const float gn = dlt * rsqrtf(var + 64e-5f) * gnw[h * 64 + lane] + gnb[h * 64 + lane];
            yrw[h] = (gn + bon[h] * vv[h]) * gate[h]; }
        asm volatile("s_waitcnt vmcnt(0)" ::: "memory");
#pragma unroll
        for (int h = 0; h < 6; ++h) { yr[h * 64 + lane] = f2bf(yg[h]); yr[640 + h * 64 + lane] = f2bf(yrw[h]); }
#pragma unroll
        for (int h = 0; h < 4; ++h) yr[384 + h * 64 + lane] = f2bf(nat[h]);
    }
}

DI void run_step(const Params& p, const int step, LAS unsigned char* lds, int tid, int lane, int wave) {
    const int G = gridDim.x, bx = blockIdx.x;
    unsigned char* ws = p.ws;
    const float* MOD = (const float*)(ws + WS_MOD);
    float* TC = (float*)(ws + WS_VT);
    {
        const int l = step < 2 ? 0 : (step - 2) / 10, st = step < 2 ? -1 : (step - 2) % 10;
        unsigned char* wl = ws + (size_t)l * WLB;
        const float* modl = MOD + (size_t)l * 33 * 6144;
        const int Mff = l == 0 ? MT : ML;
        if (st == 0 || st == 2 || st == 5 || st == 7 || st == 8) {
            const bf16_t* gA = (const bf16_t*)(ws + WS_AY); const bf16_t* gB; int gM = Mff, gN = 1024, gK = 1024, mode = 2;
            bf16_t* eO = (bf16_t*)(ws + WS_PB); const float* ex = (const float*)p.out; const float* exc = (const float*)TC; int gofs = 2 * 1024;
            if (st == 0) { gB = (const bf16_t*)(wl + OFF_WIN); gM = MT; gN = PLD; mode = 0; }
            else if (st == 2) { gB = (const bf16_t*)(wl + OFF_BT2); gM = MT; gN = 2048; gK = 384; mode = 1; eO = (bf16_t*)(ws + WS_LO); }
            else if (st == 5) { gB = (const bf16_t*)(wl + OFF_WOUT); if (l == 0) { ex = pin(p, I_X); exc = pin(p, I_CTX); } }
            else if (st == 7) { gB = (const bf16_t*)(wl + OFF_W13); gN = 2 * FH; mode = 3; }
            else { gA = (const bf16_t*)(ws + WS_PB); gB = (const bf16_t*)(wl + OFF_W2); gK = FH; gofs = 5 * 1024; }
            asm volatile("" : "+s"(gK), "+s"(gM), "+s"(gN), "+s"(mode));
            const pg8::Gemm g{gA, gB, gM, gN, gK};
            const pg8::EpiAny E{mode, pg8::EpiStoreBf16{eO, PLD}, pg8::EpiLora{eO, pin(p, I_W0) + (size_t)l * 768, pin(p, I_A0) + (size_t)l * 768},
                                pg8::EpiRes{ex, exc, p.out, TC, modl, gofs}, pg8::EpiSwiglu{eO}};
            pg8::StaticOrder S; S.init(g.M, g.N, G, bx);
#if defined(PROBE_GEMM)
            int nrep = (st == 0 || st == 2 || st == 7) ? 2 : 1; asm volatile("" : "+s"(nrep));
#pragma unroll 1
            for (int rep = 0; rep < nrep; ++rep) { pg8::gemm_phase<pg8::EpiAny, pg8::StaticOrder, true, true>(lds, g, S, E, tid); __syncthreads(); }
#else
            pg8::gemm_phase<pg8::EpiAny, pg8::StaticOrder, true, true>(lds, g, S, E, tid);
#endif
        }
#ifndef ONLYGEMM
        else if (step == 0) phase_prologue(p, lds, tid, lane, wave);
        else if (step == 1) phase_modulate0(p, lane, wave);
        else if (st == 1) phase_prep(p, l, lds, lane, wave);
#if defined(PROBE_MIX)
        else if (st == 3) { int nrep = 2; asm volatile("" : "+s"(nrep));
#pragma unroll 1
            for (int rep = 0; rep < nrep; ++rep) { phase_mixers(p, l, lds, tid, lane, wave, rep + 1 < nrep); __syncthreads(); } }
#else
        else if (st == 3) phase_mixers(p, l, lds, tid, lane, wave);
#endif
        else if (st == 4) phase_readout(p, l, Mff, lane, wave);
        else if (st == 6) phase_ln(p, lane, wave, Mff, pin(p, I_LN1W) + l * 1024, pin(p, I_LN1B) + l * 1024, modl, 3 * 1024, 4 * 1024, true, true);
        else {
            if (l == 0) phase_ln(p, lane, wave, MT, pin(p, I_LN2W), pin(p, I_LN2B), MOD + (size_t)33 * 6144, 0, 1024, true, true);
            else phase_ln(p, lane, wave, ML, pin(p, I_LN2W) + 1024, pin(p, I_LN2B) + 1024, modl, 0, 1024, true, false);
        }
#endif
    }
}
#ifdef MULTI_LAUNCH
template <int STEP> __global__ void __launch_bounds__(NTHR, 2) k_step(Params p) {
    extern __shared__ __attribute__((aligned(16))) unsigned char smem[];
    const int tid = threadIdx.x, lane = tid & 63, wave = __builtin_amdgcn_readfirstlane(tid >> 6);
    run_step(p, STEP, (LAS unsigned char*)smem, tid, lane, wave);
}
template <int STEP> static void launch_steps(const Params& p, int grid, hipStream_t stream) {
    static bool attr_done = false;
    if (!attr_done) { (void)hipFuncSetAttribute((const void*)k_step<STEP>, hipFuncAttributeMaxDynamicSharedMemorySize, LDS_BYTES); attr_done = true; }
    hipLaunchKernelGGL(k_step<STEP>, dim3(grid), dim3(NTHR), LDS_BYTES, stream, p);
    if constexpr (STEP + 1 < 22) launch_steps<STEP + 1>(p, grid, stream);
}
#else
__global__ void __launch_bounds__(NTHR, 2) hybrid_fwd(Params p) {
    extern __shared__ __attribute__((aligned(16))) unsigned char smem[];
    LAS unsigned char* lds = (LAS unsigned char*)smem;
    cg::grid_group grid = cg::this_grid();
    const int wave0 = __builtin_amdgcn_readfirstlane((int)threadIdx.x >> 6);
#pragma unroll 1
    for (int step = 0; step < 22; ++step) {
        unsigned msk = ~0u; int wave_ = wave0;
        asm volatile("" : "+s"(msk), "+s"(wave_));
        const int lane_ = (int)__builtin_amdgcn_mbcnt_hi(msk, __builtin_amdgcn_mbcnt_lo(msk, 0u));
        const int tid_ = wave_ * 64 + lane_;
        run_step(p, step, lds, tid_, lane_, wave_);
        if (step != 21) grid.sync();
    }
}
#endif

extern "C" void kernel_launch(void* const* d_in, const int* in_sizes, int n_in, void* d_out, int out_size, void* d_ws, size_t ws_size, hipStream_t stream) {
    static int grid = 0;
    if (grid == 0) {
        int dev = 0, cus = 0, per_cu = 0;
        if (n_in != 29 || ws_size < WS_END) { fprintf(stderr, "kernel_launch: unexpected n_in %d / ws_size %zu (need %zu)\n", n_in, ws_size, (size_t)WS_END); }
        hipGetDevice(&dev);
        hipDeviceGetAttribute(&cus, hipDeviceAttributeMultiprocessorCount, dev);
#ifndef MULTI_LAUNCH
        if (hipFuncSetAttribute((const void*)hybrid_fwd, hipFuncAttributeMaxDynamicSharedMemorySize, LDS_BYTES) != hipSuccess) fprintf(stderr, "kernel_launch: hipFuncSetAttribute failed\n");
        if (hipOccupancyMaxActiveBlocksPerMultiprocessor(&per_cu, (const void*)hybrid_fwd, NTHR, LDS_BYTES) != hipSuccess || per_cu < 1) { fprintf(stderr, "kernel_launch: occupancy query gave %d\n", per_cu); per_cu = 1; }
#endif
        (void)hipGetLastError();
        grid = cus > 0 ? cus : 256;
    }
    Params p{};
    for (int i = 0; i < 29; ++i) p.in[i] = (const float*)d_in[i];
    p.out = (float*)d_out; p.ws = (unsigned char*)d_ws;
#ifdef MULTI_LAUNCH
    launch_steps<0>(p, grid, stream);
#else
    void* args[] = {&p};
    hipError_t e = hipLaunchCooperativeKernel((const void*)hybrid_fwd, dim3(grid), dim3(NTHR), args, LDS_BYTES, stream);
    if (e != hipSuccess) fprintf(stderr, "kernel_launch: cooperative launch failed: %s (grid %d)\n", hipGetErrorString(e), grid);
#endif
}
```

```cpp
#include <hip/hip_runtime.h>
#include <hip/hip_cooperative_groups.h>
#include <cstdio>
#include <cstdint>
namespace cg = cooperative_groups;
namespace pg8 {
#define PG8_LAS __attribute__((address_space(3)))
typedef unsigned short bf16_t;
typedef short bf16x8 __attribute__((ext_vector_type(8)));
typedef float f32x4 __attribute__((ext_vector_type(4)));
typedef unsigned u32x4 __attribute__((ext_vector_type(4)));
constexpr int BM = 256, BK = 64, HALF = 128, HTB = HALF * BK * 2  , STAGE_BYTES = 8 * HTB, NXCD = 8, WGM = 8;

__host__ __device__ __forceinline__ int lds_byte(int r, int c) { const int st = (r >> 4) * 2 + (c >> 5), rr = r & 15, cc = c & 31, ob = rr * 64 + cc * 2; return st * 1024 + (ob ^ (((ob >> 9) & 1) << 5)); }
__host__ __device__ __forceinline__ void stage_rc(int b, int& R, int& C) { const int st = b / 1024, sb = b % 1024, swz = sb ^ (((sb >> 9) & 1) << 5); R = (st >> 1) * 16 + swz / 64; C = (st & 1) * 32 + (swz % 64) / 2; }
__host__ __device__ __forceinline__ int perm32(int rho) { const int n = rho >> 4, i = rho & 15; return 8 * (i >> 2) + 4 * n + (i & 3); }

struct Unit { int pm, pn; };
struct Gemm { const bf16_t* A; const bf16_t* Bt; int M, N, K; };

struct StaticOrder {
    int nM, nN, nwg, G, c;
    __host__ __device__ void init(int M, int N, int G_, int c_) { nM = M / BM; nN = N / BM; nwg = nM * nN; G = G_; c = c_; }
    __host__ __device__ bool next(int i, Unit& u) const {
        const long L = (long)i * G + c; if (L >= nwg) return false;
        int wgid = (int)L; { const int q = nwg / NXCD, r = nwg % NXCD, xcd = wgid % NXCD, off = wgid / NXCD; wgid = (xcd < r ? xcd * (q + 1) : r * (q + 1) + (xcd - r) * q) + off; }
        const int nig = WGM * nN, gid = wgid / nig, fm = gid * WGM, gsz = (nM - fm) < WGM ? (nM - fm) : WGM;
        u.pm = fm + ((wgid % nig) % gsz); u.pn = (wgid % nig) / gsz; return true;
    }
    __device__ __forceinline__ void a_ready(const Unit&) const {}
    __device__ __forceinline__ void done(const Unit&) const {}
};
__device__ __forceinline__ unsigned cvtpk(float lo, float hi) { typedef float v2f __attribute__((ext_vector_type(2))); typedef __bf16 v2b __attribute__((ext_vector_type(2))); v2f v = {lo, hi}; v2b b = __builtin_convertvector(v, v2b); return __builtin_bit_cast(unsigned, b); }
__device__ __forceinline__ float sigm(float x) { return 1.0f / (1.0f + __expf(-x)); }
struct EpiStoreBf16 {
    static constexpr bool PERM = true, AFTER_DRAIN = false;
    bf16_t* O; int ldc;
    __device__ __forceinline__ void operator()(const f32x4 (&acc)[2][2][4][2], const Unit& u, int wr, int wc, int fr, int fq) const {
        const int row0 = u.pm * BM + wr * 64 + fr, col0 = u.pn * BM + wc * 32 + 8 * fq;
#pragma unroll
        for (int ai = 0; ai < 2; ++ai)
#pragma unroll
            for (int m = 0; m < 4; ++m) { bf16_t* rowp = O + (size_t)(row0 + ai * HALF + m * 16) * ldc + col0;
#pragma unroll
                for (int bj = 0; bj < 2; ++bj) { const f32x4 v0 = acc[ai][bj][m][0], v1 = acc[ai][bj][m][1];
                    u32x4 w; w.x = cvtpk(v0[0], v0[1]); w.y = cvtpk(v0[2], v0[3]); w.z = cvtpk(v1[0], v1[1]); w.w = cvtpk(v1[2], v1[3]);
                    *(u32x4*)(rowp + bj * HALF) = w; } }
    }
};
struct EpiLora {
    static constexpr bool PERM = true, AFTER_DRAIN = false;
    bf16_t* O; const float* w0; const float* a0;
    __device__ __forceinline__ void operator()(const f32x4 (&acc)[2][2][4][2], const Unit& u, int wr, int wc, int fr, int fq) const {
        const int row0 = u.pm * BM + wr * 64 + fr;
#pragma unroll
        for (int bj = 0; bj < 2; ++bj) {
            const int cb = u.pn * 2 + bj;
            if (cb < 15) {
                const int c0 = cb * 128 + wc * 32 + 8 * fq;
                if (cb >= 12) {
#pragma unroll
                    for (int ai = 0; ai < 2; ++ai)
#pragma unroll
                        for (int m = 0; m < 4; ++m) { const f32x4 v0 = acc[ai][bj][m][0], v1 = acc[ai][bj][m][1];
                            u32x4 w; w.x = cvtpk(v0[0], v0[1]); w.y = cvtpk(v0[2], v0[3]); w.z = cvtpk(v1[0], v1[1]); w.w = cvtpk(v1[2], v1[3]);
                            *(u32x4*)(O + (size_t)(row0 + ai * HALF + m * 16) * 1920 + c0) = w; }
                } else {
                    const int kind = wc >> 1, g = cb / 6, h = cb % 6;
                    const float* a0v = a0; const float* w0v = w0; asm volatile("" : "+s"(a0v), "+s"(w0v));
                    const float* bp = (kind ? a0v : w0v) + g * 384 + h * 64 + (wc & 1) * 32 + 8 * fq;
                    const f32x4 b0 = *(const f32x4*)bp, b1 = *(const f32x4*)(bp + 4);
                    const float mul = kind == 0 ? 0.60653065971263342f : 1.f;
#pragma unroll
                    for (int ai = 0; ai < 2; ++ai)
#pragma unroll
                        for (int m = 0; m < 4; ++m) { const f32x4 v0 = acc[ai][bj][m][0] + b0, v1 = acc[ai][bj][m][1] + b1;
                            u32x4 w; w.x = cvtpk(mul * sigm(v0[0]), mul * sigm(v0[1])); w.y = cvtpk(mul * sigm(v0[2]), mul * sigm(v0[3]));
                            w.z = cvtpk(mul * sigm(v1[0]), mul * sigm(v1[1])); w.w = cvtpk(mul * sigm(v1[2]), mul * sigm(v1[3]));
                            *(u32x4*)(O + (size_t)(row0 + ai * HALF + m * 16) * 1920 + c0) = w; }
                }
            }
        }
    }
};
struct EpiRes {
    static constexpr bool PERM = true, AFTER_DRAIN = false;
    const float* xl; const float* xc; float* ol; float* oc; const float* mod; int gofs;
    __device__ __forceinline__ void operator()(const f32x4 (&acc)[2][2][4][2], const Unit& u, int wr, int wc, int fr, int fq) const {
        const bool lat = u.pm < 256; const int bi = lat ? (u.pm >> 3) : 32;
        const size_t rbase = (size_t)(lat ? u.pm : u.pm - 256) * BM;
        const float* xlv = xl; const float* xcv = xc; float* olv = ol; float* ocv = oc; asm volatile("" : "+s"(xlv), "+s"(xcv), "+s"(olv), "+s"(ocv));
        const float* xin = (lat ? xlv : xcv) + rbase * 1024; float* out = (lat ? olv : ocv) + rbase * 1024;
        const float* gp = mod + (size_t)bi * 6144 + gofs;
        const int col0 = u.pn * BM + wc * 32 + 8 * fq, row0 = wr * 64 + fr;
#pragma unroll
        for (int bj = 0; bj < 2; ++bj)
#pragma unroll
            for (int n = 0; n < 2; ++n) { const int c = col0 + bj * HALF + 4 * n; const f32x4 gt = *(const f32x4*)(gp + c);
#pragma unroll
                for (int ai = 0; ai < 2; ++ai)
#pragma unroll
                    for (int m = 0; m < 4; ++m) { const size_t o = (size_t)(row0 + ai * HALF + m * 16) * 1024 + c;
                        const f32x4 xv = *(const f32x4*)(xin + o); const f32x4 a = acc[ai][bj][m][n];
                        f32x4 r; r[0] = 1.41421356237f * xv[0] + gt[0] * a[0]; r[1] = 1.41421356237f * xv[1] + gt[1] * a[1]; r[2] = 1.41421356237f * xv[2] + gt[2] * a[2]; r[3] = 1.41421356237f * xv[3] + gt[3] * a[3];
                        *(f32x4*)(out + o) = r; } }
    }
};
struct EpiSwiglu {
    static constexpr bool PERM = true, AFTER_DRAIN = false;
    bf16_t* O;
    __device__ __forceinline__ void operator()(const f32x4 (&acc)[2][2][4][2], const Unit& u, int wr, int wc, int fr, int fq) const {
        const int row0 = u.pm * BM + wr * 64 + fr, col0 = u.pn * HALF + wc * 32 + 8 * fq;
#pragma unroll
        for (int ai = 0; ai < 2; ++ai)
#pragma unroll
            for (int m = 0; m < 4; ++m) { float v[8];
#pragma unroll
                for (int i = 0; i < 8; ++i) { const float g = acc[ai][0][m][i >> 2][i & 3], up = acc[ai][1][m][i >> 2][i & 3]; v[i] = g * sigm(g) * up; }
                u32x4 w; w.x = cvtpk(v[0], v[1]); w.y = cvtpk(v[2], v[3]); w.z = cvtpk(v[4], v[5]); w.w = cvtpk(v[6], v[7]);
                *(u32x4*)(O + (size_t)(row0 + ai * HALF + m * 16) * 2816 + col0) = w; }
    }
};
struct EpiAny {
    static constexpr bool PERM = true, AFTER_DRAIN = false;
    int mode; EpiStoreBf16 e0; EpiLora e1; EpiRes e2; EpiSwiglu e3;
    __device__ __forceinline__ void operator()(const f32x4 (&acc)[2][2][4][2], const Unit& u, int wr, int wc, int fr, int fq) const {
        if (mode == 0) e0(acc, u, wr, wc, fr, fq); else if (mode == 1) e1(acc, u, wr, wc, fr, fq); else if (mode == 2) e2(acc, u, wr, wc, fr, fq); else e3(acc, u, wr, wc, fr, fq);
    }
};
template <class Epi, class Sched, bool ALIGN_EPI = false, bool SP2 = false>
__device__ __forceinline__ void gemm_phase(PG8_LAS unsigned char* lds, const Gemm g, const Sched& S, const Epi& E, const int tid) {
    const int wid = __builtin_amdgcn_readfirstlane(tid >> 6), lane = tid & 63, wr = wid >> 2, wc = wid & 3, fr = lane & 15, fq = lane >> 4;
    const int K = g.K, nt = K / BK;
    unsigned voffA[2], voffB[2];
#pragma unroll
    for (int i = 0; i < 2; ++i) { int R, C; stage_rc(tid * 16 + i * 8192, R, C); const int Rb = Epi::PERM ? ((R & ~31) + perm32(R & 31)) : R;
        voffA[i] = (unsigned)(R * K + C) * 2u; voffB[i] = (unsigned)(Rb * K + C) * 2u; }
    const size_t kstep = (size_t)(BK * 2);
    const size_t hstep = (size_t)HALF * K * 2;
    const size_t tstep = 2 * hstep;
    const unsigned ldsw = (unsigned)wid * 1024u;
    const int aoff = lds_byte(wr * 64 + fr, fq * 8), boff = lds_byte(wc * 32 + fr, fq * 8);
#define PG8_SA(b, h) (((b) * 2 + (h)) * HTB)
#define PG8_SB(b, h) ((4 + (b) * 2 + (h)) * HTB)
#define PG8_STAGE(bufoff, gbase, voff) do { _Pragma("unroll") for (int _i = 0; _i < 2; ++_i) \
        __builtin_amdgcn_global_load_lds((const unsigned*)((const char*)(gbase) + (voff)[_i]), (PG8_LAS unsigned*)(lds + (bufoff) + ldsw + _i * 8192), 16, 0, 0); } while (0)
#define PG8_LDA(dst, b, h) do { _Pragma("unroll") for (int m = 0; m < 4; ++m) _Pragma("unroll") for (int k = 0; k < 2; ++k) dst[m][k] = *(const PG8_LAS bf16x8*)(lds + PG8_SA(b, h) + aoff + m * 2048 + k * 1024); } while (0)
#define PG8_LDB(dst, b, h) do { _Pragma("unroll") for (int n = 0; n < 2; ++n) _Pragma("unroll") for (int k = 0; k < 2; ++k) dst[n][k] = *(const PG8_LAS bf16x8*)(lds + PG8_SB(b, h) + boff + n * 2048 + k * 1024); } while (0)
#define PG8_MMA(ai, bj, At, Bt) do { __builtin_amdgcn_s_setprio(1); _Pragma("unroll") for (int m = 0; m < 4; ++m) _Pragma("unroll") for (int n = 0; n < 2; ++n) _Pragma("unroll") for (int k = 0; k < 2; ++k) \
        acc[ai][bj][m][n] = __builtin_amdgcn_mfma_f32_16x16x32_bf16(Bt[n][k], At[m][k], acc[ai][bj][m][n], 0, 0, 0); __builtin_amdgcn_s_setprio(0); } while (0)
#define PG8_WAIT_V(n) asm volatile("s_waitcnt vmcnt(" #n ")" ::: "memory")
#define PG8_WAIT_L(n) asm volatile("s_waitcnt lgkmcnt(" #n ")" ::: "memory")
#define PG8_BAR __builtin_amdgcn_s_barrier()
#define PG8_SCHED __builtin_amdgcn_sched_barrier(0)
    Unit cur, nxt; int ui = 0;
    if (!S.next(0, cur)) return;
    f32x4 acc[2][2][4][2];
#pragma unroll
    for (int a = 0; a < 2; ++a)
#pragma unroll
        for (int b = 0; b < 2; ++b)
#pragma unroll
            for (int m = 0; m < 4; ++m)
#pragma unroll
                for (int n = 0; n < 2; ++n) acc[a][b][m][n] = (f32x4){0.f, 0.f, 0.f, 0.f};
    bf16x8 At[4][2], B0[2][2], B1[2][2];
    const char* cA = (const char*)g.A + (size_t)cur.pm * tstep; const char* cB = (const char*)g.Bt + (size_t)cur.pn * tstep;
    S.a_ready(cur);
    if constexpr (SP2) {
        PG8_STAGE(PG8_SB(0, 0), cB, voffB); PG8_STAGE(PG8_SB(0, 1), cB + hstep, voffB); PG8_STAGE(PG8_SA(0, 0), cA, voffA); PG8_STAGE(PG8_SA(0, 1), cA + hstep, voffA);
        if (wr == 1) PG8_BAR;
        PG8_WAIT_V(2); PG8_BAR;
        PG8_STAGE(PG8_SB(1, 0), cB + kstep, voffB); PG8_STAGE(PG8_SA(1, 0), cA + kstep, voffA); PG8_STAGE(PG8_SB(1, 1), cB + hstep + kstep, voffB);
        PG8_WAIT_V(6); PG8_BAR;
    } else {
        PG8_STAGE(PG8_SB(0, 0), cB, voffB); PG8_STAGE(PG8_SA(0, 0), cA, voffA); PG8_STAGE(PG8_SB(0, 1), cB + hstep, voffB); PG8_STAGE(PG8_SA(0, 1), cA + hstep, voffA);
        if (wr == 1) PG8_BAR;
        PG8_WAIT_V(4); PG8_BAR;
        PG8_STAGE(PG8_SB(1, 0), cB + kstep, voffB); PG8_STAGE(PG8_SA(1, 0), cA + kstep, voffA); PG8_STAGE(PG8_SB(1, 1), cB + hstep + kstep, voffB);
        PG8_WAIT_V(6); PG8_BAR;
    }
    for (;;) {
        const bool has_next = S.next(ui + 1, nxt);
        const char* nA = has_next ? (const char*)g.A + (size_t)nxt.pm * tstep : cA; const char* nB = has_next ? (const char*)g.Bt + (size_t)nxt.pn * tstep : cB;
        for (int t = 0; t < nt; t += 2) {
            const bool last = (t == nt - 2);
            const char* a1 = cA + (size_t)(t + 1) * kstep;
            const char* a2 = last ? nA : cA + (size_t)(t + 2) * kstep; const char* b2 = last ? nB : cB + (size_t)(t + 2) * kstep;
            const char* a3 = a2 + kstep; const char* b3 = b2 + kstep;
            if (last && has_next) S.a_ready(nxt);
            if constexpr (SP2) {
            PG8_LDB(B0, 0, 0); PG8_LDB(B1, 0, 1); PG8_SCHED; PG8_LDA(At, 0, 0); PG8_STAGE(PG8_SA(1, 1), a1 + hstep, voffA);
            PG8_WAIT_V(8); PG8_WAIT_L(0); PG8_BAR; PG8_MMA(0, 0, At, B0); PG8_MMA(0, 1, At, B1); PG8_BAR; PG8_SCHED;
            PG8_LDA(At, 0, 1); PG8_STAGE(PG8_SB(0, 0), b2, voffB); PG8_STAGE(PG8_SB(0, 1), b2 + hstep, voffB); PG8_STAGE(PG8_SA(0, 0), a2, voffA);
            PG8_WAIT_V(8); PG8_WAIT_L(0); PG8_BAR; PG8_MMA(1, 0, At, B0); PG8_MMA(1, 1, At, B1); PG8_BAR; PG8_SCHED;
            PG8_LDB(B0, 1, 0); PG8_LDB(B1, 1, 1); PG8_SCHED; PG8_LDA(At, 1, 0); PG8_STAGE(PG8_SA(0, 1), a2 + hstep, voffA);
            PG8_WAIT_V(8); PG8_WAIT_L(0); PG8_BAR; PG8_MMA(0, 0, At, B0); PG8_MMA(0, 1, At, B1); PG8_BAR; PG8_SCHED;
            PG8_LDA(At, 1, 1); PG8_STAGE(PG8_SB(1, 0), b3, voffB); PG8_STAGE(PG8_SB(1, 1), b3 + hstep, voffB); PG8_STAGE(PG8_SA(1, 0), a3, voffA);
            PG8_WAIT_V(8); PG8_WAIT_L(0); PG8_BAR; PG8_MMA(1, 0, At, B0); PG8_MMA(1, 1, At, B1); PG8_BAR; PG8_SCHED;
            } else {
            PG8_LDB(B0, 0, 0); PG8_SCHED; PG8_LDA(At, 0, 0); PG8_STAGE(PG8_SA(1, 1), a1 + hstep, voffA);
            PG8_WAIT_L(8); PG8_BAR; PG8_WAIT_L(0); PG8_MMA(0, 0, At, B0); PG8_BAR; PG8_SCHED;
            PG8_LDB(B1, 0, 1); PG8_STAGE(PG8_SB(0, 0), b2, voffB);
            PG8_BAR; PG8_WAIT_L(0); PG8_MMA(0, 1, At, B1); PG8_BAR;
            PG8_LDA(At, 0, 1); PG8_STAGE(PG8_SA(0, 0), a2, voffA);
            PG8_BAR; PG8_WAIT_L(0); PG8_MMA(1, 0, At, B0); PG8_BAR; PG8_SCHED;
            PG8_STAGE(PG8_SB(0, 1), b2 + hstep, voffB);
            PG8_WAIT_V(6); PG8_BAR; PG8_MMA(1, 1, At, B1); PG8_BAR;
            PG8_LDB(B0, 1, 0); PG8_SCHED; PG8_LDA(At, 1, 0); PG8_STAGE(PG8_SA(0, 1), a2 + hstep, voffA);
            PG8_WAIT_L(8); PG8_BAR; PG8_WAIT_L(0); PG8_MMA(0, 0, At, B0); PG8_BAR; PG8_SCHED;
            PG8_LDB(B1, 1, 1); PG8_STAGE(PG8_SB(1, 0), b3, voffB);
            PG8_BAR; PG8_WAIT_L(0); PG8_MMA(0, 1, At, B1); PG8_BAR;
            PG8_LDA(At, 1, 1); PG8_STAGE(PG8_SA(1, 0), a3, voffA);
            PG8_BAR; PG8_WAIT_L(0); PG8_MMA(1, 0, At, B0); PG8_BAR; PG8_SCHED;
            PG8_STAGE(PG8_SB(1, 1), b3 + hstep, voffB);
            PG8_WAIT_V(6); PG8_BAR; PG8_MMA(1, 1, At, B1); PG8_BAR;
            }
        }
        if constexpr (ALIGN_EPI) { if (wr == 0) PG8_BAR; }
        if constexpr (!Epi::AFTER_DRAIN) { E(acc, cur, wr, wc, fr, fq); S.done(cur); }
        if (!has_next) break;
#pragma unroll
        for (int a = 0; a < 2; ++a)
#pragma unroll
            for (int b = 0; b < 2; ++b)
#pragma unroll
                for (int m = 0; m < 4; ++m)
#pragma unroll
                    for (int n = 0; n < 2; ++n) acc[a][b][m][n] = (f32x4){0.f, 0.f, 0.f, 0.f};
        cur = nxt; cA = nA; cB = nB; ++ui;
        if constexpr (ALIGN_EPI) { if (wr == 1) PG8_BAR; }
    }
    PG8_WAIT_V(0);
    if constexpr (!ALIGN_EPI) { if (wr == 0) PG8_BAR; }
    PG8_BAR;
    if constexpr (Epi::AFTER_DRAIN) { E.fused(acc, cur, wr, wc, fr, fq, lds, wid, lane); S.done(cur); }
#undef PG8_SA
#undef PG8_SB
#undef PG8_STAGE
#undef PG8_LDA
#undef PG8_LDB
#undef PG8_MMA
#undef PG8_WAIT_V
#undef PG8_WAIT_L
#undef PG8_BAR
#undef PG8_SCHED
}
}

#define DI __device__ __forceinline__
#define LAS __attribute__((address_space(3)))
using pg8::bf16_t; using pg8::bf16x8; using pg8::f32x4; using pg8::u32x4; using pg8::cvtpk; using pg8::sigm;
typedef float f32x2 __attribute__((ext_vector_type(2)));
typedef unsigned u32x2 __attribute__((ext_vector_type(2)));

#ifndef NAT_GLA_PCT
#define NAT_GLA_PCT 0
#endif
#ifndef MIXMASK
#define MIXMASK 3
#endif
#ifndef ROLEMASK
#define ROLEMASK 15
#endif
#ifndef PHMASK
#define PHMASK 0xffff
#endif
constexpr int NTHR = 512, NWAVE = 8, LDS_BYTES = 147456;
constexpr int D = 1024, NB = 32, SL = 2048, CL = 256, ML = NB * SL, MC = NB * CL, MT = ML + MC;
constexpr int INC = 3488, PLD = 3584, FH = 2816, LOLD = 1920;
constexpr int C_GQ = 0, C_GK = 192, C_GV = 384, C_GG = 768, C_GDN = 1152;
constexpr int C_NQ = 1184, C_NK = 1440, C_NV = 1696;
constexpr int C_RW = 1952;
constexpr size_t OFF_WIN = 0, OFF_WOUT = 7340032, OFF_W13 = 9437184, OFF_W2 = 20971520, OFF_BT2 = 26738688, WLB = 28311552;
constexpr size_t WS_MOD = 2 * WLB, WS_ROPE = WS_MOD + 1622016, WS_BON = WS_ROPE + 262144, WS_VT = WS_BON + 3538944, WS_AY = WS_VT + 37748736,
                 WS_PB = WS_AY + 150994944, WS_LO = WS_PB + 528482304, WS_END = WS_LO + 283115520;

struct Params { const float* in[29]; float* out; unsigned char* ws; };
enum { I_X = 0, I_C, I_CTX, I_CCTX, I_WMOD, I_BMOD, I_WIN, I_GUP, I_GB, I_GNW, I_RPB, I_MU, I_W0, I_WD2, I_A0, I_WA2, I_WG2, I_KK, I_KA, I_RK, I_GNWT, I_GNB,
       I_WOUT, I_LN1W, I_LN1B, I_W13, I_W2, I_LN2W, I_LN2B };

DI const float* pin(const Params& p, int i) { asm volatile("" : "+s"(i)); return p.in[i]; }
DI float bf2f(bf16_t h) { return __uint_as_float(((unsigned)h) << 16); }
DI float bflo(unsigned u) { return __uint_as_float(u << 16); }
DI float bfhi(unsigned u) { return __uint_as_float(u & 0xffff0000u); }
DI bf16_t f2bf(float f) { return (bf16_t)(cvtpk(f, 0.f) & 0xffffu); }
DI float shx(float v, int m, int lane) { return __int_as_float(__builtin_amdgcn_ds_bpermute((lane ^ m) << 2, __float_as_int(v))); }
DI float wave_sum(float v, int lane) {
#pragma unroll
    for (int o = 1; o < 64; o <<= 1) v += shx(v, o, lane);
    return v;
}
DI void load8(const bf16_t* p, float* o) { const u32x4 u = *(const u32x4*)p; o[0] = bflo(u.x); o[1] = bfhi(u.x); o[2] = bflo(u.y); o[3] = bfhi(u.y); o[4] = bflo(u.z); o[5] = bfhi(u.z); o[6] = bflo(u.w); o[7] = bfhi(u.w); }
DI void load16(const bf16_t* p, float (&o)[16]) { load8(p, &o[0]); load8(p + 8, &o[8]); }
DI void shift16(const bf16_t* prow, bool hasm, bool hasp, const float* mu, float (&y)[16]) {
    float c0[16], cm[16], cp[16];
    load16(prow, c0);
    if (hasm) load16(prow - PLD, cm); else {
#pragma unroll
        for (int j = 0; j < 16; ++j) cm[j] = 0.f; }
    if (hasp) load16(prow + PLD, cp); else {
#pragma unroll
        for (int j = 0; j < 16; ++j) cp[j] = 0.f; }
#pragma unroll
    for (int j = 0; j < 16; ++j) y[j] = c0[j] + (0.5f * (cm[j] + cp[j]) - c0[j]) * mu[j];
}
DI void step_row(int s, int g, int b, int& row, int& ts, int& Ls) {
    if (s < CL) { ts = g ? (CL - 1 - s) : s; row = ML + b * CL + ts; Ls = CL; }
    else { const int u = s - CL; ts = g ? (SL - 1 - u) : u; row = b * SL + ts; Ls = SL; }
}

DI void transpose_item(const float* W, int N, bf16_t* WT, int Kd, size_t dst_row0, int k0, int n0, LAS float* scr, int lane) {
#pragma unroll 8
    for (int i = 0; i < 32; ++i) { const int kk = 2 * i + (lane >> 5); scr[kk * 33 + (lane & 31)] = W[(size_t)(k0 + kk) * N + n0 + (lane & 31)]; }
    asm volatile("s_waitcnt lgkmcnt(0)" ::: "memory");
    const int c = lane & 7;
#pragma unroll
    for (int j = 0; j < 4; ++j) { const int n = (lane >> 3) + 8 * j; const LAS float* s = scr + (8 * c) * 33 + n;
        u32x4 o; o.x = cvtpk(s[0 * 33], s[1 * 33]); o.y = cvtpk(s[2 * 33], s[3 * 33]); o.z = cvtpk(s[4 * 33], s[5 * 33]); o.w = cvtpk(s[6 * 33], s[7 * 33]);
        *(u32x4*)(WT + (dst_row0 + n) * Kd + k0 + 8 * c) = o; }
    asm volatile("s_waitcnt lgkmcnt(0)" ::: "memory");
}

DI void phase_prologue(const Params& p, LAS unsigned char* lds, int tid, int lane, int wave) {
    unsigned char* ws = p.ws;
    float* MOD = (float*)(ws + WS_MOD);
    {
        LAS float* sc = (LAS float*)lds;
        LAS float* part = (LAS float*)(lds + 135168);
        for (int i = tid; i < 33 * 1024; i += NTHR) { const int bi = i >> 10, k = i & 1023; const float cv = bi < 32 ? pin(p, I_C)[bi * 1024 + k] : pin(p, I_CCTX)[k]; sc[k * 33 + bi] = cv * sigm(cv); }
        __syncthreads();
        for (int u = blockIdx.x; u < 192; u += gridDim.x) {
            const int l = u / 96, n0 = (u % 96) * 64;
            float acc[33];
#pragma unroll
            for (int bi = 0; bi < 33; ++bi) acc[bi] = 0.f;
            const float* wp = pin(p, I_WMOD) + (size_t)l * 1024 * 6144 + n0 + lane;
#pragma unroll 4
            for (int kk = 0; kk < 128; ++kk) { const int k = wave * 128 + kk; const float w = wp[(size_t)k * 6144];
#pragma unroll
                for (int bi = 0; bi < 33; ++bi) acc[bi] += sc[k * 33 + bi] * w; }
            for (int w = 0; w < NWAVE; ++w) {
                if (wave == w) {
#pragma unroll
                    for (int bi = 0; bi < 33; ++bi) { if (w == 0) part[bi * 64 + lane] = acc[bi]; else part[bi * 64 + lane] += acc[bi]; } }
                __syncthreads();
            }
            for (int i = tid; i < 33 * 64; i += NTHR) { const int bi = i >> 6, n = i & 63; MOD[(size_t)(l * 33 + bi) * 6144 + n0 + n] = part[i] + pin(p, I_BMOD)[l * 6144 + n0 + n]; }
            __syncthreads();
        }
        __syncthreads();
    }
    const int gw = blockIdx.x * NWAVE + wave, NGW = gridDim.x * NWAVE;
    const int gt = blockIdx.x * NTHR + tid, NGT = gridDim.x * NTHR;
    {
        LAS float* scr = (LAS float*)(lds + wave * 8448);
        constexpr int IT_IN = 16 * 109, IT_OUT = 16 * 32, IT_13 = 16 * 176, IT_2 = 44 * 32, IT_L = IT_IN + IT_OUT + IT_13 + IT_2;
        for (int it = gw; it < 2 * IT_L; it += NGW) {
            const int l = it / IT_L; int r = it % IT_L;
            unsigned char* wl = ws + (size_t)l * WLB;
            if (r < IT_IN) { const int kb = r / 109, nb = r % 109;
                transpose_item(pin(p, I_WIN) + (size_t)l * 1024 * INC, INC, (bf16_t*)(wl + OFF_WIN), 1024, (size_t)nb * 32, kb * 64, nb * 32, scr, lane); continue; }
            r -= IT_IN;
            if (r < IT_OUT) { const int kb = r / 32, nb = r % 32;
                transpose_item(pin(p, I_WOUT) + (size_t)l * 1024 * 1024, 1024, (bf16_t*)(wl + OFF_WOUT), 1024, (size_t)nb * 32, kb * 64, nb * 32, scr, lane); continue; }
            r -= IT_OUT;
            if (r < IT_13) { const int kb = r / 176, nb = r % 176; const int n0 = nb * 32;
                const int j = n0 < FH ? n0 : n0 - FH; const size_t drow = (size_t)(256 * (j / 128) + (n0 < FH ? 0 : 128) + (j % 128));
                transpose_item(pin(p, I_W13) + (size_t)l * 1024 * 2 * FH, 2 * FH, (bf16_t*)(wl + OFF_W13), 1024, drow, kb * 64, n0, scr, lane); continue; }
            r -= IT_13;
            { const int kb = r / 32, nb = r % 32;
                transpose_item(pin(p, I_W2) + (size_t)l * FH * 1024, 1024, (bf16_t*)(wl + OFF_W2), FH, (size_t)nb * 32, kb * 64, nb * 32, scr, lane); }
        }
    }
    for (int i = gt; i < 2 * 96 * 1024; i += NGT) { const int l = i / (96 * 1024), r = i % (96 * 1024); ((bf16_t*)(ws + (size_t)l * WLB + OFF_WIN))[(size_t)INC * 1024 + r] = 0; }
    for (int i = gt; i < 2 * 2048 * 384; i += NGT) {
        const int l = i / (2048 * 384), r = i % (2048 * 384), n = r / 384, k = r % 384;
        float v = 0.f;
        if (n < 1536) { const int g = n / 768, h = (n % 768) / 128, which = (n % 128) / 64, ch = n % 64, c = h * 64 + ch;
            const int kb = which ? 128 + 64 * g : 64 * g;
            if (k >= kb && k < kb + 64) v = (which ? pin(p, I_WA2) : pin(p, I_WD2))[((size_t)(l * 2 + g) * 64 + (k - kb)) * 384 + c]; }
        else if (n < 1920) { if (k >= 256) v = pin(p, I_WG2)[((size_t)l * 128 + (k - 256)) * 384 + (n - 1536)]; }
        ((bf16_t*)(ws + (size_t)l * WLB + OFF_BT2))[r] = f2bf(v);
    }
    for (int i = gt; i < SL * 16; i += NGT) { const int t = i >> 4, pi = i & 15; const float pos = (float)(pi < 8 ? (t >> 6) : (t & 63));
        const float inv = powf(10000.0f, -(float)(pi & 7) * 0.125f); const float ang = pos * inv;
        float* rt = (float*)(ws + WS_ROPE) + (size_t)i * 2; rt[0] = cosf(ang); rt[1] = sinf(ang); }
}

DI void phase_modulate0(const Params& p, int lane, int wave) {
    const int gw = blockIdx.x * NWAVE + wave, NGW = gridDim.x * NWAVE;
    const float* MOD = (const float*)(p.ws + WS_MOD); bf16_t* A = (bf16_t*)(p.ws + WS_AY);
    for (int row = gw; row < MT; row += NGW) {
        const float* src = row < ML ? pin(p, I_X) + (size_t)row * D : pin(p, I_CTX) + (size_t)(row - ML) * D;
        const int bi = row < ML ? (row >> 11) : 32; const float* md = MOD + (size_t)bi * 6144;
#pragma unroll
        for (int j = 0; j < 4; ++j) { const int c = 4 * (lane + 64 * j); const f32x4 v = *(const f32x4*)(src + c), sh = *(const f32x4*)(md + c), sc = *(const f32x4*)(md + 1024 + c);
            u32x2 o; o.x = cvtpk(v[0] * (1.f + sc[0]) + sh[0], v[1] * (1.f + sc[1]) + sh[1]); o.y = cvtpk(v[2] * (1.f + sc[2]) + sh[2], v[3] * (1.f + sc[3]) + sh[3]);
            *(u32x2*)(A + (size_t)row * D + c) = o; }
    }
}
DI void phase_ln(const Params& p, int lane, int wave, int nrows, const float* lnw, const float* lnb, const float* modl, int sh_ofs, int sc_ofs, bool write_x, bool write_A) {
    const int gw = blockIdx.x * NWAVE + wave, NGW = gridDim.x * NWAVE;
    bf16_t* A = (bf16_t*)(p.ws + WS_AY); float* tc = (float*)(p.ws + WS_VT);
    for (int row = gw; row < nrows; row += NGW) {
        const bool lat = row < ML;
        float* t = lat ? p.out + (size_t)row * D : tc + (size_t)(row - ML) * D;
        const int bi = lat ? (row >> 11) : 32;
        f32x4 v[4]; float s = 0.f;
#pragma unroll
        for (int j = 0; j < 4; ++j) { v[j] = *(const f32x4*)(t + 4 * (lane + 64 * j)); s += (v[j][0] + v[j][1]) + (v[j][2] + v[j][3]); }
        const float mean = wave_sum(s, lane) * (1.f / D); float s2 = 0.f;
#pragma unroll
        for (int j = 0; j < 4; ++j) { v[j] = v[j] - mean; s2 += (v[j][0] * v[j][0] + v[j][1] * v[j][1]) + (v[j][2] * v[j][2] + v[j][3] * v[j][3]); }
        const float rstd = rsqrtf(wave_sum(s2, lane) * (1.f / D) + 1e-5f);
        const float* md = modl + (size_t)bi * 6144;
#pragma unroll
        for (int j = 0; j < 4; ++j) { const int c = 4 * (lane + 64 * j); const f32x4 w = *(const f32x4*)(lnw + c), b = *(const f32x4*)(lnb + c);
            f32x4 y; y[0] = v[j][0] * rstd * w[0] + b[0]; y[1] = v[j][1] * rstd * w[1] + b[1]; y[2] = v[j][2] * rstd * w[2] + b[2]; y[3] = v[j][3] * rstd * w[3] + b[3];
            if (write_x && lat) *(f32x4*)(t + c) = y;
            else if (write_x) *(f32x4*)(t + c) = y;
            if (write_A) { const f32x4 sh = *(const f32x4*)(md + sh_ofs + c), sc = *(const f32x4*)(md + sc_ofs + c);
                u32x2 o; o.x = cvtpk(y[0] * (1.f + sc[0]) + sh[0], y[1] * (1.f + sc[1]) + sh[1]); o.y = cvtpk(y[2] * (1.f + sc[2]) + sh[2], y[3] * (1.f + sc[3]) + sh[3]);
                *(u32x2*)(A + (size_t)row * D + c) = o; } }
    }
}

DI void phase_prep(const Params& p, int l, LAS unsigned char* lds, int lane, int wave) {
    const int gw = blockIdx.x * NWAVE + wave, NGW = gridDim.x * NWAVE;
    const bf16_t* PB = (const bf16_t*)(p.ws + WS_PB); bf16_t* A2 = (bf16_t*)(p.ws + WS_AY); bf16_t* VT = (bf16_t*)(p.ws + WS_VT);
    const float* mu = pin(p, I_MU) + (size_t)l * 1536 + 1152;
    for (int row = gw; row < MT; row += NGW) {
        const bool lat = row < ML; const int t = lat ? (row & (SL - 1)) : ((row - ML) & (CL - 1)); const int Ls = lat ? SL : CL;
        const bf16_t* pr = PB + (size_t)row * PLD + C_RW + 1152;
#pragma unroll
        for (int i = 0; i < 6; ++i) { const int j = lane + 64 * i;
            const float c0 = bf2f(pr[j]); const float cm = t > 0 ? bf2f(pr[j - PLD]) : 0.f; const float cp = t < Ls - 1 ? bf2f(pr[j + PLD]) : 0.f;
            const float y = c0 + (0.5f * (cm + cp) - c0) * mu[j];
            float o;
            if (i < 2) o = 1.f - 2.f / (1.f + __expf(2.f * y)); else if (i < 4) o = y; else o = sigm(y);
            A2[(size_t)row * 384 + j] = f2bf(o); }
    }
    LAS bf16_t* tile = (LAS bf16_t*)(lds + wave * 8448);
    for (int it = gw; it < NB * 4 * 36; it += NGW) {
        const int tb = it % 36, h = (it / 36) & 3, b = it / 144;
        const int row0 = tb < 32 ? b * SL + tb * 64 : ML + b * CL + (tb - 32) * 64; const int tk0 = tb * 64;
        const bf16_t* src = PB + (size_t)row0 * PLD + C_NV + h * 64 + lane;
#pragma unroll 8
        for (int i = 0; i < 64; ++i) tile[i * 66 + lane] = src[(size_t)i * PLD];
        asm volatile("s_waitcnt vmcnt(0) lgkmcnt(0)" ::: "memory");
        bf16_t* dst = VT + ((size_t)(b * 4 + h) * 64) * 2304 + tk0 + lane;
#pragma unroll 8
        for (int d = 0; d < 64; ++d) dst[(size_t)d * 2304] = tile[lane * 66 + d];
        asm volatile("s_waitcnt lgkmcnt(0)" ::: "memory");
    }
}

#define MFMA16(a, b, c) __builtin_amdgcn_mfma_f32_16x16x32_bf16((a), (b), (c), 0, 0, 0)
DI u32x4 vload16(const bf16_t* p) { const volatile unsigned* q = (const volatile unsigned*)p; u32x4 r; r.x = q[0]; r.y = q[1]; r.z = q[2]; r.w = q[3]; return r; }
DI u32x2 vload8(const bf16_t* p) { const volatile unsigned* q = (const volatile unsigned*)p; u32x2 r; r.x = q[0]; r.y = q[1]; return r; }
struct NatPair { bf16x8 k[2][2]; u32x2 v[4][2]; u32x2 bias[2]; };
DI void nat_unit(const Params& p, int l, int id, bool isctx, int lane) {
    const bf16_t* PB = (const bf16_t*)(p.ws + WS_PB); const bf16_t* VT = (const bf16_t*)(p.ws + WS_VT); bf16_t* AY = (bf16_t*)(p.ws + WS_AY);
    const int l15 = lane & 15, g = lane >> 4;
    int b, h, r = 0, qt, qrow;
    if (!isctx) { qt = id & 3; r = (id >> 2) & 31; h = (id >> 7) & 3; b = id >> 9; qrow = b * SL + r * 64 + 16 * qt + l15; }
    else { qt = id & 15; h = (id >> 4) & 3; b = id >> 6; qrow = ML + b * CL + 16 * qt + l15; }
    const bf16_t* qp = PB + (size_t)qrow * PLD + C_NQ + h * 64 + 8 * g;
    const bf16x8 qf0 = *(const bf16x8*)qp, qf1 = *(const bf16x8*)(qp + 32);
    const int rs = min(max(r - 4, 0), 24);
    int ct_lo = 0, nct = 1;
    if (!isctx) { const int lo = min(max(16 * qt - 8, 0), 48), hi = min(max(16 * qt + 7, 0), 48) + 16; ct_lo = lo >> 4; nct = ((hi - 1) >> 4) - ct_lo + 1; }
    const int nloc = isctx ? 0 : 8 * nct, npairs = nloc / 2 + 8;
    const int qc = 16 * qt + l15, cs = min(max(qc - 8, 0), 48);
    float m = -1e30f, lsum = 0.f;
    f32x4 oacc[4];
#pragma unroll
    for (int dt = 0; dt < 4; ++dt) oacc[dt] = (f32x4){0.f, 0.f, 0.f, 0.f};
    const bf16_t* vt = VT + ((size_t)(b * 4 + h) * 64 + l15) * 2304 + 4 * g;
    const bf16_t* kbase = PB + (size_t)l15 * PLD + C_NK + h * 64 + 8 * g;
    const float* rp = pin(p, I_RPB) + (size_t)((l * 4 + h) * 15) * 31;
    NatPair ring[4];
    int iti = 0, ikr = 0, icj = 0;
#define NAT_ISSUE(slot) do { __builtin_amdgcn_sched_barrier(0); _Pragma("unroll") for (int e = 0; e < 2; ++e) { int tk, keyrow; f32x4 bs = (f32x4){0.f, 0.f, 0.f, 0.f}; \
        if (iti < nloc) { const int ct = ct_lo + icj; tk = (rs + ikr) * 64 + 16 * ct; keyrow = b * SL + tk; const float* rpr = rp + (rs + ikr - r + 7) * 31; \
            _Pragma("unroll") for (int rg = 0; rg < 4; ++rg) { const int kc = 16 * ct + 4 * g + rg; const bool vis = (kc >= cs) && (kc < cs + 16); const float bv = rpr[min(max(kc - qc + 15, 0), 30)]; bs[rg] = vis ? bv : -1e30f; } \
            if (++icj == nct) { icj = 0; ++ikr; } } \
        else { const int j = (iti - nloc) * 16; tk = SL + j; keyrow = ML + b * CL + j; } \
        ++iti; ring[slot].bias[e] = (u32x2){cvtpk(bs[0], bs[1]), cvtpk(bs[2], bs[3])}; \
        const bf16_t* kp = kbase + (size_t)keyrow * PLD; ring[slot].k[e][0] = *(const bf16x8*)kp; ring[slot].k[e][1] = *(const bf16x8*)(kp + 32); \
        _Pragma("unroll") for (int dt = 0; dt < 4; ++dt) ring[slot].v[dt][e] = *(const u32x2*)(vt + (size_t)(16 * dt) * 2304 + tk); } __builtin_amdgcn_sched_barrier(0); } while (0)
#pragma unroll
    for (int j = 0; j < 4; ++j) NAT_ISSUE(j);
    for (int pi0 = 0; pi0 < npairs; pi0 += 4) {
#pragma unroll
        for (int j = 0; j < 4; ++j) {
            const int pi = pi0 + j;
            f32x4 s[2];
#pragma unroll
            for (int e = 0; e < 2; ++e) {
                f32x4 a = (f32x4){0.f, 0.f, 0.f, 0.f};
                a = MFMA16(ring[j].k[e][0], qf0, a); a = MFMA16(ring[j].k[e][1], qf1, a);
                const u32x2 bb = ring[j].bias[e];
                s[e] = a * 0.125f + (f32x4){bflo(bb.x), bfhi(bb.x), bflo(bb.y), bfhi(bb.y)};
            }
            float tmax = fmaxf(fmaxf(fmaxf(s[0][0], s[0][1]), fmaxf(s[0][2], s[0][3])), fmaxf(fmaxf(s[1][0], s[1][1]), fmaxf(s[1][2], s[1][3])));
            tmax = fmaxf(tmax, shx(tmax, 16, lane)); tmax = fmaxf(tmax, shx(tmax, 32, lane));
            const float mn = fmaxf(m, tmax), corr = __expf(m - mn); m = mn;
            float pv[8]; float ps = 0.f;
#pragma unroll
            for (int i = 0; i < 8; ++i) { const float sv = s[i >> 2][i & 3]; pv[i] = sv > -1e29f ? __expf(sv - mn) : 0.f; ps += pv[i]; }
            lsum = lsum * corr + ps;
            u32x4 pk; pk.x = cvtpk(pv[0], pv[1]); pk.y = cvtpk(pv[2], pv[3]); pk.z = cvtpk(pv[4], pv[5]); pk.w = cvtpk(pv[6], pv[7]);
            const bf16x8 pf = __builtin_bit_cast(bf16x8, pk);
#pragma unroll
            for (int dt = 0; dt < 4; ++dt) {
                u32x4 vv; vv.x = ring[j].v[dt][0].x; vv.y = ring[j].v[dt][0].y; vv.z = ring[j].v[dt][1].x; vv.w = ring[j].v[dt][1].y;
                oacc[dt] = oacc[dt] * corr;
                oacc[dt] = MFMA16(__builtin_bit_cast(bf16x8, vv), pf, oacc[dt]);
            }
            if (pi + 4 < npairs) NAT_ISSUE(j);
        }
    }
#undef NAT_ISSUE
    lsum += shx(lsum, 16, lane); lsum += shx(lsum, 32, lane);
    const float inv = 1.0f / lsum;
    bf16_t* yp = AY + (size_t)qrow * D + 768 + h * 64 + 4 * g;
#pragma unroll
    for (int dt = 0; dt < 4; ++dt) { u32x2 o; o.x = cvtpk(oacc[dt][0] * inv, oacc[dt][1] * inv); o.y = cvtpk(oacc[dt][2] * inv, oacc[dt][3] * inv); *(u32x2*)(yp + 16 * dt) = o; }
}

constexpr int RW_STEP = 384, RW_BUF = 16 * RW_STEP, GL_STEP = 160, GL_BUF = 16 * GL_STEP, NCHUNK = (CL + SL) / 16;
struct RwRaw { u32x4 d[3][3][2]; u32x4 lo[4]; };
DI void rwkv_load(const Params& p, int item, int c, RwRaw& R, int lane) {
    const int g = item & 1, h = (item >> 1) % 6, b = item / 12;
    const int ti = lane >> 2, cg = lane & 3;
    int row, ts, Ls; step_row(16 * c + ti, g, b, row, ts, Ls);
    const int rm = ts > 0 ? row - 1 : row, rp = ts < Ls - 1 ? row + 1 : row;
    const bf16_t* PB = (const bf16_t*)(p.ws + WS_PB) + C_RW + h * 64 + 16 * cg;
    const bf16_t* p0 = PB + (size_t)row * PLD; const bf16_t* pm = PB + (size_t)rm * PLD; const bf16_t* pp = PB + (size_t)rp * PLD;
#pragma unroll
    for (int a = 0; a < 3; ++a)
#pragma unroll
        for (int hf = 0; hf < 2; ++hf) { R.d[a][0][hf] = *(const u32x4*)(pm + a * 384 + 8 * hf); R.d[a][1][hf] = *(const u32x4*)(p0 + a * 384 + 8 * hf); R.d[a][2][hf] = *(const u32x4*)(pp + a * 384 + 8 * hf); }
    const bf16_t* lo = (const bf16_t*)(p.ws + WS_LO) + (size_t)row * LOLD + (g * 6 + h) * 128 + 16 * cg;
    R.lo[0] = *(const u32x4*)lo; R.lo[1] = *(const u32x4*)(lo + 8); R.lo[2] = *(const u32x4*)(lo + 64); R.lo[3] = *(const u32x4*)(lo + 72);
}
DI void cvt8(const u32x4 u, float* o) { o[0] = bflo(u.x); o[1] = bfhi(u.x); o[2] = bflo(u.y); o[3] = bfhi(u.y); o[4] = bflo(u.z); o[5] = bfhi(u.z); o[6] = bflo(u.w); o[7] = bfhi(u.w); }
DI void rwkv_compute(const Params& p, int item, int c, const RwRaw& R, LAS float* buf, const LAS float* CST, int lane) {
    const int g = item & 1, h = (item >> 1) % 6, b = item / 12;
    const int ti = lane >> 2, cg = lane & 3;
    int row, ts, Ls; step_row(16 * c + ti, g, b, row, ts, Ls);
    const float mm = ts > 0 ? 0.5f : 0.f, mp = ts < Ls - 1 ? 0.5f : 0.f;
    float y[3][16];
#pragma unroll
    for (int a = 0; a < 3; ++a) {
        float c0[16], cm[16], cp[16];
        cvt8(R.d[a][0][0], &cm[0]); cvt8(R.d[a][0][1], &cm[8]); cvt8(R.d[a][1][0], &c0[0]); cvt8(R.d[a][1][1], &c0[8]); cvt8(R.d[a][2][0], &cp[0]); cvt8(R.d[a][2][1], &cp[8]);
#pragma unroll
        for (int j4 = 0; j4 < 4; ++j4) { const f32x4 mu = *(const LAS f32x4*)(CST + a * 64 + 16 * cg + 4 * j4);
#pragma unroll
            for (int jj = 0; jj < 4; ++jj) { const int j = 4 * j4 + jj; y[a][j] = c0[j] + ((mm * cm[j] + mp * cp[j]) - c0[j]) * mu[jj]; } }
    }
    float lw[16], a[16];
    cvt8(R.lo[0], &lw[0]); cvt8(R.lo[1], &lw[8]); cvt8(R.lo[2], &a[0]); cvt8(R.lo[3], &a[8]);
    float kkv[16]; float ss = 0.f;
#pragma unroll
    for (int j4 = 0; j4 < 4; ++j4) { const f32x4 kc = *(const LAS f32x4*)(CST + 3 * 64 + 16 * cg + 4 * j4);
#pragma unroll
        for (int jj = 0; jj < 4; ++jj) { const int j = 4 * j4 + jj; kkv[j] = y[1][j] * kc[jj]; ss += kkv[j] * kkv[j]; } }
    ss += shx(ss, 1, lane); ss += shx(ss, 2, lane);
    const float inv = rsqrtf(ss + 1e-12f);
    float bon = 0.f;
    LAS float* o = buf + ti * RW_STEP + 16 * cg;
#pragma unroll
    for (int j4 = 0; j4 < 4; ++j4) {
        const f32x4 kac = *(const LAS f32x4*)(CST + 4 * 64 + 16 * cg + 4 * j4), rkc = *(const LAS f32x4*)(CST + 5 * 64 + 16 * cg + 4 * j4);
        f32x4 w4, b4, km4, r4, kk4, v4;
#pragma unroll
        for (int jj = 0; jj < 4; ++jj) { const int j = 4 * j4 + jj;
            const float kkn = kkv[j] * inv, aj = a[j];
            const float km = y[1][j] * (1.f + (aj - 1.f) * kac[jj]);
            w4[jj] = __expf(-lw[j]); b4[jj] = kkn * aj; km4[jj] = km; r4[jj] = y[0][j]; kk4[jj] = kkn; v4[jj] = y[2][j];
            bon += y[0][j] * km * rkc[jj]; }
        *(LAS f32x4*)(o + 0 * 64 + 4 * j4) = w4; *(LAS f32x4*)(o + 1 * 64 + 4 * j4) = b4; *(LAS f32x4*)(o + 2 * 64 + 4 * j4) = km4;
        *(LAS f32x4*)(o + 3 * 64 + 4 * j4) = r4; *(LAS f32x4*)(o + 4 * 64 + 4 * j4) = kk4; *(LAS f32x4*)(o + 5 * 64 + 4 * j4) = v4;
    }
    bon += shx(bon, 1, lane); bon += shx(bon, 2, lane);
    if (cg == 0) ((float*)(p.ws + WS_BON))[(size_t)row * 12 + g * 6 + h] = bon;
}
DI float xhalf_sum(float x) {
    const auto r = __builtin_amdgcn_permlane32_swap(__float_as_uint(x), __float_as_uint(x), false, false);
    return __uint_as_float(r[0]) + __uint_as_float(r[1]);
}
DI void rwkv_scan_chunk(const Params& p, int item, int c, const LAS float* buf, f32x2 (&S)[16], int lane, int hf, bool dry) {
    const int g = item & 1, h = (item >> 1) % 6, b = item / 12;
    float* LOf = (float*)(p.ws + WS_LO);
    const int kh = lane >> 5, rowi = 32 * hf + (lane & 31);
    const LAS float* bk = buf + 32 * kh;
    f32x4 KK[8];
#pragma unroll
    for (int i = 0; i < 8; ++i) KK[i] = *(const LAS f32x4*)(bk + 256 + 4 * i);
    float vv = buf[320 + rowi];
    for (int st = 0; st < 16; ++st) {
        const LAS float* W = bk + st * RW_STEP;
        const LAS float* Wn = bk + (st < 15 ? st + 1 : st) * RW_STEP;
        f32x4 U[2][8];
#pragma unroll
        for (int j = 0; j < 2; ++j) { U[0][4 * j] = *(const LAS f32x4*)(W + 4 * j); U[0][4 * j + 1] = *(const LAS f32x4*)(W + 64 + 4 * j); U[0][4 * j + 2] = *(const LAS f32x4*)(W + 128 + 4 * j); U[0][4 * j + 3] = *(const LAS f32x4*)(W + 192 + 4 * j); }
        f32x2 sacc[4];
#pragma unroll
        for (int i = 0; i < 4; ++i) sacc[i] = (f32x2){0.f, 0.f};
#pragma unroll
        for (int i = 0; i < 8; ++i) { sacc[(2 * i) & 3] += S[2 * i] * (f32x2){KK[i][0], KK[i][1]}; sacc[(2 * i + 1) & 3] += S[2 * i + 1] * (f32x2){KK[i][2], KK[i][3]}; }
        const f32x2 st2 = (sacc[0] + sacc[1]) + (sacc[2] + sacc[3]);
        const float sa = -xhalf_sum(st2[0] + st2[1]);
        const f32x2 sa2 = (f32x2){sa, sa}, vv2 = (f32x2){vv, vv};
        f32x2 oacc[4];
#pragma unroll
        for (int i = 0; i < 4; ++i) oacc[i] = (f32x2){0.f, 0.f};
        asm volatile("" : "+v"(oacc[0]), "+v"(oacc[1]) :: "memory");
#pragma unroll
        for (int gi = 0; gi < 4; ++gi) {
            const int cu = gi & 1, nx = cu ^ 1;
            if (gi < 3) {
#pragma unroll
                for (int j = 0; j < 2; ++j) { const int i = 2 * (gi + 1) + j; U[nx][4 * j] = *(const LAS f32x4*)(W + 4 * i); U[nx][4 * j + 1] = *(const LAS f32x4*)(W + 64 + 4 * i);
                    U[nx][4 * j + 2] = *(const LAS f32x4*)(W + 128 + 4 * i); U[nx][4 * j + 3] = *(const LAS f32x4*)(W + 192 + 4 * i); }
            }
            if (gi >= 2) {
#pragma unroll
                for (int j = 0; j < 4; ++j) KK[4 * (gi - 2) + j] = *(const LAS f32x4*)(Wn + 256 + 4 * (4 * (gi - 2) + j));
            }
#pragma unroll
            for (int j = 0; j < 2; ++j) { const int i = 2 * gi + j; const f32x4 w4 = U[cu][4 * j], b4 = U[cu][4 * j + 1], km4 = U[cu][4 * j + 2], r4 = U[cu][4 * j + 3];
                f32x2 t0 = vv2 * (f32x2){km4[0], km4[1]}; t0 = sa2 * (f32x2){b4[0], b4[1]} + t0; S[2 * i] = S[2 * i] * (f32x2){w4[0], w4[1]} + t0;
                f32x2 t1 = vv2 * (f32x2){km4[2], km4[3]}; t1 = sa2 * (f32x2){b4[2], b4[3]} + t1; S[2 * i + 1] = S[2 * i + 1] * (f32x2){w4[2], w4[3]} + t1;
                oacc[(2 * i) & 3] += S[2 * i] * (f32x2){r4[0], r4[1]}; oacc[(2 * i + 1) & 3] += S[2 * i + 1] * (f32x2){r4[2], r4[3]}; }
            asm volatile("" : "+v"(oacc[0]), "+v"(oacc[1]), "+v"(oacc[2]), "+v"(oacc[3]) :: "memory");
        }
        vv = buf[(st < 15 ? st + 1 : st) * RW_STEP + 320 + rowi];
        const f32x2 o2 = (oacc[0] + oacc[1]) + (oacc[2] + oacc[3]);
        const float ov = xhalf_sum(o2[0] + o2[1]);
        int row, ts, Ls; step_row(16 * c + st, g, b, row, ts, Ls);
        if (kh == 0 && (!dry || ov == 1.2345e37f)) LOf[(size_t)row * (LOLD / 2) + (g * 6 + h) * 64 + rowi] = ov;
    }
}
struct GlRaw { u32x4 q, k, v[2], dn[2]; f32x4 rt[2]; };
DI void gla_load(const Params& p, int item, int c, GlRaw& R, int lane) {
    const int g = item & 1, h = (item >> 1) % 6, b = item / 12;
    const int ti = lane >> 2, cg = lane & 3;
    int row, ts, Ls; step_row(16 * c + ti, g, b, row, ts, Ls);
    const bf16_t* pr = (const bf16_t*)(p.ws + WS_PB) + (size_t)row * PLD;
    R.q = *(const u32x4*)(pr + C_GQ + h * 32 + 8 * cg); R.k = *(const u32x4*)(pr + C_GK + h * 32 + 8 * cg);
    R.v[0] = *(const u32x4*)(pr + C_GV + h * 64 + 16 * cg); R.v[1] = *(const u32x4*)(pr + C_GV + h * 64 + 16 * cg + 8);
    R.dn[0] = *(const u32x4*)(pr + C_GDN + 16 * g); R.dn[1] = *(const u32x4*)(pr + C_GDN + 16 * g + 8);
    const float* rt = (const float*)(p.ws + WS_ROPE) + (size_t)((Ls == SL ? ts : 0) * 16 + 4 * cg) * 2;
    R.rt[0] = *(const f32x4*)rt; R.rt[1] = *(const f32x4*)(rt + 4);
}
DI void gla_compute(const Params& p, int item, int c, const GlRaw& R, LAS float* buf, const LAS float* GU, int lane) {
    const int g = item & 1, b = item / 12;
    const int ti = lane >> 2, cg = lane & 3;
    int row, ts, Ls; step_row(16 * c + ti, g, b, row, ts, Ls);
    float q[8], k[8], v[16], dn[16];
    cvt8(R.q, q); cvt8(R.k, k); cvt8(R.v[0], &v[0]); cvt8(R.v[1], &v[8]); cvt8(R.dn[0], &dn[0]); cvt8(R.dn[1], &dn[8]);
    float al[8];
    {
        f32x4 z0 = *(const LAS f32x4*)(GU + 512 + 8 * cg), z1 = *(const LAS f32x4*)(GU + 512 + 8 * cg + 4);
#pragma unroll
        for (int rr = 0; rr < 16; ++rr) {
            if ((rr & 3) == 0) asm volatile("" : "+v"(z0), "+v"(z1) :: "memory");
            const f32x4 g0 = *(const LAS f32x4*)(GU + rr * 32 + 8 * cg), g1 = *(const LAS f32x4*)(GU + rr * 32 + 8 * cg + 4);
            z0 = z0 + g0 * dn[rr]; z1 = z1 + g1 * dn[rr]; }
#pragma unroll
        for (int j = 0; j < 8; ++j) { const float z = j < 4 ? z0[j & 3] : z1[j & 3];
            const float ls = fminf(z, 0.f) - __logf(1.f + __expf(-fabsf(z)));
            al[j] = __expf(ls * 0.0625f); }
    }
    if (Ls == SL) {
#pragma unroll
        for (int jj = 0; jj < 4; ++jj) { const float cc = R.rt[jj >> 1][2 * (jj & 1)], sn = R.rt[jj >> 1][2 * (jj & 1) + 1];
            const float q1 = q[2 * jj], q2 = q[2 * jj + 1]; q[2 * jj] = q1 * cc - q2 * sn; q[2 * jj + 1] = q1 * sn + q2 * cc;
            const float k1 = k[2 * jj], k2 = k[2 * jj + 1]; k[2 * jj] = k1 * cc - k2 * sn; k[2 * jj + 1] = k1 * sn + k2 * cc; }
    }
    LAS float* o = buf + ti * GL_STEP;
#pragma unroll
    for (int j4 = 0; j4 < 2; ++j4) {
        *(LAS f32x4*)(o + 8 * cg + 4 * j4) = (f32x4){al[4 * j4], al[4 * j4 + 1], al[4 * j4 + 2], al[4 * j4 + 3]};
        *(LAS f32x4*)(o + 32 + 8 * cg + 4 * j4) = (f32x4){k[4 * j4], k[4 * j4 + 1], k[4 * j4 + 2], k[4 * j4 + 3]};
        *(LAS f32x4*)(o + 64 + 8 * cg + 4 * j4) = (f32x4){q[4 * j4], q[4 * j4 + 1], q[4 * j4 + 2], q[4 * j4 + 3]} * 0.17677669529663687f; }
#pragma unroll
    for (int j4 = 0; j4 < 4; ++j4) *(LAS f32x4*)(o + 96 + 16 * cg + 4 * j4) = (f32x4){v[4 * j4], v[4 * j4 + 1], v[4 * j4 + 2], v[4 * j4 + 3]};
}
DI void gla_scan_chunk(const Params& p, int item, int c, const LAS float* buf, f32x2 (&S)[16], int lane, bool dry = false) {
    const int g = item & 1, h = (item >> 1) % 6, b = item / 12;
    bf16_t* AY = (bf16_t*)(p.ws + WS_AY);
    f32x4 U[2][12];
#pragma unroll
    for (int j = 0; j < 4; ++j) { U[0][3 * j] = ((const LAS f32x4*)buf)[j]; U[0][3 * j + 1] = ((const LAS f32x4*)buf)[8 + j]; U[0][3 * j + 2] = ((const LAS f32x4*)buf)[16 + j]; }
    float vv = buf[96 + lane];
    for (int st = 0; st < 16; ++st) {
        const LAS f32x4* W = (const LAS f32x4*)(buf + st * GL_STEP);
        const LAS float* bn = buf + (st < 15 ? st + 1 : st) * GL_STEP;
        const LAS f32x4* Wn = (const LAS f32x4*)bn;
        const f32x2 vv2 = (f32x2){vv, vv};
        f32x2 oacc[4];
#pragma unroll
        for (int i = 0; i < 4; ++i) oacc[i] = (f32x2){0.f, 0.f};
#pragma unroll
        for (int gi = 0; gi < 2; ++gi) {
            const int cu = gi, nx = gi ^ 1;
#pragma unroll
            for (int j = 0; j < 4; ++j) { const LAS f32x4* Wx = gi == 0 ? W : Wn; const int i = gi == 0 ? 4 + j : j;
                U[nx][3 * j] = Wx[i]; U[nx][3 * j + 1] = Wx[8 + i]; U[nx][3 * j + 2] = Wx[16 + i]; }
            if (gi == 1) vv = bn[96 + lane];
#pragma unroll
            for (int j = 0; j < 4; ++j) { const int i = 4 * gi + j; const f32x4 a4 = U[cu][3 * j], k4 = U[cu][3 * j + 1], q4 = U[cu][3 * j + 2];
                S[2 * i] = S[2 * i] * (f32x2){a4[0], a4[1]} + vv2 * (f32x2){k4[0], k4[1]}; S[2 * i + 1] = S[2 * i + 1] * (f32x2){a4[2], a4[3]} + vv2 * (f32x2){k4[2], k4[3]};
                oacc[(2 * i) & 3] += S[2 * i] * (f32x2){q4[0], q4[1]}; oacc[(2 * i + 1) & 3] += S[2 * i + 1] * (f32x2){q4[2], q4[3]}; }
            asm volatile("" : "+v"(oacc[0]), "+v"(oacc[1]), "+v"(oacc[2]), "+v"(oacc[3]) :: "memory");
        }
        const f32x2 o2 = (oacc[0] + oacc[1]) + (oacc[2] + oacc[3]);
        int row, ts, Ls; step_row(16 * c + st, g, b, row, ts, Ls);
        { const float ov = o2[0] + o2[1]; if (!dry || ov == 1.2345e37f) AY[(size_t)row * D + g * 384 + h * 64 + lane] = f2bf(ov); }
    }
}
DI void scan_unit_rw(const Params& p, int l, int su, LAS unsigned char* lds, int tid, int lane, int wave, bool dry) {
    LAS float* RWB = (LAS float*)lds; LAS float* CSB = (LAS float*)(lds + 143616);
    __syncthreads();
    for (int i = tid; i < 2 * 384; i += NTHR) { const int sl = i / 384, r = i % 384, a = r >> 6, ch = r & 63; const int it = 2 * su + sl, hh = (it >> 1) % 6;
        float v;
        if (a < 3) v = pin(p, I_MU)[(size_t)l * 1536 + a * 384 + hh * 64 + ch];
        else v = (a == 3 ? pin(p, I_KK) : (a == 4 ? pin(p, I_KA) : pin(p, I_RK)))[(size_t)l * 384 + hh * 64 + ch];
        CSB[i] = v; }
    __syncthreads();
    if (wave < 4) {
        asm volatile("" : "+v"(lane));
        const int slot = wave >> 1, hf = wave & 1, item = 2 * su + slot;
        f32x2 S[16];
#pragma unroll
        for (int i = 0; i < 16; ++i) S[i] = (f32x2){0.f, 0.f};
        __syncthreads();
        for (int c = 0; c < NCHUNK; ++c) { rwkv_scan_chunk(p, item, c, RWB + (slot * 2 + (c & 1)) * RW_BUF, S, lane, hf, dry); __syncthreads(); }
    } else if (wave < 6) {
        asm volatile("" : "+v"(lane));
        const int slot = wave & 1, item = 2 * su + slot;
        RwRaw R; rwkv_load(p, item, 0, R, lane);
        rwkv_compute(p, item, 0, R, RWB + (slot * 2 + 0) * RW_BUF, CSB + slot * 384, lane);
        rwkv_load(p, item, 1, R, lane);
        __syncthreads();
        for (int c = 0; c < NCHUNK; ++c) {
            if (c + 1 < NCHUNK) { rwkv_compute(p, item, c + 1, R, RWB + (slot * 2 + ((c + 1) & 1)) * RW_BUF, CSB + slot * 384, lane); if (c + 2 < NCHUNK) rwkv_load(p, item, c + 2, R, lane); }
            __syncthreads(); }
    } else {
        __syncthreads();
        for (int c = 0; c < NCHUNK; ++c) __syncthreads();
    }
}
DI void scan_unit_gl(const Params& p, int l, int gu, LAS unsigned char* lds, int tid, int lane, int wave, bool dry) {
    LAS float* GLB = (LAS float*)lds; LAS float* GUB = (LAS float*)(lds + 122880);
    __syncthreads();
    for (int i = tid; i < 6 * 544; i += NTHR) { const int sl = i / 544, r = i % 544; const int it = 6 * gu + sl, gg = it & 1, hh = (it >> 1) % 6;
        GUB[i] = r < 512 ? pin(p, I_GUP)[((size_t)(l * 2 + gg) * 16 + (r >> 5)) * 192 + hh * 32 + (r & 31)] : pin(p, I_GB)[(size_t)(l * 2 + gg) * 192 + hh * 32 + (r - 512)]; }
    __syncthreads();
    if (wave < 6) {
        asm volatile("" : "+v"(lane));
        const int item = 6 * gu + wave;
        f32x2 Sg[16];
#pragma unroll
        for (int i = 0; i < 16; ++i) Sg[i] = (f32x2){0.f, 0.f};
        __syncthreads();
        for (int c = 0; c < NCHUNK; ++c) { gla_scan_chunk(p, item, c, GLB + (wave * 2 + (c & 1)) * GL_BUF, Sg, lane, dry); __syncthreads(); }
    } else {
        asm volatile("" : "+v"(lane));
        const int s0 = (wave - 6) * 3;
        GlRaw R0, R1, R2;
        gla_load(p, 6 * gu + s0, 0, R0, lane); gla_load(p, 6 * gu + s0 + 1, 0, R1, lane); gla_load(p, 6 * gu + s0 + 2, 0, R2, lane);
        gla_compute(p, 6 * gu + s0, 0, R0, GLB + ((s0) * 2) * GL_BUF, GUB + (s0) * 544, lane);
        gla_compute(p, 6 * gu + s0 + 1, 0, R1, GLB + ((s0 + 1) * 2) * GL_BUF, GUB + (s0 + 1) * 544, lane);
        gla_compute(p, 6 * gu + s0 + 2, 0, R2, GLB + ((s0 + 2) * 2) * GL_BUF, GUB + (s0 + 2) * 544, lane);
        gla_load(p, 6 * gu + s0, 1, R0, lane); gla_load(p, 6 * gu + s0 + 1, 1, R1, lane); gla_load(p, 6 * gu + s0 + 2, 1, R2, lane);
        __syncthreads();
        for (int c = 0; c < NCHUNK; ++c) {
            if (c + 1 < NCHUNK) { const int nb = (c + 1) & 1;
                gla_compute(p, 6 * gu + s0, c + 1, R0, GLB + ((s0) * 2 + nb) * GL_BUF, GUB + (s0) * 544, lane);
                gla_compute(p, 6 * gu + s0 + 1, c + 1, R1, GLB + ((s0 + 1) * 2 + nb) * GL_BUF, GUB + (s0 + 1) * 544, lane);
                gla_compute(p, 6 * gu + s0 + 2, c + 1, R2, GLB + ((s0 + 2) * 2 + nb) * GL_BUF, GUB + (s0 + 2) * 544, lane);
                if (c + 2 < NCHUNK) { gla_load(p, 6 * gu + s0, c + 2, R0, lane); gla_load(p, 6 * gu + s0 + 1, c + 2, R1, lane); gla_load(p, 6 * gu + s0 + 2, c + 2, R2, lane); } }
            __syncthreads(); }
    }
}
DI void phase_mixers(const Params& p, int l, LAS unsigned char* lds, int tid, int lane, int wave, bool dry = false, int which = 3) {
    const int G = gridDim.x, bx = blockIdx.x;
    if (which & 1) for (int u = bx; u < 256; u += G) { if (u < 192) scan_unit_rw(p, l, u, lds, tid, lane, wave, dry); else scan_unit_gl(p, l, u - 192, lds, tid, lane, wave, dry); }
    const int nnat = NB * 4 * 32 * 4, nnatc = l == 0 ? NB * 4 * 16 : 0;
    if (which & 2) {
        const int ntot = nnat + nnatc;
        int n1 = 0;
        if (G == 256 && NAT_GLA_PCT > 0) {
            n1 = (ntot * NAT_GLA_PCT / 100) & ~7;
            if (bx >= 192) for (int id = (bx - 192) * NWAVE + wave; id < n1; id += 64 * NWAVE) { if (id < nnat) nat_unit(p, l, id, false, lane); else nat_unit(p, l, id - nnat, true, lane); }
        }
        for (int id = n1 + bx * NWAVE + wave; id < ntot; id += G * NWAVE) { if (id < nnat) nat_unit(p, l, id, false, lane); else nat_unit(p, l, id - nnat, true, lane); }
    }
}

DI void phase_readout(const Params& p, int l, int nrows, int lane, int wave) {
    const int gw = blockIdx.x * NWAVE + wave, NGW = gridDim.x * NWAVE;
    const bf16_t* PB = (const bf16_t*)(p.ws + WS_PB); bf16_t* AY = (bf16_t*)(p.ws + WS_AY);
    const float* LOf = (const float*)(p.ws + WS_LO); const bf16_t* LOb = (const bf16_t*)(p.ws + WS_LO); const float* BON = (const float*)(p.ws + WS_BON);
    const float nw = pin(p, I_GNW)[l * 64 + lane];
    const float* gnw = pin(p, I_GNWT) + l * 384; const float* gnb = pin(p, I_GNB) + l * 384;
    const float* mu = pin(p, I_MU) + (size_t)l * 1536 + 768;
    for (int row = gw; row < nrows; row += NGW) {
        const bool lat = row < ML; const int t = lat ? (row & (SL - 1)) : ((row - ML) & (CL - 1)); const int Ls = lat ? SL : CL;
        const bf16_t* pr = PB + (size_t)row * PLD; bf16_t* yr = AY + (size_t)row * D;
        float og[6], gg[6], nat[4], orw[6], vv[6], gate[6], bon[6];
#pragma unroll
        for (int h = 0; h < 6; ++h) { og[h] = bf2f(yr[h * 64 + lane]) + bf2f(yr[384 + h * 64 + lane]); gg[h] = bf2f(pr[C_GG + h * 64 + lane]);
            orw[h] = LOf[(size_t)row * (LOLD / 2) + h * 64 + lane] + LOf[(size_t)row * (LOLD / 2) + (6 + h) * 64 + lane];
            const int cv = C_RW + 768 + h * 64 + lane; const float c0 = bf2f(pr[cv]); const float cm = t > 0 ? bf2f(pr[cv - PLD]) : 0.f; const float cp = t < Ls - 1 ? bf2f(pr[cv + PLD]) : 0.f;
            vv[h] = c0 + (0.5f * (cm + cp) - c0) * mu[h * 64 + lane];
            gate[h] = bf2f(LOb[(size_t)row * LOLD + 1536 + h * 64 + lane]);
            bon[h] = BON[(size_t)row * 12 + h] + BON[(size_t)row * 12 + 6 + h]; }
#pragma unroll
        for (int h = 0; h < 4; ++h) nat[h] = bf2f(yr[768 + h * 64 + lane]);
        float yg[6], yrw[6];
#pragma unroll
        for (int h = 0; h < 6; ++h) {
            const float ss = wave_sum(og[h] * og[h], lane);
            yg[h] = og[h] * rsqrtf(ss * (1.f / 64.f) + 1e-5f) * nw * (gg[h] * sigm(gg[h]));
            const float mean = wave_sum(orw[h], lane) * (1.f / 64.f); const float dlt = orw[h] - mean; const float var = wave_sum(dlt * dlt, lane) * (1.f / 64.f);
            const float gn = dlt * rsqrtf(var + 64e-5f) * gnw[h * 64 + lane] + gnb[h * 64 + lane];
            yrw[h] = (gn + bon[h] * vv[h]) * gate[h]; }
        asm volatile("s_waitcnt vmcnt(0)" ::: "memory");
#pragma unroll
        for (int h = 0; h < 6; ++h) { yr[h * 64 + lane] = f2bf(yg[h]); yr[640 + h * 64 + lane] = f2bf(yrw[h]); }
#pragma unroll
        for (int h = 0; h < 4; ++h) yr[384 + h * 64 + lane] = f2bf(nat[h]);
    }
}

DI void grid_sync_probe() { cg::this_grid().sync(); }
DI void run_step(const Params& p, const int step, LAS unsigned char* lds, int tid, int lane, int wave) {
    const int G = gridDim.x, bx = blockIdx.x;
    unsigned char* ws = p.ws;
    const float* MOD = (const float*)(ws + WS_MOD);
    float* TC = (float*)(ws + WS_VT);
    {
        const int l = step < 2 ? 0 : (step - 2) / 10, st = step < 2 ? -1 : (step - 2) % 10;
        unsigned char* wl = ws + (size_t)l * WLB;
        const float* modl = MOD + (size_t)l * 33 * 6144;
        const int Mff = l == 0 ? MT : ML;
        if (st == 0 || st == 2 || st == 5 || st == 7 || st == 8) {
            const bf16_t* gA = (const bf16_t*)(ws + WS_AY); const bf16_t* gB; int gM = Mff, gN = 1024, gK = 1024, mode = 2;
            bf16_t* eO = (bf16_t*)(ws + WS_PB); const float* ex = (const float*)p.out; const float* exc = (const float*)TC; int gofs = 2 * 1024;
            if (st == 0) { gB = (const bf16_t*)(wl + OFF_WIN); gM = MT; gN = PLD; mode = 0; }
            else if (st == 2) { gB = (const bf16_t*)(wl + OFF_BT2); gM = MT; gN = 2048; gK = 384; mode = 1; eO = (bf16_t*)(ws + WS_LO); }
            else if (st == 5) { gB = (const bf16_t*)(wl + OFF_WOUT); if (l == 0) { ex = pin(p, I_X); exc = pin(p, I_CTX); } }
            else if (st == 7) { gB = (const bf16_t*)(wl + OFF_W13); gN = 2 * FH; mode = 3; }
            else { gA = (const bf16_t*)(ws + WS_PB); gB = (const bf16_t*)(wl + OFF_W2); gK = FH; gofs = 5 * 1024; }
            asm volatile("" : "+s"(gK), "+s"(gM), "+s"(gN), "+s"(mode));
            const pg8::Gemm g{gA, gB, gM, gN, gK};
            const pg8::EpiAny E{mode, pg8::EpiStoreBf16{eO, PLD}, pg8::EpiLora{eO, pin(p, I_W0) + (size_t)l * 768, pin(p, I_A0) + (size_t)l * 768},
                                pg8::EpiRes{ex, exc, p.out, TC, modl, gofs}, pg8::EpiSwiglu{eO}};
            pg8::StaticOrder S; S.init(g.M, g.N, G, bx);
#if defined(PROBE_GEMM)
            int nrep = (st == 0 || st == 2 || st == 7) ? 2 : 1; asm volatile("" : "+s"(nrep));
#pragma unroll 1
            for (int rep = 0; rep < nrep; ++rep) { pg8::gemm_phase<pg8::EpiAny, pg8::StaticOrder, true, true>(lds, g, S, E, tid); __syncthreads(); }
#else
            pg8::gemm_phase<pg8::EpiAny, pg8::StaticOrder, true, true>(lds, g, S, E, tid);
#endif
        }
#ifndef ONLYGEMM
        else if (step == 0) phase_prologue(p, lds, tid, lane, wave);
        else if (step == 1) phase_modulate0(p, lane, wave);
        else if (st == 1) phase_prep(p, l, lds, lane, wave);
#if defined(PROBE_MIX)
        else if (st == 3) { int nrep = 2; asm volatile("" : "+s"(nrep));
#pragma unroll 1
            for (int rep = 0; rep < nrep; ++rep) { phase_mixers(p, l, lds, tid, lane, wave, rep + 1 < nrep, rep + 1 < nrep ? PROBE_MIX : 3); __syncthreads(); grid_sync_probe(); } }
#else
        else if (st == 3) phase_mixers(p, l, lds, tid, lane, wave);
#endif
        else if (st == 4) phase_readout(p, l, Mff, lane, wave);
        else if (st == 6) phase_ln(p, lane, wave, Mff, pin(p, I_LN1W) + l * 1024, pin(p, I_LN1B) + l * 1024, modl, 3 * 1024, 4 * 1024, true, true);
        else {
            if (l == 0) phase_ln(p, lane, wave, MT, pin(p, I_LN2W), pin(p, I_LN2B), MOD + (size_t)33 * 6144, 0, 1024, true, true);
            else phase_ln(p, lane, wave, ML, pin(p, I_LN2W) + 1024, pin(p, I_LN2B) + 1024, modl, 0, 1024, true, false);
        }
#endif
    }
}
#ifdef MULTI_LAUNCH
template <int STEP> __global__ void __launch_bounds__(NTHR, 2) k_step(Params p) {
    extern __shared__ __attribute__((aligned(16))) unsigned char smem[];
    const int tid = threadIdx.x, lane = tid & 63, wave = __builtin_amdgcn_readfirstlane(tid >> 6);
    run_step(p, STEP, (LAS unsigned char*)smem, tid, lane, wave);
}
template <int STEP> static void launch_steps(const Params& p, int grid, hipStream_t stream) {
    static bool attr_done = false;
    if (!attr_done) { (void)hipFuncSetAttribute((const void*)k_step<STEP>, hipFuncAttributeMaxDynamicSharedMemorySize, LDS_BYTES); attr_done = true; }
    hipLaunchKernelGGL(k_step<STEP>, dim3(grid), dim3(NTHR), LDS_BYTES, stream, p);
    if constexpr (STEP + 1 < 22) launch_steps<STEP + 1>(p, grid, stream);
}
#else
__global__ void __launch_bounds__(NTHR, 2) hybrid_fwd(Params p) {
    extern __shared__ __attribute__((aligned(16))) unsigned char smem[];
    LAS unsigned char* lds = (LAS unsigned char*)smem;
    cg::grid_group grid = cg::this_grid();
    const int wave0 = __builtin_amdgcn_readfirstlane((int)threadIdx.x >> 6);
#if defined(PROBE_REPEAT)
    bool repeated = false;
#endif
#pragma unroll 1
    for (int step = 0; step < 22; ++step) {
        unsigned msk = ~0u; int wave_ = wave0;
        asm volatile("" : "+s"(msk), "+s"(wave_));
        const int lane_ = (int)__builtin_amdgcn_mbcnt_hi(msk, __builtin_amdgcn_mbcnt_lo(msk, 0u));
        const int tid_ = wave_ * 64 + lane_;
        run_step(p, step, lds, tid_, lane_, wave_);
        if (step != 21) grid.sync();
#if defined(PROBE_REPEAT)
        { const int st_ = step < 2 ? -1 : (step - 2) % 10; const bool rep_ok = (PROBE_REPEAT == 1) ? (st_ == 0 || st_ == 2 || st_ == 7) : (PROBE_REPEAT == 2 ? (st_ == 1) : (step == 0));
          if (rep_ok && !repeated) { repeated = true; --step; } else repeated = false; }
#endif
    }
}
#endif

extern "C" void kernel_launch(void* const* d_in, const int* in_sizes, int n_in, void* d_out, int out_size, void* d_ws, size_t ws_size, hipStream_t stream) {
    static int grid = 0;
    if (grid == 0) {
        int dev = 0, cus = 0, per_cu = 0;
        if (n_in != 29 || ws_size < WS_END) { fprintf(stderr, "kernel_launch: unexpected n_in %d / ws_size %zu (need %zu)\n", n_in, ws_size, (size_t)WS_END); }
        hipGetDevice(&dev);
        hipDeviceGetAttribute(&cus, hipDeviceAttributeMultiprocessorCount, dev);
#ifndef MULTI_LAUNCH
        if (hipFuncSetAttribute((const void*)hybrid_fwd, hipFuncAttributeMaxDynamicSharedMemorySize, LDS_BYTES) != hipSuccess) fprintf(stderr, "kernel_launch: hipFuncSetAttribute failed\n");
        if (hipOccupancyMaxActiveBlocksPerMultiprocessor(&per_cu, (const void*)hybrid_fwd, NTHR, LDS_BYTES) != hipSuccess || per_cu < 1) { fprintf(stderr, "kernel_launch: occupancy query gave %d\n", per_cu); per_cu = 1; }
#endif
        (void)hipGetLastError();
        grid = cus > 0 ? cus : 256;
    }
    Params p{};
    for (int i = 0; i < 29; ++i) p.in[i] = (const float*)d_in[i];
    p.out = (float*)d_out; p.ws = (unsigned char*)d_ws;
#ifdef MULTI_LAUNCH
    launch_steps<0>(p, grid, stream);
#else
    void* args[] = {&p};
    hipError_t e = hipLaunchCooperativeKernel((const void*)hybrid_fwd, dim3(grid), dim3(NTHR), args, LDS_BYTES, stream);
    if (e != hipSuccess) fprintf(stderr, "kernel_launch: cooperative launch failed: %s (grid %d)\n", hipGetErrorString(e), grid);
#endif
}
```

```cpp
#include <hip/hip_runtime.h>
#include <hip/hip_cooperative_groups.h>
#include <cstdio>
#include <cstdint>
namespace cg = cooperative_groups;
namespace pg8 {
#define PG8_LAS __attribute__((address_space(3)))
typedef unsigned short bf16_t;
typedef short bf16x8 __attribute__((ext_vector_type(8)));
typedef float f32x4 __attribute__((ext_vector_type(4)));
typedef unsigned u32x4 __attribute__((ext_vector_type(4)));
constexpr int BM = 256, BK = 64, HALF = 128, HTB = HALF * BK * 2  , STAGE_BYTES = 8 * HTB, NXCD = 8, WGM = 8;

__host__ __device__ __forceinline__ int lds_byte(int r, int c) { const int st = (r >> 4) * 2 + (c >> 5), rr = r & 15, cc = c & 31, ob = rr * 64 + cc * 2; return st * 1024 + (ob ^ (((ob >> 9) & 1) << 5)); }
__host__ __device__ __forceinline__ void stage_rc(int b, int& R, int& C) { const int st = b / 1024, sb = b % 1024, swz = sb ^ (((sb >> 9) & 1) << 5); R = (st >> 1) * 16 + swz / 64; C = (st & 1) * 32 + (swz % 64) / 2; }
__host__ __device__ __forceinline__ int perm32(int rho) { const int n = rho >> 4, i = rho & 15; return 8 * (i >> 2) + 4 * n + (i & 3); }

struct Unit { int pm, pn; };
struct Gemm { const bf16_t* A; const bf16_t* Bt; int M, N, K; };

struct StaticOrder {
    int nM, nN, nwg, G, c;
    __host__ __device__ void init(int M, int N, int G_, int c_) { nM = M / BM; nN = N / BM; nwg = nM * nN; G = G_; c = c_; }
    __host__ __device__ bool next(int i, Unit& u) const {
        const long L = (long)i * G + c; if (L >= nwg) return false;
        int wgid = (int)L; { const int q = nwg / NXCD, r = nwg % NXCD, xcd = wgid % NXCD, off = wgid / NXCD; wgid = (xcd < r ? xcd * (q + 1) : r * (q + 1) + (xcd - r) * q) + off; }
        const int nig = WGM * nN, gid = wgid / nig, fm = gid * WGM, gsz = (nM - fm) < WGM ? (nM - fm) : WGM;
        u.pm = fm + ((wgid % nig) % gsz); u.pn = (wgid % nig) / gsz; return true;
    }
    __device__ __forceinline__ void a_ready(const Unit&) const {}
    __device__ __forceinline__ void done(const Unit&) const {}
};
__device__ __forceinline__ unsigned cvtpk(float lo, float hi) { typedef float v2f __attribute__((ext_vector_type(2))); typedef __bf16 v2b __attribute__((ext_vector_type(2))); v2f v = {lo, hi}; v2b b = __builtin_convertvector(v, v2b); return __builtin_bit_cast(unsigned, b); }
__device__ __forceinline__ float sigm(float x) { return 1.0f / (1.0f + __expf(-x)); }
struct EpiStoreBf16 {
    static constexpr bool PERM = true, AFTER_DRAIN = false;
    bf16_t* O; int ldc;
    __device__ __forceinline__ void operator()(const f32x4 (&acc)[2][2][4][2], const Unit& u, int wr, int wc, int fr, int fq) const {
        const int row0 = u.pm * BM + wr * 64 + fr, col0 = u.pn * BM + wc * 32 + 8 * fq;
#pragma unroll
        for (int ai = 0; ai < 2; ++ai)
#pragma unroll
            for (int m = 0; m < 4; ++m) { bf16_t* rowp = O + (size_t)(row0 + ai * HALF + m * 16) * ldc + col0;
#pragma unroll
                for (int bj = 0; bj < 2; ++bj) { const f32x4 v0 = acc[ai][bj][m][0], v1 = acc[ai][bj][m][1];
                    u32x4 w; w.x = cvtpk(v0[0], v0[1]); w.y = cvtpk(v0[2], v0[3]); w.z = cvtpk(v1[0], v1[1]); w.w = cvtpk(v1[2], v1[3]);
                    *(u32x4*)(rowp + bj * HALF) = w; } }
    }
};
struct EpiLora {
    static constexpr bool PERM = true, AFTER_DRAIN = false;
    bf16_t* O; const float* w0; const float* a0;
    __device__ __forceinline__ void operator()(const f32x4 (&acc)[2][2][4][2], const Unit& u, int wr, int wc, int fr, int fq) const {
        const int row0 = u.pm * BM + wr * 64 + fr;
#pragma unroll
        for (int bj = 0; bj < 2; ++bj) {
            const int cb = u.pn * 2 + bj;
            if (cb < 15) {
                const int c0 = cb * 128 + wc * 32 + 8 * fq;
                if (cb >= 12) {
#pragma unroll
                    for (int ai = 0; ai < 2; ++ai)
#pragma unroll
                        for (int m = 0; m < 4; ++m) { const f32x4 v0 = acc[ai][bj][m][0], v1 = acc[ai][bj][m][1];
                            u32x4 w; w.x = cvtpk(v0[0], v0[1]); w.y = cvtpk(v0[2], v0[3]); w.z = cvtpk(v1[0], v1[1]); w.w = cvtpk(v1[2], v1[3]);
                            *(u32x4*)(O + (size_t)(row0 + ai * HALF + m * 16) * 1920 + c0) = w; }
                } else {
                    const int kind = wc >> 1, g = cb / 6, h = cb % 6;
                    const float* a0v = a0; const float* w0v = w0; asm volatile("" : "+s"(a0v), "+s"(w0v));
                    const float* bp = (kind ? a0v : w0v) + g * 384 + h * 64 + (wc & 1) * 32 + 8 * fq;
                    const f32x4 b0 = *(const f32x4*)bp, b1 = *(const f32x4*)(bp + 4);
                    const float mul = kind == 0 ? 0.60653065971263342f : 1.f;
#pragma unroll
                    for (int ai = 0; ai < 2; ++ai)
#pragma unroll
                        for (int m = 0; m < 4; ++m) { const f32x4 v0 = acc[ai][bj][m][0] + b0, v1 = acc[ai][bj][m][1] + b1;
                            u32x4 w; w.x = cvtpk(mul * sigm(v0[0]), mul * sigm(v0[1])); w.y = cvtpk(mul * sigm(v0[2]), mul * sigm(v0[3]));
                            w.z = cvtpk(mul * sigm(v1[0]), mul * sigm(v1[1])); w.w = cvtpk(mul * sigm(v1[2]), mul * sigm(v1[3]));
                            *(u32x4*)(O + (size_t)(row0 + ai * HALF + m * 16) * 1920 + c0) = w; }
                }
            }
        }
    }
};
struct EpiRes {
    static constexpr bool PERM = true, AFTER_DRAIN = false;
    const float* xl; const float* xc; float* ol; float* oc; const float* mod; int gofs;
    __device__ __forceinline__ void operator()(const f32x4 (&acc)[2][2][4][2], const Unit& u, int wr, int wc, int fr, int fq) const {
        const bool lat = u.pm < 256; const int bi = lat ? (u.pm >> 3) : 32;
        const size_t rbase = (size_t)(lat ? u.pm : u.pm - 256) * BM;
        const float* xlv = xl; const float* xcv = xc; float* olv = ol; float* ocv = oc; asm volatile("" : "+s"(xlv), "+s"(xcv), "+s"(olv), "+s"(ocv));
        const float* xin = (lat ? xlv : xcv) + rbase * 1024; float* out = (lat ? olv : ocv) + rbase * 1024;
        const float* gp = mod + (size_t)bi * 6144 + gofs;
        const int col0 = u.pn * BM + wc * 32 + 8 * fq, row0 = wr * 64 + fr;
#pragma unroll
        for (int bj = 0; bj < 2; ++bj)
#pragma unroll
            for (int n = 0; n < 2; ++n) { const int c = col0 + bj * HALF + 4 * n; const f32x4 gt = *(const f32x4*)(gp + c);
#pragma unroll
                for (int ai = 0; ai < 2; ++ai)
#pragma unroll
                    for (int m = 0; m < 4; ++m) { const size_t o = (size_t)(row0 + ai * HALF + m * 16) * 1024 + c;
                        const f32x4 xv = *(const f32x4*)(xin + o); const f32x4 a = acc[ai][bj][m][n];
                        f32x4 r; r[0] = 1.41421356237f * xv[0] + gt[0] * a[0]; r[1] = 1.41421356237f * xv[1] + gt[1] * a[1]; r[2] = 1.41421356237f * xv[2] + gt[2] * a[2]; r[3] = 1.41421356237f * xv[3] + gt[3] * a[3];
                        *(f32x4*)(out + o) = r; } }
    }
};
struct EpiSwiglu {
    static constexpr bool PERM = true, AFTER_DRAIN = false;
    bf16_t* O;
    __device__ __forceinline__ void operator()(const f32x4 (&acc)[2][2][4][2], const Unit& u, int wr, int wc, int fr, int fq) const {
        const int row0 = u.pm * BM + wr * 64 + fr, col0 = u.pn * HALF + wc * 32 + 8 * fq;
#pragma unroll
        for (int ai = 0; ai < 2; ++ai)
#pragma unroll
            for (int m = 0; m < 4; ++m) { float v[8];
#pragma unroll
                for (int i = 0; i < 8; ++i) { const float g = acc[ai][0][m][i >> 2][i & 3], up = acc[ai][1][m][i >> 2][i & 3]; v[i] = g * sigm(g) * up; }
                u32x4 w; w.x = cvtpk(v[0], v[1]); w.y = cvtpk(v[2], v[3]); w.z = cvtpk(v[4], v[5]); w.w = cvtpk(v[6], v[7]);
                *(u32x4*)(O + (size_t)(row0 + ai * HALF + m * 16) * 2816 + col0) = w; }
    }
};
struct EpiAny {
    static constexpr bool PERM = true, AFTER_DRAIN = false;
    int mode; EpiStoreBf16 e0; EpiLora e1; EpiRes e2; EpiSwiglu e3;
    __device__ __forceinline__ void operator()(const f32x4 (&acc)[2][2][4][2], const Unit& u, int wr, int wc, int fr, int fq) const {
        if (mode == 0) e0(acc, u, wr, wc, fr, fq); else if (mode == 1) e1(acc, u, wr, wc, fr, fq); else if (mode == 2) e2(acc, u, wr, wc, fr, fq); else e3(acc, u, wr, wc, fr, fq);
    }
};
template <class Epi, class Sched, bool ALIGN_EPI = false, bool SP2 = false>
__device__ __forceinline__ void gemm_phase(PG8_LAS unsigned char* lds, const Gemm g, const Sched& S, const Epi& E, const int tid) {
    const int wid = __builtin_amdgcn_readfirstlane(tid >> 6), lane = tid & 63, wr = wid >> 2, wc = wid & 3, fr = lane & 15, fq = lane >> 4;
    const int K = g.K, nt = K / BK;
    unsigned voffA[2], voffB[2];
#pragma unroll
    for (int i = 0; i < 2; ++i) { int R, C; stage_rc(tid * 16 + i * 8192, R, C); const int Rb = Epi::PERM ? ((R & ~31) + perm32(R & 31)) : R;
        voffA[i] = (unsigned)(R * K + C) * 2u; voffB[i] = (unsigned)(Rb * K + C) * 2u; }
    const size_t kstep = (size_t)(BK * 2);
    const size_t hstep = (size_t)HALF * K * 2;
    const size_t tstep = 2 * hstep;
    const unsigned ldsw = (unsigned)wid * 1024u;
    const int aoff = lds_byte(wr * 64 + fr, fq * 8), boff = lds_byte(wc * 32 + fr, fq * 8);
#define PG8_SA(b, h) (((b) * 2 + (h)) * HTB)
#define PG8_SB(b, h) ((4 + (b) * 2 + (h)) * HTB)
#define PG8_STAGE(bufoff, gbase, voff) do { _Pragma("unroll") for (int _i = 0; _i < 2; ++_i) \
        __builtin_amdgcn_global_load_lds((const unsigned*)((const char*)(gbase) + (voff)[_i]), (PG8_LAS unsigned*)(lds + (bufoff) + ldsw + _i * 8192), 16, 0, 0); } while (0)
#define PG8_LDA(dst, b, h) do { _Pragma("unroll") for (int m = 0; m < 4; ++m) _Pragma("unroll") for (int k = 0; k < 2; ++k) dst[m][k] = *(const PG8_LAS bf16x8*)(lds + PG8_SA(b, h) + aoff + m * 2048 + k * 1024); } while (0)
#define PG8_LDB(dst, b, h) do { _Pragma("unroll") for (int n = 0; n < 2; ++n) _Pragma("unroll") for (int k = 0; k < 2; ++k) dst[n][k] = *(const PG8_LAS bf16x8*)(lds + PG8_SB(b, h) + boff + n * 2048 + k * 1024); } while (0)
#define PG8_MMA(ai, bj, At, Bt) do { __builtin_amdgcn_s_setprio(1); _Pragma("unroll") for (int m = 0; m < 4; ++m) _Pragma("unroll") for (int n = 0; n < 2; ++n) _Pragma("unroll") for (int k = 0; k < 2; ++k) \
        acc[ai][bj][m][n] = __builtin_amdgcn_mfma_f32_16x16x32_bf16(Bt[n][k], At[m][k], acc[ai][bj][m][n], 0, 0, 0); __builtin_amdgcn_s_setprio(0); } while (0)
#define PG8_WAIT_V(n) asm volatile("s_waitcnt vmcnt(" #n ")" ::: "memory")
#define PG8_WAIT_L(n) asm volatile("s_waitcnt lgkmcnt(" #n ")" ::: "memory")
#define PG8_BAR __builtin_amdgcn_s_barrier()
#define PG8_SCHED __builtin_amdgcn_sched_barrier(0)
    Unit cur, nxt; int ui = 0;
    if (!S.next(0, cur)) return;
    f32x4 acc[2][2][4][2];
#pragma unroll
    for (int a = 0; a < 2; ++a)
#pragma unroll
        for (int b = 0; b < 2; ++b)
#pragma unroll
            for (int m = 0; m < 4; ++m)
#pragma unroll
                for (int n = 0; n < 2; ++n) acc[a][b][m][n] = (f32x4){0.f, 0.f, 0.f, 0.f};
    bf16x8 At[4][2], B0[2][2], B1[2][2];
    const char* cA = (const char*)g.A + (size_t)cur.pm * tstep; const char* cB = (const char*)g.Bt + (size_t)cur.pn * tstep;
    S.a_ready(cur);
    if constexpr (SP2) {
        PG8_STAGE(PG8_SB(0, 0), cB, voffB); PG8_STAGE(PG8_SB(0, 1), cB + hstep, voffB); PG8_STAGE(PG8_SA(0, 0), cA, voffA); PG8_STAGE(PG8_SA(0, 1), cA + hstep, voffA);
        if (wr == 1) PG8_BAR;
        PG8_WAIT_V(2); PG8_BAR;
        PG8_STAGE(PG8_SB(1, 0), cB + kstep, voffB); PG8_STAGE(PG8_SA(1, 0), cA + kstep, voffA); PG8_STAGE(PG8_SB(1, 1), cB + hstep + kstep, voffB);
        PG8_WAIT_V(6); PG8_BAR;
    } else {
        PG8_STAGE(PG8_SB(0, 0), cB, voffB); PG8_STAGE(PG8_SA(0, 0), cA, voffA); PG8_STAGE(PG8_SB(0, 1), cB + hstep, voffB); PG8_STAGE(PG8_SA(0, 1), cA + hstep, voffA);
        if (wr == 1) PG8_BAR;
        PG8_WAIT_V(4); PG8_BAR;
        PG8_STAGE(PG8_SB(1, 0), cB + kstep, voffB); PG8_STAGE(PG8_SA(1, 0), cA + kstep, voffA); PG8_STAGE(PG8_SB(1, 1), cB + hstep + kstep, voffB);
        PG8_WAIT_V(6); PG8_BAR;
    }
    for (;;) {
        const bool has_next = S.next(ui + 1, nxt);
        const char* nA = has_next ? (const char*)g.A + (size_t)nxt.pm * tstep : cA; const char* nB = has_next ? (const char*)g.Bt + (size_t)nxt.pn * tstep : cB;
        for (int t = 0; t < nt; t += 2) {
            const bool last = (t == nt - 2);
            const char* a1 = cA + (size_t)(t + 1) * kstep;
            const char* a2 = last ? nA : cA + (size_t)(t + 2) * kstep; const char* b2 = last ? nB : cB + (size_t)(t + 2) * kstep;
            const char* a3 = a2 + kstep; const char* b3 = b2 + kstep;
            if (last && has_next) S.a_ready(nxt);
            if constexpr (SP2) {
            PG8_LDB(B0, 0, 0); PG8_LDB(B1, 0, 1); PG8_SCHED; PG8_LDA(At, 0, 0); PG8_STAGE(PG8_SA(1, 1), a1 + hstep, voffA);
            PG8_WAIT_V(8); PG8_WAIT_L(0); PG8_BAR; PG8_MMA(0, 0, At, B0); PG8_MMA(0, 1, At, B1); PG8_BAR; PG8_SCHED;
            PG8_LDA(At, 0, 1); PG8_STAGE(PG8_SB(0, 0), b2, voffB); PG8_STAGE(PG8_SB(0, 1), b2 + hstep, voffB); PG8_STAGE(PG8_SA(0, 0), a2, voffA);
            PG8_WAIT_V(8); PG8_WAIT_L(0); PG8_BAR; PG8_MMA(1, 0, At, B0); PG8_MMA(1, 1, At, B1); PG8_BAR; PG8_SCHED;
            PG8_LDB(B0, 1, 0); PG8_LDB(B1, 1, 1); PG8_SCHED; PG8_LDA(At, 1, 0); PG8_STAGE(PG8_SA(0, 1), a2 + hstep, voffA);
            PG8_WAIT_V(8); PG8_WAIT_L(0); PG8_BAR; PG8_MMA(0, 0, At, B0); PG8_MMA(0, 1, At, B1); PG8_BAR; PG8_SCHED;
            PG8_LDA(At, 1, 1); PG8_STAGE(PG8_SB(1, 0), b3, voffB); PG8_STAGE(PG8_SB(1, 1), b3 + hstep, voffB); PG8_STAGE(PG8_SA(1, 0), a3, voffA);
            PG8_WAIT_V(8); PG8_WAIT_L(0); PG8_BAR; PG8_MMA(1, 0, At, B0); PG8_MMA(1, 1, At, B1); PG8_BAR; PG8_SCHED;
            } else {
            PG8_LDB(B0, 0, 0); PG8_SCHED; PG8_LDA(At, 0, 0); PG8_STAGE(PG8_SA(1, 1), a1 + hstep, voffA);
            PG8_WAIT_L(8); PG8_BAR; PG8_WAIT_L(0); PG8_MMA(0, 0, At, B0); PG8_BAR; PG8_SCHED;
            PG8_LDB(B1, 0, 1); PG8_STAGE(PG8_SB(0, 0), b2, voffB);
            PG8_BAR; PG8_WAIT_L(0); PG8_MMA(0, 1, At, B1); PG8_BAR;
            PG8_LDA(At, 0, 1); PG8_STAGE(PG8_SA(0, 0), a2, voffA);
            PG8_BAR; PG8_WAIT_L(0); PG8_MMA(1, 0, At, B0); PG8_BAR; PG8_SCHED;
            PG8_STAGE(PG8_SB(0, 1), b2 + hstep, voffB);
            PG8_WAIT_V(6); PG8_BAR; PG8_MMA(1, 1, At, B1); PG8_BAR;
            PG8_LDB(B0, 1, 0); PG8_SCHED; PG8_LDA(At, 1, 0); PG8_STAGE(PG8_SA(0, 1), a2 + hstep, voffA);
            PG8_WAIT_L(8); PG8_BAR; PG8_WAIT_L(0); PG8_MMA(0, 0, At, B0); PG8_BAR; PG8_SCHED;
            PG8_LDB(B1, 1, 1); PG8_STAGE(PG8_SB(1, 0), b3, voffB);
            PG8_BAR; PG8_WAIT_L(0); PG8_MMA(0, 1, At, B1); PG8_BAR;
            PG8_LDA(At, 1, 1); PG8_STAGE(PG8_SA(1, 0), a3, voffA);
            PG8_BAR; PG8_WAIT_L(0); PG8_MMA(1, 0, At, B0); PG8_BAR; PG8_SCHED;
            PG8_STAGE(PG8_SB(1, 1), b3 + hstep, voffB);
            PG8_WAIT_V(6); PG8_BAR; PG8_MMA(1, 1, At, B1); PG8_BAR;
            }
        }
        if constexpr (ALIGN_EPI) { if (wr == 0) PG8_BAR; }
        if constexpr (!Epi::AFTER_DRAIN) { E(acc, cur, wr, wc, fr, fq); S.done(cur); }
        if (!has_next) break;
#pragma unroll
        for (int a = 0; a < 2; ++a)
#pragma unroll
            for (int b = 0; b < 2; ++b)
#pragma unroll
                for (int m = 0; m < 4; ++m)
#pragma unroll
                    for (int n = 0; n < 2; ++n) acc[a][b][m][n] = (f32x4){0.f, 0.f, 0.f, 0.f};
        cur = nxt; cA = nA; cB = nB; ++ui;
        if constexpr (ALIGN_EPI) { if (wr == 1) PG8_BAR; }
    }
    PG8_WAIT_V(0);
    if constexpr (!ALIGN_EPI) { if (wr == 0) PG8_BAR; }
    PG8_BAR;
    if constexpr (Epi::AFTER_DRAIN) { E.fused(acc, cur, wr, wc, fr, fq, lds, wid, lane); S.done(cur); }
#undef PG8_SA
#undef PG8_SB
#undef PG8_STAGE
#undef PG8_LDA
#undef PG8_LDB
#undef PG8_MMA
#undef PG8_WAIT_V
#undef PG8_WAIT_L
#undef PG8_BAR
#undef PG8_SCHED
}
}

#define DI __device__ __forceinline__
#define LAS __attribute__((address_space(3)))
using pg8::bf16_t; using pg8::bf16x8; using pg8::f32x4; using pg8::u32x4; using pg8::cvtpk; using pg8::sigm;
typedef float f32x2 __attribute__((ext_vector_type(2)));
typedef unsigned u32x2 __attribute__((ext_vector_type(2)));

#ifndef NAT_GLA_PCT
#define NAT_GLA_PCT 0
#endif
#ifndef MIXMASK
#define MIXMASK 3
#endif
#ifndef ROLEMASK
#define ROLEMASK 15
#endif
#ifndef PHMASK
#define PHMASK 0xffff
#endif
constexpr int NTHR = 512, NWAVE = 8, LDS_BYTES = 147456;
constexpr int D = 1024, NB = 32, SL = 2048, CL = 256, ML = NB * SL, MC = NB * CL, MT = ML + MC;
constexpr int INC = 3488, PLD = 3584, FH = 2816, LOLD = 1920;
constexpr int C_GQ = 0, C_GK = 192, C_GV = 384, C_GG = 768, C_GDN = 1152;
constexpr int C_NQ = 1184, C_NK = 1440, C_NV = 1696;
constexpr int C_RW = 1952;
constexpr size_t OFF_WIN = 0, OFF_WOUT = 7340032, OFF_W13 = 9437184, OFF_W2 = 20971520, OFF_BT2 = 26738688, WLB = 28311552;
constexpr size_t WS_MOD = 2 * WLB, WS_ROPE = WS_MOD + 1622016, WS_BON = WS_ROPE + 262144, WS_VT = WS_BON + 3538944, WS_AY = WS_VT + 37748736,
                 WS_PB = WS_AY + 150994944, WS_LO = WS_PB + 528482304, WS_END = WS_LO + 283115520;

struct Params { const float* in[29]; float* out; unsigned char* ws; };
enum { I_X = 0, I_C, I_CTX, I_CCTX, I_WMOD, I_BMOD, I_WIN, I_GUP, I_GB, I_GNW, I_RPB, I_MU, I_W0, I_WD2, I_A0, I_WA2, I_WG2, I_KK, I_KA, I_RK, I_GNWT, I_GNB,
       I_WOUT, I_LN1W, I_LN1B, I_W13, I_W2, I_LN2W, I_LN2B };

DI const float* pin(const Params& p, int i) { asm volatile("" : "+s"(i)); return p.in[i]; }
DI float bf2f(bf16_t h) { return __uint_as_float(((unsigned)h) << 16); }
DI float bflo(unsigned u) { return __uint_as_float(u << 16); }
DI float bfhi(unsigned u) { return __uint_as_float(u & 0xffff0000u); }
DI bf16_t f2bf(float f) { return (bf16_t)(cvtpk(f, 0.f) & 0xffffu); }
DI float shx(float v, int m, int lane) { return __int_as_float(__builtin_amdgcn_ds_bpermute((lane ^ m) << 2, __float_as_int(v))); }
DI float wave_sum(float v, int lane) {
#pragma unroll
    for (int o = 1; o < 64; o <<= 1) v += shx(v, o, lane);
    return v;
}
DI void cvt8(const u32x4 u, float* o) { o[0] = bflo(u.x); o[1] = bfhi(u.x); o[2] = bflo(u.y); o[3] = bfhi(u.y); o[4] = bflo(u.z); o[5] = bfhi(u.z); o[6] = bflo(u.w); o[7] = bfhi(u.w); }
DI void load8(const bf16_t* p, float* o) { const u32x4 u = *(const u32x4*)p; o[0] = bflo(u.x); o[1] = bfhi(u.x); o[2] = bflo(u.y); o[3] = bfhi(u.y); o[4] = bflo(u.z); o[5] = bfhi(u.z); o[6] = bflo(u.w); o[7] = bfhi(u.w); }
DI void load16(const bf16_t* p, float (&o)[16]) { load8(p, &o[0]); load8(p + 8, &o[8]); }
DI void shift16(const bf16_t* prow, bool hasm, bool hasp, const float* mu, float (&y)[16]) {
    float c0[16], cm[16], cp[16];
    load16(prow, c0);
    if (hasm) load16(prow - PLD, cm); else {
#pragma unroll
        for (int j = 0; j < 16; ++j) cm[j] = 0.f; }
    if (hasp) load16(prow + PLD, cp); else {
#pragma unroll
        for (int j = 0; j < 16; ++j) cp[j] = 0.f; }
#pragma unroll
    for (int j = 0; j < 16; ++j) y[j] = c0[j] + (0.5f * (cm[j] + cp[j]) - c0[j]) * mu[j];
}
DI void step_row(int s, int g, int b, int& row, int& ts, int& Ls) {
    if (s < CL) { ts = g ? (CL - 1 - s) : s; row = ML + b * CL + ts; Ls = CL; }
    else { const int u = s - CL; ts = g ? (SL - 1 - u) : u; row = b * SL + ts; Ls = SL; }
}

DI void transpose_item(const float* W, int N, bf16_t* WT, int Kd, size_t dst_row0, int k0, int n0, LAS float* scr, int lane) {
#pragma unroll 8
    for (int i = 0; i < 32; ++i) { const int kk = 2 * i + (lane >> 5); scr[kk * 33 + (lane & 31)] = W[(size_t)(k0 + kk) * N + n0 + (lane & 31)]; }
    asm volatile("s_waitcnt lgkmcnt(0)" ::: "memory");
    const int c = lane & 7;
#pragma unroll
    for (int j = 0; j < 4; ++j) { const int n = (lane >> 3) + 8 * j; const LAS float* s = scr + (8 * c) * 33 + n;
        u32x4 o; o.x = cvtpk(s[0 * 33], s[1 * 33]); o.y = cvtpk(s[2 * 33], s[3 * 33]); o.z = cvtpk(s[4 * 33], s[5 * 33]); o.w = cvtpk(s[6 * 33], s[7 * 33]);
        *(u32x4*)(WT + (dst_row0 + n) * Kd + k0 + 8 * c) = o; }
    asm volatile("s_waitcnt lgkmcnt(0)" ::: "memory");
}

DI void phase_prologue(const Params& p, LAS unsigned char* lds, int tid, int lane, int wave) {
    unsigned char* ws = p.ws;
    float* MOD = (float*)(ws + WS_MOD);
    {
        LAS float* sc = (LAS float*)lds;
        LAS float* part = (LAS float*)(lds + 135168);
        for (int i = tid; i < 33 * 1024; i += NTHR) { const int bi = i >> 10, k = i & 1023; const float cv = bi < 32 ? pin(p, I_C)[bi * 1024 + k] : pin(p, I_CCTX)[k]; sc[k * 33 + bi] = cv * sigm(cv); }
        __syncthreads();
        for (int u = blockIdx.x; u < 192; u += gridDim.x) {
            const int l = u / 96, n0 = (u % 96) * 64;
            float acc[33];
#pragma unroll
            for (int bi = 0; bi < 33; ++bi) acc[bi] = 0.f;
            const float* wp = pin(p, I_WMOD) + (size_t)l * 1024 * 6144 + n0 + lane;
#pragma unroll 4
            for (int kk = 0; kk < 128; ++kk) { const int k = wave * 128 + kk; const float w = wp[(size_t)k * 6144];
#pragma unroll
                for (int bi = 0; bi < 33; ++bi) acc[bi] += sc[k * 33 + bi] * w; }
            for (int w = 0; w < NWAVE; ++w) {
                if (wave == w) {
#pragma unroll
                    for (int bi = 0; bi < 33; ++bi) { if (w == 0) part[bi * 64 + lane] = acc[bi]; else part[bi * 64 + lane] += acc[bi]; } }
                __syncthreads();
            }
            for (int i = tid; i < 33 * 64; i += NTHR) { const int bi = i >> 6, n = i & 63; MOD[(size_t)(l * 33 + bi) * 6144 + n0 + n] = part[i] + pin(p, I_BMOD)[l * 6144 + n0 + n]; }
            __syncthreads();
        }
        __syncthreads();
    }
    const int gw = blockIdx.x * NWAVE + wave, NGW = gridDim.x * NWAVE;
    const int gt = blockIdx.x * NTHR + tid, NGT = gridDim.x * NTHR;
    {
        LAS float* scr = (LAS float*)(lds + wave * 8448);
        constexpr int IT_IN = 16 * 109, IT_OUT = 16 * 32, IT_13 = 16 * 176, IT_2 = 44 * 32, IT_L = IT_IN + IT_OUT + IT_13 + IT_2;
        for (int it = gw; it < 2 * IT_L; it += NGW) {
            const int l = it / IT_L; int r = it % IT_L;
            unsigned char* wl = ws + (size_t)l * WLB;
            if (r < IT_IN) { const int kb = r / 109, nb = r % 109;
                transpose_item(pin(p, I_WIN) + (size_t)l * 1024 * INC, INC, (bf16_t*)(wl + OFF_WIN), 1024, (size_t)nb * 32, kb * 64, nb * 32, scr, lane); continue; }
            r -= IT_IN;
            if (r < IT_OUT) { const int kb = r / 32, nb = r % 32;
                transpose_item(pin(p, I_WOUT) + (size_t)l * 1024 * 1024, 1024, (bf16_t*)(wl + OFF_WOUT), 1024, (size_t)nb * 32, kb * 64, nb * 32, scr, lane); continue; }
            r -= IT_OUT;
            if (r < IT_13) { const int kb = r / 176, nb = r % 176; const int n0 = nb * 32;
                const int j = n0 < FH ? n0 : n0 - FH; const size_t drow = (size_t)(256 * (j / 128) + (n0 < FH ? 0 : 128) + (j % 128));
                transpose_item(pin(p, I_W13) + (size_t)l * 1024 * 2 * FH, 2 * FH, (bf16_t*)(wl + OFF_W13), 1024, drow, kb * 64, n0, scr, lane); continue; }
            r -= IT_13;
            { const int kb = r / 32, nb = r % 32;
                transpose_item(pin(p, I_W2) + (size_t)l * FH * 1024, 1024, (bf16_t*)(wl + OFF_W2), FH, (size_t)nb * 32, kb * 64, nb * 32, scr, lane); }
        }
    }
    for (int i = gt; i < 2 * 96 * 1024; i += NGT) { const int l = i / (96 * 1024), r = i % (96 * 1024); ((bf16_t*)(ws + (size_t)l * WLB + OFF_WIN))[(size_t)INC * 1024 + r] = 0; }
    for (int i = gt; i < 2 * 2048 * 384; i += NGT) {
        const int l = i / (2048 * 384), r = i % (2048 * 384), n = r / 384, k = r % 384;
        float v = 0.f;
        if (n < 1536) { const int g = n / 768, h = (n % 768) / 128, which = (n % 128) / 64, ch = n % 64, c = h * 64 + ch;
            const int kb = which ? 128 + 64 * g : 64 * g;
            if (k >= kb && k < kb + 64) v = (which ? pin(p, I_WA2) : pin(p, I_WD2))[((size_t)(l * 2 + g) * 64 + (k - kb)) * 384 + c]; }
        else if (n < 1920) { if (k >= 256) v = pin(p, I_WG2)[((size_t)l * 128 + (k - 256)) * 384 + (n - 1536)]; }
        ((bf16_t*)(ws + (size_t)l * WLB + OFF_BT2))[r] = f2bf(v);
    }
    for (int i = gt; i < SL * 16; i += NGT) { const int t = i >> 4, pi = i & 15; const float pos = (float)(pi < 8 ? (t >> 6) : (t & 63));
        const float inv = powf(10000.0f, -(float)(pi & 7) * 0.125f); const float ang = pos * inv;
        float* rt = (float*)(ws + WS_ROPE) + (size_t)i * 2; rt[0] = cosf(ang); rt[1] = sinf(ang); }
}

DI void phase_modulate0(const Params& p, int lane, int wave) {
    const int gw = blockIdx.x * NWAVE + wave, NGW = gridDim.x * NWAVE;
    const float* MOD = (const float*)(p.ws + WS_MOD); bf16_t* A = (bf16_t*)(p.ws + WS_AY);
    for (int row = gw; row < MT; row += NGW) {
        const float* src = row < ML ? pin(p, I_X) + (size_t)row * D : pin(p, I_CTX) + (size_t)(row - ML) * D;
        const int bi = row < ML ? (row >> 11) : 32; const float* md = MOD + (size_t)bi * 6144;
#pragma unroll
        for (int j = 0; j < 4; ++j) { const int c = 4 * (lane + 64 * j); const f32x4 v = *(const f32x4*)(src + c), sh = *(const f32x4*)(md + c), sc = *(const f32x4*)(md + 1024 + c);
            u32x2 o; o.x = cvtpk(v[0] * (1.f + sc[0]) + sh[0], v[1] * (1.f + sc[1]) + sh[1]); o.y = cvtpk(v[2] * (1.f + sc[2]) + sh[2], v[3] * (1.f + sc[3]) + sh[3]);
            *(u32x2*)(A + (size_t)row * D + c) = o; }
    }
}
DI void phase_ln(const Params& p, int lane, int wave, int nrows, const float* lnw, const float* lnb, const float* modl, int sh_ofs, int sc_ofs, bool write_x, bool write_A) {
    const int gw = blockIdx.x * NWAVE + wave, NGW = gridDim.x * NWAVE;
    bf16_t* A = (bf16_t*)(p.ws + WS_AY); float* tc = (float*)(p.ws + WS_VT);
    for (int row = gw; row < nrows; row += NGW) {
        const bool lat = row < ML;
        float* t = lat ? p.out + (size_t)row * D : tc + (size_t)(row - ML) * D;
        const int bi = lat ? (row >> 11) : 32;
        f32x4 v[4]; float s = 0.f;
#pragma unroll
        for (int j = 0; j < 4; ++j) { v[j] = *(const f32x4*)(t + 4 * (lane + 64 * j)); s += (v[j][0] + v[j][1]) + (v[j][2] + v[j][3]); }
        const float mean = wave_sum(s, lane) * (1.f / D); float s2 = 0.f;
#pragma unroll
        for (int j = 0; j < 4; ++j) { v[j] = v[j] - mean; s2 += (v[j][0] * v[j][0] + v[j][1] * v[j][1]) + (v[j][2] * v[j][2] + v[j][3] * v[j][3]); }
        const float rstd = rsqrtf(wave_sum(s2, lane) * (1.f / D) + 1e-5f);
        const float* md = modl + (size_t)bi * 6144;
#pragma unroll
        for (int j = 0; j < 4; ++j) { const int c = 4 * (lane + 64 * j); const f32x4 w = *(const f32x4*)(lnw + c), b = *(const f32x4*)(lnb + c);
            f32x4 y; y[0] = v[j][0] * rstd * w[0] + b[0]; y[1] = v[j][1] * rstd * w[1] + b[1]; y[2] = v[j][2] * rstd * w[2] + b[2]; y[3] = v[j][3] * rstd * w[3] + b[3];
            if (write_x && lat) *(f32x4*)(t + c) = y;
            else if (write_x) *(f32x4*)(t + c) = y;
            if (write_A) { const f32x4 sh = *(const f32x4*)(md + sh_ofs + c), sc = *(const f32x4*)(md + sc_ofs + c);
                u32x2 o; o.x = cvtpk(y[0] * (1.f + sc[0]) + sh[0], y[1] * (1.f + sc[1]) + sh[1]); o.y = cvtpk(y[2] * (1.f + sc[2]) + sh[2], y[3] * (1.f + sc[3]) + sh[3]);
                *(u32x2*)(A + (size_t)row * D + c) = o; } }
    }
}

DI void phase_prep(const Params& p, int l, LAS unsigned char* lds, int lane, int wave) {
    const int gw = blockIdx.x * NWAVE + wave, NGW = gridDim.x * NWAVE;
    const bf16_t* PB = (const bf16_t*)(p.ws + WS_PB); bf16_t* A2 = (bf16_t*)(p.ws + WS_AY); bf16_t* VT = (bf16_t*)(p.ws + WS_VT);
    {
        const int j8 = lane < 48 ? 8 * lane : 0, kind = j8 >> 7;
        float mu[8];
        { const float* m = pin(p, I_MU) + (size_t)l * 1536 + 1152 + j8;
#pragma unroll
          for (int j = 0; j < 8; ++j) mu[j] = m[j]; }
        for (int row = gw; row < MT; row += NGW) {
            const bool lat = row < ML; const int t = lat ? (row & (SL - 1)) : ((row - ML) & (CL - 1)); const int Ls = lat ? SL : CL;
            const bf16_t* pr = PB + (size_t)row * PLD + C_RW + 1152 + j8;
            const u32x4 r0 = *(const u32x4*)pr, rm = *(const u32x4*)(t > 0 ? pr - PLD : pr), rp = *(const u32x4*)(t < Ls - 1 ? pr + PLD : pr);
            const float mm = t > 0 ? 0.5f : 0.f, mp = t < Ls - 1 ? 0.5f : 0.f;
            float c0[8], cm[8], cp[8], o[8];
            cvt8(r0, c0); cvt8(rm, cm); cvt8(rp, cp);
#pragma unroll
            for (int j = 0; j < 8; ++j) { const float y = c0[j] + ((mm * cm[j] + mp * cp[j]) - c0[j]) * mu[j];
                o[j] = kind == 0 ? 1.f - 2.f / (1.f + __expf(2.f * y)) : (kind == 1 ? y : sigm(y)); }
            if (lane < 48) { u32x4 w; w.x = cvtpk(o[0], o[1]); w.y = cvtpk(o[2], o[3]); w.z = cvtpk(o[4], o[5]); w.w = cvtpk(o[6], o[7]); *(u32x4*)(A2 + (size_t)row * 384 + j8) = w; }
        }
    }
    LAS bf16_t* T = (LAS bf16_t*)(lds + wave * 8448);
    for (int it = gw; it < NB * 4 * 36; it += NGW) {
        const int tb = it % 36, h = (it / 36) & 3, b = it / 144;
        const int row0 = tb < 32 ? b * SL + tb * 64 : ML + b * CL + (tb - 32) * 64;
        const bf16_t* src = PB + (size_t)(row0 + (lane >> 3)) * PLD + C_NV + h * 64 + 8 * (lane & 7);
#pragma unroll
        for (int i = 0; i < 8; ++i) { const u32x4 v = *(const u32x4*)(src + (size_t)(8 * i) * PLD);
            LAS unsigned* d = (LAS unsigned*)(T + (8 * i + (lane >> 3)) * 66 + 8 * (lane & 7)); d[0] = v.x; d[1] = v.y; d[2] = v.z; d[3] = v.w; }
        asm volatile("s_waitcnt vmcnt(0) lgkmcnt(0)" ::: "memory");
        bf16_t* dst = VT + ((size_t)(b * 4 + h) * 144 + tb * 4) * 1024;
#pragma unroll
        for (int k = 0; k < 16; ++k) { const int u = k * 64 + lane, q = u >> 8, d = (u >> 2) & 63, kg = u & 3;
            const LAS bf16_t* tp = T + (16 * q + 4 * kg) * 66 + d;
            u32x2 o; o.x = (unsigned)tp[0] | ((unsigned)tp[66] << 16); o.y = (unsigned)tp[132] | ((unsigned)tp[198] << 16);
            *(u32x2*)(dst + (size_t)(q * 64 + d) * 16 + 4 * kg) = o; }
        asm volatile("s_waitcnt lgkmcnt(0)" ::: "memory");
    }
}

#define MFMA16(a, b, c) __builtin_amdgcn_mfma_f32_16x16x32_bf16((a), (b), (c), 0, 0, 0)
DI u32x4 vload16(const bf16_t* p) { const volatile unsigned* q = (const volatile unsigned*)p; u32x4 r; r.x = q[0]; r.y = q[1]; r.z = q[2]; r.w = q[3]; return r; }
DI u32x2 vload8(const bf16_t* p) { const volatile unsigned* q = (const volatile unsigned*)p; u32x2 r; r.x = q[0]; r.y = q[1]; return r; }
struct NatPair { bf16x8 k[2][2]; u32x2 v[4][2]; u32x2 bias[2]; };
DI void nat_unit(const Params& p, int l, int id, bool isctx, int lane) {
    const bf16_t* PB = (const bf16_t*)(p.ws + WS_PB); const bf16_t* VT = (const bf16_t*)(p.ws + WS_VT); bf16_t* AY = (bf16_t*)(p.ws + WS_AY);
    const int l15 = lane & 15, g = lane >> 4;
    int b, h, r = 0, qt, qrow;
    if (!isctx) { qt = id & 3; r = (id >> 2) & 31; h = (id >> 7) & 3; b = id >> 9; qrow = b * SL + r * 64 + 16 * qt + l15; }
    else { qt = id & 15; h = (id >> 4) & 3; b = id >> 6; qrow = ML + b * CL + 16 * qt + l15; }
    const bf16_t* qp = PB + (size_t)qrow * PLD + C_NQ + h * 64 + 8 * g;
    const bf16x8 qf0 = *(const bf16x8*)qp, qf1 = *(const bf16x8*)(qp + 32);
    const int rs = min(max(r - 4, 0), 24);
    int ct_lo = 0, nct = 1;
    if (!isctx) { const int lo = min(max(16 * qt - 8, 0), 48), hi = min(max(16 * qt + 7, 0), 48) + 16; ct_lo = lo >> 4; nct = ((hi - 1) >> 4) - ct_lo + 1; }
    const int nloc = isctx ? 0 : 8 * nct, npairs = nloc / 2 + 8;
    const int qc = 16 * qt + l15, cs = min(max(qc - 8, 0), 48);
    float m = -1e30f, lsum = 0.f;
    f32x4 oacc[4];
#pragma unroll
    for (int dt = 0; dt < 4; ++dt) oacc[dt] = (f32x4){0.f, 0.f, 0.f, 0.f};
    const bf16_t* vt = VT + (size_t)(b * 4 + h) * 144 * 1024 + l15 * 16 + 4 * g;
    const bf16_t* kbase = PB + (size_t)l15 * PLD + C_NK + h * 64 + 8 * g;
    const float* rp = pin(p, I_RPB) + (size_t)((l * 4 + h) * 15) * 31;
    NatPair ring[4];
    int iti = 0, ikr = 0, icj = 0;
#define NAT_ISSUE(slot) do { __builtin_amdgcn_sched_barrier(0); _Pragma("unroll") for (int e = 0; e < 2; ++e) { int tk, keyrow; f32x4 bs = (f32x4){0.f, 0.f, 0.f, 0.f}; \
        if (iti < nloc) { const int ct = ct_lo + icj; tk = (rs + ikr) * 64 + 16 * ct; keyrow = b * SL + tk; const float* rpr = rp + (rs + ikr - r + 7) * 31; \
            _Pragma("unroll") for (int rg = 0; rg < 4; ++rg) { const int kc = 16 * ct + 4 * g + rg; const bool vis = (kc >= cs) && (kc < cs + 16); const float bv = rpr[min(max(kc - qc + 15, 0), 30)]; bs[rg] = vis ? bv : -1e30f; } \
            if (++icj == nct) { icj = 0; ++ikr; } } \
        else { const int j = (iti - nloc) * 16; tk = SL + j; keyrow = ML + b * CL + j; } \
        ++iti; ring[slot].bias[e] = (u32x2){cvtpk(bs[0], bs[1]), cvtpk(bs[2], bs[3])}; \
        const bf16_t* kp = kbase + (size_t)keyrow * PLD; ring[slot].k[e][0] = *(const bf16x8*)kp; ring[slot].k[e][1] = *(const bf16x8*)(kp + 32); \
        _Pragma("unroll") for (int dt = 0; dt < 4; ++dt) ring[slot].v[dt][e] = *(const u32x2*)(vt + (size_t)(tk >> 4) * 1024 + dt * 256); } __builtin_amdgcn_sched_barrier(0); } while (0)
#pragma unroll
    for (int j = 0; j < 4; ++j) NAT_ISSUE(j);
    for (int pi0 = 0; pi0 < npairs; pi0 += 4) {
#pragma unroll
        for (int j = 0; j < 4; ++j) {
            const int pi = pi0 + j;
            f32x4 s[2];
#pragma unroll
            for (int e = 0; e < 2; ++e) {
                f32x4 a = (f32x4){0.f, 0.f, 0.f, 0.f};
                a = MFMA16(ring[j].k[e][0], qf0, a); a = MFMA16(ring[j].k[e][1], qf1, a);
                const u32x2 bb = ring[j].bias[e];
                s[e] = a * 0.125f + (f32x4){bflo(bb.x), bfhi(bb.x), bflo(bb.y), bfhi(bb.y)};
            }
            float tmax = fmaxf(fmaxf(fmaxf(s[0][0], s[0][1]), fmaxf(s[0][2], s[0][3])), fmaxf(fmaxf(s[1][0], s[1][1]), fmaxf(s[1][2], s[1][3])));
            tmax = fmaxf(tmax, shx(tmax, 16, lane)); tmax = fmaxf(tmax, shx(tmax, 32, lane));
            const float mn = fmaxf(m, tmax), corr = __expf(m - mn); m = mn;
            float pv[8]; float ps = 0.f;
#pragma unroll
            for (int i = 0; i < 8; ++i) { const float sv = s[i >> 2][i & 3]; pv[i] = sv > -1e29f ? __expf(sv - mn) : 0.f; ps += pv[i]; }
            lsum = lsum * corr + ps;
            u32x4 pk; pk.x = cvtpk(pv[0], pv[1]); pk.y = cvtpk(pv[2], pv[3]); pk.z = cvtpk(pv[4], pv[5]); pk.w = cvtpk(pv[6], pv[7]);
            const bf16x8 pf = __builtin_bit_cast(bf16x8, pk);
#pragma unroll
            for (int dt = 0; dt < 4; ++dt) {
                u32x4 vv; vv.x = ring[j].v[dt][0].x; vv.y = ring[j].v[dt][0].y; vv.z = ring[j].v[dt][1].x; vv.w = ring[j].v[dt][1].y;
                oacc[dt] = oacc[dt] * corr;
                oacc[dt] = MFMA16(__builtin_bit_cast(bf16x8, vv), pf, oacc[dt]);
            }
            if (pi + 4 < npairs) NAT_ISSUE(j);
        }
    }
#undef NAT_ISSUE
    lsum += shx(lsum, 16, lane); lsum += shx(lsum, 32, lane);
    const float inv = 1.0f / lsum;
    bf16_t* yp = AY + (size_t)qrow * D + 768 + h * 64 + 4 * g;
#pragma unroll
    for (int dt = 0; dt < 4; ++dt) { u32x2 o; o.x = cvtpk(oacc[dt][0] * inv, oacc[dt][1] * inv); o.y = cvtpk(oacc[dt][2] * inv, oacc[dt][3] * inv); *(u32x2*)(yp + 16 * dt) = o; }
}

constexpr int RW_STEP = 384, RW_BUF = 16 * RW_STEP, GL_STEP = 160, GL_BUF = 16 * GL_STEP, NCHUNK = (CL + SL) / 16;
struct RwRaw { u32x4 d[3][3][2]; u32x4 lo[4]; };
DI void rwkv_load(const Params& p, int item, int c, RwRaw& R, int lane) {
    const int g = item & 1, h = (item >> 1) % 6, b = item / 12;
    const int ti = lane >> 2, cg = lane & 3;
    int row, ts, Ls; step_row(16 * c + ti, g, b, row, ts, Ls);
    const int rm = ts > 0 ? row - 1 : row, rp = ts < Ls - 1 ? row + 1 : row;
    const bf16_t* PB = (const bf16_t*)(p.ws + WS_PB) + C_RW + h * 64 + 16 * cg;
    const bf16_t* p0 = PB + (size_t)row * PLD; const bf16_t* pm = PB + (size_t)rm * PLD; const bf16_t* pp = PB + (size_t)rp * PLD;
#pragma unroll
    for (int a = 0; a < 3; ++a)
#pragma unroll
        for (int hf = 0; hf < 2; ++hf) { R.d[a][0][hf] = *(const u32x4*)(pm + a * 384 + 8 * hf); R.d[a][1][hf] = *(const u32x4*)(p0 + a * 384 + 8 * hf); R.d[a][2][hf] = *(const u32x4*)(pp + a * 384 + 8 * hf); }
    const bf16_t* lo = (const bf16_t*)(p.ws + WS_LO) + (size_t)row * LOLD + (g * 6 + h) * 128 + 16 * cg;
    R.lo[0] = *(const u32x4*)lo; R.lo[1] = *(const u32x4*)(lo + 8); R.lo[2] = *(const u32x4*)(lo + 64); R.lo[3] = *(const u32x4*)(lo + 72);
}
DI void rwkv_compute(const Params& p, int item, int c, const RwRaw& R, LAS float* buf, const LAS float* CST, int lane) {
    const int g = item & 1, h = (item >> 1) % 6, b = item / 12;
    const int ti = lane >> 2, cg = lane & 3;
    int row, ts, Ls; step_row(16 * c + ti, g, b, row, ts, Ls);
    const float mm = ts > 0 ? 0.5f : 0.f, mp = ts < Ls - 1 ? 0.5f : 0.f;
    float y[3][16];
#pragma unroll
    for (int a = 0; a < 3; ++a) {
        float c0[16], cm[16], cp[16];
        cvt8(R.d[a][0][0], &cm[0]); cvt8(R.d[a][0][1], &cm[8]); cvt8(R.d[a][1][0], &c0[0]); cvt8(R.d[a][1][1], &c0[8]); cvt8(R.d[a][2][0], &cp[0]); cvt8(R.d[a][2][1], &cp[8]);
#pragma unroll
        for (int j4 = 0; j4 < 4; ++j4) { const f32x4 mu = *(const LAS f32x4*)(CST + a * 64 + 16 * cg + 4 * j4);
#pragma unroll
            for (int jj = 0; jj < 4; ++jj) { const int j = 4 * j4 + jj; y[a][j] = c0[j] + ((mm * cm[j] + mp * cp[j]) - c0[j]) * mu[jj]; } }
    }
    float lw[16], a[16];
    cvt8(R.lo[0], &lw[0]); cvt8(R.lo[1], &lw[8]); cvt8(R.lo[2], &a[0]); cvt8(R.lo[3], &a[8]);
    float kkv[16]; float ss = 0.f;
#pragma unroll
    for (int j4 = 0; j4 < 4; ++j4) { const f32x4 kc = *(const LAS f32x4*)(CST + 3 * 64 + 16 * cg + 4 * j4);
#pragma unroll
        for (int jj = 0; jj < 4; ++jj) { const int j = 4 * j4 + jj; kkv[j] = y[1][j] * kc[jj]; ss += kkv[j] * kkv[j]; } }
    ss += shx(ss, 1, lane); ss += shx(ss, 2, lane);
    const float inv = rsqrtf(ss + 1e-12f);
    float bon = 0.f;
    LAS float* o = buf + ti * RW_STEP + 16 * cg;
#pragma unroll
    for (int j4 = 0; j4 < 4; ++j4) {
        const f32x4 kac = *(const LAS f32x4*)(CST + 4 * 64 + 16 * cg + 4 * j4), rkc = *(const LAS f32x4*)(CST + 5 * 64 + 16 * cg + 4 * j4);
        f32x4 w4, b4, km4, r4, kk4, v4;
#pragma unroll
        for (int jj = 0; jj < 4; ++jj) { const int j = 4 * j4 + jj;
            const float kkn = kkv[j] * inv, aj = a[j];
            const float km = y[1][j] * (1.f + (aj - 1.f) * kac[jj]);
            w4[jj] = __expf(-lw[j]); b4[jj] = kkn * aj; km4[jj] = km; r4[jj] = y[0][j]; kk4[jj] = kkn; v4[jj] = y[2][j];
            bon += y[0][j] * km * rkc[jj]; }
        *(LAS f32x4*)(o + 0 * 64 + 4 * j4) = w4; *(LAS f32x4*)(o + 1 * 64 + 4 * j4) = b4; *(LAS f32x4*)(o + 2 * 64 + 4 * j4) = km4;
        *(LAS f32x4*)(o + 3 * 64 + 4 * j4) = r4; *(LAS f32x4*)(o + 4 * 64 + 4 * j4) = kk4; *(LAS f32x4*)(o + 5 * 64 + 4 * j4) = v4;
    }
    bon += shx(bon, 1, lane); bon += shx(bon, 2, lane);
    if (cg == 0) ((float*)(p.ws + WS_BON))[(size_t)row * 12 + g * 6 + h] = bon;
}
DI float xhalf_sum(float x) {
    const auto r = __builtin_amdgcn_permlane32_swap(__float_as_uint(x), __float_as_uint(x), false, false);
    return __uint_as_float(r[0]) + __uint_as_float(r[1]);
}
DI void rwkv_scan_chunk(const Params& p, int item, int c, const LAS float* buf, f32x2 (&S)[16], int lane, int hf, bool dry) {
    const int g = item & 1, h = (item >> 1) % 6, b = item / 12;
    float* LOf = (float*)(p.ws + WS_LO);
    const int kh = lane >> 5, rowi = 32 * hf + (lane & 31);
    const LAS float* bk = buf + 32 * kh;
    f32x4 KK[8];
#pragma unroll
    for (int i = 0; i < 8; ++i) KK[i] = *(const LAS f32x4*)(bk + 256 + 4 * i);
    float vv = buf[320 + rowi];
    for (int st = 0; st < 16; ++st) {
        const LAS float* W = bk + st * RW_STEP;
        const LAS float* Wn = bk + (st < 15 ? st + 1 : st) * RW_STEP;
        f32x4 U[2][8];
#pragma unroll
        for (int j = 0; j < 2; ++j) { U[0][4 * j] = *(const LAS f32x4*)(W + 4 * j); U[0][4 * j + 1] = *(const LAS f32x4*)(W + 64 + 4 * j); U[0][4 * j + 2] = *(const LAS f32x4*)(W + 128 + 4 * j); U[0][4 * j + 3] = *(const LAS f32x4*)(W + 192 + 4 * j); }
        f32x2 sacc[4];
#pragma unroll
        for (int i = 0; i < 4; ++i) sacc[i] = (f32x2){0.f, 0.f};
#pragma unroll
        for (int i = 0; i < 8; ++i) { sacc[(2 * i) & 3] += S[2 * i] * (f32x2){KK[i][0], KK[i][1]}; sacc[(2 * i + 1) & 3] += S[2 * i + 1] * (f32x2){KK[i][2], KK[i][3]}; }
        const f32x2 st2 = (sacc[0] + sacc[1]) + (sacc[2] + sacc[3]);
        const float sa = -xhalf_sum(st2[0] + st2[1]);
        const f32x2 sa2 = (f32x2){sa, sa}, vv2 = (f32x2){vv, vv};
        f32x2 oacc[4];
#pragma unroll
        for (int i = 0; i < 4; ++i) oacc[i] = (f32x2){0.f, 0.f};
        asm volatile("" : "+v"(oacc[0]), "+v"(oacc[1]) :: "memory");
#pragma unroll
        for (int gi = 0; gi < 4; ++gi) {
            const int cu = gi & 1, nx = cu ^ 1;
            if (gi < 3) {
#pragma unroll
                for (int j = 0; j < 2; ++j) { const int i = 2 * (gi + 1) + j; U[nx][4 * j] = *(const LAS f32x4*)(W + 4 * i); U[nx][4 * j + 1] = *(const LAS f32x4*)(W + 64 + 4 * i);
                    U[nx][4 * j + 2] = *(const LAS f32x4*)(W + 128 + 4 * i); U[nx][4 * j + 3] = *(const LAS f32x4*)(W + 192 + 4 * i); }
            }
            if (gi >= 2) {
#pragma unroll
                for (int j = 0; j < 4; ++j) KK[4 * (gi - 2) + j] = *(const LAS f32x4*)(Wn + 256 + 4 * (4 * (gi - 2) + j));
            }
#pragma unroll
            for (int j = 0; j < 2; ++j) { const int i = 2 * gi + j; const f32x4 w4 = U[cu][4 * j], b4 = U[cu][4 * j + 1], km4 = U[cu][4 * j + 2], r4 = U[cu][4 * j + 3];
                f32x2 t0 = vv2 * (f32x2){km4[0], km4[1]}; t0 = sa2 * (f32x2){b4[0], b4[1]} + t0; S[2 * i] = S[2 * i] * (f32x2){w4[0], w4[1]} + t0;
                f32x2 t1 = vv2 * (f32x2){km4[2], km4[3]}; t1 = sa2 * (f32x2){b4[2], b4[3]} + t1; S[2 * i + 1] = S[2 * i + 1] * (f32x2){w4[2], w4[3]} + t1;
                oacc[(2 * i) & 3] += S[2 * i] * (f32x2){r4[0], r4[1]}; oacc[(2 * i + 1) & 3] += S[2 * i + 1] * (f32x2){r4[2], r4[3]}; }
            asm volatile("" : "+v"(oacc[0]), "+v"(oacc[1]), "+v"(oacc[2]), "+v"(oacc[3]) :: "memory");
        }
        vv = buf[(st < 15 ? st + 1 : st) * RW_STEP + 320 + rowi];
        const f32x2 o2 = (oacc[0] + oacc[1]) + (oacc[2] + oacc[3]);
        const float ov = xhalf_sum(o2[0] + o2[1]);
        int row, ts, Ls; step_row(16 * c + st, g, b, row, ts, Ls);
        if (kh == 0 && (!dry || ov == 1.2345e37f)) LOf[(size_t)row * (LOLD / 2) + (g * 6 + h) * 64 + rowi] = ov;
    }
}
struct GlRaw { u32x4 q, k, v[2], dn[2]; f32x4 rt[2]; };
DI void gla_load(const Params& p, int item, int c, GlRaw& R, int lane) {
    const int g = item & 1, h = (item >> 1) % 6, b = item / 12;
    const int ti = lane >> 2, cg = lane & 3;
    int row, ts, Ls; step_row(16 * c + ti, g, b, row, ts, Ls);
    const bf16_t* pr = (const bf16_t*)(p.ws + WS_PB) + (size_t)row * PLD;
    R.q = *(const u32x4*)(pr + C_GQ + h * 32 + 8 * cg); R.k = *(const u32x4*)(pr + C_GK + h * 32 + 8 * cg);
    R.v[0] = *(const u32x4*)(pr + C_GV + h * 64 + 16 * cg); R.v[1] = *(const u32x4*)(pr + C_GV + h * 64 + 16 * cg + 8);
    R.dn[0] = *(const u32x4*)(pr + C_GDN + 16 * g); R.dn[1] = *(const u32x4*)(pr + C_GDN + 16 * g + 8);
    const float* rt = (const float*)(p.ws + WS_ROPE) + (size_t)((Ls == SL ? ts : 0) * 16 + 4 * cg) * 2;
    R.rt[0] = *(const f32x4*)rt; R.rt[1] = *(const f32x4*)(rt + 4);
}
DI void gla_compute(const Params& p, int item, int c, const GlRaw& R, LAS float* buf, const LAS float* GU, int lane) {
    const int g = item & 1, b = item / 12;
    const int ti = lane >> 2, cg = lane & 3;
    int row, ts, Ls; step_row(16 * c + ti, g, b, row, ts, Ls);
    float q[8], k[8], v[16], dn[16];
    cvt8(R.q, q); cvt8(R.k, k); cvt8(R.v[0], &v[0]); cvt8(R.v[1], &v[8]); cvt8(R.dn[0], &dn[0]); cvt8(R.dn[1], &dn[8]);
    float al[8];
    {
        f32x4 z0 = *(const LAS f32x4*)(GU + 512 + 8 * cg), z1 = *(const LAS f32x4*)(GU + 512 + 8 * cg + 4);
#pragma unroll
        for (int rr = 0; rr < 16; ++rr) {
            if ((rr & 3) == 0) asm volatile("" : "+v"(z0), "+v"(z1) :: "memory");
            const f32x4 g0 = *(const LAS f32x4*)(GU + rr * 32 + 8 * cg), g1 = *(const LAS f32x4*)(GU + rr * 32 + 8 * cg + 4);
            z0 = z0 + g0 * dn[rr]; z1 = z1 + g1 * dn[rr]; }
#pragma unroll
        for (int j = 0; j < 8; ++j) { const float z = j < 4 ? z0[j & 3] : z1[j & 3];
            const float ls = fminf(z, 0.f) - __logf(1.f + __expf(-fabsf(z)));
            al[j] = __expf(ls * 0.0625f); }
    }
    if (Ls == SL) {
#pragma unroll
        for (int jj = 0; jj < 4; ++jj) { const float cc = R.rt[jj >> 1][2 * (jj & 1)], sn = R.rt[jj >> 1][2 * (jj & 1) + 1];
            const float q1 = q[2 * jj], q2 = q[2 * jj + 1]; q[2 * jj] = q1 * cc - q2 * sn; q[2 * jj + 1] = q1 * sn + q2 * cc;
            const float k1 = k[2 * jj], k2 = k[2 * jj + 1]; k[2 * jj] = k1 * cc - k2 * sn; k[2 * jj + 1] = k1 * sn + k2 * cc; }
    }
    LAS float* o = buf + ti * GL_STEP;
#pragma unroll
    for (int j4 = 0; j4 < 2; ++j4) {
        *(LAS f32x4*)(o + 8 * cg + 4 * j4) = (f32x4){al[4 * j4], al[4 * j4 + 1], al[4 * j4 + 2], al[4 * j4 + 3]};
        *(LAS f32x4*)(o + 32 + 8 * cg + 4 * j4) = (f32x4){k[4 * j4], k[4 * j4 + 1], k[4 * j4 + 2], k[4 * j4 + 3]};
        *(LAS f32x4*)(o + 64 + 8 * cg + 4 * j4) = (f32x4){q[4 * j4], q[4 * j4 + 1], q[4 * j4 + 2], q[4 * j4 + 3]} * 0.17677669529663687f; }
#pragma unroll
    for (int j4 = 0; j4 < 4; ++j4) *(LAS f32x4*)(o + 96 + 16 * cg + 4 * j4) = (f32x4){v[4 * j4], v[4 * j4 + 1], v[4 * j4 + 2], v[4 * j4 + 3]};
}
DI void gla_scan_chunk(const Params& p, int item, int c, const LAS float* buf, f32x2 (&S)[16], int lane, bool dry = false) {
    const int g = item & 1, h = (item >> 1) % 6, b = item / 12;
    bf16_t* AY = (bf16_t*)(p.ws + WS_AY);
    f32x4 U[2][12];
#pragma unroll
    for (int j = 0; j < 4; ++j) { U[0][3 * j] = ((const LAS f32x4*)buf)[j]; U[0][3 * j + 1] = ((const LAS f32x4*)buf)[8 + j]; U[0][3 * j + 2] = ((const LAS f32x4*)buf)[16 + j]; }
    float vv = buf[96 + lane];
    for (int st = 0; st < 16; ++st) {
        const LAS f32x4* W = (const LAS f32x4*)(buf + st * GL_STEP);
        const LAS float* bn = buf + (st < 15 ? st + 1 : st) * GL_STEP;
        const LAS f32x4* Wn = (const LAS f32x4*)bn;
        const f32x2 vv2 = (f32x2){vv, vv};
        f32x2 oacc[4];
#pragma unroll
        for (int i = 0; i < 4; ++i) oacc[i] = (f32x2){0.f, 0.f};
#pragma unroll
        for (int gi = 0; gi < 2; ++gi) {
            const int cu = gi, nx = gi ^ 1;
#pragma unroll
            for (int j = 0; j < 4; ++j) { const LAS f32x4* Wx = gi == 0 ? W : Wn; const int i = gi == 0 ? 4 + j : j;
                U[nx][3 * j] = Wx[i]; U[nx][3 * j + 1] = Wx[8 + i]; U[nx][3 * j + 2] = Wx[16 + i]; }
            if (gi == 1) vv = bn[96 + lane];
#pragma unroll
            for (int j = 0; j < 4; ++j) { const int i = 4 * gi + j; const f32x4 a4 = U[cu][3 * j], k4 = U[cu][3 * j + 1], q4 = U[cu][3 * j + 2];
                S[2 * i] = S[2 * i] * (f32x2){a4[0], a4[1]} + vv2 * (f32x2){k4[0], k4[1]}; S[2 * i + 1] = S[2 * i + 1] * (f32x2){a4[2], a4[3]} + vv2 * (f32x2){k4[2], k4[3]};
                oacc[(2 * i) & 3] += S[2 * i] * (f32x2){q4[0], q4[1]}; oacc[(2 * i + 1) & 3] += S[2 * i + 1] * (f32x2){q4[2], q4[3]}; }
            asm volatile("" : "+v"(oacc[0]), "+v"(oacc[1]), "+v"(oacc[2]), "+v"(oacc[3]) :: "memory");
        }
        const f32x2 o2 = (oacc[0] + oacc[1]) + (oacc[2] + oacc[3]);
        int row, ts, Ls; step_row(16 * c + st, g, b, row, ts, Ls);
        { const float ov = o2[0] + o2[1]; if (!dry || ov == 1.2345e37f) AY[(size_t)row * D + g * 384 + h * 64 + lane] = f2bf(ov); }
    }
}
DI void scan_unit_rw(const Params& p, int l, int su, LAS unsigned char* lds, int tid, int lane, int wave, bool dry) {
    LAS float* RWB = (LAS float*)lds; LAS float* CSB = (LAS float*)(lds + 143616);
    __syncthreads();
    for (int i = tid; i < 2 * 384; i += NTHR) { const int sl = i / 384, r = i % 384, a = r >> 6, ch = r & 63; const int it = 2 * su + sl, hh = (it >> 1) % 6;
        float v;
        if (a < 3) v = pin(p, I_MU)[(size_t)l * 1536 + a * 384 + hh * 64 + ch];
        else v = (a == 3 ? pin(p, I_KK) : (a == 4 ? pin(p, I_KA) : pin(p, I_RK)))[(size_t)l * 384 + hh * 64 + ch];
        CSB[i] = v; }
    __syncthreads();
    if (wave < 4) {
        asm volatile("" : "+v"(lane));
        const int slot = wave >> 1, hf = wave & 1, item = 2 * su + slot;
        f32x2 S[16];
#pragma unroll
        for (int i = 0; i < 16; ++i) S[i] = (f32x2){0.f, 0.f};
        __syncthreads();
        for (int c = 0; c < NCHUNK; ++c) { rwkv_scan_chunk(p, item, c, RWB + (slot * 2 + (c & 1)) * RW_BUF, S, lane, hf, dry); __syncthreads(); }
    } else if (wave < 6) {
        asm volatile("" : "+v"(lane));
        const int slot = wave & 1, item = 2 * su + slot;
        RwRaw R; rwkv_load(p, item, 0, R, lane);
        rwkv_compute(p, item, 0, R, RWB + (slot * 2 + 0) * RW_BUF, CSB + slot * 384, lane);
        rwkv_load(p, item, 1, R, lane);
        __syncthreads();
        for (int c = 0; c < NCHUNK; ++c) {
            if (c + 1 < NCHUNK) { rwkv_compute(p, item, c + 1, R, RWB + (slot * 2 + ((c + 1) & 1)) * RW_BUF, CSB + slot * 384, lane); if (c + 2 < NCHUNK) rwkv_load(p, item, c + 2, R, lane); }
            __syncthreads(); }
    } else {
        __syncthreads();
        for (int c = 0; c < NCHUNK; ++c) __syncthreads();
    }
}
DI void scan_unit_gl(const Params& p, int l, int gu, LAS unsigned char* lds, int tid, int lane, int wave, bool dry) {
    LAS float* GLB = (LAS float*)lds; LAS float* GUB = (LAS float*)(lds + 122880);
    __syncthreads();
    for (int i = tid; i < 6 * 544; i += NTHR) { const int sl = i / 544, r = i % 544; const int it = 6 * gu + sl, gg = it & 1, hh = (it >> 1) % 6;
        GUB[i] = r < 512 ? pin(p, I_GUP)[((size_t)(l * 2 + gg) * 16 + (r >> 5)) * 192 + hh * 32 + (r & 31)] : pin(p, I_GB)[(size_t)(l * 2 + gg) * 192 + hh * 32 + (r - 512)]; }
    __syncthreads();
    if (wave < 6) {
        asm volatile("" : "+v"(lane));
        const int item = 6 * gu + wave;
        f32x2 Sg[16];
#pragma unroll
        for (int i = 0; i < 16; ++i) Sg[i] = (f32x2){0.f, 0.f};
        __syncthreads();
        for (int c = 0; c < NCHUNK; ++c) { gla_scan_chunk(p, item, c, GLB + (wave * 2 + (c & 1)) * GL_BUF, Sg, lane, dry); __syncthreads(); }
    } else {
        asm volatile("" : "+v"(lane));
        const int s0 = (wave - 6) * 3;
        GlRaw R0, R1, R2;
        gla_load(p, 6 * gu + s0, 0, R0, lane); gla_load(p, 6 * gu + s0 + 1, 0, R1, lane); gla_load(p, 6 * gu + s0 + 2, 0, R2, lane);
        gla_compute(p, 6 * gu + s0, 0, R0, GLB + ((s0) * 2) * GL_BUF, GUB + (s0) * 544, lane);
        gla_compute(p, 6 * gu + s0 + 1, 0, R1, GLB + ((s0 + 1) * 2) * GL_BUF, GUB + (s0 + 1) * 544, lane);
        gla_compute(p, 6 * gu + s0 + 2, 0, R2, GLB + ((s0 + 2) * 2) * GL_BUF, GUB + (s0 + 2) * 544, lane);
        gla_load(p, 6 * gu + s0, 1, R0, lane); gla_load(p, 6 * gu + s0 + 1, 1, R1, lane); gla_load(p, 6 * gu + s0 + 2, 1, R2, lane);
        __syncthreads();
        for (int c = 0; c < NCHUNK; ++c) {
            if (c + 1 < NCHUNK) { const int nb = (c + 1) & 1;
                gla_compute(p, 6 * gu + s0, c + 1, R0, GLB + ((s0) * 2 + nb) * GL_BUF, GUB + (s0) * 544, lane);
                gla_compute(p, 6 * gu + s0 + 1, c + 1, R1, GLB + ((s0 + 1) * 2 + nb) * GL_BUF, GUB + (s0 + 1) * 544, lane);
                gla_compute(p, 6 * gu + s0 + 2, c + 1, R2, GLB + ((s0 + 2) * 2 + nb) * GL_BUF, GUB + (s0 + 2) * 544, lane);
                if (c + 2 < NCHUNK) { gla_load(p, 6 * gu + s0, c + 2, R0, lane); gla_load(p, 6 * gu + s0 + 1, c + 2, R1, lane); gla_load(p, 6 * gu + s0 + 2, c + 2, R2, lane); } }
            __syncthreads(); }
    }
}
DI void phase_mixers(const Params& p, int l, LAS unsigned char* lds, int tid, int lane, int wave, bool dry = false, int which = 3) {
    const int G = gridDim.x, bx = blockIdx.x;
    if (which & 1) for (int u = bx; u < 256; u += G) { if (u < 192) scan_unit_rw(p, l, u, lds, tid, lane, wave, dry); else scan_unit_gl(p, l, u - 192, lds, tid, lane, wave, dry); }
    const int nnat = NB * 4 * 32 * 4, nnatc = l == 0 ? NB * 4 * 16 : 0;
    if (which & 2) {
        const int ntot = nnat + nnatc;
        int n1 = 0;
        if (G == 256 && NAT_GLA_PCT > 0) {
            n1 = (ntot * NAT_GLA_PCT / 100) & ~7;
            if (bx >= 192) for (int id = (bx - 192) * NWAVE + wave; id < n1; id += 64 * NWAVE) { if (id < nnat) nat_unit(p, l, id, false, lane); else nat_unit(p, l, id - nnat, true, lane); }
        }
        int nwv = G * NWAVE, w0v = bx * NWAVE + wave;
        if (G == 256 && NAT_GLA_PCT < 0) { nwv = 192 * NWAVE; if (bx >= 192) w0v = ntot; }
        for (int id = n1 + w0v; id < ntot; id += nwv) { if (id < nnat) nat_unit(p, l, id, false, lane); else nat_unit(p, l, id - nnat, true, lane); }
    }
}

DI void phase_readout(const Params& p, int l, int nrows, int lane, int wave) {
    const int gw = blockIdx.x * NWAVE + wave, NGW = gridDim.x * NWAVE;
    const bf16_t* PB = (const bf16_t*)(p.ws + WS_PB); bf16_t* AY = (bf16_t*)(p.ws + WS_AY);
    const float* LOf = (const float*)(p.ws + WS_LO); const bf16_t* LOb = (const bf16_t*)(p.ws + WS_LO); const float* BON = (const float*)(p.ws + WS_BON);
    const bool act = lane < 48; const int c8 = act ? 8 * lane : 0, h = c8 >> 6;
    float nw[8], gnw[8], gnb[8], mu[8];
    { const float* a = pin(p, I_GNW) + l * 64 + (c8 & 63); const float* b = pin(p, I_GNWT) + l * 384 + c8; const float* c = pin(p, I_GNB) + l * 384 + c8; const float* d = pin(p, I_MU) + (size_t)l * 1536 + 768 + c8;
#pragma unroll
      for (int j = 0; j < 8; ++j) { nw[j] = a[j]; gnw[j] = b[j]; gnb[j] = c[j]; mu[j] = d[j]; } }
    for (int row = gw; row < nrows; row += NGW) {
        const bool lat = row < ML; const int t = lat ? (row & (SL - 1)) : ((row - ML) & (CL - 1)); const int Ls = lat ? SL : CL;
        const bf16_t* pr = PB + (size_t)row * PLD; bf16_t* yr = AY + (size_t)row * D;
        const u32x4 r_of = *(const u32x4*)(yr + c8), r_ob = *(const u32x4*)(yr + 384 + c8), r_gg = *(const u32x4*)(pr + C_GG + c8);
        const u32x4 r_nat = *(const u32x4*)(yr + 768 + 8 * (lane & 31));
        const float* lf = LOf + (size_t)row * (LOLD / 2) + c8;
        const f32x4 f0 = *(const f32x4*)lf, f1 = *(const f32x4*)(lf + 4), b0 = *(const f32x4*)(lf + 384), b1 = *(const f32x4*)(lf + 388);
        const bf16_t* pv = pr + C_RW + 768 + c8;
        const u32x4 r_v0 = *(const u32x4*)pv, r_vm = *(const u32x4*)(t > 0 ? pv - PLD : pv), r_vp = *(const u32x4*)(t < Ls - 1 ? pv + PLD : pv);
        const u32x4 r_gt = *(const u32x4*)(LOb + (size_t)row * LOLD + 1536 + c8);
        const float bon = BON[(size_t)row * 12 + h] + BON[(size_t)row * 12 + 6 + h];
        const float mm = t > 0 ? 0.5f : 0.f, mp = t < Ls - 1 ? 0.5f : 0.f;
        float of[8], ob[8], gg[8], v0[8], vm[8], vp[8], gt[8];
        cvt8(r_of, of); cvt8(r_ob, ob); cvt8(r_gg, gg); cvt8(r_v0, v0); cvt8(r_vm, vm); cvt8(r_vp, vp); cvt8(r_gt, gt);
        float og[8], orw[8]; float ss = 0.f, sm = 0.f;
#pragma unroll
        for (int j = 0; j < 8; ++j) { og[j] = of[j] + ob[j]; ss += og[j] * og[j]; orw[j] = (j < 4 ? f0[j & 3] : f1[j & 3]) + (j < 4 ? b0[j & 3] : b1[j & 3]); sm += orw[j]; }
        ss += shx(ss, 1, lane); ss += shx(ss, 2, lane); ss += shx(ss, 4, lane);
        sm += shx(sm, 1, lane); sm += shx(sm, 2, lane); sm += shx(sm, 4, lane);
        const float mean = sm * (1.f / 64.f); float sq = 0.f;
#pragma unroll
        for (int j = 0; j < 8; ++j) { orw[j] -= mean; sq += orw[j] * orw[j]; }
        sq += shx(sq, 1, lane); sq += shx(sq, 2, lane); sq += shx(sq, 4, lane);
        float e1 = 1e-5f, e2 = 64e-5f; asm volatile("" : "+v"(e1), "+v"(e2));
        const float rg = rsqrtf(ss * (1.f / 64.f) + e1), rn = rsqrtf(sq * (1.f / 64.f) + e2);
        float yg[8], yw[8];
#pragma unroll
        for (int j = 0; j < 8; ++j) { yg[j] = og[j] * rg * nw[j] * (gg[j] * sigm(gg[j]));
            const float vs = v0[j] + ((mm * vm[j] + mp * vp[j]) - v0[j]) * mu[j];
            yw[j] = (orw[j] * rn * gnw[j] + gnb[j] + bon * vs) * gt[j]; }
        asm volatile("s_waitcnt vmcnt(0)" ::: "memory");
        if (act) { u32x4 o; o.x = cvtpk(yg[0], yg[1]); o.y = cvtpk(yg[2], yg[3]); o.z = cvtpk(yg[4], yg[5]); o.w = cvtpk(yg[6], yg[7]); *(u32x4*)(yr + c8) = o;
            u32x4 w; w.x = cvtpk(yw[0], yw[1]); w.y = cvtpk(yw[2], yw[3]); w.z = cvtpk(yw[4], yw[5]); w.w = cvtpk(yw[6], yw[7]); *(u32x4*)(yr + 640 + c8) = w; }
        if (lane < 32) *(u32x4*)(yr + 384 + 8 * lane) = r_nat;
    }
}

DI void grid_sync_probe() { cg::this_grid().sync(); }
DI void run_step(const Params& p, const int step, LAS unsigned char* lds, int tid, int lane, int wave) {
    const int G = gridDim.x, bx = blockIdx.x;
    unsigned char* ws = p.ws;
    const float* MOD = (const float*)(ws + WS_MOD);
    float* TC = (float*)(ws + WS_VT);
    {
        const int l = step < 2 ? 0 : (step - 2) / 10, st = step < 2 ? -1 : (step - 2) % 10;
        unsigned char* wl = ws + (size_t)l * WLB;
        const float* modl = MOD + (size_t)l * 33 * 6144;
        const int Mff = l == 0 ? MT : ML;
        if (st == 0 || st == 2 || st == 5 || st == 7 || st == 8) {
            const bf16_t* gA = (const bf16_t*)(ws + WS_AY); const bf16_t* gB; int gM = Mff, gN = 1024, gK = 1024, mode = 2;
            bf16_t* eO = (bf16_t*)(ws + WS_PB); const float* ex = (const float*)p.out; const float* exc = (const float*)TC; int gofs = 2 * 1024;
            if (st == 0) { gB = (const bf16_t*)(wl + OFF_WIN); gM = MT; gN = PLD; mode = 0; }
            else if (st == 2) { gB = (const bf16_t*)(wl + OFF_BT2); gM = MT; gN = 2048; gK = 384; mode = 1; eO = (bf16_t*)(ws + WS_LO); }
            else if (st == 5) { gB = (const bf16_t*)(wl + OFF_WOUT); if (l == 0) { ex = pin(p, I_X); exc = pin(p, I_CTX); } }
            else if (st == 7) { gB = (const bf16_t*)(wl + OFF_W13); gN = 2 * FH; mode = 3; }
            else { gA = (const bf16_t*)(ws + WS_PB); gB = (const bf16_t*)(wl + OFF_W2); gK = FH; gofs = 5 * 1024; }
            asm volatile("" : "+s"(gK), "+s"(gM), "+s"(gN), "+s"(mode), "+s"(gofs));
            asm volatile("" : "+s"(gA), "+s"(gB), "+s"(eO), "+s"(ex), "+s"(exc));
            const pg8::Gemm g{gA, gB, gM, gN, gK};
            const pg8::EpiAny E{mode, pg8::EpiStoreBf16{eO, PLD}, pg8::EpiLora{eO, pin(p, I_W0) + (size_t)l * 768, pin(p, I_A0) + (size_t)l * 768},
                                pg8::EpiRes{ex, exc, p.out, TC, modl, gofs}, pg8::EpiSwiglu{eO}};
            pg8::StaticOrder S; S.init(g.M, g.N, G, bx);
#if defined(PROBE_GEMM)
            int nrep = (st == 0 || st == 2 || st == 7) ? 2 : 1; asm volatile("" : "+s"(nrep));
#pragma unroll 1
            for (int rep = 0; rep < nrep; ++rep) { pg8::gemm_phase<pg8::EpiAny, pg8::StaticOrder, true, true>(lds, g, S, E, tid); __syncthreads(); }
#else
            pg8::gemm_phase<pg8::EpiAny, pg8::StaticOrder, true, true>(lds, g, S, E, tid);
#endif
        }
#ifndef ONLYGEMM
        else if (step == 0) phase_prologue(p, lds, tid, lane, wave);
        else if (step == 1) phase_modulate0(p, lane, wave);
        else if (st == 1) phase_prep(p, l, lds, lane, wave);
#if defined(PROBE_MIX)
        else if (st == 3) { int nrep = 2; asm volatile("" : "+s"(nrep));
#pragma unroll 1
            for (int rep = 0; rep < nrep; ++rep) { phase_mixers(p, l, lds, tid, lane, wave, rep + 1 < nrep, rep + 1 < nrep ? PROBE_MIX : 3); __syncthreads(); grid_sync_probe(); } }
#else
        else if (st == 3) phase_mixers(p, l, lds, tid, lane, wave);
#endif
        else if (st == 4) phase_readout(p, l, Mff, lane, wave);
        else if (st == 6) phase_ln(p, lane, wave, Mff, pin(p, I_LN1W) + l * 1024, pin(p, I_LN1B) + l * 1024, modl, 3 * 1024, 4 * 1024, true, true);
        else {
            if (l == 0) phase_ln(p, lane, wave, MT, pin(p, I_LN2W), pin(p, I_LN2B), MOD + (size_t)33 * 6144, 0, 1024, true, true);
            else phase_ln(p, lane, wave, ML, pin(p, I_LN2W) + 1024, pin(p, I_LN2B) + 1024, modl, 0, 1024, true, false);
        }
#endif
    }
}
#ifdef MULTI_LAUNCH
template <int STEP> __global__ void __launch_bounds__(NTHR, 2) k_step(Params p) {
    extern __shared__ __attribute__((aligned(16))) unsigned char smem[];
    const int tid = threadIdx.x, lane = tid & 63, wave = __builtin_amdgcn_readfirstlane(tid >> 6);
    run_step(p, STEP, (LAS unsigned char*)smem, tid, lane, wave);
}
template <int STEP> static void launch_steps(const Params& p, int grid, hipStream_t stream) {
    static bool attr_done = false;
    if (!attr_done) { (void)hipFuncSetAttribute((const void*)k_step<STEP>, hipFuncAttributeMaxDynamicSharedMemorySize, LDS_BYTES); attr_done = true; }
    hipLaunchKernelGGL(k_step<STEP>, dim3(grid), dim3(NTHR), LDS_BYTES, stream, p);
    if constexpr (STEP + 1 < 22) launch_steps<STEP + 1>(p, grid, stream);
}
#else
__global__ void __launch_bounds__(NTHR, 2) hybrid_fwd(Params p) {
    extern __shared__ __attribute__((aligned(16))) unsigned char smem[];
    LAS unsigned char* lds = (LAS unsigned char*)smem;
    cg::grid_group grid = cg::this_grid();
    const int wave0 = __builtin_amdgcn_readfirstlane((int)threadIdx.x >> 6);
#if defined(PROBE_REPEAT)
    bool repeated = false;
#endif
#pragma unroll 1
    for (int step = 0; step < 22; ++step) {
        unsigned msk = ~0u; int wave_ = wave0;
        asm volatile("" : "+s"(msk), "+s"(wave_));
        const int lane_ = (int)__builtin_amdgcn_mbcnt_hi(msk, __builtin_amdgcn_mbcnt_lo(msk, 0u));
        const int tid_ = wave_ * 64 + lane_;
        run_step(p, step, lds, tid_, lane_, wave_);
        if (step != 21) grid.sync();
#if defined(PROBE_REPEAT)
        { const int st_ = step < 2 ? -1 : (step - 2) % 10; const bool rep_ok = ((PROBE_REPEAT & 1) && (st_ == 0 || st_ == 2 || st_ == 7)) || ((PROBE_REPEAT & 2) && st_ == 1) || ((PROBE_REPEAT & 4) && step == 0) || ((PROBE_REPEAT & 8) && step == 1);
          if (rep_ok && !repeated) { repeated = true; --step; } else repeated = false; }
#endif
    }
}
#endif

extern "C" void kernel_launch(void* const* d_in, const int* in_sizes, int n_in, void* d_out, int out_size, void* d_ws, size_t ws_size, hipStream_t stream) {
    static int grid = 0;
    if (grid == 0) {
        int dev = 0, cus = 0, per_cu = 0;
        if (n_in != 29 || ws_size < WS_END) { fprintf(stderr, "kernel_launch: unexpected n_in %d / ws_size %zu (need %zu)\n", n_in, ws_size, (size_t)WS_END); }
        hipGetDevice(&dev);
        hipDeviceGetAttribute(&cus, hipDeviceAttributeMultiprocessorCount, dev);
#ifndef MULTI_LAUNCH
        if (hipFuncSetAttribute((const void*)hybrid_fwd, hipFuncAttributeMaxDynamicSharedMemorySize, LDS_BYTES) != hipSuccess) fprintf(stderr, "kernel_launch: hipFuncSetAttribute failed\n");
        if (hipOccupancyMaxActiveBlocksPerMultiprocessor(&per_cu, (const void*)hybrid_fwd, NTHR, LDS_BYTES) != hipSuccess || per_cu < 1) { fprintf(stderr, "kernel_launch: occupancy query gave %d\n", per_cu); per_cu = 1; }
#endif
        (void)hipGetLastError();
        grid = cus > 0 ? cus : 256;
    }
    Params p{};
    for (int i = 0; i < 29; ++i) p.in[i] = (const float*)d_in[i];
    p.out = (float*)d_out; p.ws = (unsigned char*)d_ws;
#ifdef MULTI_LAUNCH
    launch_steps<0>(p, grid, stream);
#else
    void* args[] = {&p};
    hipError_t e = hipLaunchCooperativeKernel((const void*)hybrid_fwd, dim3(grid), dim3(NTHR), args, LDS_BYTES, stream);
    if (e != hipSuccess) fprintf(stderr, "kernel_launch: cooperative launch failed: %s (grid %d)\n", hipGetErrorString(e), grid);
#endif
}
```

```cpp
#include <hip/hip_runtime.h>
#include <hip/hip_cooperative_groups.h>
#include <cstdio>
#include <cstdint>
namespace cg = cooperative_groups;
namespace pg8 {
#define PG8_LAS __attribute__((address_space(3)))
typedef unsigned short bf16_t;
typedef short bf16x8 __attribute__((ext_vector_type(8)));
typedef float f32x4 __attribute__((ext_vector_type(4)));
typedef unsigned u32x4 __attribute__((ext_vector_type(4)));
constexpr int BM = 256, BK = 64, HALF = 128, HTB = HALF * BK * 2  , STAGE_BYTES = 8 * HTB, NXCD = 8, WGM = 8;

__host__ __device__ __forceinline__ int lds_byte(int r, int c) { const int st = (r >> 4) * 2 + (c >> 5), rr = r & 15, cc = c & 31, ob = rr * 64 + cc * 2; return st * 1024 + (ob ^ (((ob >> 9) & 1) << 5)); }
__host__ __device__ __forceinline__ void stage_rc(int b, int& R, int& C) { const int st = b / 1024, sb = b % 1024, swz = sb ^ (((sb >> 9) & 1) << 5); R = (st >> 1) * 16 + swz / 64; C = (st & 1) * 32 + (swz % 64) / 2; }
__host__ __device__ __forceinline__ int perm32(int rho) { const int n = rho >> 4, i = rho & 15; return 8 * (i >> 2) + 4 * n + (i & 3); }

struct Unit { int pm, pn; };
struct Gemm { const bf16_t* A; const bf16_t* Bt; int M, N, K; };

struct StaticOrder {
    int nM, nN, nwg, G, c;
    __host__ __device__ void init(int M, int N, int G_, int c_) { nM = M / BM; nN = N / BM; nwg = nM * nN; G = G_; c = c_; }
    __host__ __device__ bool next(int i, Unit& u) const {
        const long L = (long)i * G + c; if (L >= nwg) return false;
        int wgid = (int)L; { const int q = nwg / NXCD, r = nwg % NXCD, xcd = wgid % NXCD, off = wgid / NXCD; wgid = (xcd < r ? xcd * (q + 1) : r * (q + 1) + (xcd - r) * q) + off; }
        const int nig = WGM * nN, gid = wgid / nig, fm = gid * WGM, gsz = (nM - fm) < WGM ? (nM - fm) : WGM;
        u.pm = fm + ((wgid % nig) % gsz); u.pn = (wgid % nig) / gsz; return true;
    }
    __device__ __forceinline__ void a_ready(const Unit&) const {}
    __device__ __forceinline__ void done(const Unit&) const {}
};
__device__ __forceinline__ unsigned cvtpk(float lo, float hi) { typedef float v2f __attribute__((ext_vector_type(2))); typedef __bf16 v2b __attribute__((ext_vector_type(2))); v2f v = {lo, hi}; v2b b = __builtin_convertvector(v, v2b); return __builtin_bit_cast(unsigned, b); }
__device__ __forceinline__ float sigm(float x) { return 1.0f / (1.0f + __expf(-x)); }
struct EpiStoreBf16 {
    static constexpr bool PERM = true, AFTER_DRAIN = false;
    bf16_t* O; int ldc;
    __device__ __forceinline__ void operator()(const f32x4 (&acc)[2][2][4][2], const Unit& u, int wr, int wc, int fr, int fq) const {
        const int row0 = u.pm * BM + wr * 64 + fr, col0 = u.pn * BM + wc * 32 + 8 * fq;
#pragma unroll
        for (int ai = 0; ai < 2; ++ai)
#pragma unroll
            for (int m = 0; m < 4; ++m) { bf16_t* rowp = O + (size_t)(row0 + ai * HALF + m * 16) * ldc + col0;
#pragma unroll
                for (int bj = 0; bj < 2; ++bj) { const f32x4 v0 = acc[ai][bj][m][0], v1 = acc[ai][bj][m][1];
                    u32x4 w; w.x = cvtpk(v0[0], v0[1]); w.y = cvtpk(v0[2], v0[3]); w.z = cvtpk(v1[0], v1[1]); w.w = cvtpk(v1[2], v1[3]);
                    *(u32x4*)(rowp + bj * HALF) = w; } }
    }
};
struct EpiLora {
    static constexpr bool PERM = true, AFTER_DRAIN = false;
    bf16_t* O; const float* w0; const float* a0;
    __device__ __forceinline__ void operator()(const f32x4 (&acc)[2][2][4][2], const Unit& u, int wr, int wc, int fr, int fq) const {
        const int row0 = u.pm * BM + wr * 64 + fr;
#pragma unroll
        for (int bj = 0; bj < 2; ++bj) {
            const int cb = u.pn * 2 + bj;
            if (cb < 15) {
                const int c0 = cb * 128 + wc * 32 + 8 * fq;
                if (cb >= 12) {
#pragma unroll
                    for (int ai = 0; ai < 2; ++ai)
#pragma unroll
                        for (int m = 0; m < 4; ++m) { const f32x4 v0 = acc[ai][bj][m][0], v1 = acc[ai][bj][m][1];
                            u32x4 w; w.x = cvtpk(v0[0], v0[1]); w.y = cvtpk(v0[2], v0[3]); w.z = cvtpk(v1[0], v1[1]); w.w = cvtpk(v1[2], v1[3]);
                            *(u32x4*)(O + (size_t)(row0 + ai * HALF + m * 16) * 1920 + c0) = w; }
                } else {
                    const int kind = wc >> 1, g = cb / 6, h = cb % 6;
                    const float* a0v = a0; const float* w0v = w0; asm volatile("" : "+s"(a0v), "+s"(w0v));
                    const float* bp = (kind ? a0v : w0v) + g * 384 + h * 64 + (wc & 1) * 32 + 8 * fq;
                    const f32x4 b0 = *(const f32x4*)bp, b1 = *(const f32x4*)(bp + 4);
                    const float mul = kind == 0 ? 0.60653065971263342f : 1.f;
#pragma unroll
                    for (int ai = 0; ai < 2; ++ai)
#pragma unroll
                        for (int m = 0; m < 4; ++m) { const f32x4 v0 = acc[ai][bj][m][0] + b0, v1 = acc[ai][bj][m][1] + b1;
                            u32x4 w; w.x = cvtpk(mul * sigm(v0[0]), mul * sigm(v0[1])); w.y = cvtpk(mul * sigm(v0[2]), mul * sigm(v0[3]));
                            w.z = cvtpk(mul * sigm(v1[0]), mul * sigm(v1[1])); w.w = cvtpk(mul * sigm(v1[2]), mul * sigm(v1[3]));
                            *(u32x4*)(O + (size_t)(row0 + ai * HALF + m * 16) * 1920 + c0) = w; }
                }
            }
        }
    }
};
struct EpiRes {
    static constexpr bool PERM = true, AFTER_DRAIN = false;
    const float* xl; const float* xc; float* ol; float* oc; const float* mod; int gofs;
    __device__ __forceinline__ void operator()(const f32x4 (&acc)[2][2][4][2], const Unit& u, int wr, int wc, int fr, int fq) const {
        const bool lat = u.pm < 256; const int bi = lat ? (u.pm >> 3) : 32;
        const size_t rbase = (size_t)(lat ? u.pm : u.pm - 256) * BM;
        const float* xlv = xl; const float* xcv = xc; float* olv = ol; float* ocv = oc; asm volatile("" : "+s"(xlv), "+s"(xcv), "+s"(olv), "+s"(ocv));
        const float* xin = (lat ? xlv : xcv) + rbase * 1024; float* out = (lat ? olv : ocv) + rbase * 1024;
        const float* gp = mod + (size_t)bi * 6144 + gofs;
        const int col0 = u.pn * BM + wc * 32 + 8 * fq, row0 = wr * 64 + fr;
#pragma unroll
        for (int bj = 0; bj < 2; ++bj)
#pragma unroll
            for (int n = 0; n < 2; ++n) { const int c = col0 + bj * HALF + 4 * n; const f32x4 gt = *(const f32x4*)(gp + c);
#pragma unroll
                for (int ai = 0; ai < 2; ++ai)
#pragma unroll
                    for (int m = 0; m < 4; ++m) { const size_t o = (size_t)(row0 + ai * HALF + m * 16) * 1024 + c;
                        const f32x4 xv = *(const f32x4*)(xin + o); const f32x4 a = acc[ai][bj][m][n];
                        f32x4 r; r[0] = 1.41421356237f * xv[0] + gt[0] * a[0]; r[1] = 1.41421356237f * xv[1] + gt[1] * a[1]; r[2] = 1.41421356237f * xv[2] + gt[2] * a[2]; r[3] = 1.41421356237f * xv[3] + gt[3] * a[3];
                        *(f32x4*)(out + o) = r; } }
    }
};
struct EpiSwiglu {
    static constexpr bool PERM = true, AFTER_DRAIN = false;
    bf16_t* O;
    __device__ __forceinline__ void operator()(const f32x4 (&acc)[2][2][4][2], const Unit& u, int wr, int wc, int fr, int fq) const {
        const int row0 = u.pm * BM + wr * 64 + fr, col0 = u.pn * HALF + wc * 32 + 8 * fq;
#pragma unroll
        for (int ai = 0; ai < 2; ++ai)
#pragma unroll
            for (int m = 0; m < 4; ++m) { float v[8];
#pragma unroll
                for (int i = 0; i < 8; ++i) { const float g = acc[ai][0][m][i >> 2][i & 3], up = acc[ai][1][m][i >> 2][i & 3]; v[i] = g * sigm(g) * up; }
                u32x4 w; w.x = cvtpk(v[0], v[1]); w.y = cvtpk(v[2], v[3]); w.z = cvtpk(v[4], v[5]); w.w = cvtpk(v[6], v[7]);
                *(u32x4*)(O + (size_t)(row0 + ai * HALF + m * 16) * 2816 + col0) = w; }
    }
};
struct EpiAny {
    static constexpr bool PERM = true, AFTER_DRAIN = false;
    int mode; EpiStoreBf16 e0; EpiLora e1; EpiRes e2; EpiSwiglu e3;
    __device__ __forceinline__ void operator()(const f32x4 (&acc)[2][2][4][2], const Unit& u, int wr, int wc, int fr, int fq) const {
        if (mode == 0) e0(acc, u, wr, wc, fr, fq); else if (mode == 1) e1(acc, u, wr, wc, fr, fq); else if (mode == 2) e2(acc, u, wr, wc, fr, fq); else e3(acc, u, wr, wc, fr, fq);
    }
};
template <class Epi, class Sched, bool ALIGN_EPI = false, bool SP2 = false>
__device__ __forceinline__ void gemm_phase(PG8_LAS unsigned char* lds, const Gemm g, const Sched& S, const Epi& E, const int tid) {
    const int wid = __builtin_amdgcn_readfirstlane(tid >> 6), lane = tid & 63, wr = wid >> 2, wc = wid & 3, fr = lane & 15, fq = lane >> 4;
    const int K = g.K, nt = K / BK;
    unsigned voffA[2], voffB[2];
#pragma unroll
    for (int i = 0; i < 2; ++i) { int R, C; stage_rc(tid * 16 + i * 8192, R, C); const int Rb = Epi::PERM ? ((R & ~31) + perm32(R & 31)) : R;
        voffA[i] = (unsigned)(R * K + C) * 2u; voffB[i] = (unsigned)(Rb * K + C) * 2u; }
    const size_t kstep = (size_t)(BK * 2);
    const size_t hstep = (size_t)HALF * K * 2;
    const size_t tstep = 2 * hstep;
    const unsigned ldsw = (unsigned)wid * 1024u;
    const int aoff = lds_byte(wr * 64 + fr, fq * 8), boff = lds_byte(wc * 32 + fr, fq * 8);
#define PG8_SA(b, h) (((b) * 2 + (h)) * HTB)
#define PG8_SB(b, h) ((4 + (b) * 2 + (h)) * HTB)
#define PG8_STAGE(bufoff, gbase, voff) do { _Pragma("unroll") for (int _i = 0; _i < 2; ++_i) \
        __builtin_amdgcn_global_load_lds((const unsigned*)((const char*)(gbase) + (voff)[_i]), (PG8_LAS unsigned*)(lds + (bufoff) + ldsw + _i * 8192), 16, 0, 0); } while (0)
#define PG8_LDA(dst, b, h) do { _Pragma("unroll") for (int m = 0; m < 4; ++m) _Pragma("unroll") for (int k = 0; k < 2; ++k) dst[m][k] = *(const PG8_LAS bf16x8*)(lds + PG8_SA(b, h) + aoff + m * 2048 + k * 1024); } while (0)
#define PG8_LDB(dst, b, h) do { _Pragma("unroll") for (int n = 0; n < 2; ++n) _Pragma("unroll") for (int k = 0; k < 2; ++k) dst[n][k] = *(const PG8_LAS bf16x8*)(lds + PG8_SB(b, h) + boff + n * 2048 + k * 1024); } while (0)
#define PG8_MMA(ai, bj, At, Bt) do { __builtin_amdgcn_s_setprio(1); _Pragma("unroll") for (int m = 0; m < 4; ++m) _Pragma("unroll") for (int n = 0; n < 2; ++n) _Pragma("unroll") for (int k = 0; k < 2; ++k) \
        acc[ai][bj][m][n] = __builtin_amdgcn_mfma_f32_16x16x32_bf16(Bt[n][k], At[m][k], acc[ai][bj][m][n], 0, 0, 0); __builtin_amdgcn_s_setprio(0); } while (0)
#define PG8_WAIT_V(n) asm volatile("s_waitcnt vmcnt(" #n ")" ::: "memory")
#define PG8_WAIT_L(n) asm volatile("s_waitcnt lgkmcnt(" #n ")" ::: "memory")
#define PG8_BAR __builtin_amdgcn_s_barrier()
#define PG8_SCHED __builtin_amdgcn_sched_barrier(0)
    Unit cur, nxt; int ui = 0;
    if (!S.next(0, cur)) return;
    f32x4 acc[2][2][4][2];
#pragma unroll
    for (int a = 0; a < 2; ++a)
#pragma unroll
        for (int b = 0; b < 2; ++b)
#pragma unroll
            for (int m = 0; m < 4; ++m)
#pragma unroll
                for (int n = 0; n < 2; ++n) acc[a][b][m][n] = (f32x4){0.f, 0.f, 0.f, 0.f};
    bf16x8 At[4][2], B0[2][2], B1[2][2];
    const char* cA = (const char*)g.A + (size_t)cur.pm * tstep; const char* cB = (const char*)g.Bt + (size_t)cur.pn * tstep;
    S.a_ready(cur);
    if constexpr (SP2) {
        PG8_STAGE(PG8_SB(0, 0), cB, voffB); PG8_STAGE(PG8_SB(0, 1), cB + hstep, voffB); PG8_STAGE(PG8_SA(0, 0), cA, voffA); PG8_STAGE(PG8_SA(0, 1), cA + hstep, voffA);
        if (wr == 1) PG8_BAR;
        PG8_WAIT_V(2); PG8_BAR;
        PG8_STAGE(PG8_SB(1, 0), cB + kstep, voffB); PG8_STAGE(PG8_SA(1, 0), cA + kstep, voffA); PG8_STAGE(PG8_SB(1, 1), cB + hstep + kstep, voffB);
        PG8_WAIT_V(6); PG8_BAR;
    } else {
        PG8_STAGE(PG8_SB(0, 0), cB, voffB); PG8_STAGE(PG8_SA(0, 0), cA, voffA); PG8_STAGE(PG8_SB(0, 1), cB + hstep, voffB); PG8_STAGE(PG8_SA(0, 1), cA + hstep, voffA);
        if (wr == 1) PG8_BAR;
        PG8_WAIT_V(4); PG8_BAR;
        PG8_STAGE(PG8_SB(1, 0), cB + kstep, voffB); PG8_STAGE(PG8_SA(1, 0), cA + kstep, voffA); PG8_STAGE(PG8_SB(1, 1), cB + hstep + kstep, voffB);
        PG8_WAIT_V(6); PG8_BAR;
    }
    for (;;) {
        const bool has_next = S.next(ui + 1, nxt);
        const char* nA = has_next ? (const char*)g.A + (size_t)nxt.pm * tstep : cA; const char* nB = has_next ? (const char*)g.Bt + (size_t)nxt.pn * tstep : cB;
        for (int t = 0; t < nt; t += 2) {
            const bool last = (t == nt - 2);
            const char* a1 = cA + (size_t)(t + 1) * kstep;
            const char* a2 = last ? nA : cA + (size_t)(t + 2) * kstep; const char* b2 = last ? nB : cB + (size_t)(t + 2) * kstep;
            const char* a3 = a2 + kstep; const char* b3 = b2 + kstep;
            if (last && has_next) S.a_ready(nxt);
            if constexpr (SP2) {
            PG8_LDB(B0, 0, 0); PG8_LDB(B1, 0, 1); PG8_SCHED; PG8_LDA(At, 0, 0); PG8_STAGE(PG8_SA(1, 1), a1 + hstep, voffA);
            PG8_WAIT_V(8); PG8_WAIT_L(0); PG8_BAR; PG8_MMA(0, 0, At, B0); PG8_MMA(0, 1, At, B1); PG8_BAR; PG8_SCHED;
            PG8_LDA(At, 0, 1); PG8_STAGE(PG8_SB(0, 0), b2, voffB); PG8_STAGE(PG8_SB(0, 1), b2 + hstep, voffB); PG8_STAGE(PG8_SA(0, 0), a2, voffA);
            PG8_WAIT_V(8); PG8_WAIT_L(0); PG8_BAR; PG8_MMA(1, 0, At, B0); PG8_MMA(1, 1, At, B1); PG8_BAR; PG8_SCHED;
            PG8_LDB(B0, 1, 0); PG8_LDB(B1, 1, 1); PG8_SCHED; PG8_LDA(At, 1, 0); PG8_STAGE(PG8_SA(0, 1), a2 + hstep, voffA);
            PG8_WAIT_V(8); PG8_WAIT_L(0); PG8_BAR; PG8_MMA(0, 0, At, B0); PG8_MMA(0, 1, At, B1); PG8_BAR; PG8_SCHED;
            PG8_LDA(At, 1, 1); PG8_STAGE(PG8_SB(1, 0), b3, voffB); PG8_STAGE(PG8_SB(1, 1), b3 + hstep, voffB); PG8_STAGE(PG8_SA(1, 0), a3, voffA);
            PG8_WAIT_V(8); PG8_WAIT_L(0); PG8_BAR; PG8_MMA(1, 0, At, B0); PG8_MMA(1, 1, At, B1); PG8_BAR; PG8_SCHED;
            } else {
            PG8_LDB(B0, 0, 0); PG8_SCHED; PG8_LDA(At, 0, 0); PG8_STAGE(PG8_SA(1, 1), a1 + hstep, voffA);
            PG8_WAIT_L(8); PG8_BAR; PG8_WAIT_L(0); PG8_MMA(0, 0, At, B0); PG8_BAR; PG8_SCHED;
            PG8_LDB(B1, 0, 1); PG8_STAGE(PG8_SB(0, 0), b2, voffB);
            PG8_BAR; PG8_WAIT_L(0); PG8_MMA(0, 1, At, B1); PG8_BAR;
            PG8_LDA(At, 0, 1); PG8_STAGE(PG8_SA(0, 0), a2, voffA);
            PG8_BAR; PG8_WAIT_L(0); PG8_MMA(1, 0, At, B0); PG8_BAR; PG8_SCHED;
            PG8_STAGE(PG8_SB(0, 1), b2 + hstep, voffB);
            PG8_WAIT_V(6); PG8_BAR; PG8_MMA(1, 1, At, B1); PG8_BAR;
            PG8_LDB(B0, 1, 0); PG8_SCHED; PG8_LDA(At, 1, 0); PG8_STAGE(PG8_SA(0, 1), a2 + hstep, voffA);
            PG8_WAIT_L(8); PG8_BAR; PG8_WAIT_L(0); PG8_MMA(0, 0, At, B0); PG8_BAR; PG8_SCHED;
            PG8_LDB(B1, 1, 1); PG8_STAGE(PG8_SB(1, 0), b3, voffB);
            PG8_BAR; PG8_WAIT_L(0); PG8_MMA(0, 1, At, B1); PG8_BAR;
            PG8_LDA(At, 1, 1); PG8_STAGE(PG8_SA(1, 0), a3, voffA);
            PG8_BAR; PG8_WAIT_L(0); PG8_MMA(1, 0, At, B0); PG8_BAR; PG8_SCHED;
            PG8_STAGE(PG8_SB(1, 1), b3 + hstep, voffB);
            PG8_WAIT_V(6); PG8_BAR; PG8_MMA(1, 1, At, B1); PG8_BAR;
            }
        }
        if constexpr (ALIGN_EPI) { if (wr == 0) PG8_BAR; }
        if constexpr (!Epi::AFTER_DRAIN) { E(acc, cur, wr, wc, fr, fq); S.done(cur); }
        if (!has_next) break;
#pragma unroll
        for (int a = 0; a < 2; ++a)
#pragma unroll
            for (int b = 0; b < 2; ++b)
#pragma unroll
                for (int m = 0; m < 4; ++m)
#pragma unroll
                    for (int n = 0; n < 2; ++n) acc[a][b][m][n] = (f32x4){0.f, 0.f, 0.f, 0.f};
        cur = nxt; cA = nA; cB = nB; ++ui;
        if constexpr (ALIGN_EPI) { if (wr == 1) PG8_BAR; }
    }
    PG8_WAIT_V(0);
    if constexpr (!ALIGN_EPI) { if (wr == 0) PG8_BAR; }
    PG8_BAR;
    if constexpr (Epi::AFTER_DRAIN) { E.fused(acc, cur, wr, wc, fr, fq, lds, wid, lane); S.done(cur); }
#undef PG8_SA
#undef PG8_SB
#undef PG8_STAGE
#undef PG8_LDA
#undef PG8_LDB
#undef PG8_MMA
#undef PG8_WAIT_V
#undef PG8_WAIT_L
#undef PG8_BAR
#undef PG8_SCHED
}
}

#define DI __device__ __forceinline__
#define LAS __attribute__((address_space(3)))
using pg8::bf16_t; using pg8::bf16x8; using pg8::f32x4; using pg8::u32x4; using pg8::cvtpk; using pg8::sigm;
typedef float f32x2 __attribute__((ext_vector_type(2)));
typedef unsigned u32x2 __attribute__((ext_vector_type(2)));

#ifndef NAT_GLA_PCT
#define NAT_GLA_PCT 0
#endif
#ifndef MIXMASK
#define MIXMASK 3
#endif
#ifndef ROLEMASK
#define ROLEMASK 15
#endif
#ifndef PHMASK
#define PHMASK 0xffff
#endif
constexpr int NTHR = 512, NWAVE = 8, LDS_BYTES = 147456;
constexpr int D = 1024, NB = 32, SL = 2048, CL = 256, ML = NB * SL, MC = NB * CL, MT = ML + MC;
constexpr int INC = 3488, PLD = 3584, FH = 2816, LOLD = 1920;
constexpr int C_GQ = 0, C_GK = 192, C_GV = 384, C_GG = 768, C_GDN = 1152;
constexpr int C_NQ = 1184, C_NK = 1440, C_NV = 1696;
constexpr int C_RW = 1952;
constexpr size_t OFF_WIN = 0, OFF_WOUT = 7340032, OFF_W13 = 9437184, OFF_W2 = 20971520, OFF_BT2 = 26738688, WLB = 28311552;
constexpr size_t WS_MOD = 2 * WLB, WS_ROPE = WS_MOD + 1622016, WS_BON = WS_ROPE + 262144, WS_VT = WS_BON + 3538944, WS_AY = WS_VT + 37748736,
                 WS_PB = WS_AY + 150994944, WS_LO = WS_PB + 528482304, WS_END = WS_LO + 283115520;

struct Params { const float* in[29]; float* out; unsigned char* ws; };
enum { I_X = 0, I_C, I_CTX, I_CCTX, I_WMOD, I_BMOD, I_WIN, I_GUP, I_GB, I_GNW, I_RPB, I_MU, I_W0, I_WD2, I_A0, I_WA2, I_WG2, I_KK, I_KA, I_RK, I_GNWT, I_GNB,
       I_WOUT, I_LN1W, I_LN1B, I_W13, I_W2, I_LN2W, I_LN2B };

DI const float* pin(const Params& p, int i) { asm volatile("" : "+s"(i)); return p.in[i]; }
DI float bf2f(bf16_t h) { return __uint_as_float(((unsigned)h) << 16); }
DI float bflo(unsigned u) { return __uint_as_float(u << 16); }
DI float bfhi(unsigned u) { return __uint_as_float(u & 0xffff0000u); }
DI bf16_t f2bf(float f) { return (bf16_t)(cvtpk(f, 0.f) & 0xffffu); }
DI float shx(float v, int m, int lane) { return __int_as_float(__builtin_amdgcn_ds_bpermute((lane ^ m) << 2, __float_as_int(v))); }
#define DPPF(v, ctrl) __int_as_float(__builtin_amdgcn_mov_dpp(__float_as_int(v), (ctrl), 0xf, 0xf, true))
DI float sum4(float v) { v += DPPF(v, 0xB1); v += DPPF(v, 0x4E); return v; }
DI float sum8(float v) { v = sum4(v); v += DPPF(v, 0x141); return v; }
DI float sum16(float v) { v = sum8(v); v += DPPF(v, 0x140); return v; }
DI float x16_sum(float x) { const auto r = __builtin_amdgcn_permlane16_swap(__float_as_uint(x), __float_as_uint(x), false, false); return __uint_as_float(r[0]) + __uint_as_float(r[1]); }
DI float x32_sum(float x) { const auto r = __builtin_amdgcn_permlane32_swap(__float_as_uint(x), __float_as_uint(x), false, false); return __uint_as_float(r[0]) + __uint_as_float(r[1]); }
DI float x16_max(float x) { const auto r = __builtin_amdgcn_permlane16_swap(__float_as_uint(x), __float_as_uint(x), false, false); return fmaxf(__uint_as_float(r[0]), __uint_as_float(r[1])); }
DI float x32_max(float x) { const auto r = __builtin_amdgcn_permlane32_swap(__float_as_uint(x), __float_as_uint(x), false, false); return fmaxf(__uint_as_float(r[0]), __uint_as_float(r[1])); }
DI float wave_sum(float v, int) { return x32_sum(x16_sum(sum16(v))); }
DI void cvt8(const u32x4 u, float* o) { o[0] = bflo(u.x); o[1] = bfhi(u.x); o[2] = bflo(u.y); o[3] = bfhi(u.y); o[4] = bflo(u.z); o[5] = bfhi(u.z); o[6] = bflo(u.w); o[7] = bfhi(u.w); }
DI void load8(const bf16_t* p, float* o) { const u32x4 u = *(const u32x4*)p; o[0] = bflo(u.x); o[1] = bfhi(u.x); o[2] = bflo(u.y); o[3] = bfhi(u.y); o[4] = bflo(u.z); o[5] = bfhi(u.z); o[6] = bflo(u.w); o[7] = bfhi(u.w); }
DI void load16(const bf16_t* p, float (&o)[16]) { load8(p, &o[0]); load8(p + 8, &o[8]); }
DI void shift16(const bf16_t* prow, bool hasm, bool hasp, const float* mu, float (&y)[16]) {
    float c0[16], cm[16], cp[16];
    load16(prow, c0);
    if (hasm) load16(prow - PLD, cm); else {
#pragma unroll
        for (int j = 0; j < 16; ++j) cm[j] = 0.f; }
    if (hasp) load16(prow + PLD, cp); else {
#pragma unroll
        for (int j = 0; j < 16; ++j) cp[j] = 0.f; }
#pragma unroll
    for (int j = 0; j < 16; ++j) y[j] = c0[j] + (0.5f * (cm[j] + cp[j]) - c0[j]) * mu[j];
}
DI void step_row(int s, int g, int b, int& row, int& ts, int& Ls) {
    if (s < CL) { ts = g ? (CL - 1 - s) : s; row = ML + b * CL + ts; Ls = CL; }
    else { const int u = s - CL; ts = g ? (SL - 1 - u) : u; row = b * SL + ts; Ls = SL; }
}

DI void transpose_item(const float* W, int N, bf16_t* WT, int Kd, size_t dst_row0, int k0, int n0, LAS float* scr, int lane) {
#pragma unroll 8
    for (int i = 0; i < 32; ++i) { const int kk = 2 * i + (lane >> 5); scr[kk * 33 + (lane & 31)] = W[(size_t)(k0 + kk) * N + n0 + (lane & 31)]; }
    asm volatile("s_waitcnt lgkmcnt(0)" ::: "memory");
    const int c = lane & 7;
#pragma unroll
    for (int j = 0; j < 4; ++j) { const int n = (lane >> 3) + 8 * j; const LAS float* s = scr + (8 * c) * 33 + n;
        u32x4 o; o.x = cvtpk(s[0 * 33], s[1 * 33]); o.y = cvtpk(s[2 * 33], s[3 * 33]); o.z = cvtpk(s[4 * 33], s[5 * 33]); o.w = cvtpk(s[6 * 33], s[7 * 33]);
        *(u32x4*)(WT + (dst_row0 + n) * Kd + k0 + 8 * c) = o; }
    asm volatile("s_waitcnt lgkmcnt(0)" ::: "memory");
}

DI void phase_prologue(const Params& p, LAS unsigned char* lds, int tid, int lane, int wave) {
    unsigned char* ws = p.ws;
    float* MOD = (float*)(ws + WS_MOD);
    {
        LAS float* sc = (LAS float*)lds;
        LAS float* part = (LAS float*)(lds + 135168);
        for (int i = tid; i < 33 * 1024; i += NTHR) { const int bi = i >> 10, k = i & 1023; const float cv = bi < 32 ? pin(p, I_C)[bi * 1024 + k] : pin(p, I_CCTX)[k]; sc[k * 33 + bi] = cv * sigm(cv); }
        __syncthreads();
        for (int u = blockIdx.x; u < 192; u += gridDim.x) {
            const int l = u / 96, n0 = (u % 96) * 64;
            float acc[33];
#pragma unroll
            for (int bi = 0; bi < 33; ++bi) acc[bi] = 0.f;
            const float* wp = pin(p, I_WMOD) + (size_t)l * 1024 * 6144 + n0 + lane;
#pragma unroll 4
            for (int kk = 0; kk < 128; ++kk) { const int k = wave * 128 + kk; const float w = wp[(size_t)k * 6144];
#pragma unroll
                for (int bi = 0; bi < 33; ++bi) acc[bi] += sc[k * 33 + bi] * w; }
            for (int w = 0; w < NWAVE; ++w) {
                if (wave == w) {
#pragma unroll
                    for (int bi = 0; bi < 33; ++bi) { if (w == 0) part[bi * 64 + lane] = acc[bi]; else part[bi * 64 + lane] += acc[bi]; } }
                __syncthreads();
            }
            for (int i = tid; i < 33 * 64; i += NTHR) { const int bi = i >> 6, n = i & 63; MOD[(size_t)(l * 33 + bi) * 6144 + n0 + n] = part[i] + pin(p, I_BMOD)[l * 6144 + n0 + n]; }
            __syncthreads();
        }
        __syncthreads();
    }
    const int gw = blockIdx.x * NWAVE + wave, NGW = gridDim.x * NWAVE;
    const int gt = blockIdx.x * NTHR + tid, NGT = gridDim.x * NTHR;
    {
        LAS float* scr = (LAS float*)(lds + wave * 8448);
        constexpr int IT_IN = 16 * 109, IT_OUT = 16 * 32, IT_13 = 16 * 176, IT_2 = 44 * 32, IT_L = IT_IN + IT_OUT + IT_13 + IT_2;
        for (int it = gw; it < 2 * IT_L; it += NGW) {
            const int l = it / IT_L; int r = it % IT_L;
            unsigned char* wl = ws + (size_t)l * WLB;
            if (r < IT_IN) { const int kb = r / 109, nb = r % 109;
                transpose_item(pin(p, I_WIN) + (size_t)l * 1024 * INC, INC, (bf16_t*)(wl + OFF_WIN), 1024, (size_t)nb * 32, kb * 64, nb * 32, scr, lane); continue; }
            r -= IT_IN;
            if (r < IT_OUT) { const int kb = r / 32, nb = r % 32;
                transpose_item(pin(p, I_WOUT) + (size_t)l * 1024 * 1024, 1024, (bf16_t*)(wl + OFF_WOUT), 1024, (size_t)nb * 32, kb * 64, nb * 32, scr, lane); continue; }
            r -= IT_OUT;
            if (r < IT_13) { const int kb = r / 176, nb = r % 176; const int n0 = nb * 32;
                const int j = n0 < FH ? n0 : n0 - FH; const size_t drow = (size_t)(256 * (j / 128) + (n0 < FH ? 0 : 128) + (j % 128));
                transpose_item(pin(p, I_W13) + (size_t)l * 1024 * 2 * FH, 2 * FH, (bf16_t*)(wl + OFF_W13), 1024, drow, kb * 64, n0, scr, lane); continue; }
            r -= IT_13;
            { const int kb = r / 32, nb = r % 32;
                transpose_item(pin(p, I_W2) + (size_t)l * FH * 1024, 1024, (bf16_t*)(wl + OFF_W2), FH, (size_t)nb * 32, kb * 64, nb * 32, scr, lane); }
        }
    }
    for (int i = gt; i < 2 * 96 * 1024; i += NGT) { const int l = i / (96 * 1024), r = i % (96 * 1024); ((bf16_t*)(ws + (size_t)l * WLB + OFF_WIN))[(size_t)INC * 1024 + r] = 0; }
    for (int i = gt; i < 2 * 2048 * 384; i += NGT) {
        const int l = i / (2048 * 384), r = i % (2048 * 384), n = r / 384, k = r % 384;
        float v = 0.f;
        if (n < 1536) { const int g = n / 768, h = (n % 768) / 128, which = (n % 128) / 64, ch = n % 64, c = h * 64 + ch;
            const int kb = which ? 128 + 64 * g : 64 * g;
            if (k >= kb && k < kb + 64) v = (which ? pin(p, I_WA2) : pin(p, I_WD2))[((size_t)(l * 2 + g) * 64 + (k - kb)) * 384 + c]; }
        else if (n < 1920) { if (k >= 256) v = pin(p, I_WG2)[((size_t)l * 128 + (k - 256)) * 384 + (n - 1536)]; }
        ((bf16_t*)(ws + (size_t)l * WLB + OFF_BT2))[r] = f2bf(v);
    }
    for (int i = gt; i < SL * 16; i += NGT) { const int t = i >> 4, pi = i & 15; const float pos = (float)(pi < 8 ? (t >> 6) : (t & 63));
        const float inv = powf(10000.0f, -(float)(pi & 7) * 0.125f); const float ang = pos * inv;
        float* rt = (float*)(ws + WS_ROPE) + (size_t)i * 2; rt[0] = cosf(ang); rt[1] = sinf(ang); }
}

DI void phase_modulate0(const Params& p, int lane, int wave) {
    const int gw = blockIdx.x * NWAVE + wave, NGW = gridDim.x * NWAVE;
    const float* MOD = (const float*)(p.ws + WS_MOD); bf16_t* A = (bf16_t*)(p.ws + WS_AY);
    for (int row = gw; row < MT; row += NGW) {
        const float* src = row < ML ? pin(p, I_X) + (size_t)row * D : pin(p, I_CTX) + (size_t)(row - ML) * D;
        const int bi = row < ML ? (row >> 11) : 32; const float* md = MOD + (size_t)bi * 6144;
#pragma unroll
        for (int j = 0; j < 4; ++j) { const int c = 4 * (lane + 64 * j); const f32x4 v = *(const f32x4*)(src + c), sh = *(const f32x4*)(md + c), sc = *(const f32x4*)(md + 1024 + c);
            u32x2 o; o.x = cvtpk(v[0] * (1.f + sc[0]) + sh[0], v[1] * (1.f + sc[1]) + sh[1]); o.y = cvtpk(v[2] * (1.f + sc[2]) + sh[2], v[3] * (1.f + sc[3]) + sh[3]);
            *(u32x2*)(A + (size_t)row * D + c) = o; }
    }
}
DI void phase_ln(const Params& p, int lane, int wave, int nrows, const float* lnw, const float* lnb, const float* modl, int sh_ofs, int sc_ofs, bool write_x, bool write_A) {
    const int gw = blockIdx.x * NWAVE + wave, NGW = gridDim.x * NWAVE;
    bf16_t* A = (bf16_t*)(p.ws + WS_AY); float* tc = (float*)(p.ws + WS_VT);
    f32x4 nx[4];
    if (gw < nrows) { const float* t0 = gw < ML ? p.out + (size_t)gw * D : tc + (size_t)(gw - ML) * D;
#pragma unroll
        for (int j = 0; j < 4; ++j) nx[j] = *(const f32x4*)(t0 + 4 * (lane + 64 * j)); }
    for (int row = gw; row < nrows; row += NGW) {
        const bool lat = row < ML;
        float* t = lat ? p.out + (size_t)row * D : tc + (size_t)(row - ML) * D;
        const int bi = lat ? (row >> 11) : 32;
        f32x4 v[4]; float s = 0.f;
#pragma unroll
        for (int j = 0; j < 4; ++j) { v[j] = nx[j]; s += (v[j][0] + v[j][1]) + (v[j][2] + v[j][3]); }
        { const int rn = row + NGW; if (rn < nrows) { const float* tn = rn < ML ? p.out + (size_t)rn * D : tc + (size_t)(rn - ML) * D;
#pragma unroll
            for (int j = 0; j < 4; ++j) nx[j] = *(const f32x4*)(tn + 4 * (lane + 64 * j)); } }
        const float mean = wave_sum(s, lane) * (1.f / D); float s2 = 0.f;
#pragma unroll
        for (int j = 0; j < 4; ++j) { v[j] = v[j] - mean; s2 += (v[j][0] * v[j][0] + v[j][1] * v[j][1]) + (v[j][2] * v[j][2] + v[j][3] * v[j][3]); }
        const float rstd = rsqrtf(wave_sum(s2, lane) * (1.f / D) + 1e-5f);
        const float* md = modl + (size_t)bi * 6144;
#pragma unroll
        for (int j = 0; j < 4; ++j) { const int c = 4 * (lane + 64 * j); const f32x4 w = *(const f32x4*)(lnw + c), b = *(const f32x4*)(lnb + c);
            f32x4 y; y[0] = v[j][0] * rstd * w[0] + b[0]; y[1] = v[j][1] * rstd * w[1] + b[1]; y[2] = v[j][2] * rstd * w[2] + b[2]; y[3] = v[j][3] * rstd * w[3] + b[3];
            if (write_x) *(f32x4*)(t + c) = y;
            if (write_A) { const f32x4 sh = *(const f32x4*)(md + sh_ofs + c), sc = *(const f32x4*)(md + sc_ofs + c);
                u32x2 o; o.x = cvtpk(y[0] * (1.f + sc[0]) + sh[0], y[1] * (1.f + sc[1]) + sh[1]); o.y = cvtpk(y[2] * (1.f + sc[2]) + sh[2], y[3] * (1.f + sc[3]) + sh[3]);
                *(u32x2*)(A + (size_t)row * D + c) = o; } }
    }
}

DI void phase_prep(const Params& p, int l, LAS unsigned char* lds, int lane, int wave) {
    const int gw = blockIdx.x * NWAVE + wave, NGW = gridDim.x * NWAVE;
    const bf16_t* PB = (const bf16_t*)(p.ws + WS_PB); bf16_t* A2 = (bf16_t*)(p.ws + WS_AY); bf16_t* VT = (bf16_t*)(p.ws + WS_VT);
    {
        const int j8 = lane < 48 ? 8 * lane : 0, kind = j8 >> 7;
        float mu[8];
        { const float* m = pin(p, I_MU) + (size_t)l * 1536 + 1152 + j8;
#pragma unroll
          for (int j = 0; j < 8; ++j) mu[j] = m[j]; }
        for (int row = gw; row < MT; row += NGW) {
            const bool lat = row < ML; const int t = lat ? (row & (SL - 1)) : ((row - ML) & (CL - 1)); const int Ls = lat ? SL : CL;
            const bf16_t* pr = PB + (size_t)row * PLD + C_RW + 1152 + j8;
            const u32x4 r0 = *(const u32x4*)pr, rm = *(const u32x4*)(t > 0 ? pr - PLD : pr), rp = *(const u32x4*)(t < Ls - 1 ? pr + PLD : pr);
            const float mm = t > 0 ? 0.5f : 0.f, mp = t < Ls - 1 ? 0.5f : 0.f;
            float c0[8], cm[8], cp[8], o[8];
            cvt8(r0, c0); cvt8(rm, cm); cvt8(rp, cp);
#pragma unroll
            for (int j = 0; j < 8; ++j) { const float y = c0[j] + ((mm * cm[j] + mp * cp[j]) - c0[j]) * mu[j];
                o[j] = kind == 0 ? 1.f - 2.f / (1.f + __expf(2.f * y)) : (kind == 1 ? y : sigm(y)); }
            if (lane < 48) { u32x4 w; w.x = cvtpk(o[0], o[1]); w.y = cvtpk(o[2], o[3]); w.z = cvtpk(o[4], o[5]); w.w = cvtpk(o[6], o[7]); *(u32x4*)(A2 + (size_t)row * 384 + j8) = w; }
        }
    }
    LAS bf16_t* T = (LAS bf16_t*)(lds + wave * 8448);
    for (int it = gw; it < NB * 4 * 36; it += NGW) {
        const int tb = it % 36, h = (it / 36) & 3, b = it / 144;
        const int row0 = tb < 32 ? b * SL + tb * 64 : ML + b * CL + (tb - 32) * 64;
        const bf16_t* src = PB + (size_t)(row0 + (lane >> 3)) * PLD + C_NV + h * 64 + 8 * (lane & 7);
#pragma unroll
        for (int i = 0; i < 8; ++i) { const u32x4 v = *(const u32x4*)(src + (size_t)(8 * i) * PLD);
            LAS unsigned* d = (LAS unsigned*)(T + (8 * i + (lane >> 3)) * 66 + 8 * (lane & 7)); d[0] = v.x; d[1] = v.y; d[2] = v.z; d[3] = v.w; }
        asm volatile("s_waitcnt vmcnt(0) lgkmcnt(0)" ::: "memory");
        bf16_t* dst = VT + ((size_t)(b * 4 + h) * 144 + tb * 4) * 1024;
#pragma unroll
        for (int k = 0; k < 16; ++k) { const int u = k * 64 + lane, q = u >> 8, d = (u >> 2) & 63, kg = u & 3;
            const LAS bf16_t* tp = T + (16 * q + 4 * kg) * 66 + d;
            u32x2 o; o.x = (unsigned)tp[0] | ((unsigned)tp[66] << 16); o.y = (unsigned)tp[132] | ((unsigned)tp[198] << 16);
            *(u32x2*)(dst + (size_t)(q * 64 + d) * 16 + 4 * kg) = o; }
        asm volatile("s_waitcnt lgkmcnt(0)" ::: "memory");
    }
}

#define MFMA16(a, b, c) __builtin_amdgcn_mfma_f32_16x16x32_bf16((a), (b), (c), 0, 0, 0)
DI u32x4 vload16(const bf16_t* p) { const volatile unsigned* q = (const volatile unsigned*)p; u32x4 r; r.x = q[0]; r.y = q[1]; r.z = q[2]; r.w = q[3]; return r; }
DI u32x2 vload8(const bf16_t* p) { const volatile unsigned* q = (const volatile unsigned*)p; u32x2 r; r.x = q[0]; r.y = q[1]; return r; }
struct NatPair { bf16x8 k[2][2]; u32x2 v[4][2]; u32x2 bias[2]; };
DI void nat_unit(const Params& p, int l, int id, bool isctx, int lane) {
    const bf16_t* PB = (const bf16_t*)(p.ws + WS_PB); const bf16_t* VT = (const bf16_t*)(p.ws + WS_VT); bf16_t* AY = (bf16_t*)(p.ws + WS_AY);
    const int l15 = lane & 15, g = lane >> 4;
    int b, h, r = 0, qt, qrow;
    if (!isctx) { qt = id & 3; r = (id >> 2) & 31; h = (id >> 7) & 3; b = id >> 9; qrow = b * SL + r * 64 + 16 * qt + l15; }
    else { qt = id & 15; h = (id >> 4) & 3; b = id >> 6; qrow = ML + b * CL + 16 * qt + l15; }
    const bf16_t* qp = PB + (size_t)qrow * PLD + C_NQ + h * 64 + 8 * g;
    const bf16x8 qf0 = *(const bf16x8*)qp, qf1 = *(const bf16x8*)(qp + 32);
    const int rs = min(max(r - 4, 0), 24);
    int ct_lo = 0, nct = 1;
    if (!isctx) { const int lo = min(max(16 * qt - 8, 0), 48), hi = min(max(16 * qt + 7, 0), 48) + 16; ct_lo = lo >> 4; nct = ((hi - 1) >> 4) - ct_lo + 1; }
    const int nloc = isctx ? 0 : 8 * nct, npairs = nloc / 2 + 8;
    const int qc = 16 * qt + l15, cs = min(max(qc - 8, 0), 48);
    float m = -1e30f, lsum = 0.f;
    f32x4 oacc[4];
#pragma unroll
    for (int dt = 0; dt < 4; ++dt) oacc[dt] = (f32x4){0.f, 0.f, 0.f, 0.f};
    const bf16_t* vt = VT + (size_t)(b * 4 + h) * 144 * 1024 + l15 * 16 + 4 * g;
    const bf16_t* kbase = PB + (size_t)l15 * PLD + C_NK + h * 64 + 8 * g;
    const float* rp = pin(p, I_RPB) + (size_t)((l * 4 + h) * 15) * 31;
    NatPair ring[4];
    int iti = 0, ikr = 0, icj = 0;
#define NAT_ISSUE(slot) do { __builtin_amdgcn_sched_barrier(0); _Pragma("unroll") for (int e = 0; e < 2; ++e) { int tk, keyrow; f32x4 bs = (f32x4){0.f, 0.f, 0.f, 0.f}; \
        if (iti < nloc) { const int ct = ct_lo + icj; tk = (rs + ikr) * 64 + 16 * ct; keyrow = b * SL + tk; const float* rpr = rp + (rs + ikr - r + 7) * 31; \
            _Pragma("unroll") for (int rg = 0; rg < 4; ++rg) { const int kc = 16 * ct + 4 * g + rg; const bool vis = (kc >= cs) && (kc < cs + 16); const float bv = rpr[min(max(kc - qc + 15, 0), 30)]; bs[rg] = vis ? bv : -1e30f; } \
            if (++icj == nct) { icj = 0; ++ikr; } } \
        else { const int j = (iti - nloc) * 16; tk = SL + j; keyrow = ML + b * CL + j; } \
        ++iti; ring[slot].bias[e] = (u32x2){cvtpk(bs[0], bs[1]), cvtpk(bs[2], bs[3])}; \
        const bf16_t* kp = kbase + (size_t)keyrow * PLD; ring[slot].k[e][0] = *(const bf16x8*)kp; ring[slot].k[e][1] = *(const bf16x8*)(kp + 32); \
        _Pragma("unroll") for (int dt = 0; dt < 4; ++dt) ring[slot].v[dt][e] = *(const u32x2*)(vt + (size_t)(tk >> 4) * 1024 + dt * 256); } __builtin_amdgcn_sched_barrier(0); } while (0)
#pragma unroll
    for (int j = 0; j < 4; ++j) NAT_ISSUE(j);
    for (int pi0 = 0; pi0 < npairs; pi0 += 4) {
#pragma unroll
        for (int j = 0; j < 4; ++j) {
            const int pi = pi0 + j;
            f32x4 s[2];
#pragma unroll
            for (int e = 0; e < 2; ++e) {
                f32x4 a = (f32x4){0.f, 0.f, 0.f, 0.f};
                a = MFMA16(ring[j].k[e][0], qf0, a); a = MFMA16(ring[j].k[e][1], qf1, a);
                const u32x2 bb = ring[j].bias[e];
                s[e] = a * 0.125f + (f32x4){bflo(bb.x), bfhi(bb.x), bflo(bb.y), bfhi(bb.y)};
            }
            float tmax = fmaxf(fmaxf(fmaxf(s[0][0], s[0][1]), fmaxf(s[0][2], s[0][3])), fmaxf(fmaxf(s[1][0], s[1][1]), fmaxf(s[1][2], s[1][3])));
            tmax = x32_max(x16_max(tmax));
            const float mn = fmaxf(m, tmax), corr = __expf(m - mn); m = mn;
            float pv[8]; float ps = 0.f;
#pragma unroll
            for (int i = 0; i < 8; ++i) { const float sv = s[i >> 2][i & 3]; pv[i] = sv > -1e29f ? __expf(sv - mn) : 0.f; ps += pv[i]; }
            lsum = lsum * corr + ps;
            u32x4 pk; pk.x = cvtpk(pv[0], pv[1]); pk.y = cvtpk(pv[2], pv[3]); pk.z = cvtpk(pv[4], pv[5]); pk.w = cvtpk(pv[6], pv[7]);
            const bf16x8 pf = __builtin_bit_cast(bf16x8, pk);
#pragma unroll
            for (int dt = 0; dt < 4; ++dt) {
                u32x4 vv; vv.x = ring[j].v[dt][0].x; vv.y = ring[j].v[dt][0].y; vv.z = ring[j].v[dt][1].x; vv.w = ring[j].v[dt][1].y;
                oacc[dt] = oacc[dt] * corr;
                oacc[dt] = MFMA16(__builtin_bit_cast(bf16x8, vv), pf, oacc[dt]);
            }
            if (pi + 4 < npairs) NAT_ISSUE(j);
        }
    }
#undef NAT_ISSUE
    lsum = x32_sum(x16_sum(lsum));
    const float inv = 1.0f / lsum;
    bf16_t* yp = AY + (size_t)qrow * D + 768 + h * 64 + 4 * g;
#pragma unroll
    for (int dt = 0; dt < 4; ++dt) { u32x2 o; o.x = cvtpk(oacc[dt][0] * inv, oacc[dt][1] * inv); o.y = cvtpk(oacc[dt][2] * inv, oacc[dt][3] * inv); *(u32x2*)(yp + 16 * dt) = o; }
}

constexpr int RW_STEP = 384, RW_BUF = 16 * RW_STEP, GL_STEP = 160, GL_BUF = 16 * GL_STEP, NCHUNK = (CL + SL) / 16;
struct RwRaw { u32x4 d[3][3][2]; u32x4 lo[4]; };
DI void rwkv_load(const Params& p, int item, int c, RwRaw& R, int lane) {
    const int g = item & 1, h = (item >> 1) % 6, b = item / 12;
    const int ti = lane >> 2, cg = lane & 3;
    int row, ts, Ls; step_row(16 * c + ti, g, b, row, ts, Ls);
    const int rm = ts > 0 ? row - 1 : row, rp = ts < Ls - 1 ? row + 1 : row;
    const bf16_t* PB = (const bf16_t*)(p.ws + WS_PB) + C_RW + h * 64 + 16 * cg;
    const bf16_t* p0 = PB + (size_t)row * PLD; const bf16_t* pm = PB + (size_t)rm * PLD; const bf16_t* pp = PB + (size_t)rp * PLD;
#pragma unroll
    for (int a = 0; a < 3; ++a)
#pragma unroll
        for (int hf = 0; hf < 2; ++hf) { R.d[a][0][hf] = *(const u32x4*)(pm + a * 384 + 8 * hf); R.d[a][1][hf] = *(const u32x4*)(p0 + a * 384 + 8 * hf); R.d[a][2][hf] = *(const u32x4*)(pp + a * 384 + 8 * hf); }
    const bf16_t* lo = (const bf16_t*)(p.ws + WS_LO) + (size_t)row * LOLD + (g * 6 + h) * 128 + 16 * cg;
    R.lo[0] = *(const u32x4*)lo; R.lo[1] = *(const u32x4*)(lo + 8); R.lo[2] = *(const u32x4*)(lo + 64); R.lo[3] = *(const u32x4*)(lo + 72);
}
DI void rwkv_compute(const Params& p, int item, int c, const RwRaw& R, LAS float* buf, const LAS float* CST, int lane) {
    const int g = item & 1, h = (item >> 1) % 6, b = item / 12;
    const int ti = lane >> 2, cg = lane & 3;
    int row, ts, Ls; step_row(16 * c + ti, g, b, row, ts, Ls);
    const float mm = ts > 0 ? 0.5f : 0.f, mp = ts < Ls - 1 ? 0.5f : 0.f;
    float y[3][16];
#pragma unroll
    for (int a = 0; a < 3; ++a) {
        float c0[16], cm[16], cp[16];
        cvt8(R.d[a][0][0], &cm[0]); cvt8(R.d[a][0][1], &cm[8]); cvt8(R.d[a][1][0], &c0[0]); cvt8(R.d[a][1][1], &c0[8]); cvt8(R.d[a][2][0], &cp[0]); cvt8(R.d[a][2][1], &cp[8]);
#pragma unroll
        for (int j4 = 0; j4 < 4; ++j4) { const f32x4 mu = *(const LAS f32x4*)(CST + a * 64 + 16 * cg + 4 * j4);
#pragma unroll
            for (int jj = 0; jj < 4; ++jj) { const int j = 4 * j4 + jj; y[a][j] = c0[j] + ((mm * cm[j] + mp * cp[j]) - c0[j]) * mu[jj]; } }
    }
    float lw[16], a[16];
    cvt8(R.lo[0], &lw[0]); cvt8(R.lo[1], &lw[8]); cvt8(R.lo[2], &a[0]); cvt8(R.lo[3], &a[8]);
    float kkv[16]; float ss = 0.f;
#pragma unroll
    for (int j4 = 0; j4 < 4; ++j4) { const f32x4 kc = *(const LAS f32x4*)(CST + 3 * 64 + 16 * cg + 4 * j4);
#pragma unroll
        for (int jj = 0; jj < 4; ++jj) { const int j = 4 * j4 + jj; kkv[j] = y[1][j] * kc[jj]; ss += kkv[j] * kkv[j]; } }
    ss = sum4(ss);
    const float inv = rsqrtf(ss + 1e-12f);
    float bon = 0.f;
    LAS float* o = buf + ti * RW_STEP + 16 * cg;
#pragma unroll
    for (int j4 = 0; j4 < 4; ++j4) {
        const f32x4 kac = *(const LAS f32x4*)(CST + 4 * 64 + 16 * cg + 4 * j4), rkc = *(const LAS f32x4*)(CST + 5 * 64 + 16 * cg + 4 * j4);
        f32x4 w4, b4, km4, r4, kk4, v4;
#pragma unroll
        for (int jj = 0; jj < 4; ++jj) { const int j = 4 * j4 + jj;
            const float kkn = kkv[j] * inv, aj = a[j];
            const float km = y[1][j] * (1.f + (aj - 1.f) * kac[jj]);
            w4[jj] = __expf(-lw[j]); b4[jj] = kkn * aj; km4[jj] = km; r4[jj] = y[0][j]; kk4[jj] = kkn; v4[jj] = y[2][j];
            bon += y[0][j] * km * rkc[jj]; }
        *(LAS f32x4*)(o + 0 * 64 + 4 * j4) = w4; *(LAS f32x4*)(o + 1 * 64 + 4 * j4) = b4; *(LAS f32x4*)(o + 2 * 64 + 4 * j4) = km4;
        *(LAS f32x4*)(o + 3 * 64 + 4 * j4) = r4; *(LAS f32x4*)(o + 4 * 64 + 4 * j4) = kk4; *(LAS f32x4*)(o + 5 * 64 + 4 * j4) = v4;
    }
    bon = sum4(bon);
    if (cg == 0) ((float*)(p.ws + WS_BON))[(size_t)row * 12 + g * 6 + h] = bon;
}
DI float xhalf_sum(float x) {
    const auto r = __builtin_amdgcn_permlane32_swap(__float_as_uint(x), __float_as_uint(x), false, false);
    return __uint_as_float(r[0]) + __uint_as_float(r[1]);
}
DI void rwkv_scan_chunk(const Params& p, int item, int c, const LAS float* buf, f32x2 (&S)[16], int lane, int hf, bool dry) {
    const int g = item & 1, h = (item >> 1) % 6, b = item / 12;
    float* LOf = (float*)(p.ws + WS_LO);
    const int kh = lane >> 5, rowi = 32 * hf + (lane & 31);
    const LAS float* bk = buf + 32 * kh;
    f32x4 KK[8];
#pragma unroll
    for (int i = 0; i < 8; ++i) KK[i] = *(const LAS f32x4*)(bk + 256 + 4 * i);
    float vv = buf[320 + rowi];
    for (int st = 0; st < 16; ++st) {
        const LAS float* W = bk + st * RW_STEP;
        const LAS float* Wn = bk + (st < 15 ? st + 1 : st) * RW_STEP;
        f32x4 U[2][8];
#pragma unroll
        for (int j = 0; j < 2; ++j) { U[0][4 * j] = *(const LAS f32x4*)(W + 4 * j); U[0][4 * j + 1] = *(const LAS f32x4*)(W + 64 + 4 * j); U[0][4 * j + 2] = *(const LAS f32x4*)(W + 128 + 4 * j); U[0][4 * j + 3] = *(const LAS f32x4*)(W + 192 + 4 * j); }
        f32x2 sacc[4];
#pragma unroll
        for (int i = 0; i < 4; ++i) sacc[i] = (f32x2){0.f, 0.f};
#pragma unroll
        for (int i = 0; i < 8; ++i) { sacc[(2 * i) & 3] += S[2 * i] * (f32x2){KK[i][0], KK[i][1]}; sacc[(2 * i + 1) & 3] += S[2 * i + 1] * (f32x2){KK[i][2], KK[i][3]}; }
        const f32x2 st2 = (sacc[0] + sacc[1]) + (sacc[2] + sacc[3]);
        const float sa = -xhalf_sum(st2[0] + st2[1]);
        const f32x2 sa2 = (f32x2){sa, sa}, vv2 = (f32x2){vv, vv};
        f32x2 oacc[4];
#pragma unroll
        for (int i = 0; i < 4; ++i) oacc[i] = (f32x2){0.f, 0.f};
        asm volatile("" : "+v"(oacc[0]), "+v"(oacc[1]) :: "memory");
#pragma unroll
        for (int gi = 0; gi < 4; ++gi) {
            const int cu = gi & 1, nx = cu ^ 1;
            if (gi < 3) {
#pragma unroll
                for (int j = 0; j < 2; ++j) { const int i = 2 * (gi + 1) + j; U[nx][4 * j] = *(const LAS f32x4*)(W + 4 * i); U[nx][4 * j + 1] = *(const LAS f32x4*)(W + 64 + 4 * i);
                    U[nx][4 * j + 2] = *(const LAS f32x4*)(W + 128 + 4 * i); U[nx][4 * j + 3] = *(const LAS f32x4*)(W + 192 + 4 * i); }
            }
            if (gi >= 2) {
#pragma unroll
                for (int j = 0; j < 4; ++j) KK[4 * (gi - 2) + j] = *(const LAS f32x4*)(Wn + 256 + 4 * (4 * (gi - 2) + j));
            }
#pragma unroll
            for (int j = 0; j < 2; ++j) { const int i = 2 * gi + j; const f32x4 w4 = U[cu][4 * j], b4 = U[cu][4 * j + 1], km4 = U[cu][4 * j + 2], r4 = U[cu][4 * j + 3];
                f32x2 t0 = vv2 * (f32x2){km4[0], km4[1]}; t0 = sa2 * (f32x2){b4[0], b4[1]} + t0; S[2 * i] = S[2 * i] * (f32x2){w4[0], w4[1]} + t0;
                f32x2 t1 = vv2 * (f32x2){km4[2], km4[3]}; t1 = sa2 * (f32x2){b4[2], b4[3]} + t1; S[2 * i + 1] = S[2 * i + 1] * (f32x2){w4[2], w4[3]} + t1;
                oacc[(2 * i) & 3] += S[2 * i] * (f32x2){r4[0], r4[1]}; oacc[(2 * i + 1) & 3] += S[2 * i + 1] * (f32x2){r4[2], r4[3]}; }
            asm volatile("" : "+v"(oacc[0]), "+v"(oacc[1]), "+v"(oacc[2]), "+v"(oacc[3]) :: "memory");
        }
        vv = buf[(st < 15 ? st + 1 : st) * RW_STEP + 320 + rowi];
        const f32x2 o2 = (oacc[0] + oacc[1]) + (oacc[2] + oacc[3]);
        const float ov = xhalf_sum(o2[0] + o2[1]);
        int row, ts, Ls; step_row(16 * c + st, g, b, row, ts, Ls);
        if (kh == 0 && (!dry || ov == 1.2345e37f)) LOf[(size_t)row * (LOLD / 2) + (g * 6 + h) * 64 + rowi] = ov;
    }
}
struct GlRaw { u32x4 q, k, v[2], dn[2]; f32x4 rt[2]; };
DI void gla_load(const Params& p, int item, int c, GlRaw& R, int lane) {
    const int g = item & 1, h = (item >> 1) % 6, b = item / 12;
    const int ti = lane >> 2, cg = lane & 3;
    int row, ts, Ls; step_row(16 * c + ti, g, b, row, ts, Ls);
    const bf16_t* pr = (const bf16_t*)(p.ws + WS_PB) + (size_t)row * PLD;
    R.q = *(const u32x4*)(pr + C_GQ + h * 32 + 8 * cg); R.k = *(const u32x4*)(pr + C_GK + h * 32 + 8 * cg);
    R.v[0] = *(const u32x4*)(pr + C_GV + h * 64 + 16 * cg); R.v[1] = *(const u32x4*)(pr + C_GV + h * 64 + 16 * cg + 8);
    R.dn[0] = *(const u32x4*)(pr + C_GDN + 16 * g); R.dn[1] = *(const u32x4*)(pr + C_GDN + 16 * g + 8);
    const float* rt = (const float*)(p.ws + WS_ROPE) + (size_t)((Ls == SL ? ts : 0) * 16 + 4 * cg) * 2;
    R.rt[0] = *(const f32x4*)rt; R.rt[1] = *(const f32x4*)(rt + 4);
}
DI void gla_compute(const Params& p, int item, int c, const GlRaw& R, LAS float* buf, const LAS float* GU, int lane) {
    const int g = item & 1, b = item / 12;
    const int ti = lane >> 2, cg = lane & 3;
    int row, ts, Ls; step_row(16 * c + ti, g, b, row, ts, Ls);
    float q[8], k[8], v[16], dn[16];
    cvt8(R.q, q); cvt8(R.k, k); cvt8(R.v[0], &v[0]); cvt8(R.v[1], &v[8]); cvt8(R.dn[0], &dn[0]); cvt8(R.dn[1], &dn[8]);
    float al[8];
    {
        f32x4 z0 = *(const LAS f32x4*)(GU + 512 + 8 * cg), z1 = *(const LAS f32x4*)(GU + 512 + 8 * cg + 4);
#pragma unroll
        for (int rr = 0; rr < 16; ++rr) {
            if ((rr & 3) == 0) asm volatile("" : "+v"(z0), "+v"(z1) :: "memory");
            const f32x4 g0 = *(const LAS f32x4*)(GU + rr * 32 + 8 * cg), g1 = *(const LAS f32x4*)(GU + rr * 32 + 8 * cg + 4);
            z0 = z0 + g0 * dn[rr]; z1 = z1 + g1 * dn[rr]; }
#pragma unroll
        for (int j = 0; j < 8; ++j) { const float z = j < 4 ? z0[j & 3] : z1[j & 3];
            const float ls = fminf(z, 0.f) - __logf(1.f + __expf(-fabsf(z)));
            al[j] = __expf(ls * 0.0625f); }
    }
    if (Ls == SL) {
#pragma unroll
        for (int jj = 0; jj < 4; ++jj) { const float cc = R.rt[jj >> 1][2 * (jj & 1)], sn = R.rt[jj >> 1][2 * (jj & 1) + 1];
            const float q1 = q[2 * jj], q2 = q[2 * jj + 1]; q[2 * jj] = q1 * cc - q2 * sn; q[2 * jj + 1] = q1 * sn + q2 * cc;
            const float k1 = k[2 * jj], k2 = k[2 * jj + 1]; k[2 * jj] = k1 * cc - k2 * sn; k[2 * jj + 1] = k1 * sn + k2 * cc; }
    }
    LAS float* o = buf + ti * GL_STEP;
#pragma unroll
    for (int j4 = 0; j4 < 2; ++j4) {
        *(LAS f32x4*)(o + 8 * cg + 4 * j4) = (f32x4){al[4 * j4], al[4 * j4 + 1], al[4 * j4 + 2], al[4 * j4 + 3]};
        *(LAS f32x4*)(o + 32 + 8 * cg + 4 * j4) = (f32x4){k[4 * j4], k[4 * j4 + 1], k[4 * j4 + 2], k[4 * j4 + 3]};
        *(LAS f32x4*)(o + 64 + 8 * cg + 4 * j4) = (f32x4){q[4 * j4], q[4 * j4 + 1], q[4 * j4 + 2], q[4 * j4 + 3]} * 0.17677669529663687f; }
#pragma unroll
    for (int j4 = 0; j4 < 4; ++j4) *(LAS f32x4*)(o + 96 + 16 * cg + 4 * j4) = (f32x4){v[4 * j4], v[4 * j4 + 1], v[4 * j4 + 2], v[4 * j4 + 3]};
}
DI void gla_scan_chunk(const Params& p, int item, int c, const LAS float* buf, f32x2 (&S)[16], int lane, bool dry = false) {
    const int g = item & 1, h = (item >> 1) % 6, b = item / 12;
    bf16_t* AY = (bf16_t*)(p.ws + WS_AY);
    f32x4 U[2][12];
#pragma unroll
    for (int j = 0; j < 4; ++j) { U[0][3 * j] = ((const LAS f32x4*)buf)[j]; U[0][3 * j + 1] = ((const LAS f32x4*)buf)[8 + j]; U[0][3 * j + 2] = ((const LAS f32x4*)buf)[16 + j]; }
    float vv = buf[96 + lane];
    for (int st = 0; st < 16; ++st) {
        const LAS f32x4* W = (const LAS f32x4*)(buf + st * GL_STEP);
        const LAS float* bn = buf + (st < 15 ? st + 1 : st) * GL_STEP;
        const LAS f32x4* Wn = (const LAS f32x4*)bn;
        const f32x2 vv2 = (f32x2){vv, vv};
        f32x2 oacc[4];
#pragma unroll
        for (int i = 0; i < 4; ++i) oacc[i] = (f32x2){0.f, 0.f};
#pragma unroll
        for (int gi = 0; gi < 2; ++gi) {
            const int cu = gi, nx = gi ^ 1;
#pragma unroll
            for (int j = 0; j < 4; ++j) { const LAS f32x4* Wx = gi == 0 ? W : Wn; const int i = gi == 0 ? 4 + j : j;
                U[nx][3 * j] = Wx[i]; U[nx][3 * j + 1] = Wx[8 + i]; U[nx][3 * j + 2] = Wx[16 + i]; }
            if (gi == 1) vv = bn[96 + lane];
#pragma unroll
            for (int j = 0; j < 4; ++j) { const int i = 4 * gi + j; const f32x4 a4 = U[cu][3 * j], k4 = U[cu][3 * j + 1], q4 = U[cu][3 * j + 2];
                S[2 * i] = S[2 * i] * (f32x2){a4[0], a4[1]} + vv2 * (f32x2){k4[0], k4[1]}; S[2 * i + 1] = S[2 * i + 1] * (f32x2){a4[2], a4[3]} + vv2 * (f32x2){k4[2], k4[3]};
                oacc[(2 * i) & 3] += S[2 * i] * (f32x2){q4[0], q4[1]}; oacc[(2 * i + 1) & 3] += S[2 * i + 1] * (f32x2){q4[2], q4[3]}; }
            asm volatile("" : "+v"(oacc[0]), "+v"(oacc[1]), "+v"(oacc[2]), "+v"(oacc[3]) :: "memory");
        }
        const f32x2 o2 = (oacc[0] + oacc[1]) + (oacc[2] + oacc[3]);
        int row, ts, Ls; step_row(16 * c + st, g, b, row, ts, Ls);
        { const float ov = o2[0] + o2[1]; if (!dry || ov == 1.2345e37f) AY[(size_t)row * D + g * 384 + h * 64 + lane] = f2bf(ov); }
    }
}
DI void scan_unit_rw(const Params& p, int l, int su, LAS unsigned char* lds, int tid, int lane, int wave, bool dry) {
    LAS float* RWB = (LAS float*)lds; LAS float* CSB = (LAS float*)(lds + 143616);
    __syncthreads();
    for (int i = tid; i < 2 * 384; i += NTHR) { const int sl = i / 384, r = i % 384, a = r >> 6, ch = r & 63; const int it = 2 * su + sl, hh = (it >> 1) % 6;
        float v;
        if (a < 3) v = pin(p, I_MU)[(size_t)l * 1536 + a * 384 + hh * 64 + ch];
        else v = (a == 3 ? pin(p, I_KK) : (a == 4 ? pin(p, I_KA) : pin(p, I_RK)))[(size_t)l * 384 + hh * 64 + ch];
        CSB[i] = v; }
    __syncthreads();
    if (wave < 4) {
        asm volatile("" : "+v"(lane));
        const int slot = wave >> 1, hf = wave & 1, item = 2 * su + slot;
        f32x2 S[16];
#pragma unroll
        for (int i = 0; i < 16; ++i) S[i] = (f32x2){0.f, 0.f};
        __syncthreads();
        for (int c = 0; c < NCHUNK; ++c) { rwkv_scan_chunk(p, item, c, RWB + (slot * 2 + (c & 1)) * RW_BUF, S, lane, hf, dry); __syncthreads(); }
    } else if (wave < 6) {
        asm volatile("" : "+v"(lane));
        const int slot = wave & 1, item = 2 * su + slot;
        RwRaw R; rwkv_load(p, item, 0, R, lane);
        rwkv_compute(p, item, 0, R, RWB + (slot * 2 + 0) * RW_BUF, CSB + slot * 384, lane);
        rwkv_load(p, item, 1, R, lane);
        __syncthreads();
        for (int c = 0; c < NCHUNK; ++c) {
            if (c + 1 < NCHUNK) { rwkv_compute(p, item, c + 1, R, RWB + (slot * 2 + ((c + 1) & 1)) * RW_BUF, CSB + slot * 384, lane); if (c + 2 < NCHUNK) rwkv_load(p, item, c + 2, R, lane); }
            __syncthreads(); }
    } else {
        __syncthreads();
        for (int c = 0; c < NCHUNK; ++c) __syncthreads();
    }
}
DI void scan_unit_gl(const Params& p, int l, int gu, LAS unsigned char* lds, int tid, int lane, int wave, bool dry) {
    LAS float* GLB = (LAS float*)lds; LAS float* GUB = (LAS float*)(lds + 122880);
    __syncthreads();
    for (int i = tid; i < 6 * 544; i += NTHR) { const int sl = i / 544, r = i % 544; const int it = 6 * gu + sl, gg = it & 1, hh = (it >> 1) % 6;
        GUB[i] = r < 512 ? pin(p, I_GUP)[((size_t)(l * 2 + gg) * 16 + (r >> 5)) * 192 + hh * 32 + (r & 31)] : pin(p, I_GB)[(size_t)(l * 2 + gg) * 192 + hh * 32 + (r - 512)]; }
    __syncthreads();
    if (wave < 6) {
        asm volatile("" : "+v"(lane));
        const int item = 6 * gu + wave;
        f32x2 Sg[16];
#pragma unroll
        for (int i = 0; i < 16; ++i) Sg[i] = (f32x2){0.f, 0.f};
        __syncthreads();
        for (int c = 0; c < NCHUNK; ++c) { gla_scan_chunk(p, item, c, GLB + (wave * 2 + (c & 1)) * GL_BUF, Sg, lane, dry); __syncthreads(); }
    } else {
        asm volatile("" : "+v"(lane));
        const int s0 = (wave - 6) * 3;
        GlRaw R0, R1, R2;
        gla_load(p, 6 * gu + s0, 0, R0, lane); gla_load(p, 6 * gu + s0 + 1, 0, R1, lane); gla_load(p, 6 * gu + s0 + 2, 0, R2, lane);
        gla_compute(p, 6 * gu + s0, 0, R0, GLB + ((s0) * 2) * GL_BUF, GUB + (s0) * 544, lane);
        gla_compute(p, 6 * gu + s0 + 1, 0, R1, GLB + ((s0 + 1) * 2) * GL_BUF, GUB + (s0 + 1) * 544, lane);
        gla_compute(p, 6 * gu + s0 + 2, 0, R2, GLB + ((s0 + 2) * 2) * GL_BUF, GUB + (s0 + 2) * 544, lane);
        gla_load(p, 6 * gu + s0, 1, R0, lane); gla_load(p, 6 * gu + s0 + 1, 1, R1, lane); gla_load(p, 6 * gu + s0 + 2, 1, R2, lane);
        __syncthreads();
        for (int c = 0; c < NCHUNK; ++c) {
            if (c + 1 < NCHUNK) { const int nb = (c + 1) & 1;
                gla_compute(p, 6 * gu + s0, c + 1, R0, GLB + ((s0) * 2 + nb) * GL_BUF, GUB + (s0) * 544, lane);
                gla_compute(p, 6 * gu + s0 + 1, c + 1, R1, GLB + ((s0 + 1) * 2 + nb) * GL_BUF, GUB + (s0 + 1) * 544, lane);
                gla_compute(p, 6 * gu + s0 + 2, c + 1, R2, GLB + ((s0 + 2) * 2 + nb) * GL_BUF, GUB + (s0 + 2) * 544, lane);
                if (c + 2 < NCHUNK) { gla_load(p, 6 * gu + s0, c + 2, R0, lane); gla_load(p, 6 * gu + s0 + 1, c + 2, R1, lane); gla_load(p, 6 * gu + s0 + 2, c + 2, R2, lane); } }
            __syncthreads(); }
    }
}
DI void phase_mixers(const Params& p, int l, LAS unsigned char* lds, int tid, int lane, int wave, bool dry = false, int which = 3) {
    const int G = gridDim.x, bx = blockIdx.x;
    if (which & 1) for (int u = bx; u < 256; u += G) { if (u < 192) scan_unit_rw(p, l, u, lds, tid, lane, wave, dry); else scan_unit_gl(p, l, u - 192, lds, tid, lane, wave, dry); }
    const int nnat = NB * 4 * 32 * 4, nnatc = l == 0 ? NB * 4 * 16 : 0;
    if (which & 2) {
        const int ntot = nnat + nnatc;
        int n1 = 0;
        if (G == 256 && NAT_GLA_PCT > 0) {
            n1 = (ntot * NAT_GLA_PCT / 100) & ~7;
            if (bx >= 192) for (int id = (bx - 192) * NWAVE + wave; id < n1; id += 64 * NWAVE) { if (id < nnat) nat_unit(p, l, id, false, lane); else nat_unit(p, l, id - nnat, true, lane); }
        }
        int nwv = G * NWAVE, w0v = bx * NWAVE + wave;
        if (G == 256 && NAT_GLA_PCT < 0) { nwv = 192 * NWAVE; if (bx >= 192) w0v = ntot; }
        for (int id = n1 + w0v; id < ntot; id += nwv) { if (id < nnat) nat_unit(p, l, id, false, lane); else nat_unit(p, l, id - nnat, true, lane); }
    }
}

DI void phase_readout(const Params& p, int l, int nrows, int lane, int wave) {
    const int gw = blockIdx.x * NWAVE + wave, NGW = gridDim.x * NWAVE;
    const bf16_t* PB = (const bf16_t*)(p.ws + WS_PB); bf16_t* AY = (bf16_t*)(p.ws + WS_AY);
    const float* LOf = (const float*)(p.ws + WS_LO); const bf16_t* LOb = (const bf16_t*)(p.ws + WS_LO); const float* BON = (const float*)(p.ws + WS_BON);
    const bool act = lane < 48; const int c8 = act ? 8 * lane : 0, h = c8 >> 6;
    float nw[8], gnw[8], gnb[8], mu[8];
    { const float* a = pin(p, I_GNW) + l * 64 + (c8 & 63); const float* b = pin(p, I_GNWT) + l * 384 + c8; const float* c = pin(p, I_GNB) + l * 384 + c8; const float* d = pin(p, I_MU) + (size_t)l * 1536 + 768 + c8;
#pragma unroll
      for (int j = 0; j < 8; ++j) { nw[j] = a[j]; gnw[j] = b[j]; gnb[j] = c[j]; mu[j] = d[j]; } }
    for (int row = gw; row < nrows; row += NGW) {
        const bool lat = row < ML; const int t = lat ? (row & (SL - 1)) : ((row - ML) & (CL - 1)); const int Ls = lat ? SL : CL;
        const bf16_t* pr = PB + (size_t)row * PLD; bf16_t* yr = AY + (size_t)row * D;
        const u32x4 r_of = *(const u32x4*)(yr + c8), r_ob = *(const u32x4*)(yr + 384 + c8), r_gg = *(const u32x4*)(pr + C_GG + c8);
        const u32x4 r_nat = *(const u32x4*)(yr + 768 + 8 * (lane & 31));
        const float* lf = LOf + (size_t)row * (LOLD / 2) + c8;
        const f32x4 f0 = *(const f32x4*)lf, f1 = *(const f32x4*)(lf + 4), b0 = *(const f32x4*)(lf + 384), b1 = *(const f32x4*)(lf + 388);
        const bf16_t* pv = pr + C_RW + 768 + c8;
        const u32x4 r_v0 = *(const u32x4*)pv, r_vm = *(const u32x4*)(t > 0 ? pv - PLD : pv), r_vp = *(const u32x4*)(t < Ls - 1 ? pv + PLD : pv);
        const u32x4 r_gt = *(const u32x4*)(LOb + (size_t)row * LOLD + 1536 + c8);
        const float bon = BON[(size_t)row * 12 + h] + BON[(size_t)row * 12 + 6 + h];
        const float mm = t > 0 ? 0.5f : 0.f, mp = t < Ls - 1 ? 0.5f : 0.f;
        float of[8], ob[8], gg[8], v0[8], vm[8], vp[8], gt[8];
        cvt8(r_of, of); cvt8(r_ob, ob); cvt8(r_gg, gg); cvt8(r_v0, v0); cvt8(r_vm, vm); cvt8(r_vp, vp); cvt8(r_gt, gt);
        float og[8], orw[8]; float ss = 0.f, sm = 0.f;
#pragma unroll
        for (int j = 0; j < 8; ++j) { og[j] = of[j] + ob[j]; ss += og[j] * og[j]; orw[j] = (j < 4 ? f0[j & 3] : f1[j & 3]) + (j < 4 ? b0[j & 3] : b1[j & 3]); sm += orw[j]; }
        ss = sum8(ss); sm = sum8(sm);
        const float mean = sm * (1.f / 64.f); float sq = 0.f;
#pragma unroll
        for (int j = 0; j < 8; ++j) { orw[j] -= mean; sq += orw[j] * orw[j]; }
        sq = sum8(sq);
        float e1 = 1e-5f, e2 = 64e-5f; asm volatile("" : "+v"(e1), "+v"(e2));
        const float rg = rsqrtf(ss * (1.f / 64.f) + e1), rn = rsqrtf(sq * (1.f / 64.f) + e2);
        float yg[8], yw[8];
#pragma unroll
        for (int j = 0; j < 8; ++j) { yg[j] = og[j] * rg * nw[j] * (gg[j] * sigm(gg[j]));
            const float vs = v0[j] + ((mm * vm[j] + mp * vp[j]) - v0[j]) * mu[j];
            yw[j] = (orw[j] * rn * gnw[j] + gnb[j] + bon * vs) * gt[j]; }
        asm volatile("s_waitcnt vmcnt(0)" ::: "memory");
        if (act) { u32x4 o; o.x = cvtpk(yg[0], yg[1]); o.y = cvtpk(yg[2], yg[3]); o.z = cvtpk(yg[4], yg[5]); o.w = cvtpk(yg[6], yg[7]); *(u32x4*)(yr + c8) = o;
            u32x4 w; w.x = cvtpk(yw[0], yw[1]); w.y = cvtpk(yw[2], yw[3]); w.z = cvtpk(yw[4], yw[5]); w.w = cvtpk(yw[6], yw[7]); *(u32x4*)(yr + 640 + c8) = w; }
        if (lane < 32) *(u32x4*)(yr + 384 + 8 * lane) = r_nat;
    }
}

DI void grid_sync_probe() { cg::this_grid().sync(); }
DI void run_step(const Params& p, const int step, LAS unsigned char* lds, int tid, int lane, int wave) {
    const int G = gridDim.x, bx = blockIdx.x;
    unsigned char* ws = p.ws;
    const float* MOD = (const float*)(ws + WS_MOD);
    float* TC = (float*)(ws + WS_VT);
    {
        const int l = step < 2 ? 0 : (step - 2) / 10, st = step < 2 ? -1 : (step - 2) % 10;
        unsigned char* wl = ws + (size_t)l * WLB;
        const float* modl = MOD + (size_t)l * 33 * 6144;
        const int Mff = l == 0 ? MT : ML;
        if (st == 0 || st == 2 || st == 5 || st == 7 || st == 8) {
            const bf16_t* gA = (const bf16_t*)(ws + WS_AY); const bf16_t* gB; int gM = Mff, gN = 1024, gK = 1024, mode = 2;
            bf16_t* eO = (bf16_t*)(ws + WS_PB); const float* ex = (const float*)p.out; const float* exc = (const float*)TC; int gofs = 2 * 1024;
            if (st == 0) { gB = (const bf16_t*)(wl + OFF_WIN); gM = MT; gN = PLD; mode = 0; }
            else if (st == 2) { gB = (const bf16_t*)(wl + OFF_BT2); gM = MT; gN = 2048; gK = 384; mode = 1; eO = (bf16_t*)(ws + WS_LO); }
            else if (st == 5) { gB = (const bf16_t*)(wl + OFF_WOUT); if (l == 0) { ex = pin(p, I_X); exc = pin(p, I_CTX); } }
            else if (st == 7) { gB = (const bf16_t*)(wl + OFF_W13); gN = 2 * FH; mode = 3; }
            else { gA = (const bf16_t*)(ws + WS_PB); gB = (const bf16_t*)(wl + OFF_W2); gK = FH; gofs = 5 * 1024; }
            asm volatile("" : "+s"(gK), "+s"(gM), "+s"(gN), "+s"(mode), "+s"(gofs));
            asm volatile("" : "+s"(gA), "+s"(gB), "+s"(eO), "+s"(ex), "+s"(exc));
            const pg8::Gemm g{gA, gB, gM, gN, gK};
            const pg8::EpiAny E{mode, pg8::EpiStoreBf16{eO, PLD}, pg8::EpiLora{eO, pin(p, I_W0) + (size_t)l * 768, pin(p, I_A0) + (size_t)l * 768},
                                pg8::EpiRes{ex, exc, p.out, TC, modl, gofs}, pg8::EpiSwiglu{eO}};
            pg8::StaticOrder S; S.init(g.M, g.N, G, bx);
#if defined(PROBE_GEMM)
            int nrep = (st == 0 || st == 2 || st == 7) ? 2 : 1; asm volatile("" : "+s"(nrep));
#pragma unroll 1
            for (int rep = 0; rep < nrep; ++rep) { pg8::gemm_phase<pg8::EpiAny, pg8::StaticOrder, true, true>(lds, g, S, E, tid); __syncthreads(); }
#else
            pg8::gemm_phase<pg8::EpiAny, pg8::StaticOrder, true, true>(lds, g, S, E, tid);
#endif
        }
#ifndef ONLYGEMM
        else if (step == 0) phase_prologue(p, lds, tid, lane, wave);
        else if (step == 1) phase_modulate0(p, lane, wave);
        else if (st == 1) phase_prep(p, l, lds, lane, wave);
#if defined(PROBE_MIX)
        else if (st == 3) { int nrep = 2; asm volatile("" : "+s"(nrep));
#pragma unroll 1
            for (int rep = 0; rep < nrep; ++rep) { phase_mixers(p, l, lds, tid, lane, wave, rep + 1 < nrep, rep + 1 < nrep ? PROBE_MIX : 3); __syncthreads(); grid_sync_probe(); } }
#else
        else if (st == 3) phase_mixers(p, l, lds, tid, lane, wave);
#endif
        else if (st == 4) phase_readout(p, l, Mff, lane, wave);
        else if (st == 6) phase_ln(p, lane, wave, Mff, pin(p, I_LN1W) + l * 1024, pin(p, I_LN1B) + l * 1024, modl, 3 * 1024, 4 * 1024, true, true);
        else {
            if (l == 0) phase_ln(p, lane, wave, MT, pin(p, I_LN2W), pin(p, I_LN2B), MOD + (size_t)33 * 6144, 0, 1024, true, true);
            else phase_ln(p, lane, wave, ML, pin(p, I_LN2W) + 1024, pin(p, I_LN2B) + 1024, modl, 0, 1024, true, false);
        }
#endif
    }
}
#ifdef MULTI_LAUNCH
template <int STEP> __global__ void __launch_bounds__(NTHR, 2) k_step(Params p) {
    extern __shared__ __attribute__((aligned(16))) unsigned char smem[];
    const int tid = threadIdx.x, lane = tid & 63, wave = __builtin_amdgcn_readfirstlane(tid >> 6);
    run_step(p, STEP, (LAS unsigned char*)smem, tid, lane, wave);
}
template <int STEP> static void launch_steps(const Params& p, int grid, hipStream_t stream) {
    static bool attr_done = false;
    if (!attr_done) { (void)hipFuncSetAttribute((const void*)k_step<STEP>, hipFuncAttributeMaxDynamicSharedMemorySize, LDS_BYTES); attr_done = true; }
    hipLaunchKernelGGL(k_step<STEP>, dim3(grid), dim3(NTHR), LDS_BYTES, stream, p);
    if constexpr (STEP + 1 < 22) launch_steps<STEP + 1>(p, grid, stream);
}
#else
__global__ void __launch_bounds__(NTHR, 2) hybrid_fwd(Params p) {
    extern __shared__ __attribute__((aligned(16))) unsigned char smem[];
    LAS unsigned char* lds = (LAS unsigned char*)smem;
    cg::grid_group grid = cg::this_grid();
    const int wave0 = __builtin_amdgcn_readfirstlane((int)threadIdx.x >> 6);
#if defined(PROBE_REPEAT)
    bool repeated = false;
#endif
#pragma unroll 1
    for (int step = 0; step < 22; ++step) {
        unsigned msk = ~0u; int wave_ = wave0;
        asm volatile("" : "+s"(msk), "+s"(wave_));
        const int lane_ = (int)__builtin_amdgcn_mbcnt_hi(msk, __builtin_amdgcn_mbcnt_lo(msk, 0u));
        const int tid_ = wave_ * 64 + lane_;
        run_step(p, step, lds, tid_, lane_, wave_);
        if (step != 21) grid.sync();
#if defined(PROBE_REPEAT)
        { const int st_ = step < 2 ? -1 : (step - 2) % 10; const bool rep_ok = ((PROBE_REPEAT & 1) && (st_ == 0 || st_ == 2 || st_ == 7)) || ((PROBE_REPEAT & 2) && st_ == 1) || ((PROBE_REPEAT & 4) && step == 0) || ((PROBE_REPEAT & 8) && step == 1);
          if (rep_ok && !repeated) { repeated = true; --step; } else repeated = false; }
#endif
    }
}
#endif

extern "C" void kernel_launch(void* const* d_in, const int* in_sizes, int n_in, void* d_out, int out_size, void* d_ws, size_t ws_size, hipStream_t stream) {
    static int grid = 0;
    if (grid == 0) {
        int dev = 0, cus = 0, per_cu = 0;
        if (n_in != 29 || ws_size < WS_END) { fprintf(stderr, "kernel_launch: unexpected n_in %d / ws_size %zu (need %zu)\n", n_in, ws_size, (size_t)WS_END); }
        hipGetDevice(&dev);
        hipDeviceGetAttribute(&cus, hipDeviceAttributeMultiprocessorCount, dev);
#ifndef MULTI_LAUNCH
        if (hipFuncSetAttribute((const void*)hybrid_fwd, hipFuncAttributeMaxDynamicSharedMemorySize, LDS_BYTES) != hipSuccess) fprintf(stderr, "kernel_launch: hipFuncSetAttribute failed\n");
        if (hipOccupancyMaxActiveBlocksPerMultiprocessor(&per_cu, (const void*)hybrid_fwd, NTHR, LDS_BYTES) != hipSuccess || per_cu < 1) { fprintf(stderr, "kernel_launch: occupancy query gave %d\n", per_cu); per_cu = 1; }
#endif
        (void)hipGetLastError();
        grid = cus > 0 ? cus : 256;
    }
    Params p{};
    for (int i = 0; i < 29; ++i) p.in[i] = (const float*)d_in[i];
    p.out = (float*)d_out; p.ws = (unsigned char*)d_ws;
#ifdef MULTI_LAUNCH
    launch_steps<0>(p, grid, stream);
#else
    void* args[] = {&p};
    hipError_t e = hipLaunchCooperativeKernel((const void*)hybrid_fwd, dim3(grid), dim3(NTHR), args, LDS_BYTES, stream);
    if (e != hipSuccess) fprintf(stderr, "kernel_launch: cooperative launch failed: %s (grid %d)\n", hipGetErrorString(e), grid);
#endif
}
```

```cpp
#include <hip/hip_runtime.h>
#include <hip/hip_cooperative_groups.h>
#include <cstdio>
#include <cstdint>
namespace cg = cooperative_groups;
namespace pg8 {
#define PG8_LAS __attribute__((address_space(3)))
typedef unsigned short bf16_t;
typedef short bf16x8 __attribute__((ext_vector_type(8)));
typedef float f32x4 __attribute__((ext_vector_type(4)));
typedef unsigned u32x4 __attribute__((ext_vector_type(4)));
constexpr int BM = 256, BK = 64, HALF = 128, HTB = HALF * BK * 2  , STAGE_BYTES = 8 * HTB, NXCD = 8, WGM = 8;

__host__ __device__ __forceinline__ int lds_byte(int r, int c) { const int st = (r >> 4) * 2 + (c >> 5), rr = r & 15, cc = c & 31, ob = rr * 64 + cc * 2; return st * 1024 + (ob ^ (((ob >> 9) & 1) << 5)); }
__host__ __device__ __forceinline__ void stage_rc(int b, int& R, int& C) { const int st = b / 1024, sb = b % 1024, swz = sb ^ (((sb >> 9) & 1) << 5); R = (st >> 1) * 16 + swz / 64; C = (st & 1) * 32 + (swz % 64) / 2; }
__host__ __device__ __forceinline__ int perm32(int rho) { const int n = rho >> 4, i = rho & 15; return 8 * (i >> 2) + 4 * n + (i & 3); }

struct Unit { int pm, pn; };
struct Gemm { const bf16_t* A; const bf16_t* Bt; int M, N, K; };

struct StaticOrder {
    int nM, nN, nwg, G, c;
    __host__ __device__ void init(int M, int N, int G_, int c_) { nM = M / BM; nN = N / BM; nwg = nM * nN; G = G_; c = c_; }
    __host__ __device__ bool next(int i, Unit& u) const {
        const long L = (long)i * G + c; if (L >= nwg) return false;
        int wgid = (int)L; { const int q = nwg / NXCD, r = nwg % NXCD, xcd = wgid % NXCD, off = wgid / NXCD; wgid = (xcd < r ? xcd * (q + 1) : r * (q + 1) + (xcd - r) * q) + off; }
        const int nig = WGM * nN, gid = wgid / nig, fm = gid * WGM, gsz = (nM - fm) < WGM ? (nM - fm) : WGM;
        u.pm = fm + ((wgid % nig) % gsz); u.pn = (wgid % nig) / gsz; return true;
    }
    __device__ __forceinline__ void a_ready(const Unit&) const {}
    __device__ __forceinline__ void done(const Unit&) const {}
};
__device__ __forceinline__ unsigned cvtpk(float lo, float hi) { typedef float v2f __attribute__((ext_vector_type(2))); typedef __bf16 v2b __attribute__((ext_vector_type(2))); v2f v = {lo, hi}; v2b b = __builtin_convertvector(v, v2b); return __builtin_bit_cast(unsigned, b); }
__device__ __forceinline__ float sigm(float x) { return 1.0f / (1.0f + __expf(-x)); }
struct EpiStoreBf16 {
    static constexpr bool PERM = true, AFTER_DRAIN = false;
    bf16_t* O; int ldc;
    __device__ __forceinline__ void operator()(const f32x4 (&acc)[2][2][4][2], const Unit& u, int wr, int wc, int fr, int fq) const {
        const int row0 = u.pm * BM + wr * 64 + fr, col0 = u.pn * BM + wc * 32 + 8 * fq;
#pragma unroll
        for (int ai = 0; ai < 2; ++ai)
#pragma unroll
            for (int m = 0; m < 4; ++m) { bf16_t* rowp = O + (size_t)(row0 + ai * HALF + m * 16) * ldc + col0;
#pragma unroll
                for (int bj = 0; bj < 2; ++bj) { const f32x4 v0 = acc[ai][bj][m][0], v1 = acc[ai][bj][m][1];
                    u32x4 w; w.x = cvtpk(v0[0], v0[1]); w.y = cvtpk(v0[2], v0[3]); w.z = cvtpk(v1[0], v1[1]); w.w = cvtpk(v1[2], v1[3]);
                    *(u32x4*)(rowp + bj * HALF) = w; } }
    }
};
struct EpiLora {
    static constexpr bool PERM = true, AFTER_DRAIN = false;
    bf16_t* O; const float* w0; const float* a0;
    __device__ __forceinline__ void operator()(const f32x4 (&acc)[2][2][4][2], const Unit& u, int wr, int wc, int fr, int fq) const {
        const int row0 = u.pm * BM + wr * 64 + fr;
#pragma unroll
        for (int bj = 0; bj < 2; ++bj) {
            const int cb = u.pn * 2 + bj;
            if (cb < 15) {
                const int c0 = cb * 128 + wc * 32 + 8 * fq;
                if (cb >= 12) {
#pragma unroll
                    for (int ai = 0; ai < 2; ++ai)
#pragma unroll
                        for (int m = 0; m < 4; ++m) { const f32x4 v0 = acc[ai][bj][m][0], v1 = acc[ai][bj][m][1];
                            u32x4 w; w.x = cvtpk(v0[0], v0[1]); w.y = cvtpk(v0[2], v0[3]); w.z = cvtpk(v1[0], v1[1]); w.w = cvtpk(v1[2], v1[3]);
                            *(u32x4*)(O + (size_t)(row0 + ai * HALF + m * 16) * 1920 + c0) = w; }
                } else {
                    const int kind = wc >> 1, g = cb / 6, h = cb % 6;
                    const float* a0v = a0; const float* w0v = w0; asm volatile("" : "+s"(a0v), "+s"(w0v));
                    const float* bp = (kind ? a0v : w0v) + g * 384 + h * 64 + (wc & 1) * 32 + 8 * fq;
                    const f32x4 b0 = *(const f32x4*)bp, b1 = *(const f32x4*)(bp + 4);
                    const float mul = kind == 0 ? 0.60653065971263342f : 1.f;
#pragma unroll
                    for (int ai = 0; ai < 2; ++ai)
#pragma unroll
                        for (int m = 0; m < 4; ++m) { const f32x4 v0 = acc[ai][bj][m][0] + b0, v1 = acc[ai][bj][m][1] + b1;
                            u32x4 w; w.x = cvtpk(mul * sigm(v0[0]), mul * sigm(v0[1])); w.y = cvtpk(mul * sigm(v0[2]), mul * sigm(v0[3]));
                            w.z = cvtpk(mul * sigm(v1[0]), mul * sigm(v1[1])); w.w = cvtpk(mul * sigm(v1[2]), mul * sigm(v1[3]));
                            *(u32x4*)(O + (size_t)(row0 + ai * HALF + m * 16) * 1920 + c0) = w; }
                }
            }
        }
    }
};
struct EpiRes {
    static constexpr bool PERM = true, AFTER_DRAIN = false;
    const float* xl; const float* xc; float* ol; float* oc; const float* mod; int gofs;
    __device__ __forceinline__ void operator()(const f32x4 (&acc)[2][2][4][2], const Unit& u, int wr, int wc, int fr, int fq) const {
        const bool lat = u.pm < 256; const int bi = lat ? (u.pm >> 3) : 32;
        const size_t rbase = (size_t)(lat ? u.pm : u.pm - 256) * BM;
        const float* xlv = xl; const float* xcv = xc; float* olv = ol; float* ocv = oc; asm volatile("" : "+s"(xlv), "+s"(xcv), "+s"(olv), "+s"(ocv));
        const float* xin = (lat ? xlv : xcv) + rbase * 1024; float* out = (lat ? olv : ocv) + rbase * 1024;
        const float* gp = mod + (size_t)bi * 6144 + gofs;
        const int col0 = u.pn * BM + wc * 32 + 8 * fq, row0 = wr * 64 + fr;
#pragma unroll
        for (int bj = 0; bj < 2; ++bj)
#pragma unroll
            for (int n = 0; n < 2; ++n) { const int c = col0 + bj * HALF + 4 * n; const f32x4 gt = *(const f32x4*)(gp + c);
#pragma unroll
                for (int ai = 0; ai < 2; ++ai)
#pragma unroll
                    for (int m = 0; m < 4; ++m) { const size_t o = (size_t)(row0 + ai * HALF + m * 16) * 1024 + c;
                        const f32x4 xv = *(const f32x4*)(xin + o); const f32x4 a = acc[ai][bj][m][n];
                        f32x4 r; r[0] = 1.41421356237f * xv[0] + gt[0] * a[0]; r[1] = 1.41421356237f * xv[1] + gt[1] * a[1]; r[2] = 1.41421356237f * xv[2] + gt[2] * a[2]; r[3] = 1.41421356237f * xv[3] + gt[3] * a[3];
                        *(f32x4*)(out + o) = r; } }
    }
};
struct EpiSwiglu {
    static constexpr bool PERM = true, AFTER_DRAIN = false;
    bf16_t* O;
    __device__ __forceinline__ void operator()(const f32x4 (&acc)[2][2][4][2], const Unit& u, int wr, int wc, int fr, int fq) const {
        const int row0 = u.pm * BM + wr * 64 + fr, col0 = u.pn * HALF + wc * 32 + 8 * fq;
#pragma unroll
        for (int ai = 0; ai < 2; ++ai)
#pragma unroll
            for (int m = 0; m < 4; ++m) { float v[8];
#pragma unroll
                for (int i = 0; i < 8; ++i) { const float g = acc[ai][0][m][i >> 2][i & 3], up = acc[ai][1][m][i >> 2][i & 3]; v[i] = g * sigm(g) * up; }
                u32x4 w; w.x = cvtpk(v[0], v[1]); w.y = cvtpk(v[2], v[3]); w.z = cvtpk(v[4], v[5]); w.w = cvtpk(v[6], v[7]);
                *(u32x4*)(O + (size_t)(row0 + ai * HALF + m * 16) * 2816 + col0) = w; }
    }
};
struct EpiAny {
    static constexpr bool PERM = true, AFTER_DRAIN = false;
    int mode; EpiStoreBf16 e0; EpiLora e1; EpiRes e2; EpiSwiglu e3;
    __device__ __forceinline__ void operator()(const f32x4 (&acc)[2][2][4][2], const Unit& u, int wr, int wc, int fr, int fq) const {
        if (mode == 0) e0(acc, u, wr, wc, fr, fq); else if (mode == 1) e1(acc, u, wr, wc, fr, fq); else if (mode == 2) e2(acc, u, wr, wc, fr, fq); else e3(acc, u, wr, wc, fr, fq);
    }
};
template <class Epi, class Sched, bool ALIGN_EPI = false, bool SP2 = false>
__device__ __forceinline__ void gemm_phase(PG8_LAS unsigned char* lds, const Gemm g, const Sched& S, const Epi& E, const int tid) {
    const int wid = __builtin_amdgcn_readfirstlane(tid >> 6), lane = tid & 63, wr = wid >> 2, wc = wid & 3, fr = lane & 15, fq = lane >> 4;
    const int K = g.K, nt = K / BK;
    unsigned voffA[2], voffB[2];
#pragma unroll
    for (int i = 0; i < 2; ++i) { int R, C; stage_rc(tid * 16 + i * 8192, R, C); const int Rb = Epi::PERM ? ((R & ~31) + perm32(R & 31)) : R;
        voffA[i] = (unsigned)(R * K + C) * 2u; voffB[i] = (unsigned)(Rb * K + C) * 2u; }
    const size_t kstep = (size_t)(BK * 2);
    const size_t hstep = (size_t)HALF * K * 2;
    const size_t tstep = 2 * hstep;
    const unsigned ldsw = (unsigned)wid * 1024u;
    const int aoff = lds_byte(wr * 64 + fr, fq * 8), boff = lds_byte(wc * 32 + fr, fq * 8);
#define PG8_SA(b, h) (((b) * 2 + (h)) * HTB)
#define PG8_SB(b, h) ((4 + (b) * 2 + (h)) * HTB)
#define PG8_STAGE(bufoff, gbase, voff) do { _Pragma("unroll") for (int _i = 0; _i < 2; ++_i) \
        __builtin_amdgcn_global_load_lds((const unsigned*)((const char*)(gbase) + (voff)[_i]), (PG8_LAS unsigned*)(lds + (bufoff) + ldsw + _i * 8192), 16, 0, 0); } while (0)
#define PG8_LDA(dst, b, h) do { _Pragma("unroll") for (int m = 0; m < 4; ++m) _Pragma("unroll") for (int k = 0; k < 2; ++k) dst[m][k] = *(const PG8_LAS bf16x8*)(lds + PG8_SA(b, h) + aoff + m * 2048 + k * 1024); } while (0)
#define PG8_LDB(dst, b, h) do { _Pragma("unroll") for (int n = 0; n < 2; ++n) _Pragma("unroll") for (int k = 0; k < 2; ++k) dst[n][k] = *(const PG8_LAS bf16x8*)(lds + PG8_SB(b, h) + boff + n * 2048 + k * 1024); } while (0)
#define PG8_MMA(ai, bj, At, Bt) do { __builtin_amdgcn_s_setprio(1); _Pragma("unroll") for (int m = 0; m < 4; ++m) _Pragma("unroll") for (int n = 0; n < 2; ++n) _Pragma("unroll") for (int k = 0; k < 2; ++k) \
        acc[ai][bj][m][n] = __builtin_amdgcn_mfma_f32_16x16x32_bf16(Bt[n][k], At[m][k], acc[ai][bj][m][n], 0, 0, 0); __builtin_amdgcn_s_setprio(0); } while (0)
#define PG8_WAIT_V(n) asm volatile("s_waitcnt vmcnt(" #n ")" ::: "memory")
#define PG8_WAIT_L(n) asm volatile("s_waitcnt lgkmcnt(" #n ")" ::: "memory")
#define PG8_BAR __builtin_amdgcn_s_barrier()
#define PG8_SCHED __builtin_amdgcn_sched_barrier(0)
    Unit cur, nxt; int ui = 0;
    if (!S.next(0, cur)) return;
    f32x4 acc[2][2][4][2];
#pragma unroll
    for (int a = 0; a < 2; ++a)
#pragma unroll
        for (int b = 0; b < 2; ++b)
#pragma unroll
            for (int m = 0; m < 4; ++m)
#pragma unroll
                for (int n = 0; n < 2; ++n) acc[a][b][m][n] = (f32x4){0.f, 0.f, 0.f, 0.f};
    bf16x8 At[4][2], B0[2][2], B1[2][2];
    const char* cA = (const char*)g.A + (size_t)cur.pm * tstep; const char* cB = (const char*)g.Bt + (size_t)cur.pn * tstep;
    S.a_ready(cur);
    if constexpr (SP2) {
        PG8_STAGE(PG8_SB(0, 0), cB, voffB); PG8_STAGE(PG8_SB(0, 1), cB + hstep, voffB); PG8_STAGE(PG8_SA(0, 0), cA, voffA); PG8_STAGE(PG8_SA(0, 1), cA + hstep, voffA);
        if (wr == 1) PG8_BAR;
        PG8_WAIT_V(2); PG8_BAR;
        PG8_STAGE(PG8_SB(1, 0), cB + kstep, voffB); PG8_STAGE(PG8_SA(1, 0), cA + kstep, voffA); PG8_STAGE(PG8_SB(1, 1), cB + hstep + kstep, voffB);
        PG8_WAIT_V(6); PG8_BAR;
    } else {
        PG8_STAGE(PG8_SB(0, 0), cB, voffB); PG8_STAGE(PG8_SA(0, 0), cA, voffA); PG8_STAGE(PG8_SB(0, 1), cB + hstep, voffB); PG8_STAGE(PG8_SA(0, 1), cA + hstep, voffA);
        if (wr == 1) PG8_BAR;
        PG8_WAIT_V(4); PG8_BAR;
        PG8_STAGE(PG8_SB(1, 0), cB + kstep, voffB); PG8_STAGE(PG8_SA(1, 0), cA + kstep, voffA); PG8_STAGE(PG8_SB(1, 1), cB + hstep + kstep, voffB);
        PG8_WAIT_V(6); PG8_BAR;
    }
    for (;;) {
        const bool has_next = S.next(ui + 1, nxt);
        const char* nA = has_next ? (const char*)g.A + (size_t)nxt.pm * tstep : cA; const char* nB = has_next ? (const char*)g.Bt + (size_t)nxt.pn * tstep : cB;
        for (int t = 0; t < nt; t += 2) {
            const bool last = (t == nt - 2);
            const char* a1 = cA + (size_t)(t + 1) * kstep;
            const char* a2 = last ? nA : cA + (size_t)(t + 2) * kstep; const char* b2 = last ? nB : cB + (size_t)(t + 2) * kstep;
            const char* a3 = a2 + kstep; const char* b3 = b2 + kstep;
            if (last && has_next) S.a_ready(nxt);
            if constexpr (SP2) {
            PG8_LDB(B0, 0, 0); PG8_LDB(B1, 0, 1); PG8_SCHED; PG8_LDA(At, 0, 0); PG8_STAGE(PG8_SA(1, 1), a1 + hstep, voffA);
            PG8_WAIT_V(8); PG8_WAIT_L(0); PG8_BAR; PG8_MMA(0, 0, At, B0); PG8_MMA(0, 1, At, B1); PG8_BAR; PG8_SCHED;
            PG8_LDA(At, 0, 1); PG8_STAGE(PG8_SB(0, 0), b2, voffB); PG8_STAGE(PG8_SB(0, 1), b2 + hstep, voffB); PG8_STAGE(PG8_SA(0, 0), a2, voffA);
            PG8_WAIT_V(8); PG8_WAIT_L(0); PG8_BAR; PG8_MMA(1, 0, At, B0); PG8_MMA(1, 1, At, B1); PG8_BAR; PG8_SCHED;
            PG8_LDB(B0, 1, 0); PG8_LDB(B1, 1, 1); PG8_SCHED; PG8_LDA(At, 1, 0); PG8_STAGE(PG8_SA(0, 1), a2 + hstep, voffA);
            PG8_WAIT_V(8); PG8_WAIT_L(0); PG8_BAR; PG8_MMA(0, 0, At, B0); PG8_MMA(0, 1, At, B1); PG8_BAR; PG8_SCHED;
            PG8_LDA(At, 1, 1); PG8_STAGE(PG8_SB(1, 0), b3, voffB); PG8_STAGE(PG8_SB(1, 1), b3 + hstep, voffB); PG8_STAGE(PG8_SA(1, 0), a3, voffA);
            PG8_WAIT_V(8); PG8_WAIT_L(0); PG8_BAR; PG8_MMA(1, 0, At, B0); PG8_MMA(1, 1, At, B1); PG8_BAR; PG8_SCHED;
            } else {
            PG8_LDB(B0, 0, 0); PG8_SCHED; PG8_LDA(At, 0, 0); PG8_STAGE(PG8_SA(1, 1), a1 + hstep, voffA);
            PG8_WAIT_L(8); PG8_BAR; PG8_WAIT_L(0); PG8_MMA(0, 0, At, B0); PG8_BAR; PG8_SCHED;
            PG8_LDB(B1, 0, 1); PG8_STAGE(PG8_SB(0, 0), b2, voffB);
            PG8_BAR; PG8_WAIT_L(0); PG8_MMA(0, 1, At, B1); PG8_BAR;
            PG8_LDA(At, 0, 1); PG8_STAGE(PG8_SA(0, 0), a2, voffA);
            PG8_BAR; PG8_WAIT_L(0); PG8_MMA(1, 0, At, B0); PG8_BAR; PG8_SCHED;
            PG8_STAGE(PG8_SB(0, 1), b2 + hstep, voffB);
            PG8_WAIT_V(6); PG8_BAR; PG8_MMA(1, 1, At, B1); PG8_BAR;
            PG8_LDB(B0, 1, 0); PG8_SCHED; PG8_LDA(At, 1, 0); PG8_STAGE(PG8_SA(0, 1), a2 + hstep, voffA);
            PG8_WAIT_L(8); PG8_BAR; PG8_WAIT_L(0); PG8_MMA(0, 0, At, B0); PG8_BAR; PG8_SCHED;
            PG8_LDB(B1, 1, 1); PG8_STAGE(PG8_SB(1, 0), b3, voffB);
            PG8_BAR; PG8_WAIT_L(0); PG8_MMA(0, 1, At, B1); PG8_BAR;
            PG8_LDA(At, 1, 1); PG8_STAGE(PG8_SA(1, 0), a3, voffA);
            PG8_BAR; PG8_WAIT_L(0); PG8_MMA(1, 0, At, B0); PG8_BAR; PG8_SCHED;
            PG8_STAGE(PG8_SB(1, 1), b3 + hstep, voffB);
            PG8_WAIT_V(6); PG8_BAR; PG8_MMA(1, 1, At, B1); PG8_BAR;
            }
        }
        if constexpr (ALIGN_EPI) { if (wr == 0) PG8_BAR; }
        if constexpr (!Epi::AFTER_DRAIN) { E(acc, cur, wr, wc, fr, fq); S.done(cur); }
        if (!has_next) break;
#pragma unroll
        for (int a = 0; a < 2; ++a)
#pragma unroll
            for (int b = 0; b < 2; ++b)
#pragma unroll
                for (int m = 0; m < 4; ++m)
#pragma unroll
                    for (int n = 0; n < 2; ++n) acc[a][b][m][n] = (f32x4){0.f, 0.f, 0.f, 0.f};
        cur = nxt; cA = nA; cB = nB; ++ui;
        if constexpr (ALIGN_EPI) { if (wr == 1) PG8_BAR; }
    }
    PG8_WAIT_V(0);
    if constexpr (!ALIGN_EPI) { if (wr == 0) PG8_BAR; }
    PG8_BAR;
    if constexpr (Epi::AFTER_DRAIN) { E.fused(acc, cur, wr, wc, fr, fq, lds, wid, lane); S.done(cur); }
#undef PG8_SA
#undef PG8_SB
#undef PG8_STAGE
#undef PG8_LDA
#undef PG8_LDB
#undef PG8_MMA
#undef PG8_WAIT_V
#undef PG8_WAIT_L
#undef PG8_BAR
#undef PG8_SCHED
}
}

#define DI __device__ __forceinline__
#define LAS __attribute__((address_space(3)))
using pg8::bf16_t; using pg8::bf16x8; using pg8::f32x4; using pg8::u32x4; using pg8::cvtpk; using pg8::sigm;
typedef float f32x2 __attribute__((ext_vector_type(2)));
typedef unsigned u32x2 __attribute__((ext_vector_type(2)));

#ifndef NAT_GLA_PCT
#define NAT_GLA_PCT 0
#endif
#ifndef MIXMASK
#define MIXMASK 3
#endif
#ifndef ROLEMASK
#define ROLEMASK 15
#endif
#ifndef PHMASK
#define PHMASK 0xffff
#endif
constexpr int NTHR = 512, NWAVE = 8, LDS_BYTES = 147456;
constexpr int D = 1024, NB = 32, SL = 2048, CL = 256, ML = NB * SL, MC = NB * CL, MT = ML + MC;
constexpr int INC = 3488, PLD = 3584, FH = 2816, LOLD = 1920;
constexpr int C_GQ = 0, C_GK = 192, C_GV = 384, C_GG = 768, C_GDN = 1152;
constexpr int C_NQ = 1184, C_NK = 1440, C_NV = 1696;
constexpr int C_RW = 1952;
constexpr size_t OFF_WIN = 0, OFF_WOUT = 7340032, OFF_W13 = 9437184, OFF_W2 = 20971520, OFF_BT2 = 26738688, WLB = 28311552;
constexpr size_t WS_MOD = 2 * WLB, WS_ROPE = WS_MOD + 1622016, WS_BON = WS_ROPE + 262144, WS_VT = WS_BON + 3538944, WS_AY = WS_VT + 37748736,
                 WS_PB = WS_AY + 150994944, WS_LO = WS_PB + 528482304, WS_BAR = WS_LO + 283115520, WS_END = WS_BAR + 16384;

struct Params { const float* in[29]; float* out; unsigned char* ws; };
enum { I_X = 0, I_C, I_CTX, I_CCTX, I_WMOD, I_BMOD, I_WIN, I_GUP, I_GB, I_GNW, I_RPB, I_MU, I_W0, I_WD2, I_A0, I_WA2, I_WG2, I_KK, I_KA, I_RK, I_GNWT, I_GNB,
       I_WOUT, I_LN1W, I_LN1B, I_W13, I_W2, I_LN2W, I_LN2B };

DI const float* pin(const Params& p, int i) { asm volatile("" : "+s"(i)); return p.in[i]; }
DI float bf2f(bf16_t h) { return __uint_as_float(((unsigned)h) << 16); }
DI float bflo(unsigned u) { return __uint_as_float(u << 16); }
DI float bfhi(unsigned u) { return __uint_as_float(u & 0xffff0000u); }
DI bf16_t f2bf(float f) { return (bf16_t)(cvtpk(f, 0.f) & 0xffffu); }
DI float shx(float v, int m, int lane) { return __int_as_float(__builtin_amdgcn_ds_bpermute((lane ^ m) << 2, __float_as_int(v))); }
#define DPPF(v, ctrl) __int_as_float(__builtin_amdgcn_mov_dpp(__float_as_int(v), (ctrl), 0xf, 0xf, true))
DI float sum4(float v) { v += DPPF(v, 0xB1); v += DPPF(v, 0x4E); return v; }
DI float sum8(float v) { v = sum4(v); v += DPPF(v, 0x141); return v; }
DI float sum16(float v) { v = sum8(v); v += DPPF(v, 0x140); return v; }
DI float x16_sum(float x) { const auto r = __builtin_amdgcn_permlane16_swap(__float_as_uint(x), __float_as_uint(x), false, false); return __uint_as_float(r[0]) + __uint_as_float(r[1]); }
DI float x32_sum(float x) { const auto r = __builtin_amdgcn_permlane32_swap(__float_as_uint(x), __float_as_uint(x), false, false); return __uint_as_float(r[0]) + __uint_as_float(r[1]); }
DI float x16_max(float x) { const auto r = __builtin_amdgcn_permlane16_swap(__float_as_uint(x), __float_as_uint(x), false, false); return fmaxf(__uint_as_float(r[0]), __uint_as_float(r[1])); }
DI float x32_max(float x) { const auto r = __builtin_amdgcn_permlane32_swap(__float_as_uint(x), __float_as_uint(x), false, false); return fmaxf(__uint_as_float(r[0]), __uint_as_float(r[1])); }
DI float wave_sum(float v, int) { return x32_sum(x16_sum(sum16(v))); }
DI void cvt8(const u32x4 u, float* o) { o[0] = bflo(u.x); o[1] = bfhi(u.x); o[2] = bflo(u.y); o[3] = bfhi(u.y); o[4] = bflo(u.z); o[5] = bfhi(u.z); o[6] = bflo(u.w); o[7] = bfhi(u.w); }
DI void load8(const bf16_t* p, float* o) { const u32x4 u = *(const u32x4*)p; o[0] = bflo(u.x); o[1] = bfhi(u.x); o[2] = bflo(u.y); o[3] = bfhi(u.y); o[4] = bflo(u.z); o[5] = bfhi(u.z); o[6] = bflo(u.w); o[7] = bfhi(u.w); }
DI void load16(const bf16_t* p, float (&o)[16]) { load8(p, &o[0]); load8(p + 8, &o[8]); }
DI void shift16(const bf16_t* prow, bool hasm, bool hasp, const float* mu, float (&y)[16]) {
    float c0[16], cm[16], cp[16];
    load16(prow, c0);
    if (hasm) load16(prow - PLD, cm); else {
#pragma unroll
        for (int j = 0; j < 16; ++j) cm[j] = 0.f; }
    if (hasp) load16(prow + PLD, cp); else {
#pragma unroll
        for (int j = 0; j < 16; ++j) cp[j] = 0.f; }
#pragma unroll
    for (int j = 0; j < 16; ++j) y[j] = c0[j] + (0.5f * (cm[j] + cp[j]) - c0[j]) * mu[j];
}
DI void step_row(int s, int g, int b, int& row, int& ts, int& Ls) {
    if (s < CL) { ts = g ? (CL - 1 - s) : s; row = ML + b * CL + ts; Ls = CL; }
    else { const int u = s - CL; ts = g ? (SL - 1 - u) : u; row = b * SL + ts; Ls = SL; }
}

DI void transpose_item(const float* W, int N, bf16_t* WT, int Kd, size_t dst_row0, int k0, int n0, LAS float* scr, int lane) {
#pragma unroll 8
    for (int i = 0; i < 32; ++i) { const int kk = 2 * i + (lane >> 5); scr[kk * 33 + (lane & 31)] = W[(size_t)(k0 + kk) * N + n0 + (lane & 31)]; }
    asm volatile("s_waitcnt lgkmcnt(0)" ::: "memory");
    const int c = lane & 7;
#pragma unroll
    for (int j = 0; j < 4; ++j) { const int n = (lane >> 3) + 8 * j; const LAS float* s = scr + (8 * c) * 33 + n;
        u32x4 o; o.x = cvtpk(s[0 * 33], s[1 * 33]); o.y = cvtpk(s[2 * 33], s[3 * 33]); o.z = cvtpk(s[4 * 33], s[5 * 33]); o.w = cvtpk(s[6 * 33], s[7 * 33]);
        *(u32x4*)(WT + (dst_row0 + n) * Kd + k0 + 8 * c) = o; }
    asm volatile("s_waitcnt lgkmcnt(0)" ::: "memory");
}

DI void phase_prologue(const Params& p, LAS unsigned char* lds, int tid, int lane, int wave) {
    unsigned char* ws = p.ws;
    float* MOD = (float*)(ws + WS_MOD);
    {
        LAS float* sc = (LAS float*)lds;
        LAS float* part = (LAS float*)(lds + 135168);
        for (int i = tid; i < 33 * 1024; i += NTHR) { const int bi = i >> 10, k = i & 1023; const float cv = bi < 32 ? pin(p, I_C)[bi * 1024 + k] : pin(p, I_CCTX)[k]; sc[k * 33 + bi] = cv * sigm(cv); }
        __syncthreads();
        for (int u = blockIdx.x; u < 192; u += gridDim.x) {
            const int l = u / 96, n0 = (u % 96) * 64;
            float acc[33];
#pragma unroll
            for (int bi = 0; bi < 33; ++bi) acc[bi] = 0.f;
            const float* wp = pin(p, I_WMOD) + (size_t)l * 1024 * 6144 + n0 + lane;
#pragma unroll 4
            for (int kk = 0; kk < 128; ++kk) { const int k = wave * 128 + kk; const float w = wp[(size_t)k * 6144];
#pragma unroll
                for (int bi = 0; bi < 33; ++bi) acc[bi] += sc[k * 33 + bi] * w; }
            for (int w = 0; w < NWAVE; ++w) {
                if (wave == w) {
#pragma unroll
                    for (int bi = 0; bi < 33; ++bi) { if (w == 0) part[bi * 64 + lane] = acc[bi]; else part[bi * 64 + lane] += acc[bi]; } }
                __syncthreads();
            }
            for (int i = tid; i < 33 * 64; i += NTHR) { const int bi = i >> 6, n = i & 63; MOD[(size_t)(l * 33 + bi) * 6144 + n0 + n] = part[i] + pin(p, I_BMOD)[l * 6144 + n0 + n]; }
            __syncthreads();
        }
        __syncthreads();
    }
    const int gw = blockIdx.x * NWAVE + wave, NGW = gridDim.x * NWAVE;
    const int gt = blockIdx.x * NTHR + tid, NGT = gridDim.x * NTHR;
    {
        LAS float* scr = (LAS float*)(lds + wave * 8448);
        constexpr int IT_IN = 16 * 109, IT_OUT = 16 * 32, IT_13 = 16 * 176, IT_2 = 44 * 32, IT_L = IT_IN + IT_OUT + IT_13 + IT_2;
        for (int it = gw; it < 2 * IT_L; it += NGW) {
            const int l = it / IT_L; int r = it % IT_L;
            unsigned char* wl = ws + (size_t)l * WLB;
            if (r < IT_IN) { const int kb = r / 109, nb = r % 109;
                transpose_item(pin(p, I_WIN) + (size_t)l * 1024 * INC, INC, (bf16_t*)(wl + OFF_WIN), 1024, (size_t)nb * 32, kb * 64, nb * 32, scr, lane); continue; }
            r -= IT_IN;
            if (r < IT_OUT) { const int kb = r / 32, nb = r % 32;
                transpose_item(pin(p, I_WOUT) + (size_t)l * 1024 * 1024, 1024, (bf16_t*)(wl + OFF_WOUT), 1024, (size_t)nb * 32, kb * 64, nb * 32, scr, lane); continue; }
            r -= IT_OUT;
            if (r < IT_13) { const int kb = r / 176, nb = r % 176; const int n0 = nb * 32;
                const int j = n0 < FH ? n0 : n0 - FH; const size_t drow = (size_t)(256 * (j / 128) + (n0 < FH ? 0 : 128) + (j % 128));
                transpose_item(pin(p, I_W13) + (size_t)l * 1024 * 2 * FH, 2 * FH, (bf16_t*)(wl + OFF_W13), 1024, drow, kb * 64, n0, scr, lane); continue; }
            r -= IT_13;
            { const int kb = r / 32, nb = r % 32;
                transpose_item(pin(p, I_W2) + (size_t)l * FH * 1024, 1024, (bf16_t*)(wl + OFF_W2), FH, (size_t)nb * 32, kb * 64, nb * 32, scr, lane); }
        }
    }
    for (int i = gt; i < 2 * 96 * 1024; i += NGT) { const int l = i / (96 * 1024), r = i % (96 * 1024); ((bf16_t*)(ws + (size_t)l * WLB + OFF_WIN))[(size_t)INC * 1024 + r] = 0; }
    for (int i = gt; i < 2 * 2048 * 384; i += NGT) {
        const int l = i / (2048 * 384), r = i % (2048 * 384), n = r / 384, k = r % 384;
        float v = 0.f;
        if (n < 1536) { const int g = n / 768, h = (n % 768) / 128, which = (n % 128) / 64, ch = n % 64, c = h * 64 + ch;
            const int kb = which ? 128 + 64 * g : 64 * g;
            if (k >= kb && k < kb + 64) v = (which ? pin(p, I_WA2) : pin(p, I_WD2))[((size_t)(l * 2 + g) * 64 + (k - kb)) * 384 + c]; }
        else if (n < 1920) { if (k >= 256) v = pin(p, I_WG2)[((size_t)l * 128 + (k - 256)) * 384 + (n - 1536)]; }
        ((bf16_t*)(ws + (size_t)l * WLB + OFF_BT2))[r] = f2bf(v);
    }
    for (int i = gt; i < SL * 16; i += NGT) { const int t = i >> 4, pi = i & 15; const float pos = (float)(pi < 8 ? (t >> 6) : (t & 63));
        const float inv = powf(10000.0f, -(float)(pi & 7) * 0.125f); const float ang = pos * inv;
        float* rt = (float*)(ws + WS_ROPE) + (size_t)i * 2; rt[0] = cosf(ang); rt[1] = sinf(ang); }
}

DI void phase_modulate0(const Params& p, int lane, int wave) {
    const int gw = blockIdx.x * NWAVE + wave, NGW = gridDim.x * NWAVE;
    const float* MOD = (const float*)(p.ws + WS_MOD); bf16_t* A = (bf16_t*)(p.ws + WS_AY);
    for (int row = gw; row < MT; row += NGW) {
        const float* src = row < ML ? pin(p, I_X) + (size_t)row * D : pin(p, I_CTX) + (size_t)(row - ML) * D;
        const int bi = row < ML ? (row >> 11) : 32; const float* md = MOD + (size_t)bi * 6144;
#pragma unroll
        for (int j = 0; j < 4; ++j) { const int c = 4 * (lane + 64 * j); const f32x4 v = *(const f32x4*)(src + c), sh = *(const f32x4*)(md + c), sc = *(const f32x4*)(md + 1024 + c);
            u32x2 o; o.x = cvtpk(v[0] * (1.f + sc[0]) + sh[0], v[1] * (1.f + sc[1]) + sh[1]); o.y = cvtpk(v[2] * (1.f + sc[2]) + sh[2], v[3] * (1.f + sc[3]) + sh[3]);
            *(u32x2*)(A + (size_t)row * D + c) = o; }
    }
}
DI void phase_ln(const Params& p, int lane, int wave, int nrows, const float* lnw, const float* lnb, const float* modl, int sh_ofs, int sc_ofs, bool write_x, bool write_A) {
    const int gw = blockIdx.x * NWAVE + wave, NGW = gridDim.x * NWAVE;
    bf16_t* A = (bf16_t*)(p.ws + WS_AY); float* tc = (float*)(p.ws + WS_VT);
    f32x4 nx[4];
    if (gw < nrows) { const float* t0 = gw < ML ? p.out + (size_t)gw * D : tc + (size_t)(gw - ML) * D;
#pragma unroll
        for (int j = 0; j < 4; ++j) nx[j] = *(const f32x4*)(t0 + 4 * (lane + 64 * j)); }
    for (int row = gw; row < nrows; row += NGW) {
        const bool lat = row < ML;
        float* t = lat ? p.out + (size_t)row * D : tc + (size_t)(row - ML) * D;
        const int bi = lat ? (row >> 11) : 32;
        f32x4 v[4]; float s = 0.f;
#pragma unroll
        for (int j = 0; j < 4; ++j) { v[j] = nx[j]; s += (v[j][0] + v[j][1]) + (v[j][2] + v[j][3]); }
        { const int rn = row + NGW; if (rn < nrows) { const float* tn = rn < ML ? p.out + (size_t)rn * D : tc + (size_t)(rn - ML) * D;
#pragma unroll
            for (int j = 0; j < 4; ++j) nx[j] = *(const f32x4*)(tn + 4 * (lane + 64 * j)); } }
        const float mean = wave_sum(s, lane) * (1.f / D); float s2 = 0.f;
#pragma unroll
        for (int j = 0; j < 4; ++j) { v[j] = v[j] - mean; s2 += (v[j][0] * v[j][0] + v[j][1] * v[j][1]) + (v[j][2] * v[j][2] + v[j][3] * v[j][3]); }
        const float rstd = rsqrtf(wave_sum(s2, lane) * (1.f / D) + 1e-5f);
        const float* md = modl + (size_t)bi * 6144;
#pragma unroll
        for (int j = 0; j < 4; ++j) { const int c = 4 * (lane + 64 * j); const f32x4 w = *(const f32x4*)(lnw + c), b = *(const f32x4*)(lnb + c);
            f32x4 y; y[0] = v[j][0] * rstd * w[0] + b[0]; y[1] = v[j][1] * rstd * w[1] + b[1]; y[2] = v[j][2] * rstd * w[2] + b[2]; y[3] = v[j][3] * rstd * w[3] + b[3];
            if (write_x) *(f32x4*)(t + c) = y;
            if (write_A) { const f32x4 sh = *(const f32x4*)(md + sh_ofs + c), sc = *(const f32x4*)(md + sc_ofs + c);
                u32x2 o; o.x = cvtpk(y[0] * (1.f + sc[0]) + sh[0], y[1] * (1.f + sc[1]) + sh[1]); o.y = cvtpk(y[2] * (1.f + sc[2]) + sh[2], y[3] * (1.f + sc[3]) + sh[3]);
                *(u32x2*)(A + (size_t)row * D + c) = o; } }
    }
}

DI void phase_prep(const Params& p, int l, LAS unsigned char* lds, int lane, int wave) {
    const int gw = blockIdx.x * NWAVE + wave, NGW = gridDim.x * NWAVE;
    const bf16_t* PB = (const bf16_t*)(p.ws + WS_PB); bf16_t* A2 = (bf16_t*)(p.ws + WS_AY); bf16_t* VT = (bf16_t*)(p.ws + WS_VT);
    {
        const int j8 = lane < 48 ? 8 * lane : 0, kind = j8 >> 7;
        float mu[8];
        { const float* m = pin(p, I_MU) + (size_t)l * 1536 + 1152 + j8;
#pragma unroll
          for (int j = 0; j < 8; ++j) mu[j] = m[j]; }
        for (int row = gw; row < MT; row += NGW) {
            const bool lat = row < ML; const int t = lat ? (row & (SL - 1)) : ((row - ML) & (CL - 1)); const int Ls = lat ? SL : CL;
            const bf16_t* pr = PB + (size_t)row * PLD + C_RW + 1152 + j8;
            const u32x4 r0 = *(const u32x4*)pr, rm = *(const u32x4*)(t > 0 ? pr - PLD : pr), rp = *(const u32x4*)(t < Ls - 1 ? pr + PLD : pr);
            const float mm = t > 0 ? 0.5f : 0.f, mp = t < Ls - 1 ? 0.5f : 0.f;
            float c0[8], cm[8], cp[8], o[8];
            cvt8(r0, c0); cvt8(rm, cm); cvt8(rp, cp);
#pragma unroll
            for (int j = 0; j < 8; ++j) { const float y = c0[j] + ((mm * cm[j] + mp * cp[j]) - c0[j]) * mu[j];
                o[j] = kind == 0 ? 1.f - 2.f / (1.f + __expf(2.f * y)) : (kind == 1 ? y : sigm(y)); }
            if (lane < 48) { u32x4 w; w.x = cvtpk(o[0], o[1]); w.y = cvtpk(o[2], o[3]); w.z = cvtpk(o[4], o[5]); w.w = cvtpk(o[6], o[7]); *(u32x4*)(A2 + (size_t)row * 384 + j8) = w; }
        }
    }
    LAS bf16_t* T = (LAS bf16_t*)(lds + wave * 8448);
    for (int it = gw; it < NB * 4 * 36; it += NGW) {
        const int tb = it % 36, h = (it / 36) & 3, b = it / 144;
        const int row0 = tb < 32 ? b * SL + tb * 64 : ML + b * CL + (tb - 32) * 64;
        const bf16_t* src = PB + (size_t)(row0 + (lane >> 3)) * PLD + C_NV + h * 64 + 8 * (lane & 7);
#pragma unroll
        for (int i = 0; i < 8; ++i) { const u32x4 v = *(const u32x4*)(src + (size_t)(8 * i) * PLD);
            LAS unsigned* d = (LAS unsigned*)(T + (8 * i + (lane >> 3)) * 66 + 8 * (lane & 7)); d[0] = v.x; d[1] = v.y; d[2] = v.z; d[3] = v.w; }
        asm volatile("s_waitcnt vmcnt(0) lgkmcnt(0)" ::: "memory");
        bf16_t* dst = VT + ((size_t)(b * 4 + h) * 144 + tb * 4) * 1024;
#pragma unroll
        for (int k = 0; k < 16; ++k) { const int u = k * 64 + lane, q = u >> 8, d = (u >> 2) & 63, kg = u & 3;
            const LAS bf16_t* tp = T + (16 * q + 4 * kg) * 66 + d;
            u32x2 o; o.x = (unsigned)tp[0] | ((unsigned)tp[66] << 16); o.y = (unsigned)tp[132] | ((unsigned)tp[198] << 16);
            *(u32x2*)(dst + (size_t)(q * 64 + d) * 16 + 4 * kg) = o; }
        asm volatile("s_waitcnt lgkmcnt(0)" ::: "memory");
    }
}

#define MFMA16(a, b, c) __builtin_amdgcn_mfma_f32_16x16x32_bf16((a), (b), (c), 0, 0, 0)
DI u32x4 vload16(const bf16_t* p) { const volatile unsigned* q = (const volatile unsigned*)p; u32x4 r; r.x = q[0]; r.y = q[1]; r.z = q[2]; r.w = q[3]; return r; }
DI u32x2 vload8(const bf16_t* p) { const volatile unsigned* q = (const volatile unsigned*)p; u32x2 r; r.x = q[0]; r.y = q[1]; return r; }
struct NatPair { bf16x8 k[2][2]; u32x2 v[4][2]; u32x2 bias[2]; };
DI void nat_unit(const Params& p, int l, int id, bool isctx, int lane) {
    const bf16_t* PB = (const bf16_t*)(p.ws + WS_PB); const bf16_t* VT = (const bf16_t*)(p.ws + WS_VT); bf16_t* AY = (bf16_t*)(p.ws + WS_AY);
    const int l15 = lane & 15, g = lane >> 4;
    int b, h, r = 0, qt, qrow;
    if (!isctx) { qt = id & 3; r = (id >> 2) & 31; h = (id >> 7) & 3; b = id >> 9; qrow = b * SL + r * 64 + 16 * qt + l15; }
    else { qt = id & 15; h = (id >> 4) & 3; b = id >> 6; qrow = ML + b * CL + 16 * qt + l15; }
    const bf16_t* qp = PB + (size_t)qrow * PLD + C_NQ + h * 64 + 8 * g;
    const bf16x8 qf0 = *(const bf16x8*)qp, qf1 = *(const bf16x8*)(qp + 32);
    const int rs = min(max(r - 4, 0), 24);
    int ct_lo = 0, nct = 1;
    if (!isctx) { const int lo = min(max(16 * qt - 8, 0), 48), hi = min(max(16 * qt + 7, 0), 48) + 16; ct_lo = lo >> 4; nct = ((hi - 1) >> 4) - ct_lo + 1; }
    const int nloc = isctx ? 0 : 8 * nct, npairs = nloc / 2 + 8;
    const int qc = 16 * qt + l15, cs = min(max(qc - 8, 0), 48);
    float m = -1e30f, lsum = 0.f;
    f32x4 oacc[4];
#pragma unroll
    for (int dt = 0; dt < 4; ++dt) oacc[dt] = (f32x4){0.f, 0.f, 0.f, 0.f};
    const bf16_t* vt = VT + (size_t)(b * 4 + h) * 144 * 1024 + l15 * 16 + 4 * g;
    const bf16_t* kbase = PB + (size_t)l15 * PLD + C_NK + h * 64 + 8 * g;
    const float* rp = pin(p, I_RPB) + (size_t)((l * 4 + h) * 15) * 31;
    NatPair ring[4];
    int iti = 0, ikr = 0, icj = 0;
#define NAT_ISSUE(slot) do { __builtin_amdgcn_sched_barrier(0); _Pragma("unroll") for (int e = 0; e < 2; ++e) { int tk, keyrow; f32x4 bs = (f32x4){0.f, 0.f, 0.f, 0.f}; \
        if (iti < nloc) { const int ct = ct_lo + icj; tk = (rs + ikr) * 64 + 16 * ct; keyrow = b * SL + tk; const float* rpr = rp + (rs + ikr - r + 7) * 31; \
            _Pragma("unroll") for (int rg = 0; rg < 4; ++rg) { const int kc = 16 * ct + 4 * g + rg; const bool vis = (kc >= cs) && (kc < cs + 16); const float bv = rpr[min(max(kc - qc + 15, 0), 30)]; bs[rg] = vis ? bv : -1e30f; } \
            if (++icj == nct) { icj = 0; ++ikr; } } \
        else { const int j = (iti - nloc) * 16; tk = SL + j; keyrow = ML + b * CL + j; } \
        ++iti; ring[slot].bias[e] = (u32x2){cvtpk(bs[0], bs[1]), cvtpk(bs[2], bs[3])}; \
        const bf16_t* kp = kbase + (size_t)keyrow * PLD; ring[slot].k[e][0] = *(const bf16x8*)kp; ring[slot].k[e][1] = *(const bf16x8*)(kp + 32); \
        _Pragma("unroll") for (int dt = 0; dt < 4; ++dt) ring[slot].v[dt][e] = *(const u32x2*)(vt + (size_t)(tk >> 4) * 1024 + dt * 256); } __builtin_amdgcn_sched_barrier(0); } while (0)
#pragma unroll
    for (int j = 0; j < 4; ++j) NAT_ISSUE(j);
    for (int pi0 = 0; pi0 < npairs; pi0 += 4) {
#pragma unroll
        for (int j = 0; j < 4; ++j) {
            const int pi = pi0 + j;
            f32x4 s[2];
#pragma unroll
            for (int e = 0; e < 2; ++e) {
                f32x4 a = (f32x4){0.f, 0.f, 0.f, 0.f};
                a = MFMA16(ring[j].k[e][0], qf0, a); a = MFMA16(ring[j].k[e][1], qf1, a);
                const u32x2 bb = ring[j].bias[e];
                s[e] = a * 0.125f + (f32x4){bflo(bb.x), bfhi(bb.x), bflo(bb.y), bfhi(bb.y)};
            }
            float tmax = fmaxf(fmaxf(fmaxf(s[0][0], s[0][1]), fmaxf(s[0][2], s[0][3])), fmaxf(fmaxf(s[1][0], s[1][1]), fmaxf(s[1][2], s[1][3])));
            tmax = x32_max(x16_max(tmax));
            const float mn = fmaxf(m, tmax), corr = __expf(m - mn); m = mn;
            float pv[8]; float ps = 0.f;
#pragma unroll
            for (int i = 0; i < 8; ++i) { const float sv = s[i >> 2][i & 3]; pv[i] = sv > -1e29f ? __expf(sv - mn) : 0.f; ps += pv[i]; }
            lsum = lsum * corr + ps;
            u32x4 pk; pk.x = cvtpk(pv[0], pv[1]); pk.y = cvtpk(pv[2], pv[3]); pk.z = cvtpk(pv[4], pv[5]); pk.w = cvtpk(pv[6], pv[7]);
            const bf16x8 pf = __builtin_bit_cast(bf16x8, pk);
#pragma unroll
            for (int dt = 0; dt < 4; ++dt) {
                u32x4 vv; vv.x = ring[j].v[dt][0].x; vv.y = ring[j].v[dt][0].y; vv.z = ring[j].v[dt][1].x; vv.w = ring[j].v[dt][1].y;
                oacc[dt] = oacc[dt] * corr;
                oacc[dt] = MFMA16(__builtin_bit_cast(bf16x8, vv), pf, oacc[dt]);
            }
            if (pi + 4 < npairs) NAT_ISSUE(j);
        }
    }
#undef NAT_ISSUE
    lsum = x32_sum(x16_sum(lsum));
    const float inv = 1.0f / lsum;
    bf16_t* yp = AY + (size_t)qrow * D + 768 + h * 64 + 4 * g;
#pragma unroll
    for (int dt = 0; dt < 4; ++dt) { u32x2 o; o.x = cvtpk(oacc[dt][0] * inv, oacc[dt][1] * inv); o.y = cvtpk(oacc[dt][2] * inv, oacc[dt][3] * inv); *(u32x2*)(yp + 16 * dt) = o; }
}

constexpr int RW_STEP = 384, RW_BUF = 16 * RW_STEP, GL_STEP = 160, GL_BUF = 16 * GL_STEP, NCHUNK = (CL + SL) / 16;
struct RwRaw { u32x4 d[3][3][2]; u32x4 lo[4]; };
DI void rwkv_load(const Params& p, int item, int c, RwRaw& R, int lane) {
    const int g = item & 1, h = (item >> 1) % 6, b = item / 12;
    const int ti = lane >> 2, cg = lane & 3;
    int row, ts, Ls; step_row(16 * c + ti, g, b, row, ts, Ls);
    const int rm = ts > 0 ? row - 1 : row, rp = ts < Ls - 1 ? row + 1 : row;
    const bf16_t* PB = (const bf16_t*)(p.ws + WS_PB) + C_RW + h * 64 + 16 * cg;
    const bf16_t* p0 = PB + (size_t)row * PLD; const bf16_t* pm = PB + (size_t)rm * PLD; const bf16_t* pp = PB + (size_t)rp * PLD;
#pragma unroll
    for (int a = 0; a < 3; ++a)
#pragma unroll
        for (int hf = 0; hf < 2; ++hf) { R.d[a][0][hf] = *(const u32x4*)(pm + a * 384 + 8 * hf); R.d[a][1][hf] = *(const u32x4*)(p0 + a * 384 + 8 * hf); R.d[a][2][hf] = *(const u32x4*)(pp + a * 384 + 8 * hf); }
    const bf16_t* lo = (const bf16_t*)(p.ws + WS_LO) + (size_t)row * LOLD + (g * 6 + h) * 128 + 16 * cg;
    R.lo[0] = *(const u32x4*)lo; R.lo[1] = *(const u32x4*)(lo + 8); R.lo[2] = *(const u32x4*)(lo + 64); R.lo[3] = *(const u32x4*)(lo + 72);
}
DI void rwkv_compute(const Params& p, int item, int c, const RwRaw& R, LAS float* buf, const LAS float* CST, int lane) {
    const int g = item & 1, h = (item >> 1) % 6, b = item / 12;
    const int ti = lane >> 2, cg = lane & 3;
    int row, ts, Ls; step_row(16 * c + ti, g, b, row, ts, Ls);
    const float mm = ts > 0 ? 0.5f : 0.f, mp = ts < Ls - 1 ? 0.5f : 0.f;
    float y[3][16];
#pragma unroll
    for (int a = 0; a < 3; ++a) {
        float c0[16], cm[16], cp[16];
        cvt8(R.d[a][0][0], &cm[0]); cvt8(R.d[a][0][1], &cm[8]); cvt8(R.d[a][1][0], &c0[0]); cvt8(R.d[a][1][1], &c0[8]); cvt8(R.d[a][2][0], &cp[0]); cvt8(R.d[a][2][1], &cp[8]);
#pragma unroll
        for (int j4 = 0; j4 < 4; ++j4) { const f32x4 mu = *(const LAS f32x4*)(CST + a * 64 + 16 * cg + 4 * j4);
#pragma unroll
            for (int jj = 0; jj < 4; ++jj) { const int j = 4 * j4 + jj; y[a][j] = c0[j] + ((mm * cm[j] + mp * cp[j]) - c0[j]) * mu[jj]; } }
    }
    float lw[16], a[16];
    cvt8(R.lo[0], &lw[0]); cvt8(R.lo[1], &lw[8]); cvt8(R.lo[2], &a[0]); cvt8(R.lo[3], &a[8]);
    float kkv[16]; float ss = 0.f;
#pragma unroll
    for (int j4 = 0; j4 < 4; ++j4) { const f32x4 kc = *(const LAS f32x4*)(CST + 3 * 64 + 16 * cg + 4 * j4);
#pragma unroll
        for (int jj = 0; jj < 4; ++jj) { const int j = 4 * j4 + jj; kkv[j] = y[1][j] * kc[jj]; ss += kkv[j] * kkv[j]; } }
    ss = sum4(ss);
    const float inv = rsqrtf(ss + 1e-12f);
    float bon = 0.f;
    LAS float* o = buf + ti * RW_STEP + 16 * cg;
#pragma unroll
    for (int j4 = 0; j4 < 4; ++j4) {
        const f32x4 kac = *(const LAS f32x4*)(CST + 4 * 64 + 16 * cg + 4 * j4), rkc = *(const LAS f32x4*)(CST + 5 * 64 + 16 * cg + 4 * j4);
        f32x4 w4, b4, km4, r4, kk4, v4;
#pragma unroll
        for (int jj = 0; jj < 4; ++jj) { const int j = 4 * j4 + jj;
            const float kkn = kkv[j] * inv, aj = a[j];
            const float km = y[1][j] * (1.f + (aj - 1.f) * kac[jj]);
            w4[jj] = __expf(-lw[j]); b4[jj] = kkn * aj; km4[jj] = km; r4[jj] = y[0][j]; kk4[jj] = kkn; v4[jj] = y[2][j];
            bon += y[0][j] * km * rkc[jj]; }
        *(LAS f32x4*)(o + 0 * 64 + 4 * j4) = w4; *(LAS f32x4*)(o + 1 * 64 + 4 * j4) = b4; *(LAS f32x4*)(o + 2 * 64 + 4 * j4) = km4;
        *(LAS f32x4*)(o + 3 * 64 + 4 * j4) = r4; *(LAS f32x4*)(o + 4 * 64 + 4 * j4) = kk4; *(LAS f32x4*)(o + 5 * 64 + 4 * j4) = v4;
    }
    bon = sum4(bon);
    if (cg == 0) ((float*)(p.ws + WS_BON))[(size_t)row * 12 + g * 6 + h] = bon;
}
DI float xhalf_sum(float x) {
    const auto r = __builtin_amdgcn_permlane32_swap(__float_as_uint(x), __float_as_uint(x), false, false);
    return __uint_as_float(r[0]) + __uint_as_float(r[1]);
}
DI void rwkv_scan_chunk(const Params& p, int item, int c, const LAS float* buf, f32x2 (&S)[16], int lane, int hf, bool dry) {
    const int g = item & 1, h = (item >> 1) % 6, b = item / 12;
    float* LOf = (float*)(p.ws + WS_LO);
    const int kh = lane >> 5, rowi = 32 * hf + (lane & 31);
    const LAS float* bk = buf + 32 * kh;
    f32x4 KK[8];
#pragma unroll
    for (int i = 0; i < 8; ++i) KK[i] = *(const LAS f32x4*)(bk + 256 + 4 * i);
    float vv = buf[320 + rowi];
    for (int st = 0; st < 16; ++st) {
        const LAS float* W = bk + st * RW_STEP;
        const LAS float* Wn = bk + (st < 15 ? st + 1 : st) * RW_STEP;
        f32x4 U[2][8];
#pragma unroll
        for (int j = 0; j < 2; ++j) { U[0][4 * j] = *(const LAS f32x4*)(W + 4 * j); U[0][4 * j + 1] = *(const LAS f32x4*)(W + 64 + 4 * j); U[0][4 * j + 2] = *(const LAS f32x4*)(W + 128 + 4 * j); U[0][4 * j + 3] = *(const LAS f32x4*)(W + 192 + 4 * j); }
        f32x2 sacc[4];
#pragma unroll
        for (int i = 0; i < 4; ++i) sacc[i] = (f32x2){0.f, 0.f};
#pragma unroll
        for (int i = 0; i < 8; ++i) { sacc[(2 * i) & 3] += S[2 * i] * (f32x2){KK[i][0], KK[i][1]}; sacc[(2 * i + 1) & 3] += S[2 * i + 1] * (f32x2){KK[i][2], KK[i][3]}; }
        const f32x2 st2 = (sacc[0] + sacc[1]) + (sacc[2] + sacc[3]);
        const float sa = -xhalf_sum(st2[0] + st2[1]);
        const f32x2 sa2 = (f32x2){sa, sa}, vv2 = (f32x2){vv, vv};
        f32x2 oacc[4];
#pragma unroll
        for (int i = 0; i < 4; ++i) oacc[i] = (f32x2){0.f, 0.f};
        asm volatile("" : "+v"(oacc[0]), "+v"(oacc[1]) :: "memory");
#pragma unroll
        for (int gi = 0; gi < 4; ++gi) {
            const int cu = gi & 1, nx = cu ^ 1;
            if (gi < 3) {
#pragma unroll
                for (int j = 0; j < 2; ++j) { const int i = 2 * (gi + 1) + j; U[nx][4 * j] = *(const LAS f32x4*)(W + 4 * i); U[nx][4 * j + 1] = *(const LAS f32x4*)(W + 64 + 4 * i);
                    U[nx][4 * j + 2] = *(const LAS f32x4*)(W + 128 + 4 * i); U[nx][4 * j + 3] = *(const LAS f32x4*)(W + 192 + 4 * i); }
            }
            if (gi >= 2) {
#pragma unroll
                for (int j = 0; j < 4; ++j) KK[4 * (gi - 2) + j] = *(const LAS f32x4*)(Wn + 256 + 4 * (4 * (gi - 2) + j));
            }
#pragma unroll
            for (int j = 0; j < 2; ++j) { const int i = 2 * gi + j; const f32x4 w4 = U[cu][4 * j], b4 = U[cu][4 * j + 1], km4 = U[cu][4 * j + 2], r4 = U[cu][4 * j + 3];
                f32x2 t0 = vv2 * (f32x2){km4[0], km4[1]}; t0 = sa2 * (f32x2){b4[0], b4[1]} + t0; S[2 * i] = S[2 * i] * (f32x2){w4[0], w4[1]} + t0;
                f32x2 t1 = vv2 * (f32x2){km4[2], km4[3]}; t1 = sa2 * (f32x2){b4[2], b4[3]} + t1; S[2 * i + 1] = S[2 * i + 1] * (f32x2){w4[2], w4[3]} + t1;
                oacc[(2 * i) & 3] += S[2 * i] * (f32x2){r4[0], r4[1]}; oacc[(2 * i + 1) & 3] += S[2 * i + 1] * (f32x2){r4[2], r4[3]}; }
            asm volatile("" : "+v"(oacc[0]), "+v"(oacc[1]), "+v"(oacc[2]), "+v"(oacc[3]) :: "memory");
        }
        vv = buf[(st < 15 ? st + 1 : st) * RW_STEP + 320 + rowi];
        const f32x2 o2 = (oacc[0] + oacc[1]) + (oacc[2] + oacc[3]);
        const float ov = xhalf_sum(o2[0] + o2[1]);
        int row, ts, Ls; step_row(16 * c + st, g, b, row, ts, Ls);
        if (kh == 0 && (!dry || ov == 1.2345e37f)) LOf[(size_t)row * (LOLD / 2) + (g * 6 + h) * 64 + rowi] = ov;
    }
}
struct GlRaw { u32x4 q, k, v[2], dn[2]; f32x4 rt[2]; };
DI void gla_load(const Params& p, int item, int c, GlRaw& R, int lane) {
    const int g = item & 1, h = (item >> 1) % 6, b = item / 12;
    const int ti = lane >> 2, cg = lane & 3;
    int row, ts, Ls; step_row(16 * c + ti, g, b, row, ts, Ls);
    const bf16_t* pr = (const bf16_t*)(p.ws + WS_PB) + (size_t)row * PLD;
    R.q = *(const u32x4*)(pr + C_GQ + h * 32 + 8 * cg); R.k = *(const u32x4*)(pr + C_GK + h * 32 + 8 * cg);
    R.v[0] = *(const u32x4*)(pr + C_GV + h * 64 + 16 * cg); R.v[1] = *(const u32x4*)(pr + C_GV + h * 64 + 16 * cg + 8);
    R.dn[0] = *(const u32x4*)(pr + C_GDN + 16 * g); R.dn[1] = *(const u32x4*)(pr + C_GDN + 16 * g + 8);
    const float* rt = (const float*)(p.ws + WS_ROPE) + (size_t)((Ls == SL ? ts : 0) * 16 + 4 * cg) * 2;
    R.rt[0] = *(const f32x4*)rt; R.rt[1] = *(const f32x4*)(rt + 4);
}
DI void gla_compute(const Params& p, int item, int c, const GlRaw& R, LAS float* buf, const LAS float* GU, int lane) {
    const int g = item & 1, b = item / 12;
    const int ti = lane >> 2, cg = lane & 3;
    int row, ts, Ls; step_row(16 * c + ti, g, b, row, ts, Ls);
    float q[8], k[8], v[16], dn[16];
    cvt8(R.q, q); cvt8(R.k, k); cvt8(R.v[0], &v[0]); cvt8(R.v[1], &v[8]); cvt8(R.dn[0], &dn[0]); cvt8(R.dn[1], &dn[8]);
    float al[8];
    {
        f32x4 z0 = *(const LAS f32x4*)(GU + 512 + 8 * cg), z1 = *(const LAS f32x4*)(GU + 512 + 8 * cg + 4);
#pragma unroll
        for (int rr = 0; rr < 16; ++rr) {
            if ((rr & 3) == 0) asm volatile("" : "+v"(z0), "+v"(z1) :: "memory");
            const f32x4 g0 = *(const LAS f32x4*)(GU + rr * 32 + 8 * cg), g1 = *(const LAS f32x4*)(GU + rr * 32 + 8 * cg + 4);
            z0 = z0 + g0 * dn[rr]; z1 = z1 + g1 * dn[rr]; }
#pragma unroll
        for (int j = 0; j < 8; ++j) { const float z = j < 4 ? z0[j & 3] : z1[j & 3];
            const float ls = fminf(z, 0.f) - __logf(1.f + __expf(-fabsf(z)));
            al[j] = __expf(ls * 0.0625f); }
    }
    if (Ls == SL) {
#pragma unroll
        for (int jj = 0; jj < 4; ++jj) { const float cc = R.rt[jj >> 1][2 * (jj & 1)], sn = R.rt[jj >> 1][2 * (jj & 1) + 1];
            const float q1 = q[2 * jj], q2 = q[2 * jj + 1]; q[2 * jj] = q1 * cc - q2 * sn; q[2 * jj + 1] = q1 * sn + q2 * cc;
            const float k1 = k[2 * jj], k2 = k[2 * jj + 1]; k[2 * jj] = k1 * cc - k2 * sn; k[2 * jj + 1] = k1 * sn + k2 * cc; }
    }
    LAS float* o = buf + ti * GL_STEP;
#pragma unroll
    for (int j4 = 0; j4 < 2; ++j4) {
        *(LAS f32x4*)(o + 8 * cg + 4 * j4) = (f32x4){al[4 * j4], al[4 * j4 + 1], al[4 * j4 + 2], al[4 * j4 + 3]};
        *(LAS f32x4*)(o + 32 + 8 * cg + 4 * j4) = (f32x4){k[4 * j4], k[4 * j4 + 1], k[4 * j4 + 2], k[4 * j4 + 3]};
        *(LAS f32x4*)(o + 64 + 8 * cg + 4 * j4) = (f32x4){q[4 * j4], q[4 * j4 + 1], q[4 * j4 + 2], q[4 * j4 + 3]} * 0.17677669529663687f; }
#pragma unroll
    for (int j4 = 0; j4 < 4; ++j4) *(LAS f32x4*)(o + 96 + 16 * cg + 4 * j4) = (f32x4){v[4 * j4], v[4 * j4 + 1], v[4 * j4 + 2], v[4 * j4 + 3]};
}
DI void gla_scan_chunk(const Params& p, int item, int c, const LAS float* buf, f32x2 (&S)[16], int lane, bool dry = false) {
    const int g = item & 1, h = (item >> 1) % 6, b = item / 12;
    bf16_t* AY = (bf16_t*)(p.ws + WS_AY);
    f32x4 U[2][12];
#pragma unroll
    for (int j = 0; j < 4; ++j) { U[0][3 * j] = ((const LAS f32x4*)buf)[j]; U[0][3 * j + 1] = ((const LAS f32x4*)buf)[8 + j]; U[0][3 * j + 2] = ((const LAS f32x4*)buf)[16 + j]; }
    float vv = buf[96 + lane];
    for (int st = 0; st < 16; ++st) {
        const LAS f32x4* W = (const LAS f32x4*)(buf + st * GL_STEP);
        const LAS float* bn = buf + (st < 15 ? st + 1 : st) * GL_STEP;
        const LAS f32x4* Wn = (const LAS f32x4*)bn;
        const f32x2 vv2 = (f32x2){vv, vv};
        f32x2 oacc[4];
#pragma unroll
        for (int i = 0; i < 4; ++i) oacc[i] = (f32x2){0.f, 0.f};
#pragma unroll
        for (int gi = 0; gi < 2; ++gi) {
            const int cu = gi, nx = gi ^ 1;
#pragma unroll
            for (int j = 0; j < 4; ++j) { const LAS f32x4* Wx = gi == 0 ? W : Wn; const int i = gi == 0 ? 4 + j : j;
                U[nx][3 * j] = Wx[i]; U[nx][3 * j + 1] = Wx[8 + i]; U[nx][3 * j + 2] = Wx[16 + i]; }
            if (gi == 1) vv = bn[96 + lane];
#pragma unroll
            for (int j = 0; j < 4; ++j) { const int i = 4 * gi + j; const f32x4 a4 = U[cu][3 * j], k4 = U[cu][3 * j + 1], q4 = U[cu][3 * j + 2];
                S[2 * i] = S[2 * i] * (f32x2){a4[0], a4[1]} + vv2 * (f32x2){k4[0], k4[1]}; S[2 * i + 1] = S[2 * i + 1] * (f32x2){a4[2], a4[3]} + vv2 * (f32x2){k4[2], k4[3]};
                oacc[(2 * i) & 3] += S[2 * i] * (f32x2){q4[0], q4[1]}; oacc[(2 * i + 1) & 3] += S[2 * i + 1] * (f32x2){q4[2], q4[3]}; }
            asm volatile("" : "+v"(oacc[0]), "+v"(oacc[1]), "+v"(oacc[2]), "+v"(oacc[3]) :: "memory");
        }
        const f32x2 o2 = (oacc[0] + oacc[1]) + (oacc[2] + oacc[3]);
        int row, ts, Ls; step_row(16 * c + st, g, b, row, ts, Ls);
        { const float ov = o2[0] + o2[1]; if (!dry || ov == 1.2345e37f) AY[(size_t)row * D + g * 384 + h * 64 + lane] = f2bf(ov); }
    }
}
DI void scan_unit_rw(const Params& p, int l, int su, LAS unsigned char* lds, int tid, int lane, int wave, bool dry) {
    LAS float* RWB = (LAS float*)lds; LAS float* CSB = (LAS float*)(lds + 143616);
    __syncthreads();
    for (int i = tid; i < 2 * 384; i += NTHR) { const int sl = i / 384, r = i % 384, a = r >> 6, ch = r & 63; const int it = 2 * su + sl, hh = (it >> 1) % 6;
        float v;
        if (a < 3) v = pin(p, I_MU)[(size_t)l * 1536 + a * 384 + hh * 64 + ch];
        else v = (a == 3 ? pin(p, I_KK) : (a == 4 ? pin(p, I_KA) : pin(p, I_RK)))[(size_t)l * 384 + hh * 64 + ch];
        CSB[i] = v; }
    __syncthreads();
    if (wave < 4) {
        asm volatile("" : "+v"(lane));
        const int slot = wave >> 1, hf = wave & 1, item = 2 * su + slot;
        f32x2 S[16];
#pragma unroll
        for (int i = 0; i < 16; ++i) S[i] = (f32x2){0.f, 0.f};
        __syncthreads();
        for (int c = 0; c < NCHUNK; ++c) { rwkv_scan_chunk(p, item, c, RWB + (slot * 2 + (c & 1)) * RW_BUF, S, lane, hf, dry); __syncthreads(); }
    } else if (wave < 6) {
        asm volatile("" : "+v"(lane));
        const int slot = wave & 1, item = 2 * su + slot;
        RwRaw R; rwkv_load(p, item, 0, R, lane);
        rwkv_compute(p, item, 0, R, RWB + (slot * 2 + 0) * RW_BUF, CSB + slot * 384, lane);
        rwkv_load(p, item, 1, R, lane);
        __syncthreads();
        for (int c = 0; c < NCHUNK; ++c) {
            if (c + 1 < NCHUNK) { rwkv_compute(p, item, c + 1, R, RWB + (slot * 2 + ((c + 1) & 1)) * RW_BUF, CSB + slot * 384, lane); if (c + 2 < NCHUNK) rwkv_load(p, item, c + 2, R, lane); }
            __syncthreads(); }
    } else {
        __syncthreads();
        for (int c = 0; c < NCHUNK; ++c) __syncthreads();
    }
}
DI void scan_unit_gl(const Params& p, int l, int gu, LAS unsigned char* lds, int tid, int lane, int wave, bool dry) {
    LAS float* GLB = (LAS float*)lds; LAS float* GUB = (LAS float*)(lds + 122880);
    __syncthreads();
    for (int i = tid; i < 6 * 544; i += NTHR) { const int sl = i / 544, r = i % 544; const int it = 6 * gu + sl, gg = it & 1, hh = (it >> 1) % 6;
        GUB[i] = r < 512 ? pin(p, I_GUP)[((size_t)(l * 2 + gg) * 16 + (r >> 5)) * 192 + hh * 32 + (r & 31)] : pin(p, I_GB)[(size_t)(l * 2 + gg) * 192 + hh * 32 + (r - 512)]; }
    __syncthreads();
    if (wave < 6) {
        asm volatile("" : "+v"(lane));
        const int item = 6 * gu + wave;
        f32x2 Sg[16];
#pragma unroll
        for (int i = 0; i < 16; ++i) Sg[i] = (f32x2){0.f, 0.f};
        __syncthreads();
        for (int c = 0; c < NCHUNK; ++c) { gla_scan_chunk(p, item, c, GLB + (wave * 2 + (c & 1)) * GL_BUF, Sg, lane, dry); __syncthreads(); }
    } else {
        asm volatile("" : "+v"(lane));
        const int s0 = (wave - 6) * 3;
        GlRaw R0, R1, R2;
        gla_load(p, 6 * gu + s0, 0, R0, lane); gla_load(p, 6 * gu + s0 + 1, 0, R1, lane); gla_load(p, 6 * gu + s0 + 2, 0, R2, lane);
        gla_compute(p, 6 * gu + s0, 0, R0, GLB + ((s0) * 2) * GL_BUF, GUB + (s0) * 544, lane);
        gla_compute(p, 6 * gu + s0 + 1, 0, R1, GLB + ((s0 + 1) * 2) * GL_BUF, GUB + (s0 + 1) * 544, lane);
        gla_compute(p, 6 * gu + s0 + 2, 0, R2, GLB + ((s0 + 2) * 2) * GL_BUF, GUB + (s0 + 2) * 544, lane);
        gla_load(p, 6 * gu + s0, 1, R0, lane); gla_load(p, 6 * gu + s0 + 1, 1, R1, lane); gla_load(p, 6 * gu + s0 + 2, 1, R2, lane);
        __syncthreads();
        for (int c = 0; c < NCHUNK; ++c) {
            if (c + 1 < NCHUNK) { const int nb = (c + 1) & 1;
                gla_compute(p, 6 * gu + s0, c + 1, R0, GLB + ((s0) * 2 + nb) * GL_BUF, GUB + (s0) * 544, lane);
                gla_compute(p, 6 * gu + s0 + 1, c + 1, R1, GLB + ((s0 + 1) * 2 + nb) * GL_BUF, GUB + (s0 + 1) * 544, lane);
                gla_compute(p, 6 * gu + s0 + 2, c + 1, R2, GLB + ((s0 + 2) * 2 + nb) * GL_BUF, GUB + (s0 + 2) * 544, lane);
                if (c + 2 < NCHUNK) { gla_load(p, 6 * gu + s0, c + 2, R0, lane); gla_load(p, 6 * gu + s0 + 1, c + 2, R1, lane); gla_load(p, 6 * gu + s0 + 2, c + 2, R2, lane); } }
            __syncthreads(); }
    }
}
DI void phase_mixers(const Params& p, int l, LAS unsigned char* lds, int tid, int lane, int wave, bool dry = false, int which = 3) {
    const int G = gridDim.x, bx = blockIdx.x;
    if (which & 1) for (int u = bx; u < 256; u += G) { if (u < 192) scan_unit_rw(p, l, u, lds, tid, lane, wave, dry); else scan_unit_gl(p, l, u - 192, lds, tid, lane, wave, dry); }
    const int nnat = NB * 4 * 32 * 4, nnatc = l == 0 ? NB * 4 * 16 : 0;
    if (which & 2) {
        const int ntot = nnat + nnatc;
        int n1 = 0;
        if (G == 256 && NAT_GLA_PCT > 0) {
            n1 = (ntot * NAT_GLA_PCT / 100) & ~7;
            if (bx >= 192) for (int id = (bx - 192) * NWAVE + wave; id < n1; id += 64 * NWAVE) { if (id < nnat) nat_unit(p, l, id, false, lane); else nat_unit(p, l, id - nnat, true, lane); }
        }
        int nwv = G * NWAVE, w0v = bx * NWAVE + wave;
        if (G == 256 && NAT_GLA_PCT < 0) { nwv = 192 * NWAVE; if (bx >= 192) w0v = ntot; }
        for (int id = n1 + w0v; id < ntot; id += nwv) { if (id < nnat) nat_unit(p, l, id, false, lane); else nat_unit(p, l, id - nnat, true, lane); }
    }
}

DI void phase_readout(const Params& p, int l, int nrows, int lane, int wave) {
    const int gw = blockIdx.x * NWAVE + wave, NGW = gridDim.x * NWAVE;
    const bf16_t* PB = (const bf16_t*)(p.ws + WS_PB); bf16_t* AY = (bf16_t*)(p.ws + WS_AY);
    const float* LOf = (const float*)(p.ws + WS_LO); const bf16_t* LOb = (const bf16_t*)(p.ws + WS_LO); const float* BON = (const float*)(p.ws + WS_BON);
    const bool act = lane < 48; const int c8 = act ? 8 * lane : 0, h = c8 >> 6;
    float nw[8], gnw[8], gnb[8], mu[8];
    { const float* a = pin(p, I_GNW) + l * 64 + (c8 & 63); const float* b = pin(p, I_GNWT) + l * 384 + c8; const float* c = pin(p, I_GNB) + l * 384 + c8; const float* d = pin(p, I_MU) + (size_t)l * 1536 + 768 + c8;
#pragma unroll
      for (int j = 0; j < 8; ++j) { nw[j] = a[j]; gnw[j] = b[j]; gnb[j] = c[j]; mu[j] = d[j]; } }
    for (int row = gw; row < nrows; row += NGW) {
        const bool lat = row < ML; const int t = lat ? (row & (SL - 1)) : ((row - ML) & (CL - 1)); const int Ls = lat ? SL : CL;
        const bf16_t* pr = PB + (size_t)row * PLD; bf16_t* yr = AY + (size_t)row * D;
        const u32x4 r_of = *(const u32x4*)(yr + c8), r_ob = *(const u32x4*)(yr + 384 + c8), r_gg = *(const u32x4*)(pr + C_GG + c8);
        const u32x4 r_nat = *(const u32x4*)(yr + 768 + 8 * (lane & 31));
        const float* lf = LOf + (size_t)row * (LOLD / 2) + c8;
        const f32x4 f0 = *(const f32x4*)lf, f1 = *(const f32x4*)(lf + 4), b0 = *(const f32x4*)(lf + 384), b1 = *(const f32x4*)(lf + 388);
        const bf16_t* pv = pr + C_RW + 768 + c8;
        const u32x4 r_v0 = *(const u32x4*)pv, r_vm = *(const u32x4*)(t > 0 ? pv - PLD : pv), r_vp = *(const u32x4*)(t < Ls - 1 ? pv + PLD : pv);
        const u32x4 r_gt = *(const u32x4*)(LOb + (size_t)row * LOLD + 1536 + c8);
        const float bon = BON[(size_t)row * 12 + h] + BON[(size_t)row * 12 + 6 + h];
        const float mm = t > 0 ? 0.5f : 0.f, mp = t < Ls - 1 ? 0.5f : 0.f;
        float of[8], ob[8], gg[8], v0[8], vm[8], vp[8], gt[8];
        cvt8(r_of, of); cvt8(r_ob, ob); cvt8(r_gg, gg); cvt8(r_v0, v0); cvt8(r_vm, vm); cvt8(r_vp, vp); cvt8(r_gt, gt);
        float og[8], orw[8]; float ss = 0.f, sm = 0.f;
#pragma unroll
        for (int j = 0; j < 8; ++j) { og[j] = of[j] + ob[j]; ss += og[j] * og[j]; orw[j] = (j < 4 ? f0[j & 3] : f1[j & 3]) + (j < 4 ? b0[j & 3] : b1[j & 3]); sm += orw[j]; }
        ss = sum8(ss); sm = sum8(sm);
        const float mean = sm * (1.f / 64.f); float sq = 0.f;
#pragma unroll
        for (int j = 0; j < 8; ++j) { orw[j] -= mean; sq += orw[j] * orw[j]; }
        sq = sum8(sq);
        float e1 = 1e-5f, e2 = 64e-5f; asm volatile("" : "+v"(e1), "+v"(e2));
        const float rg = rsqrtf(ss * (1.f / 64.f) + e1), rn = rsqrtf(sq * (1.f / 64.f) + e2);
        float yg[8], yw[8];
#pragma unroll
        for (int j = 0; j < 8; ++j) { yg[j] = og[j] * rg * nw[j] * (gg[j] * sigm(gg[j]));
            const float vs = v0[j] + ((mm * vm[j] + mp * vp[j]) - v0[j]) * mu[j];
            yw[j] = (orw[j] * rn * gnw[j] + gnb[j] + bon * vs) * gt[j]; }
        asm volatile("s_waitcnt vmcnt(0)" ::: "memory");
        if (act) { u32x4 o; o.x = cvtpk(yg[0], yg[1]); o.y = cvtpk(yg[2], yg[3]); o.z = cvtpk(yg[4], yg[5]); o.w = cvtpk(yg[6], yg[7]); *(u32x4*)(yr + c8) = o;
            u32x4 w; w.x = cvtpk(yw[0], yw[1]); w.y = cvtpk(yw[2], yw[3]); w.z = cvtpk(yw[4], yw[5]); w.w = cvtpk(yw[6], yw[7]); *(u32x4*)(yr + 640 + c8) = w; }
        if (lane < 32) *(u32x4*)(yr + 384 + 8 * lane) = r_nat;
    }
}

#define XB_TMO      128
#define XB_XCNT(j)  (256  + 64 * (j))
#define XB_XSUB(j)  (1280 + 64 * (j))
#define XB_XGEN(j)  (2304 + 64 * (j))
#define XB_TOP      3328
#define XB_TOPGEN   3392
#define XCD_BAR_WORDS 3456
#define XB_SPIN_CAP (1u << 18)

__device__ __forceinline__ unsigned xb_ld(unsigned* p)              { return __hip_atomic_load(p, __ATOMIC_RELAXED, __HIP_MEMORY_SCOPE_AGENT); }
__device__ __forceinline__ unsigned xb_add(unsigned* p, unsigned v) { return __hip_atomic_fetch_add(p, v, __ATOMIC_RELAXED, __HIP_MEMORY_SCOPE_AGENT); }
__device__ __forceinline__ unsigned xb_xcc_id() { return (unsigned)__builtin_amdgcn_s_getreg((3 << 11) | 20) & 0xFu; }
#define XB_SPIN(cond, bar) do { unsigned _sp = 0; while (cond) { __builtin_amdgcn_s_sleep(1); \
    if ((++_sp & 255u) == 0u) { if (xb_ld(&(bar)[XB_TMO])) break; if (_sp > XB_SPIN_CAP) { atomicAdd(&(bar)[XB_TMO], 1u); break; } } } } while (0)

struct XcdBarrier {
    unsigned* bar; unsigned x;
    volatile LAS unsigned* st;
};

__device__ __forceinline__ XcdBarrier xcd_barrier_post(unsigned* bar, volatile LAS unsigned* st, int tid) {
    XcdBarrier b; b.bar = bar; b.x = xb_xcc_id(); b.st = st;
    if (tid == 0) (void)xb_add(&bar[XB_XCNT(b.x)], 1u);
    return b;
}
__device__ __forceinline__ void xcd_barrier_complete(unsigned* bar, unsigned x, unsigned& nloc, unsigned& nx) {
    const unsigned G = gridDim.x * gridDim.y * gridDim.z;
    unsigned sum, cnt, mine, sp = 0u;
    for (;;) {
        sum = 0u; cnt = 0u; mine = 0u;
#pragma unroll
        for (unsigned j = 0; j < 16; ++j) { const unsigned c = xb_ld(&bar[XB_XCNT(j)]); sum += c; cnt += (c > 0u) ? 1u : 0u; mine = (j == x) ? c : mine; }
        if (sum == G) break;
        __builtin_amdgcn_s_sleep(1);
        if ((++sp & 255u) == 0u) { if (xb_ld(&bar[XB_TMO])) break; if (sp > XB_SPIN_CAP) { atomicAdd(&bar[XB_TMO], 1u); break; } }
    }
    nloc = mine > 0u ? mine : 1u; nx = cnt > 0u ? cnt : 1u;
}

__device__ __forceinline__ void xcd_barrier(const XcdBarrier& b, int tid) {
    asm volatile("s_waitcnt vmcnt(0)" ::: "memory");
    __syncthreads();
    if (tid == 0) {
        unsigned* bar = b.bar;
        __builtin_amdgcn_s_waitcnt(0);
        unsigned nloc = b.st[0], nx = b.st[1];
        if (nloc == 0u) { xcd_barrier_complete(bar, b.x, nloc, nx); b.st[0] = nloc; b.st[1] = nx; }
        const unsigned old = xb_add(&bar[XB_XSUB(b.x)], 1u);
        const unsigned gen = old / nloc;
        if (old + 1u == (gen + 1u) * nloc) {
            __builtin_amdgcn_fence(__ATOMIC_RELEASE, "agent");
            asm volatile("s_waitcnt vmcnt(0)" ::: "memory");
            const unsigned og = xb_add(&bar[XB_TOP], 1u);
            const unsigned tg = og / nx;
            if (og + 1u == (tg + 1u) * nx) xb_add(&bar[XB_TOPGEN], 1u);
            else XB_SPIN(xb_ld(&bar[XB_TOPGEN]) == tg, bar);
            __builtin_amdgcn_fence(__ATOMIC_ACQUIRE, "agent");
            xb_add(&bar[XB_XGEN(b.x)], 1u);
            asm volatile("s_waitcnt vmcnt(0)" ::: "memory");
        } else {
            XB_SPIN(xb_ld(&bar[XB_XGEN(b.x)]) == gen, bar);
            __builtin_amdgcn_fence(__ATOMIC_ACQUIRE, "agent");
            asm volatile("s_waitcnt vmcnt(0)" ::: "memory");
        }
    }
    __syncthreads();
}


DI void grid_sync_probe() { cg::this_grid().sync(); }
DI void run_step(const Params& p, const int step, LAS unsigned char* lds, int tid, int lane, int wave) {
    const int G = gridDim.x, bx = blockIdx.x;
    unsigned char* ws = p.ws;
    const float* MOD = (const float*)(ws + WS_MOD);
    float* TC = (float*)(ws + WS_VT);
    {
        const int l = step < 2 ? 0 : (step - 2) / 10, st = step < 2 ? -1 : (step - 2) % 10;
        unsigned char* wl = ws + (size_t)l * WLB;
        const float* modl = MOD + (size_t)l * 33 * 6144;
        const int Mff = l == 0 ? MT : ML;
        if (st == 0 || st == 2 || st == 5 || st == 7 || st == 8) {
            const bf16_t* gA = (const bf16_t*)(ws + WS_AY); const bf16_t* gB; int gM = Mff, gN = 1024, gK = 1024, mode = 2;
            bf16_t* eO = (bf16_t*)(ws + WS_PB); const float* ex = (const float*)p.out; const float* exc = (const float*)TC; int gofs = 2 * 1024;
            if (st == 0) { gB = (const bf16_t*)(wl + OFF_WIN); gM = MT; gN = PLD; mode = 0; }
            else if (st == 2) { gB = (const bf16_t*)(wl + OFF_BT2); gM = MT; gN = 2048; gK = 384; mode = 1; eO = (bf16_t*)(ws + WS_LO); }
            else if (st == 5) { gB = (const bf16_t*)(wl + OFF_WOUT); if (l == 0) { ex = pin(p, I_X); exc = pin(p, I_CTX); } }
            else if (st == 7) { gB = (const bf16_t*)(wl + OFF_W13); gN = 2 * FH; mode = 3; }
            else { gA = (const bf16_t*)(ws + WS_PB); gB = (const bf16_t*)(wl + OFF_W2); gK = FH; gofs = 5 * 1024; }
            asm volatile("" : "+s"(gK), "+s"(gM), "+s"(gN), "+s"(mode), "+s"(gofs));
            asm volatile("" : "+s"(gA), "+s"(gB), "+s"(eO), "+s"(ex), "+s"(exc));
            const pg8::Gemm g{gA, gB, gM, gN, gK};
            const pg8::EpiAny E{mode, pg8::EpiStoreBf16{eO, PLD}, pg8::EpiLora{eO, pin(p, I_W0) + (size_t)l * 768, pin(p, I_A0) + (size_t)l * 768},
                                pg8::EpiRes{ex, exc, p.out, TC, modl, gofs}, pg8::EpiSwiglu{eO}};
            pg8::StaticOrder S; S.init(g.M, g.N, G, bx);
#if defined(PROBE_GEMM)
            int nrep = (st == 0 || st == 2 || st == 7) ? 2 : 1; asm volatile("" : "+s"(nrep));
#pragma unroll 1
            for (int rep = 0; rep < nrep; ++rep) { pg8::gemm_phase<pg8::EpiAny, pg8::StaticOrder, true, true>(lds, g, S, E, tid); __syncthreads(); }
#else
            pg8::gemm_phase<pg8::EpiAny, pg8::StaticOrder, true, true>(lds, g, S, E, tid);
#endif
        }
#ifndef ONLYGEMM
        else if (step == 0) phase_prologue(p, lds, tid, lane, wave);
        else if (step == 1) phase_modulate0(p, lane, wave);
        else if (st == 1) phase_prep(p, l, lds, lane, wave);
#if defined(PROBE_MIX)
        else if (st == 3) { int nrep = 2; asm volatile("" : "+s"(nrep));
#pragma unroll 1
            for (int rep = 0; rep < nrep; ++rep) { phase_mixers(p, l, lds, tid, lane, wave, rep + 1 < nrep, rep + 1 < nrep ? PROBE_MIX : 3); __syncthreads(); grid_sync_probe(); } }
#else
        else if (st == 3) phase_mixers(p, l, lds, tid, lane, wave);
#endif
        else if (st == 4) phase_readout(p, l, Mff, lane, wave);
        else if (st == 6) phase_ln(p, lane, wave, Mff, pin(p, I_LN1W) + l * 1024, pin(p, I_LN1B) + l * 1024, modl, 3 * 1024, 4 * 1024, true, true);
        else {
            if (l == 0) phase_ln(p, lane, wave, MT, pin(p, I_LN2W), pin(p, I_LN2B), MOD + (size_t)33 * 6144, 0, 1024, true, true);
            else phase_ln(p, lane, wave, ML, pin(p, I_LN2W) + 1024, pin(p, I_LN2B) + 1024, modl, 0, 1024, true, false);
        }
#endif
    }
}
#ifdef MULTI_LAUNCH
template <int STEP> __global__ void __launch_bounds__(NTHR, 2) k_step(Params p) {
    extern __shared__ __attribute__((aligned(16))) unsigned char smem[];
    const int tid = threadIdx.x, lane = tid & 63, wave = __builtin_amdgcn_readfirstlane(tid >> 6);
    run_step(p, STEP, (LAS unsigned char*)smem, tid, lane, wave);
}
template <int STEP> static void launch_steps(const Params& p, int grid, hipStream_t stream) {
    static bool attr_done = false;
    if (!attr_done) { (void)hipFuncSetAttribute((const void*)k_step<STEP>, hipFuncAttributeMaxDynamicSharedMemorySize, LDS_BYTES); attr_done = true; }
    hipLaunchKernelGGL(k_step<STEP>, dim3(grid), dim3(NTHR), LDS_BYTES, stream, p);
    if constexpr (STEP + 1 < 22) launch_steps<STEP + 1>(p, grid, stream);
}
#else
__global__ void __launch_bounds__(NTHR, 2) hybrid_fwd(Params p) {
    extern __shared__ __attribute__((aligned(16))) unsigned char smem[];
    LAS unsigned char* lds = (LAS unsigned char*)smem;
    cg::grid_group grid = cg::this_grid();
    const int wave0 = __builtin_amdgcn_readfirstlane((int)threadIdx.x >> 6);
    volatile LAS unsigned* MISC = (volatile LAS unsigned*)(lds + LDS_BYTES - 64);
#if defined(PROBE_REPEAT)
    bool repeated = false;
#endif
#pragma unroll 1
    for (int step = 0; step < 22; ++step) {
        unsigned msk = ~0u; int wave_ = wave0;
        asm volatile("" : "+s"(msk), "+s"(wave_));
        const int lane_ = (int)__builtin_amdgcn_mbcnt_hi(msk, __builtin_amdgcn_mbcnt_lo(msk, 0u));
        const int tid_ = wave_ * 64 + lane_;
        const int stepu = __builtin_amdgcn_readfirstlane(step);
        run_step(p, stepu, lds, tid_, lane_, wave_);
        XcdBarrier bar; bar.bar = (unsigned*)(p.ws + WS_BAR); bar.x = xb_xcc_id(); bar.st = MISC;
        if (stepu == 0) {
            if (tid_ < 2) MISC[tid_] = 0u;
            if (tid_ == 0) (void)xb_add(&bar.bar[XB_XCNT(bar.x)], 1u);
            grid.sync();
        } else if (stepu != 21) xcd_barrier(bar, tid_);
#if defined(PROBE_REPEAT)
        { const int st_ = step < 2 ? -1 : (step - 2) % 10; const bool rep_ok = ((PROBE_REPEAT & 1) && (st_ == 0 || st_ == 2 || st_ == 7)) || ((PROBE_REPEAT & 2) && st_ == 1) || ((PROBE_REPEAT & 4) && step == 0) || ((PROBE_REPEAT & 8) && step == 1);
          if (rep_ok && !repeated) { repeated = true; --step; } else repeated = false; }
#endif
    }
}
#endif

extern "C" void kernel_launch(void* const* d_in, const int* in_sizes, int n_in, void* d_out, int out_size, void* d_ws, size_t ws_size, hipStream_t stream) {
    static int grid = 0;
    if (grid == 0) {
        int dev = 0, cus = 0, per_cu = 0;
        if (n_in != 29 || ws_size < WS_END) { fprintf(stderr, "kernel_launch: unexpected n_in %d / ws_size %zu (need %zu)\n", n_in, ws_size, (size_t)WS_END); }
        hipGetDevice(&dev);
        hipDeviceGetAttribute(&cus, hipDeviceAttributeMultiprocessorCount, dev);
#ifndef MULTI_LAUNCH
        if (hipFuncSetAttribute((const void*)hybrid_fwd, hipFuncAttributeMaxDynamicSharedMemorySize, LDS_BYTES) != hipSuccess) fprintf(stderr, "kernel_launch: hipFuncSetAttribute failed\n");
        if (hipOccupancyMaxActiveBlocksPerMultiprocessor(&per_cu, (const void*)hybrid_fwd, NTHR, LDS_BYTES) != hipSuccess || per_cu < 1) { fprintf(stderr, "kernel_launch: occupancy query gave %d\n", per_cu); per_cu = 1; }
#endif
        (void)hipGetLastError();
        grid = cus > 0 ? cus : 256;
    }
    Params p{};
    for (int i = 0; i < 29; ++i) p.in[i] = (const float*)d_in[i];
    p.out = (float*)d_out; p.ws = (unsigned char*)d_ws;
#ifdef MULTI_LAUNCH
    launch_steps<0>(p, grid, stream);
#else
    (void)hipMemsetAsync((unsigned char*)d_ws + WS_BAR, 0, 16384, stream);
    void* args[] = {&p};
    hipError_t e = hipLaunchCooperativeKernel((const void*)hybrid_fwd, dim3(grid), dim3(NTHR), args, LDS_BYTES, stream);
    if (e != hipSuccess) fprintf(stderr, "kernel_launch: cooperative launch failed: %s (grid %d)\n", hipGetErrorString(e), grid);
#endif
}
```

```cpp
#include <hip/hip_runtime.h>
#include <hip/hip_cooperative_groups.h>
#include <cstdio>
#include <cstdint>
namespace cg = cooperative_groups;
namespace pg8 {
#define PG8_LAS __attribute__((address_space(3)))
typedef unsigned short bf16_t;
typedef short bf16x8 __attribute__((ext_vector_type(8)));
typedef float f32x4 __attribute__((ext_vector_type(4)));
typedef unsigned u32x4 __attribute__((ext_vector_type(4)));
constexpr int BM = 256, BK = 64, HALF = 128, HTB = HALF * BK * 2  , STAGE_BYTES = 8 * HTB, NXCD = 8, WGM = 8;

__host__ __device__ __forceinline__ int lds_byte(int r, int c) { const int st = (r >> 4) * 2 + (c >> 5), rr = r & 15, cc = c & 31, ob = rr * 64 + cc * 2; return st * 1024 + (ob ^ (((ob >> 9) & 1) << 5)); }
__host__ __device__ __forceinline__ void stage_rc(int b, int& R, int& C) { const int st = b / 1024, sb = b % 1024, swz = sb ^ (((sb >> 9) & 1) << 5); R = (st >> 1) * 16 + swz / 64; C = (st & 1) * 32 + (swz % 64) / 2; }
__host__ __device__ __forceinline__ int perm32(int rho) { const int n = rho >> 4, i = rho & 15; return 8 * (i >> 2) + 4 * n + (i & 3); }

struct Unit { int pm, pn; };
struct Gemm { const bf16_t* A; const bf16_t* Bt; int M, N, K; };

struct StaticOrder {
    int nM, nN, nwg, G, c;
    __host__ __device__ void init(int M, int N, int G_, int c_) { nM = M / BM; nN = N / BM; nwg = nM * nN; G = G_; c = c_; }
    __host__ __device__ bool next(int i, Unit& u) const {
        const long L = (long)i * G + c; if (L >= nwg) return false;
        int wgid = (int)L; { const int q = nwg / NXCD, r = nwg % NXCD, xcd = wgid % NXCD, off = wgid / NXCD; wgid = (xcd < r ? xcd * (q + 1) : r * (q + 1) + (xcd - r) * q) + off; }
        const int nig = WGM * nN, gid = wgid / nig, fm = gid * WGM, gsz = (nM - fm) < WGM ? (nM - fm) : WGM;
        u.pm = fm + ((wgid % nig) % gsz); u.pn = (wgid % nig) / gsz; return true;
    }
    __device__ __forceinline__ void a_ready(const Unit&) const {}
    __device__ __forceinline__ void done(const Unit&) const {}
};
__device__ __forceinline__ unsigned cvtpk(float lo, float hi) { typedef float v2f __attribute__((ext_vector_type(2))); typedef __bf16 v2b __attribute__((ext_vector_type(2))); v2f v = {lo, hi}; v2b b = __builtin_convertvector(v, v2b); return __builtin_bit_cast(unsigned, b); }
__device__ __forceinline__ float sigm(float x) { return 1.0f / (1.0f + __expf(-x)); }
struct EpiStoreBf16 {
    static constexpr bool PERM = true, AFTER_DRAIN = false;
    bf16_t* O; int ldc;
    __device__ __forceinline__ void operator()(const f32x4 (&acc)[2][2][4][2], const Unit& u, int wr, int wc, int fr, int fq) const {
        const int row0 = u.pm * BM + wr * 64 + fr, col0 = u.pn * BM + wc * 32 + 8 * fq;
#pragma unroll
        for (int ai = 0; ai < 2; ++ai)
#pragma unroll
            for (int m = 0; m < 4; ++m) { bf16_t* rowp = O + (size_t)(row0 + ai * HALF + m * 16) * ldc + col0;
#pragma unroll
                for (int bj = 0; bj < 2; ++bj) { const f32x4 v0 = acc[ai][bj][m][0], v1 = acc[ai][bj][m][1];
                    u32x4 w; w.x = cvtpk(v0[0], v0[1]); w.y = cvtpk(v0[2], v0[3]); w.z = cvtpk(v1[0], v1[1]); w.w = cvtpk(v1[2], v1[3]);
                    *(u32x4*)(rowp + bj * HALF) = w; } }
    }
};
struct EpiLora {
    static constexpr bool PERM = true, AFTER_DRAIN = false;
    bf16_t* O; const float* w0; const float* a0;
    __device__ __forceinline__ void operator()(const f32x4 (&acc)[2][2][4][2], const Unit& u, int wr, int wc, int fr, int fq) const {
        const int row0 = u.pm * BM + wr * 64 + fr;
#pragma unroll
        for (int bj = 0; bj < 2; ++bj) {
            const int cb = u.pn * 2 + bj;
            if (cb < 15) {
                const int c0 = cb * 128 + wc * 32 + 8 * fq;
                if (cb >= 12) {
#pragma unroll
                    for (int ai = 0; ai < 2; ++ai)
#pragma unroll
                        for (int m = 0; m < 4; ++m) { const f32x4 v0 = acc[ai][bj][m][0], v1 = acc[ai][bj][m][1];
                            u32x4 w; w.x = cvtpk(v0[0], v0[1]); w.y = cvtpk(v0[2], v0[3]); w.z = cvtpk(v1[0], v1[1]); w.w = cvtpk(v1[2], v1[3]);
                            *(u32x4*)(O + (size_t)(row0 + ai * HALF + m * 16) * 1920 + c0) = w; }
                } else {
                    const int kind = wc >> 1, g = cb / 6, h = cb % 6;
                    const float* a0v = a0; const float* w0v = w0; asm volatile("" : "+s"(a0v), "+s"(w0v));
                    const float* bp = (kind ? a0v : w0v) + g * 384 + h * 64 + (wc & 1) * 32 + 8 * fq;
                    const f32x4 b0 = *(const f32x4*)bp, b1 = *(const f32x4*)(bp + 4);
                    const float mul = kind == 0 ? 0.60653065971263342f : 1.f;
#pragma unroll
                    for (int ai = 0; ai < 2; ++ai)
#pragma unroll
                        for (int m = 0; m < 4; ++m) { const f32x4 v0 = acc[ai][bj][m][0] + b0, v1 = acc[ai][bj][m][1] + b1;
                            u32x4 w; w.x = cvtpk(mul * sigm(v0[0]), mul * sigm(v0[1])); w.y = cvtpk(mul * sigm(v0[2]), mul * sigm(v0[3]));
                            w.z = cvtpk(mul * sigm(v1[0]), mul * sigm(v1[1])); w.w = cvtpk(mul * sigm(v1[2]), mul * sigm(v1[3]));
                            *(u32x4*)(O + (size_t)(row0 + ai * HALF + m * 16) * 1920 + c0) = w; }
                }
            }
        }
    }
};
struct EpiRes {
    static constexpr bool PERM = true, AFTER_DRAIN = false;
    const float* xl; const float* xc; float* ol; float* oc; const float* mod; int gofs;
    __device__ __forceinline__ void operator()(const f32x4 (&acc)[2][2][4][2], const Unit& u, int wr, int wc, int fr, int fq) const {
        const bool lat = u.pm < 256; const int bi = lat ? (u.pm >> 3) : 32;
        const size_t rbase = (size_t)(lat ? u.pm : u.pm - 256) * BM;
        const float* xlv = xl; const float* xcv = xc; float* olv = ol; float* ocv = oc; asm volatile("" : "+s"(xlv), "+s"(xcv), "+s"(olv), "+s"(ocv));
        const float* xin = (lat ? xlv : xcv) + rbase * 1024; float* out = (lat ? olv : ocv) + rbase * 1024;
        const float* gp = mod + (size_t)bi * 6144 + gofs;
        const int col0 = u.pn * BM + wc * 32 + 8 * fq, row0 = wr * 64 + fr;
#pragma unroll
        for (int bj = 0; bj < 2; ++bj)
#pragma unroll
            for (int n = 0; n < 2; ++n) { const int c = col0 + bj * HALF + 4 * n; const f32x4 gt = *(const f32x4*)(gp + c);
#pragma unroll
                for (int ai = 0; ai < 2; ++ai)
#pragma unroll
                    for (int m = 0; m < 4; ++m) { const size_t o = (size_t)(row0 + ai * HALF + m * 16) * 1024 + c;
                        const f32x4 xv = *(const f32x4*)(xin + o); const f32x4 a = acc[ai][bj][m][n];
                        f32x4 r; r[0] = 1.41421356237f * xv[0] + gt[0] * a[0]; r[1] = 1.41421356237f * xv[1] + gt[1] * a[1]; r[2] = 1.41421356237f * xv[2] + gt[2] * a[2]; r[3] = 1.41421356237f * xv[3] + gt[3] * a[3];
                        *(f32x4*)(out + o) = r; } }
    }
};
struct EpiSwiglu {
    static constexpr bool PERM = true, AFTER_DRAIN = false;
    bf16_t* O;
    __device__ __forceinline__ void operator()(const f32x4 (&acc)[2][2][4][2], const Unit& u, int wr, int wc, int fr, int fq) const {
        const int row0 = u.pm * BM + wr * 64 + fr, col0 = u.pn * HALF + wc * 32 + 8 * fq;
#pragma unroll
        for (int ai = 0; ai < 2; ++ai)
#pragma unroll
            for (int m = 0; m < 4; ++m) { float v[8];
#pragma unroll
                for (int i = 0; i < 8; ++i) { const float g = acc[ai][0][m][i >> 2][i & 3], up = acc[ai][1][m][i >> 2][i & 3]; v[i] = g * sigm(g) * up; }
                u32x4 w; w.x = cvtpk(v[0], v[1]); w.y = cvtpk(v[2], v[3]); w.z = cvtpk(v[4], v[5]); w.w = cvtpk(v[6], v[7]);
                *(u32x4*)(O + (size_t)(row0 + ai * HALF + m * 16) * 2816 + col0) = w; }
    }
};
struct EpiAny {
    static constexpr bool PERM = true, AFTER_DRAIN = false;
    int mode; EpiStoreBf16 e0; EpiLora e1; EpiRes e2; EpiSwiglu e3;
    __device__ __forceinline__ void operator()(const f32x4 (&acc)[2][2][4][2], const Unit& u, int wr, int wc, int fr, int fq) const {
        if (mode == 0) e0(acc, u, wr, wc, fr, fq); else if (mode == 1) e1(acc, u, wr, wc, fr, fq); else if (mode == 2) e2(acc, u, wr, wc, fr, fq); else e3(acc, u, wr, wc, fr, fq);
    }
};
template <class Epi, class Sched, bool ALIGN_EPI = false, bool SP2 = false>
__device__ __forceinline__ void gemm_phase(PG8_LAS unsigned char* lds, const Gemm g, const Sched& S, const Epi& E, const int tid) {
    const int wid = __builtin_amdgcn_readfirstlane(tid >> 6), lane = tid & 63, wr = wid >> 2, wc = wid & 3, fr = lane & 15, fq = lane >> 4;
    const int K = g.K, nt = K / BK;
    unsigned voffA[2], voffB[2];
#pragma unroll
    for (int i = 0; i < 2; ++i) { int R, C; stage_rc(tid * 16 + i * 8192, R, C); const int Rb = Epi::PERM ? ((R & ~31) + perm32(R & 31)) : R;
        voffA[i] = (unsigned)(R * K + C) * 2u; voffB[i] = (unsigned)(Rb * K + C) * 2u; }
    const size_t kstep = (size_t)(BK * 2);
    const size_t hstep = (size_t)HALF * K * 2;
    const size_t tstep = 2 * hstep;
    const unsigned ldsw = (unsigned)wid * 1024u;
    const int aoff = lds_byte(wr * 64 + fr, fq * 8), boff = lds_byte(wc * 32 + fr, fq * 8);
#define PG8_SA(b, h) (((b) * 2 + (h)) * HTB)
#define PG8_SB(b, h) ((4 + (b) * 2 + (h)) * HTB)
#define PG8_STAGE(bufoff, gbase, voff) do { _Pragma("unroll") for (int _i = 0; _i < 2; ++_i) \
        __builtin_amdgcn_global_load_lds((const unsigned*)((const char*)(gbase) + (voff)[_i]), (PG8_LAS unsigned*)(lds + (bufoff) + ldsw + _i * 8192), 16, 0, 0); } while (0)
#define PG8_LDA(dst, b, h) do { _Pragma("unroll") for (int m = 0; m < 4; ++m) _Pragma("unroll") for (int k = 0; k < 2; ++k) dst[m][k] = *(const PG8_LAS bf16x8*)(lds + PG8_SA(b, h) + aoff + m * 2048 + k * 1024); } while (0)
#define PG8_LDB(dst, b, h) do { _Pragma("unroll") for (int n = 0; n < 2; ++n) _Pragma("unroll") for (int k = 0; k < 2; ++k) dst[n][k] = *(const PG8_LAS bf16x8*)(lds + PG8_SB(b, h) + boff + n * 2048 + k * 1024); } while (0)
#define PG8_MMA(ai, bj, At, Bt) do { __builtin_amdgcn_s_setprio(1); _Pragma("unroll") for (int m = 0; m < 4; ++m) _Pragma("unroll") for (int n = 0; n < 2; ++n) _Pragma("unroll") for (int k = 0; k < 2; ++k) \
        acc[ai][bj][m][n] = __builtin_amdgcn_mfma_f32_16x16x32_bf16(Bt[n][k], At[m][k], acc[ai][bj][m][n], 0, 0, 0); __builtin_amdgcn_s_setprio(0); } while (0)
#define PG8_WAIT_V(n) asm volatile("s_waitcnt vmcnt(" #n ")" ::: "memory")
#define PG8_WAIT_L(n) asm volatile("s_waitcnt lgkmcnt(" #n ")" ::: "memory")
#define PG8_BAR __builtin_amdgcn_s_barrier()
#define PG8_SCHED __builtin_amdgcn_sched_barrier(0)
    Unit cur, nxt; int ui = 0;
    if (!S.next(0, cur)) return;
    f32x4 acc[2][2][4][2];
#pragma unroll
    for (int a = 0; a < 2; ++a)
#pragma unroll
        for (int b = 0; b < 2; ++b)
#pragma unroll
            for (int m = 0; m < 4; ++m)
#pragma unroll
                for (int n = 0; n < 2; ++n) acc[a][b][m][n] = (f32x4){0.f, 0.f, 0.f, 0.f};
    bf16x8 At[4][2], B0[2][2], B1[2][2];
    const char* cA = (const char*)g.A + (size_t)cur.pm * tstep; const char* cB = (const char*)g.Bt + (size_t)cur.pn * tstep;
    S.a_ready(cur);
    if constexpr (SP2) {
        PG8_STAGE(PG8_SB(0, 0), cB, voffB); PG8_STAGE(PG8_SB(0, 1), cB + hstep, voffB); PG8_STAGE(PG8_SA(0, 0), cA, voffA); PG8_STAGE(PG8_SA(0, 1), cA + hstep, voffA);
        if (wr == 1) PG8_BAR;
        PG8_WAIT_V(2); PG8_BAR;
        PG8_STAGE(PG8_SB(1, 0), cB + kstep, voffB); PG8_STAGE(PG8_SA(1, 0), cA + kstep, voffA); PG8_STAGE(PG8_SB(1, 1), cB + hstep + kstep, voffB);
        PG8_WAIT_V(6); PG8_BAR;
    } else {
        PG8_STAGE(PG8_SB(0, 0), cB, voffB); PG8_STAGE(PG8_SA(0, 0), cA, voffA); PG8_STAGE(PG8_SB(0, 1), cB + hstep, voffB); PG8_STAGE(PG8_SA(0, 1), cA + hstep, voffA);
        if (wr == 1) PG8_BAR;
        PG8_WAIT_V(4); PG8_BAR;
        PG8_STAGE(PG8_SB(1, 0), cB + kstep, voffB); PG8_STAGE(PG8_SA(1, 0), cA + kstep, voffA); PG8_STAGE(PG8_SB(1, 1), cB + hstep + kstep, voffB);
        PG8_WAIT_V(6); PG8_BAR;
    }
    for (;;) {
        const bool has_next = S.next(ui + 1, nxt);
        const char* nA = has_next ? (const char*)g.A + (size_t)nxt.pm * tstep : cA; const char* nB = has_next ? (const char*)g.Bt + (size_t)nxt.pn * tstep : cB;
        for (int t = 0; t < nt; t += 2) {
            const bool last = (t == nt - 2);
            const char* a1 = cA + (size_t)(t + 1) * kstep;
            const char* a2 = last ? nA : cA + (size_t)(t + 2) * kstep; const char* b2 = last ? nB : cB + (size_t)(t + 2) * kstep;
            const char* a3 = a2 + kstep; const char* b3 = b2 + kstep;
            if (last && has_next) S.a_ready(nxt);
            if constexpr (SP2) {
            PG8_LDB(B0, 0, 0); PG8_LDB(B1, 0, 1); PG8_SCHED; PG8_LDA(At, 0, 0); PG8_STAGE(PG8_SA(1, 1), a1 + hstep, voffA);
            PG8_WAIT_V(8); PG8_WAIT_L(0); PG8_BAR; PG8_MMA(0, 0, At, B0); PG8_MMA(0, 1, At, B1); PG8_BAR; PG8_SCHED;
            PG8_LDA(At, 0, 1); PG8_STAGE(PG8_SB(0, 0), b2, voffB); PG8_STAGE(PG8_SB(0, 1), b2 + hstep, voffB); PG8_STAGE(PG8_SA(0, 0), a2, voffA);
            PG8_WAIT_V(8); PG8_WAIT_L(0); PG8_BAR; PG8_MMA(1, 0, At, B0); PG8_MMA(1, 1, At, B1); PG8_BAR; PG8_SCHED;
            PG8_LDB(B0, 1, 0); PG8_LDB(B1, 1, 1); PG8_SCHED; PG8_LDA(At, 1, 0); PG8_STAGE(PG8_SA(0, 1), a2 + hstep, voffA);
            PG8_WAIT_V(8); PG8_WAIT_L(0); PG8_BAR; PG8_MMA(0, 0, At, B0); PG8_MMA(0, 1, At, B1); PG8_BAR; PG8_SCHED;
            PG8_LDA(At, 1, 1); PG8_STAGE(PG8_SB(1, 0), b3, voffB); PG8_STAGE(PG8_SB(1, 1), b3 + hstep, voffB); PG8_STAGE(PG8_SA(1, 0), a3, voffA);
            PG8_WAIT_V(8); PG8_WAIT_L(0); PG8_BAR; PG8_MMA(1, 0, At, B0); PG8_MMA(1, 1, At, B1); PG8_BAR; PG8_SCHED;
            } else {
            PG8_LDB(B0, 0, 0); PG8_SCHED; PG8_LDA(At, 0, 0); PG8_STAGE(PG8_SA(1, 1), a1 + hstep, voffA);
            PG8_WAIT_L(8); PG8_BAR; PG8_WAIT_L(0); PG8_MMA(0, 0, At, B0); PG8_BAR; PG8_SCHED;
            PG8_LDB(B1, 0, 1); PG8_STAGE(PG8_SB(0, 0), b2, voffB);
            PG8_BAR; PG8_WAIT_L(0); PG8_MMA(0, 1, At, B1); PG8_BAR;
            PG8_LDA(At, 0, 1); PG8_STAGE(PG8_SA(0, 0), a2, voffA);
            PG8_BAR; PG8_WAIT_L(0); PG8_MMA(1, 0, At, B0); PG8_BAR; PG8_SCHED;
            PG8_STAGE(PG8_SB(0, 1), b2 + hstep, voffB);
            PG8_WAIT_V(6); PG8_BAR; PG8_MMA(1, 1, At, B1); PG8_BAR;
            PG8_LDB(B0, 1, 0); PG8_SCHED; PG8_LDA(At, 1, 0); PG8_STAGE(PG8_SA(0, 1), a2 + hstep, voffA);
            PG8_WAIT_L(8); PG8_BAR; PG8_WAIT_L(0); PG8_MMA(0, 0, At, B0); PG8_BAR; PG8_SCHED;
            PG8_LDB(B1, 1, 1); PG8_STAGE(PG8_SB(1, 0), b3, voffB);
            PG8_BAR; PG8_WAIT_L(0); PG8_MMA(0, 1, At, B1); PG8_BAR;
            PG8_LDA(At, 1, 1); PG8_STAGE(PG8_SA(1, 0), a3, voffA);
            PG8_BAR; PG8_WAIT_L(0); PG8_MMA(1, 0, At, B0); PG8_BAR; PG8_SCHED;
            PG8_STAGE(PG8_SB(1, 1), b3 + hstep, voffB);
            PG8_WAIT_V(6); PG8_BAR; PG8_MMA(1, 1, At, B1); PG8_BAR;
            }
        }
        if constexpr (ALIGN_EPI) { if (wr == 0) PG8_BAR; }
        if constexpr (!Epi::AFTER_DRAIN) { E(acc, cur, wr, wc, fr, fq); S.done(cur); }
        if (!has_next) break;
#pragma unroll
        for (int a = 0; a < 2; ++a)
#pragma unroll
            for (int b = 0; b < 2; ++b)
#pragma unroll
                for (int m = 0; m < 4; ++m)
#pragma unroll
                    for (int n = 0; n < 2; ++n) acc[a][b][m][n] = (f32x4){0.f, 0.f, 0.f, 0.f};
        cur = nxt; cA = nA; cB = nB; ++ui;
        if constexpr (ALIGN_EPI) { if (wr == 1) PG8_BAR; }
    }
    PG8_WAIT_V(0);
    if constexpr (!ALIGN_EPI) { if (wr == 0) PG8_BAR; }
    PG8_BAR;
    if constexpr (Epi::AFTER_DRAIN) { E.fused(acc, cur, wr, wc, fr, fq, lds, wid, lane); S.done(cur); }
#undef PG8_SA
#undef PG8_SB
#undef PG8_STAGE
#undef PG8_LDA
#undef PG8_LDB
#undef PG8_MMA
#undef PG8_WAIT_V
#undef PG8_WAIT_L
#undef PG8_BAR
#undef PG8_SCHED
}
}

#define DI __device__ __forceinline__
#define LAS __attribute__((address_space(3)))
using pg8::bf16_t; using pg8::bf16x8; using pg8::f32x4; using pg8::u32x4; using pg8::cvtpk; using pg8::sigm;
typedef float f32x2 __attribute__((ext_vector_type(2)));
typedef unsigned u32x2 __attribute__((ext_vector_type(2)));

#ifndef NAT_IN
#define NAT_IN 24
#endif
#ifndef MIXMASK
#define MIXMASK 3
#endif
#ifndef ROLEMASK
#define ROLEMASK 15
#endif
#ifndef PHMASK
#define PHMASK 0xffff
#endif
constexpr int NTHR = 512, NWAVE = 8, LDS_BYTES = 147456;
constexpr int D = 1024, NB = 32, SL = 2048, CL = 256, ML = NB * SL, MC = NB * CL, MT = ML + MC;
constexpr int INC = 3488, PLD = 3584, FH = 2816, LOLD = 1920;
constexpr int C_NQ = 0, C_NK = 256, C_NV = 512;
constexpr int C_GQ = 768, C_GK = 960, C_GV = 1152, C_GG = 1536, C_GDN = 1920;
constexpr int C_RW = 1952;
constexpr size_t OFF_WIN = 0, OFF_WOUT = 7340032, OFF_W13 = 9437184, OFF_W2 = 20971520, OFF_BT2 = 26738688, WLB = 28311552;
constexpr size_t WS_MOD = 2 * WLB, WS_ROPE = WS_MOD + 1622016, WS_BON = WS_ROPE + 262144, WS_VT = WS_BON + 3538944, WS_AY = WS_VT + 37748736,
                 WS_PB = WS_AY + 150994944, WS_LO = WS_PB + 528482304, WS_BAR = WS_LO + 283115520, WS_END = WS_BAR + 16384;

struct Params { const float* in[29]; float* out; unsigned char* ws; };
enum { I_X = 0, I_C, I_CTX, I_CCTX, I_WMOD, I_BMOD, I_WIN, I_GUP, I_GB, I_GNW, I_RPB, I_MU, I_W0, I_WD2, I_A0, I_WA2, I_WG2, I_KK, I_KA, I_RK, I_GNWT, I_GNB,
       I_WOUT, I_LN1W, I_LN1B, I_W13, I_W2, I_LN2W, I_LN2B };

DI const float* pin(const Params& p, int i) { asm volatile("" : "+s"(i)); return p.in[i]; }
DI float bf2f(bf16_t h) { return __uint_as_float(((unsigned)h) << 16); }
DI float bflo(unsigned u) { return __uint_as_float(u << 16); }
DI float bfhi(unsigned u) { return __uint_as_float(u & 0xffff0000u); }
DI bf16_t f2bf(float f) { return (bf16_t)(cvtpk(f, 0.f) & 0xffffu); }
DI float shx(float v, int m, int lane) { return __int_as_float(__builtin_amdgcn_ds_bpermute((lane ^ m) << 2, __float_as_int(v))); }
#define DPPF(v, ctrl) __int_as_float(__builtin_amdgcn_mov_dpp(__float_as_int(v), (ctrl), 0xf, 0xf, true))
DI float sum4(float v) { v += DPPF(v, 0xB1); v += DPPF(v, 0x4E); return v; }
DI float sum8(float v) { v = sum4(v); v += DPPF(v, 0x141); return v; }
DI float sum16(float v) { v = sum8(v); v += DPPF(v, 0x140); return v; }
DI float x16_sum(float x) { const auto r = __builtin_amdgcn_permlane16_swap(__float_as_uint(x), __float_as_uint(x), false, false); return __uint_as_float(r[0]) + __uint_as_float(r[1]); }
DI float x32_sum(float x) { const auto r = __builtin_amdgcn_permlane32_swap(__float_as_uint(x), __float_as_uint(x), false, false); return __uint_as_float(r[0]) + __uint_as_float(r[1]); }
DI float x16_max(float x) { const auto r = __builtin_amdgcn_permlane16_swap(__float_as_uint(x), __float_as_uint(x), false, false); return fmaxf(__uint_as_float(r[0]), __uint_as_float(r[1])); }
DI float x32_max(float x) { const auto r = __builtin_amdgcn_permlane32_swap(__float_as_uint(x), __float_as_uint(x), false, false); return fmaxf(__uint_as_float(r[0]), __uint_as_float(r[1])); }
DI float wave_sum(float v, int) { return x32_sum(x16_sum(sum16(v))); }
DI void cvt8(const u32x4 u, float* o) { o[0] = bflo(u.x); o[1] = bfhi(u.x); o[2] = bflo(u.y); o[3] = bfhi(u.y); o[4] = bflo(u.z); o[5] = bfhi(u.z); o[6] = bflo(u.w); o[7] = bfhi(u.w); }
DI void load8(const bf16_t* p, float* o) { const u32x4 u = *(const u32x4*)p; o[0] = bflo(u.x); o[1] = bfhi(u.x); o[2] = bflo(u.y); o[3] = bfhi(u.y); o[4] = bflo(u.z); o[5] = bfhi(u.z); o[6] = bflo(u.w); o[7] = bfhi(u.w); }
DI void load16(const bf16_t* p, float (&o)[16]) { load8(p, &o[0]); load8(p + 8, &o[8]); }
DI void shift16(const bf16_t* prow, bool hasm, bool hasp, const float* mu, float (&y)[16]) {
    float c0[16], cm[16], cp[16];
    load16(prow, c0);
    if (hasm) load16(prow - PLD, cm); else {
#pragma unroll
        for (int j = 0; j < 16; ++j) cm[j] = 0.f; }
    if (hasp) load16(prow + PLD, cp); else {
#pragma unroll
        for (int j = 0; j < 16; ++j) cp[j] = 0.f; }
#pragma unroll
    for (int j = 0; j < 16; ++j) y[j] = c0[j] + (0.5f * (cm[j] + cp[j]) - c0[j]) * mu[j];
}
DI void step_row(int s, int g, int b, int& row, int& ts, int& Ls) {
    if (s < CL) { ts = g ? (CL - 1 - s) : s; row = ML + b * CL + ts; Ls = CL; }
    else { const int u = s - CL; ts = g ? (SL - 1 - u) : u; row = b * SL + ts; Ls = SL; }
}

DI void transpose_item(const float* W, int N, bf16_t* WT, int Kd, size_t dst_row0, int k0, int n0, LAS float* scr, int lane) {
#pragma unroll 8
    for (int i = 0; i < 32; ++i) { const int kk = 2 * i + (lane >> 5); scr[kk * 33 + (lane & 31)] = W[(size_t)(k0 + kk) * N + n0 + (lane & 31)]; }
    asm volatile("s_waitcnt lgkmcnt(0)" ::: "memory");
    const int c = lane & 7;
#pragma unroll
    for (int j = 0; j < 4; ++j) { const int n = (lane >> 3) + 8 * j; const LAS float* s = scr + (8 * c) * 33 + n;
        u32x4 o; o.x = cvtpk(s[0 * 33], s[1 * 33]); o.y = cvtpk(s[2 * 33], s[3 * 33]); o.z = cvtpk(s[4 * 33], s[5 * 33]); o.w = cvtpk(s[6 * 33], s[7 * 33]);
        *(u32x4*)(WT + (dst_row0 + n) * Kd + k0 + 8 * c) = o; }
    asm volatile("s_waitcnt lgkmcnt(0)" ::: "memory");
}

DI void phase_prologue(const Params& p, LAS unsigned char* lds, int tid, int lane, int wave) {
    unsigned char* ws = p.ws;
    float* MOD = (float*)(ws + WS_MOD);
    {
        LAS float* sc = (LAS float*)lds;
        LAS float* part = (LAS float*)(lds + 135168);
        for (int i = tid; i < 33 * 1024; i += NTHR) { const int bi = i >> 10, k = i & 1023; const float cv = bi < 32 ? pin(p, I_C)[bi * 1024 + k] : pin(p, I_CCTX)[k]; sc[k * 33 + bi] = cv * sigm(cv); }
        __syncthreads();
        for (int u = blockIdx.x; u < 192; u += gridDim.x) {
            const int l = u / 96, n0 = (u % 96) * 64;
            float acc[33];
#pragma unroll
            for (int bi = 0; bi < 33; ++bi) acc[bi] = 0.f;
            const float* wp = pin(p, I_WMOD) + (size_t)l * 1024 * 6144 + n0 + lane;
#pragma unroll 4
            for (int kk = 0; kk < 128; ++kk) { const int k = wave * 128 + kk; const float w = wp[(size_t)k * 6144];
#pragma unroll
                for (int bi = 0; bi < 33; ++bi) acc[bi] += sc[k * 33 + bi] * w; }
            for (int w = 0; w < NWAVE; ++w) {
                if (wave == w) {
#pragma unroll
                    for (int bi = 0; bi < 33; ++bi) { if (w == 0) part[bi * 64 + lane] = acc[bi]; else part[bi * 64 + lane] += acc[bi]; } }
                __syncthreads();
            }
            for (int i = tid; i < 33 * 64; i += NTHR) { const int bi = i >> 6, n = i & 63; MOD[(size_t)(l * 33 + bi) * 6144 + n0 + n] = part[i] + pin(p, I_BMOD)[l * 6144 + n0 + n]; }
            __syncthreads();
        }
        __syncthreads();
    }
    const int gw = blockIdx.x * NWAVE + wave, NGW = gridDim.x * NWAVE;
    const int gt = blockIdx.x * NTHR + tid, NGT = gridDim.x * NTHR;
    {
        LAS float* scr = (LAS float*)(lds + wave * 8448);
        constexpr int IT_IN = 16 * 109, IT_OUT = 16 * 32, IT_13 = 16 * 176, IT_2 = 44 * 32, IT_L = IT_IN + IT_OUT + IT_13 + IT_2;
        for (int it = gw; it < 2 * IT_L; it += NGW) {
            const int l = it / IT_L; int r = it % IT_L;
            unsigned char* wl = ws + (size_t)l * WLB;
            if (r < IT_IN) { const int kb = r / 109, nb = r % 109;
                const int n0 = nb * 32; const int drow = n0 < 1184 ? n0 + 768 : (n0 < 1952 ? n0 - 1184 : n0);
                transpose_item(pin(p, I_WIN) + (size_t)l * 1024 * INC, INC, (bf16_t*)(wl + OFF_WIN), 1024, (size_t)drow, kb * 64, n0, scr, lane); continue; }
            r -= IT_IN;
            if (r < IT_OUT) { const int kb = r / 32, nb = r % 32;
                transpose_item(pin(p, I_WOUT) + (size_t)l * 1024 * 1024, 1024, (bf16_t*)(wl + OFF_WOUT), 1024, (size_t)nb * 32, kb * 64, nb * 32, scr, lane); continue; }
            r -= IT_OUT;
            if (r < IT_13) { const int kb = r / 176, nb = r % 176; const int n0 = nb * 32;
                const int j = n0 < FH ? n0 : n0 - FH; const size_t drow = (size_t)(256 * (j / 128) + (n0 < FH ? 0 : 128) + (j % 128));
                transpose_item(pin(p, I_W13) + (size_t)l * 1024 * 2 * FH, 2 * FH, (bf16_t*)(wl + OFF_W13), 1024, drow, kb * 64, n0, scr, lane); continue; }
            r -= IT_13;
            { const int kb = r / 32, nb = r % 32;
                transpose_item(pin(p, I_W2) + (size_t)l * FH * 1024, 1024, (bf16_t*)(wl + OFF_W2), FH, (size_t)nb * 32, kb * 64, nb * 32, scr, lane); }
        }
    }
    for (int i = gt; i < 2 * 96 * 1024; i += NGT) { const int l = i / (96 * 1024), r = i % (96 * 1024); ((bf16_t*)(ws + (size_t)l * WLB + OFF_WIN))[(size_t)INC * 1024 + r] = 0; }
    for (int i = gt; i < 2 * 2048 * 384; i += NGT) {
        const int l = i / (2048 * 384), r = i % (2048 * 384), n = r / 384, k = r % 384;
        float v = 0.f;
        if (n < 1536) { const int g = n / 768, h = (n % 768) / 128, which = (n % 128) / 64, ch = n % 64, c = h * 64 + ch;
            const int kb = which ? 128 + 64 * g : 64 * g;
            if (k >= kb && k < kb + 64) v = (which ? pin(p, I_WA2) : pin(p, I_WD2))[((size_t)(l * 2 + g) * 64 + (k - kb)) * 384 + c]; }
        else if (n < 1920) { if (k >= 256) v = pin(p, I_WG2)[((size_t)l * 128 + (k - 256)) * 384 + (n - 1536)]; }
        ((bf16_t*)(ws + (size_t)l * WLB + OFF_BT2))[r] = f2bf(v);
    }
    for (int i = gt; i < SL * 16; i += NGT) { const int t = i >> 4, pi = i & 15; const float pos = (float)(pi < 8 ? (t >> 6) : (t & 63));
        const float inv = powf(10000.0f, -(float)(pi & 7) * 0.125f); const float ang = pos * inv;
        float* rt = (float*)(ws + WS_ROPE) + (size_t)i * 2; rt[0] = cosf(ang); rt[1] = sinf(ang); }
}

DI void phase_modulate0(const Params& p, int lane, int wave) {
    const int gw = blockIdx.x * NWAVE + wave, NGW = gridDim.x * NWAVE;
    const float* MOD = (const float*)(p.ws + WS_MOD); bf16_t* A = (bf16_t*)(p.ws + WS_AY);
    for (int row = gw; row < MT; row += NGW) {
        const float* src = row < ML ? pin(p, I_X) + (size_t)row * D : pin(p, I_CTX) + (size_t)(row - ML) * D;
        const int bi = row < ML ? (row >> 11) : 32; const float* md = MOD + (size_t)bi * 6144;
#pragma unroll
        for (int j = 0; j < 4; ++j) { const int c = 4 * (lane + 64 * j); const f32x4 v = *(const f32x4*)(src + c), sh = *(const f32x4*)(md + c), sc = *(const f32x4*)(md + 1024 + c);
            u32x2 o; o.x = cvtpk(v[0] * (1.f + sc[0]) + sh[0], v[1] * (1.f + sc[1]) + sh[1]); o.y = cvtpk(v[2] * (1.f + sc[2]) + sh[2], v[3] * (1.f + sc[3]) + sh[3]);
            *(u32x2*)(A + (size_t)row * D + c) = o; }
    }
}
DI void phase_ln(const Params& p, int lane, int wave, int nrows, const float* lnw, const float* lnb, const float* modl, int sh_ofs, int sc_ofs, bool write_x, bool write_A, bool dry = false) {
    const int gw = blockIdx.x * NWAVE + wave, NGW = gridDim.x * NWAVE;
    bf16_t* A = (bf16_t*)(p.ws + WS_AY); float* tc = (float*)(p.ws + WS_VT);
    f32x4 nx[4];
    if (gw < nrows) { const float* t0 = gw < ML ? p.out + (size_t)gw * D : tc + (size_t)(gw - ML) * D;
#pragma unroll
        for (int j = 0; j < 4; ++j) nx[j] = *(const f32x4*)(t0 + 4 * (lane + 64 * j)); }
    for (int row = gw; row < nrows; row += NGW) {
        const bool lat = row < ML;
        float* t = lat ? p.out + (size_t)row * D : tc + (size_t)(row - ML) * D;
        const int bi = lat ? (row >> 11) : 32;
        f32x4 v[4]; float s = 0.f;
#pragma unroll
        for (int j = 0; j < 4; ++j) { v[j] = nx[j]; s += (v[j][0] + v[j][1]) + (v[j][2] + v[j][3]); }
        { const int rn = row + NGW; if (rn < nrows) { const float* tn = rn < ML ? p.out + (size_t)rn * D : tc + (size_t)(rn - ML) * D;
#pragma unroll
            for (int j = 0; j < 4; ++j) nx[j] = *(const f32x4*)(tn + 4 * (lane + 64 * j)); } }
        const float mean = wave_sum(s, lane) * (1.f / D); float s2 = 0.f;
#pragma unroll
        for (int j = 0; j < 4; ++j) { v[j] = v[j] - mean; s2 += (v[j][0] * v[j][0] + v[j][1] * v[j][1]) + (v[j][2] * v[j][2] + v[j][3] * v[j][3]); }
        const float rstd = rsqrtf(wave_sum(s2, lane) * (1.f / D) + 1e-5f);
        const float* md = modl + (size_t)bi * 6144;
#pragma unroll
        for (int j = 0; j < 4; ++j) { const int c = 4 * (lane + 64 * j); const f32x4 w = *(const f32x4*)(lnw + c), b = *(const f32x4*)(lnb + c);
            f32x4 y; y[0] = v[j][0] * rstd * w[0] + b[0]; y[1] = v[j][1] * rstd * w[1] + b[1]; y[2] = v[j][2] * rstd * w[2] + b[2]; y[3] = v[j][3] * rstd * w[3] + b[3];
            const bool okst = !dry || y[0] == 1.2345e37f;
            if (write_x && okst) *(f32x4*)(t + c) = y;
            if (write_A && okst) { const f32x4 sh = *(const f32x4*)(md + sh_ofs + c), sc = *(const f32x4*)(md + sc_ofs + c);
                u32x2 o; o.x = cvtpk(y[0] * (1.f + sc[0]) + sh[0], y[1] * (1.f + sc[1]) + sh[1]); o.y = cvtpk(y[2] * (1.f + sc[2]) + sh[2], y[3] * (1.f + sc[3]) + sh[3]);
                *(u32x2*)(A + (size_t)row * D + c) = o; } }
    }
}

DI void phase_prep(const Params& p, int l, LAS unsigned char* lds, int lane, int wave) {
    const int gw = blockIdx.x * NWAVE + wave, NGW = gridDim.x * NWAVE;
    const bf16_t* PB = (const bf16_t*)(p.ws + WS_PB); bf16_t* A2 = (bf16_t*)(p.ws + WS_AY); bf16_t* VT = (bf16_t*)(p.ws + WS_VT);
    {
        const int j8 = lane < 48 ? 8 * lane : 0, kind = j8 >> 7;
        float mu[8];
        { const float* m = pin(p, I_MU) + (size_t)l * 1536 + 1152 + j8;
#pragma unroll
          for (int j = 0; j < 8; ++j) mu[j] = m[j]; }
        for (int row = gw; row < MT; row += NGW) {
            const bool lat = row < ML; const int t = lat ? (row & (SL - 1)) : ((row - ML) & (CL - 1)); const int Ls = lat ? SL : CL;
            const bf16_t* pr = PB + (size_t)row * PLD + C_RW + 1152 + j8;
            const u32x4 r0 = *(const u32x4*)pr, rm = *(const u32x4*)(t > 0 ? pr - PLD : pr), rp = *(const u32x4*)(t < Ls - 1 ? pr + PLD : pr);
            const float mm = t > 0 ? 0.5f : 0.f, mp = t < Ls - 1 ? 0.5f : 0.f;
            float c0[8], cm[8], cp[8], o[8];
            cvt8(r0, c0); cvt8(rm, cm); cvt8(rp, cp);
#pragma unroll
            for (int j = 0; j < 8; ++j) { const float y = c0[j] + ((mm * cm[j] + mp * cp[j]) - c0[j]) * mu[j];
                o[j] = kind == 0 ? 1.f - 2.f / (1.f + __expf(2.f * y)) : (kind == 1 ? y : sigm(y)); }
            if (lane < 48) { u32x4 w; w.x = cvtpk(o[0], o[1]); w.y = cvtpk(o[2], o[3]); w.z = cvtpk(o[4], o[5]); w.w = cvtpk(o[6], o[7]); *(u32x4*)(A2 + (size_t)row * 384 + j8) = w; }
        }
    }
    LAS bf16_t* T = (LAS bf16_t*)(lds + wave * 8448);
    for (int it = gw; it < NB * 4 * 36; it += NGW) {
        const int tb = it % 36, h = (it / 36) & 3, b = it / 144;
        const int row0 = tb < 32 ? b * SL + tb * 64 : ML + b * CL + (tb - 32) * 64;
        const bf16_t* src = PB + (size_t)(row0 + (lane >> 3)) * PLD + C_NV + h * 64 + 8 * (lane & 7);
#pragma unroll
        for (int i = 0; i < 8; ++i) { const u32x4 v = *(const u32x4*)(src + (size_t)(8 * i) * PLD);
            LAS unsigned* d = (LAS unsigned*)(T + (8 * i + (lane >> 3)) * 66 + 8 * (lane & 7)); d[0] = v.x; d[1] = v.y; d[2] = v.z; d[3] = v.w; }
        asm volatile("s_waitcnt vmcnt(0) lgkmcnt(0)" ::: "memory");
        bf16_t* dst = VT + ((size_t)(b * 4 + h) * 144 + tb * 4) * 1024;
#pragma unroll
        for (int k = 0; k < 16; ++k) { const int u = k * 64 + lane, q = u >> 8, d = (u >> 2) & 63, kg = u & 3;
            const LAS bf16_t* tp = T + (16 * q + 4 * kg) * 66 + d;
            u32x2 o; o.x = (unsigned)tp[0] | ((unsigned)tp[66] << 16); o.y = (unsigned)tp[132] | ((unsigned)tp[198] << 16);
            *(u32x2*)(dst + (size_t)(q * 64 + d) * 16 + 4 * kg) = o; }
        asm volatile("s_waitcnt lgkmcnt(0)" ::: "memory");
    }
}

#define MFMA16(a, b, c) __builtin_amdgcn_mfma_f32_16x16x32_bf16((a), (b), (c), 0, 0, 0)
DI u32x4 vload16(const bf16_t* p) { const volatile unsigned* q = (const volatile unsigned*)p; u32x4 r; r.x = q[0]; r.y = q[1]; r.z = q[2]; r.w = q[3]; return r; }
DI u32x2 vload8(const bf16_t* p) { const volatile unsigned* q = (const volatile unsigned*)p; u32x2 r; r.x = q[0]; r.y = q[1]; return r; }
struct NatPair { bf16x8 k[2][2]; u32x2 v[4][2]; u32x2 bias[2]; };
DI void nat_unit(const Params& p, int l, int id, bool isctx, int lane) {
    const bf16_t* PB = (const bf16_t*)(p.ws + WS_PB); const bf16_t* VT = (const bf16_t*)(p.ws + WS_VT); bf16_t* AY = (bf16_t*)(p.ws + WS_AY);
    const int l15 = lane & 15, g = lane >> 4;
    int b, h, r = 0, qt, qrow;
    if (!isctx) { qt = id & 3; r = (id >> 2) & 31; h = (id >> 7) & 3; b = id >> 9; qrow = b * SL + r * 64 + 16 * qt + l15; }
    else { qt = id & 15; h = (id >> 4) & 3; b = id >> 6; qrow = ML + b * CL + 16 * qt + l15; }
    const bf16_t* qp = PB + (size_t)qrow * PLD + C_NQ + h * 64 + 8 * g;
    const bf16x8 qf0 = *(const bf16x8*)qp, qf1 = *(const bf16x8*)(qp + 32);
    const int rs = min(max(r - 4, 0), 24);
    int ct_lo = 0, nct = 1;
    if (!isctx) { const int lo = min(max(16 * qt - 8, 0), 48), hi = min(max(16 * qt + 7, 0), 48) + 16; ct_lo = lo >> 4; nct = ((hi - 1) >> 4) - ct_lo + 1; }
    const int nloc = isctx ? 0 : 8 * nct, npairs = nloc / 2 + 8;
    const int qc = 16 * qt + l15, cs = min(max(qc - 8, 0), 48);
    float m = -1e30f, lsum = 0.f;
    f32x4 oacc[4];
#pragma unroll
    for (int dt = 0; dt < 4; ++dt) oacc[dt] = (f32x4){0.f, 0.f, 0.f, 0.f};
    const bf16_t* vt = VT + (size_t)(b * 4 + h) * 144 * 1024 + l15 * 16 + 4 * g;
    const bf16_t* kbase = PB + (size_t)l15 * PLD + C_NK + h * 64 + 8 * g;
    const float* rp = pin(p, I_RPB) + (size_t)((l * 4 + h) * 15) * 31;
    NatPair ring[4];
    int iti = 0, ikr = 0, icj = 0;
#define NAT_ISSUE(slot) do { __builtin_amdgcn_sched_barrier(0); _Pragma("unroll") for (int e = 0; e < 2; ++e) { int tk, keyrow; f32x4 bs = (f32x4){0.f, 0.f, 0.f, 0.f}; \
        if (iti < nloc) { const int ct = ct_lo + icj; tk = (rs + ikr) * 64 + 16 * ct; keyrow = b * SL + tk; const float* rpr = rp + (rs + ikr - r + 7) * 31; \
            _Pragma("unroll") for (int rg = 0; rg < 4; ++rg) { const int kc = 16 * ct + 4 * g + rg; const bool vis = (kc >= cs) && (kc < cs + 16); const float bv = rpr[min(max(kc - qc + 15, 0), 30)]; bs[rg] = vis ? bv : -1e30f; } \
            if (++icj == nct) { icj = 0; ++ikr; } } \
        else { const int j = (iti - nloc) * 16; tk = SL + j; keyrow = ML + b * CL + j; } \
        ++iti; ring[slot].bias[e] = (u32x2){cvtpk(bs[0], bs[1]), cvtpk(bs[2], bs[3])}; \
        const bf16_t* kp = kbase + (size_t)keyrow * PLD; ring[slot].k[e][0] = *(const bf16x8*)kp; ring[slot].k[e][1] = *(const bf16x8*)(kp + 32); \
        _Pragma("unroll") for (int dt = 0; dt < 4; ++dt) ring[slot].v[dt][e] = *(const u32x2*)(vt + (size_t)(tk >> 4) * 1024 + dt * 256); } __builtin_amdgcn_sched_barrier(0); } while (0)
#pragma unroll
    for (int j = 0; j < 4; ++j) NAT_ISSUE(j);
    for (int pi0 = 0; pi0 < npairs; pi0 += 4) {
#pragma unroll
        for (int j = 0; j < 4; ++j) {
            const int pi = pi0 + j;
            f32x4 s[2];
#pragma unroll
            for (int e = 0; e < 2; ++e) {
                f32x4 a = (f32x4){0.f, 0.f, 0.f, 0.f};
                a = MFMA16(ring[j].k[e][0], qf0, a); a = MFMA16(ring[j].k[e][1], qf1, a);
                const u32x2 bb = ring[j].bias[e];
                s[e] = a * 0.125f + (f32x4){bflo(bb.x), bfhi(bb.x), bflo(bb.y), bfhi(bb.y)};
            }
            float tmax = fmaxf(fmaxf(fmaxf(s[0][0], s[0][1]), fmaxf(s[0][2], s[0][3])), fmaxf(fmaxf(s[1][0], s[1][1]), fmaxf(s[1][2], s[1][3])));
            tmax = x32_max(x16_max(tmax));
            const float mn = fmaxf(m, tmax), corr = __expf(m - mn); m = mn;
            float pv[8]; float ps = 0.f;
#pragma unroll
            for (int i = 0; i < 8; ++i) { const float sv = s[i >> 2][i & 3]; pv[i] = sv > -1e29f ? __expf(sv - mn) : 0.f; ps += pv[i]; }
            lsum = lsum * corr + ps;
            u32x4 pk; pk.x = cvtpk(pv[0], pv[1]); pk.y = cvtpk(pv[2], pv[3]); pk.z = cvtpk(pv[4], pv[5]); pk.w = cvtpk(pv[6], pv[7]);
            const bf16x8 pf = __builtin_bit_cast(bf16x8, pk);
#pragma unroll
            for (int dt = 0; dt < 4; ++dt) {
                u32x4 vv; vv.x = ring[j].v[dt][0].x; vv.y = ring[j].v[dt][0].y; vv.z = ring[j].v[dt][1].x; vv.w = ring[j].v[dt][1].y;
                oacc[dt] = oacc[dt] * corr;
                oacc[dt] = MFMA16(__builtin_bit_cast(bf16x8, vv), pf, oacc[dt]);
            }
            if (pi + 4 < npairs) NAT_ISSUE(j);
        }
    }
#undef NAT_ISSUE
    lsum = x32_sum(x16_sum(lsum));
    const float inv = 1.0f / lsum;
    bf16_t* yp = AY + (size_t)qrow * D + 768 + h * 64 + 4 * g;
#pragma unroll
    for (int dt = 0; dt < 4; ++dt) { u32x2 o; o.x = cvtpk(oacc[dt][0] * inv, oacc[dt][1] * inv); o.y = cvtpk(oacc[dt][2] * inv, oacc[dt][3] * inv); *(u32x2*)(yp + 16 * dt) = o; }
}

constexpr int RW_STEP = 384, RW_BUF = 16 * RW_STEP, GL_STEP = 160, GL_BUF = 16 * GL_STEP, NCHUNK = (CL + SL) / 16;
struct RwRaw { u32x4 d[3][3][2]; u32x4 lo[4]; };
DI void rwkv_load(const Params& p, int item, int c, RwRaw& R, int lane) {
    const int g = item & 1, h = (item >> 1) % 6, b = item / 12;
    const int ti = lane >> 2, cg = lane & 3;
    int row, ts, Ls; step_row(16 * c + ti, g, b, row, ts, Ls);
    const int rm = ts > 0 ? row - 1 : row, rp = ts < Ls - 1 ? row + 1 : row;
    const bf16_t* PB = (const bf16_t*)(p.ws + WS_PB) + C_RW + h * 64 + 16 * cg;
    const bf16_t* p0 = PB + (size_t)row * PLD; const bf16_t* pm = PB + (size_t)rm * PLD; const bf16_t* pp = PB + (size_t)rp * PLD;
#pragma unroll
    for (int a = 0; a < 3; ++a)
#pragma unroll
        for (int hf = 0; hf < 2; ++hf) { R.d[a][0][hf] = *(const u32x4*)(pm + a * 384 + 8 * hf); R.d[a][1][hf] = *(const u32x4*)(p0 + a * 384 + 8 * hf); R.d[a][2][hf] = *(const u32x4*)(pp + a * 384 + 8 * hf); }
    const bf16_t* lo = (const bf16_t*)(p.ws + WS_LO) + (size_t)row * LOLD + (g * 6 + h) * 128 + 16 * cg;
    R.lo[0] = *(const u32x4*)lo; R.lo[1] = *(const u32x4*)(lo + 8); R.lo[2] = *(const u32x4*)(lo + 64); R.lo[3] = *(const u32x4*)(lo + 72);
}
DI void rwkv_compute(const Params& p, int item, int c, const RwRaw& R, LAS float* buf, const LAS float* CST, int lane) {
    const int g = item & 1, h = (item >> 1) % 6, b = item / 12;
    const int ti = lane >> 2, cg = lane & 3;
    int row, ts, Ls; step_row(16 * c + ti, g, b, row, ts, Ls);
    const float mm = ts > 0 ? 0.5f : 0.f, mp = ts < Ls - 1 ? 0.5f : 0.f;
    float y[3][16];
#pragma unroll
    for (int a = 0; a < 3; ++a) {
        float c0[16], cm[16], cp[16];
        cvt8(R.d[a][0][0], &cm[0]); cvt8(R.d[a][0][1], &cm[8]); cvt8(R.d[a][1][0], &c0[0]); cvt8(R.d[a][1][1], &c0[8]); cvt8(R.d[a][2][0], &cp[0]); cvt8(R.d[a][2][1], &cp[8]);
#pragma unroll
        for (int j4 = 0; j4 < 4; ++j4) { const f32x4 mu = *(const LAS f32x4*)(CST + a * 64 + 16 * cg + 4 * j4);
#pragma unroll
            for (int jj = 0; jj < 4; ++jj) { const int j = 4 * j4 + jj; y[a][j] = c0[j] + ((mm * cm[j] + mp * cp[j]) - c0[j]) * mu[jj]; } }
    }
    float lw[16], a[16];
    cvt8(R.lo[0], &lw[0]); cvt8(R.lo[1], &lw[8]); cvt8(R.lo[2], &a[0]); cvt8(R.lo[3], &a[8]);
    float kkv[16]; float ss = 0.f;
#pragma unroll
    for (int j4 = 0; j4 < 4; ++j4) { const f32x4 kc = *(const LAS f32x4*)(CST + 3 * 64 + 16 * cg + 4 * j4);
#pragma unroll
        for (int jj = 0; jj < 4; ++jj) { const int j = 4 * j4 + jj; kkv[j] = y[1][j] * kc[jj]; ss += kkv[j] * kkv[j]; } }
    ss = sum4(ss);
    const float inv = rsqrtf(ss + 1e-12f);
    float bon = 0.f;
    LAS float* o = buf + ti * RW_STEP + 16 * cg;
#pragma unroll
    for (int j4 = 0; j4 < 4; ++j4) {
        const f32x4 kac = *(const LAS f32x4*)(CST + 4 * 64 + 16 * cg + 4 * j4), rkc = *(const LAS f32x4*)(CST + 5 * 64 + 16 * cg + 4 * j4);
        f32x4 w4, b4, km4, r4, kk4, v4;
#pragma unroll
        for (int jj = 0; jj < 4; ++jj) { const int j = 4 * j4 + jj;
            const float kkn = kkv[j] * inv, aj = a[j];
            const float km = y[1][j] * (1.f + (aj - 1.f) * kac[jj]);
            w4[jj] = __expf(-lw[j]); b4[jj] = kkn * aj; km4[jj] = km; r4[jj] = y[0][j]; kk4[jj] = kkn; v4[jj] = y[2][j];
            bon += y[0][j] * km * rkc[jj]; }
        *(LAS f32x4*)(o + 0 * 64 + 4 * j4) = w4; *(LAS f32x4*)(o + 1 * 64 + 4 * j4) = b4; *(LAS f32x4*)(o + 2 * 64 + 4 * j4) = km4;
        *(LAS f32x4*)(o + 3 * 64 + 4 * j4) = r4; *(LAS f32x4*)(o + 4 * 64 + 4 * j4) = kk4; *(LAS f32x4*)(o + 5 * 64 + 4 * j4) = v4;
    }
    bon = sum4(bon);
    if (cg == 0) ((float*)(p.ws + WS_BON))[(size_t)row * 12 + g * 6 + h] = bon;
}
DI float xhalf_sum(float x) {
    const auto r = __builtin_amdgcn_permlane32_swap(__float_as_uint(x), __float_as_uint(x), false, false);
    return __uint_as_float(r[0]) + __uint_as_float(r[1]);
}
DI void rwkv_scan_chunk(const Params& p, int item, int c, const LAS float* buf, f32x2 (&S)[16], int lane, int hf, bool dry) {
    const int g = item & 1, h = (item >> 1) % 6, b = item / 12;
    float* LOf = (float*)(p.ws + WS_LO);
    const int kh = lane >> 5, rowi = 32 * hf + (lane & 31);
    const LAS float* bk = buf + 32 * kh;
    f32x4 KK[8];
#pragma unroll
    for (int i = 0; i < 8; ++i) KK[i] = *(const LAS f32x4*)(bk + 256 + 4 * i);
    float vv = buf[320 + rowi];
    for (int st = 0; st < 16; ++st) {
        const LAS float* W = bk + st * RW_STEP;
        const LAS float* Wn = bk + (st < 15 ? st + 1 : st) * RW_STEP;
        f32x4 U[2][8];
#pragma unroll
        for (int j = 0; j < 2; ++j) { U[0][4 * j] = *(const LAS f32x4*)(W + 4 * j); U[0][4 * j + 1] = *(const LAS f32x4*)(W + 64 + 4 * j); U[0][4 * j + 2] = *(const LAS f32x4*)(W + 128 + 4 * j); U[0][4 * j + 3] = *(const LAS f32x4*)(W + 192 + 4 * j); }
        f32x2 sacc[4];
#pragma unroll
        for (int i = 0; i < 4; ++i) sacc[i] = (f32x2){0.f, 0.f};
#pragma unroll
        for (int i = 0; i < 8; ++i) { sacc[(2 * i) & 3] += S[2 * i] * (f32x2){KK[i][0], KK[i][1]}; sacc[(2 * i + 1) & 3] += S[2 * i + 1] * (f32x2){KK[i][2], KK[i][3]}; }
        const f32x2 st2 = (sacc[0] + sacc[1]) + (sacc[2] + sacc[3]);
        const float sa = -xhalf_sum(st2[0] + st2[1]);
        const f32x2 sa2 = (f32x2){sa, sa}, vv2 = (f32x2){vv, vv};
        f32x2 oacc[4];
#pragma unroll
        for (int i = 0; i < 4; ++i) oacc[i] = (f32x2){0.f, 0.f};
        asm volatile("" : "+v"(oacc[0]), "+v"(oacc[1]) :: "memory");
#pragma unroll
        for (int gi = 0; gi < 4; ++gi) {
            const int cu = gi & 1, nx = cu ^ 1;
            if (gi < 3) {
#pragma unroll
                for (int j = 0; j < 2; ++j) { const int i = 2 * (gi + 1) + j; U[nx][4 * j] = *(const LAS f32x4*)(W + 4 * i); U[nx][4 * j + 1] = *(const LAS f32x4*)(W + 64 + 4 * i);
                    U[nx][4 * j + 2] = *(const LAS f32x4*)(W + 128 + 4 * i); U[nx][4 * j + 3] = *(const LAS f32x4*)(W + 192 + 4 * i); }
            }
            if (gi >= 2) {
#pragma unroll
                for (int j = 0; j < 4; ++j) KK[4 * (gi - 2) + j] = *(const LAS f32x4*)(Wn + 256 + 4 * (4 * (gi - 2) + j));
            }
#pragma unroll
            for (int j = 0; j < 2; ++j) { const int i = 2 * gi + j; const f32x4 w4 = U[cu][4 * j], b4 = U[cu][4 * j + 1], km4 = U[cu][4 * j + 2], r4 = U[cu][4 * j + 3];
                f32x2 t0 = vv2 * (f32x2){km4[0], km4[1]}; t0 = sa2 * (f32x2){b4[0], b4[1]} + t0; S[2 * i] = S[2 * i] * (f32x2){w4[0], w4[1]} + t0;
                f32x2 t1 = vv2 * (f32x2){km4[2], km4[3]}; t1 = sa2 * (f32x2){b4[2], b4[3]} + t1; S[2 * i + 1] = S[2 * i + 1] * (f32x2){w4[2], w4[3]} + t1;
                oacc[(2 * i) & 3] += S[2 * i] * (f32x2){r4[0], r4[1]}; oacc[(2 * i + 1) & 3] += S[2 * i + 1] * (f32x2){r4[2], r4[3]}; }
            asm volatile("" : "+v"(oacc[0]), "+v"(oacc[1]), "+v"(oacc[2]), "+v"(oacc[3]) :: "memory");
        }
        vv = buf[(st < 15 ? st + 1 : st) * RW_STEP + 320 + rowi];
        const f32x2 o2 = (oacc[0] + oacc[1]) + (oacc[2] + oacc[3]);
        const float ov = xhalf_sum(o2[0] + o2[1]);
        int row, ts, Ls; step_row(16 * c + st, g, b, row, ts, Ls);
        if (kh == 0 && (!dry || ov == 1.2345e37f)) LOf[(size_t)row * (LOLD / 2) + (g * 6 + h) * 64 + rowi] = ov;
    }
}
struct GlRaw { u32x4 q, k, v[2], dn[2]; f32x4 rt[2]; };
DI void gla_load(const Params& p, int item, int c, GlRaw& R, int lane) {
    const int g = item & 1, h = (item >> 1) % 6, b = item / 12;
    const int ti = lane >> 2, cg = lane & 3;
    int row, ts, Ls; step_row(16 * c + ti, g, b, row, ts, Ls);
    const bf16_t* pr = (const bf16_t*)(p.ws + WS_PB) + (size_t)row * PLD;
    R.q = *(const u32x4*)(pr + C_GQ + h * 32 + 8 * cg); R.k = *(const u32x4*)(pr + C_GK + h * 32 + 8 * cg);
    R.v[0] = *(const u32x4*)(pr + C_GV + h * 64 + 16 * cg); R.v[1] = *(const u32x4*)(pr + C_GV + h * 64 + 16 * cg + 8);
    R.dn[0] = *(const u32x4*)(pr + C_GDN + 16 * g); R.dn[1] = *(const u32x4*)(pr + C_GDN + 16 * g + 8);
    const float* rt = (const float*)(p.ws + WS_ROPE) + (size_t)((Ls == SL ? ts : 0) * 16 + 4 * cg) * 2;
    R.rt[0] = *(const f32x4*)rt; R.rt[1] = *(const f32x4*)(rt + 4);
}
DI void gla_compute(const Params& p, int item, int c, const GlRaw& R, LAS float* buf, const LAS float* GU, int lane) {
    const int g = item & 1, b = item / 12;
    const int ti = lane >> 2, cg = lane & 3;
    int row, ts, Ls; step_row(16 * c + ti, g, b, row, ts, Ls);
    float q[8], k[8], v[16], dn[16];
    cvt8(R.q, q); cvt8(R.k, k); cvt8(R.v[0], &v[0]); cvt8(R.v[1], &v[8]); cvt8(R.dn[0], &dn[0]); cvt8(R.dn[1], &dn[8]);
    float al[8];
    {
        f32x4 z0 = *(const LAS f32x4*)(GU + 512 + 8 * cg), z1 = *(const LAS f32x4*)(GU + 512 + 8 * cg + 4);
#pragma unroll
        for (int rr = 0; rr < 16; ++rr) {
            if ((rr & 3) == 0) asm volatile("" : "+v"(z0), "+v"(z1) :: "memory");
            const f32x4 g0 = *(const LAS f32x4*)(GU + rr * 32 + 8 * cg), g1 = *(const LAS f32x4*)(GU + rr * 32 + 8 * cg + 4);
            z0 = z0 + g0 * dn[rr]; z1 = z1 + g1 * dn[rr]; }
#pragma unroll
        for (int j = 0; j < 8; ++j) { const float z = j < 4 ? z0[j & 3] : z1[j & 3];
            const float ls = fminf(z, 0.f) - __logf(1.f + __expf(-fabsf(z)));
            al[j] = __expf(ls * 0.0625f); }
    }
    if (Ls == SL) {
#pragma unroll
        for (int jj = 0; jj < 4; ++jj) { const float cc = R.rt[jj >> 1][2 * (jj & 1)], sn = R.rt[jj >> 1][2 * (jj & 1) + 1];
            const float q1 = q[2 * jj], q2 = q[2 * jj + 1]; q[2 * jj] = q1 * cc - q2 * sn; q[2 * jj + 1] = q1 * sn + q2 * cc;
            const float k1 = k[2 * jj], k2 = k[2 * jj + 1]; k[2 * jj] = k1 * cc - k2 * sn; k[2 * jj + 1] = k1 * sn + k2 * cc; }
    }
    LAS float* o = buf + ti * GL_STEP;
#pragma unroll
    for (int j4 = 0; j4 < 2; ++j4) {
        *(LAS f32x4*)(o + 8 * cg + 4 * j4) = (f32x4){al[4 * j4], al[4 * j4 + 1], al[4 * j4 + 2], al[4 * j4 + 3]};
        *(LAS f32x4*)(o + 32 + 8 * cg + 4 * j4) = (f32x4){k[4 * j4], k[4 * j4 + 1], k[4 * j4 + 2], k[4 * j4 + 3]};
        *(LAS f32x4*)(o + 64 + 8 * cg + 4 * j4) = (f32x4){q[4 * j4], q[4 * j4 + 1], q[4 * j4 + 2], q[4 * j4 + 3]} * 0.17677669529663687f; }
#pragma unroll
    for (int j4 = 0; j4 < 4; ++j4) *(LAS f32x4*)(o + 96 + 16 * cg + 4 * j4) = (f32x4){v[4 * j4], v[4 * j4 + 1], v[4 * j4 + 2], v[4 * j4 + 3]};
}
DI void gla_scan_chunk(const Params& p, int item, int c, const LAS float* buf, f32x2 (&S)[16], int lane, bool dry = false) {
    const int g = item & 1, h = (item >> 1) % 6, b = item / 12;
    bf16_t* AY = (bf16_t*)(p.ws + WS_AY);
    f32x4 U[2][12];
#pragma unroll
    for (int j = 0; j < 4; ++j) { U[0][3 * j] = ((const LAS f32x4*)buf)[j]; U[0][3 * j + 1] = ((const LAS f32x4*)buf)[8 + j]; U[0][3 * j + 2] = ((const LAS f32x4*)buf)[16 + j]; }
    float vv = buf[96 + lane];
    for (int st = 0; st < 16; ++st) {
        const LAS f32x4* W = (const LAS f32x4*)(buf + st * GL_STEP);
        const LAS float* bn = buf + (st < 15 ? st + 1 : st) * GL_STEP;
        const LAS f32x4* Wn = (const LAS f32x4*)bn;
        const f32x2 vv2 = (f32x2){vv, vv};
        f32x2 oacc[4];
#pragma unroll
        for (int i = 0; i < 4; ++i) oacc[i] = (f32x2){0.f, 0.f};
#pragma unroll
        for (int gi = 0; gi < 2; ++gi) {
            const int cu = gi, nx = gi ^ 1;
#pragma unroll
            for (int j = 0; j < 4; ++j) { const LAS f32x4* Wx = gi == 0 ? W : Wn; const int i = gi == 0 ? 4 + j : j;
                U[nx][3 * j] = Wx[i]; U[nx][3 * j + 1] = Wx[8 + i]; U[nx][3 * j + 2] = Wx[16 + i]; }
            if (gi == 1) vv = bn[96 + lane];
#pragma unroll
            for (int j = 0; j < 4; ++j) { const int i = 4 * gi + j; const f32x4 a4 = U[cu][3 * j], k4 = U[cu][3 * j + 1], q4 = U[cu][3 * j + 2];
                S[2 * i] = S[2 * i] * (f32x2){a4[0], a4[1]} + vv2 * (f32x2){k4[0], k4[1]}; S[2 * i + 1] = S[2 * i + 1] * (f32x2){a4[2], a4[3]} + vv2 * (f32x2){k4[2], k4[3]};
                oacc[(2 * i) & 3] += S[2 * i] * (f32x2){q4[0], q4[1]}; oacc[(2 * i + 1) & 3] += S[2 * i + 1] * (f32x2){q4[2], q4[3]}; }
            asm volatile("" : "+v"(oacc[0]), "+v"(oacc[1]), "+v"(oacc[2]), "+v"(oacc[3]) :: "memory");
        }
        const f32x2 o2 = (oacc[0] + oacc[1]) + (oacc[2] + oacc[3]);
        int row, ts, Ls; step_row(16 * c + st, g, b, row, ts, Ls);
        { const float ov = o2[0] + o2[1]; if (!dry || ov == 1.2345e37f) AY[(size_t)row * D + g * 384 + h * 64 + lane] = f2bf(ov); }
    }
}
DI void lds_wait_ge(volatile LAS unsigned* f, unsigned v) { while (*f < v) __builtin_amdgcn_s_sleep(1); }
DI void scan_unit_rw(const Params& p, int l, int su, LAS unsigned char* lds, int tid, int lane, int wave, bool dry, int nat_lo, int nat_hi, int nat_stride, int nnat) {
    LAS float* RWB = (LAS float*)lds; LAS float* CSB = (LAS float*)(lds + 143616);
    volatile LAS unsigned* FLG = (volatile LAS unsigned*)(lds + 146688);
    __syncthreads();
    for (int i = tid; i < 2 * 384; i += NTHR) { const int sl = i / 384, r = i % 384, a = r >> 6, ch = r & 63; const int it = 2 * su + sl, hh = (it >> 1) % 6;
        float v;
        if (a < 3) v = pin(p, I_MU)[(size_t)l * 1536 + a * 384 + hh * 64 + ch];
        else v = (a == 3 ? pin(p, I_KK) : (a == 4 ? pin(p, I_KA) : pin(p, I_RK)))[(size_t)l * 384 + hh * 64 + ch];
        CSB[i] = v; }
    if (tid < 8) FLG[tid] = 0u;
    __syncthreads();
    if (wave < 4) {
        asm volatile("" : "+v"(lane));
        const int slot = wave >> 1, hf = wave & 1, item = 2 * su + slot;
        f32x2 S[16];
#pragma unroll
        for (int i = 0; i < 16; ++i) S[i] = (f32x2){0.f, 0.f};
        for (int c = 0; c < NCHUNK; ++c) {
            lds_wait_ge(FLG + slot, (unsigned)(c + 1));
            asm volatile("" ::: "memory");
            rwkv_scan_chunk(p, item, c, RWB + (slot * 2 + (c & 1)) * RW_BUF, S, lane, hf, dry);
            asm volatile("s_waitcnt lgkmcnt(0)" ::: "memory");
            FLG[2 + slot * 2 + hf] = (unsigned)(c + 1);
        }
    } else if (wave < 6) {
        asm volatile("" : "+v"(lane));
        const int slot = wave & 1, item = 2 * su + slot;
        RwRaw R; rwkv_load(p, item, 0, R, lane);
        for (int c = 0; c < NCHUNK; ++c) {
            if (c >= 2) { lds_wait_ge(FLG + 2 + slot * 2, (unsigned)(c - 1)); lds_wait_ge(FLG + 3 + slot * 2, (unsigned)(c - 1)); }
            asm volatile("" ::: "memory");
            rwkv_compute(p, item, c, R, RWB + (slot * 2 + (c & 1)) * RW_BUF, CSB + slot * 384, lane);
            if (c + 1 < NCHUNK) rwkv_load(p, item, c + 1, R, lane);
            asm volatile("s_waitcnt lgkmcnt(0)" ::: "memory");
            FLG[slot] = (unsigned)(c + 1);
        }
    } else {
        asm volatile("" : "+v"(lane));
        for (int id = nat_lo + su * 2 + (wave - 6); id < nat_hi; id += nat_stride) { if (id < nnat) nat_unit(p, l, id, false, lane); else nat_unit(p, l, id - nnat, true, lane); }
    }
}
DI void scan_unit_gl(const Params& p, int l, int gu, LAS unsigned char* lds, int tid, int lane, int wave, bool dry) {
    LAS float* GLB = (LAS float*)lds; LAS float* GUB = (LAS float*)(lds + 122880);
    __syncthreads();
    for (int i = tid; i < 6 * 544; i += NTHR) { const int sl = i / 544, r = i % 544; const int it = 6 * gu + sl, gg = it & 1, hh = (it >> 1) % 6;
        GUB[i] = r < 512 ? pin(p, I_GUP)[((size_t)(l * 2 + gg) * 16 + (r >> 5)) * 192 + hh * 32 + (r & 31)] : pin(p, I_GB)[(size_t)(l * 2 + gg) * 192 + hh * 32 + (r - 512)]; }
    __syncthreads();
    if (wave < 6) {
        asm volatile("" : "+v"(lane));
        const int item = 6 * gu + wave;
        f32x2 Sg[16];
#pragma unroll
        for (int i = 0; i < 16; ++i) Sg[i] = (f32x2){0.f, 0.f};
        __syncthreads();
        for (int c = 0; c < NCHUNK; ++c) { gla_scan_chunk(p, item, c, GLB + (wave * 2 + (c & 1)) * GL_BUF, Sg, lane, dry); __syncthreads(); }
    } else {
        asm volatile("" : "+v"(lane));
        const int s0 = (wave - 6) * 3;
        GlRaw R0, R1, R2;
        gla_load(p, 6 * gu + s0, 0, R0, lane); gla_load(p, 6 * gu + s0 + 1, 0, R1, lane); gla_load(p, 6 * gu + s0 + 2, 0, R2, lane);
        gla_compute(p, 6 * gu + s0, 0, R0, GLB + ((s0) * 2) * GL_BUF, GUB + (s0) * 544, lane);
        gla_compute(p, 6 * gu + s0 + 1, 0, R1, GLB + ((s0 + 1) * 2) * GL_BUF, GUB + (s0 + 1) * 544, lane);
        gla_compute(p, 6 * gu + s0 + 2, 0, R2, GLB + ((s0 + 2) * 2) * GL_BUF, GUB + (s0 + 2) * 544, lane);
        gla_load(p, 6 * gu + s0, 1, R0, lane); gla_load(p, 6 * gu + s0 + 1, 1, R1, lane); gla_load(p, 6 * gu + s0 + 2, 1, R2, lane);
        __syncthreads();
        for (int c = 0; c < NCHUNK; ++c) {
            if (c + 1 < NCHUNK) { const int nb = (c + 1) & 1;
                gla_compute(p, 6 * gu + s0, c + 1, R0, GLB + ((s0) * 2 + nb) * GL_BUF, GUB + (s0) * 544, lane);
                gla_compute(p, 6 * gu + s0 + 1, c + 1, R1, GLB + ((s0 + 1) * 2 + nb) * GL_BUF, GUB + (s0 + 1) * 544, lane);
                gla_compute(p, 6 * gu + s0 + 2, c + 1, R2, GLB + ((s0 + 2) * 2 + nb) * GL_BUF, GUB + (s0 + 2) * 544, lane);
                if (c + 2 < NCHUNK) { gla_load(p, 6 * gu + s0, c + 2, R0, lane); gla_load(p, 6 * gu + s0 + 1, c + 2, R1, lane); gla_load(p, 6 * gu + s0 + 2, c + 2, R2, lane); } }
            __syncthreads(); }
    }
}
DI void phase_mixers(const Params& p, int l, LAS unsigned char* lds, int tid, int lane, int wave, bool dry = false, int which = 3) {
    const int G = gridDim.x, bx = blockIdx.x;
    const int nnat = NB * 4 * 32 * 4, nnatc = l == 0 ? NB * 4 * 16 : 0, ntot = nnat + nnatc;
    const int n_in = (G == 256 && (which & 2)) ? min(ntot, 384 * NAT_IN) : 0;
    if (which & 1) for (int u = bx; u < 256; u += G) { if (u < 192) scan_unit_rw(p, l, u, lds, tid, lane, wave, dry, 0, n_in, 384, nnat); else scan_unit_gl(p, l, u - 192, lds, tid, lane, wave, dry); }
    if (which & 2) for (int id = n_in + bx * NWAVE + wave; id < ntot; id += G * NWAVE) { if (id < nnat) nat_unit(p, l, id, false, lane); else nat_unit(p, l, id - nnat, true, lane); }
}

DI void phase_readout(const Params& p, int l, int nrows, int lane, int wave, bool dry = false) {
    const int gw = blockIdx.x * NWAVE + wave, NGW = gridDim.x * NWAVE;
    const bf16_t* PB = (const bf16_t*)(p.ws + WS_PB); bf16_t* AY = (bf16_t*)(p.ws + WS_AY);
    const float* LOf = (const float*)(p.ws + WS_LO); const bf16_t* LOb = (const bf16_t*)(p.ws + WS_LO); const float* BON = (const float*)(p.ws + WS_BON);
    const bool act = lane < 48; const int c8 = act ? 8 * lane : 0, h = c8 >> 6;
    float nw[8], gnw[8], gnb[8], mu[8];
    { const float* a = pin(p, I_GNW) + l * 64 + (c8 & 63); const float* b = pin(p, I_GNWT) + l * 384 + c8; const float* c = pin(p, I_GNB) + l * 384 + c8; const float* d = pin(p, I_MU) + (size_t)l * 1536 + 768 + c8;
#pragma unroll
      for (int j = 0; j < 8; ++j) { nw[j] = a[j]; gnw[j] = b[j]; gnb[j] = c[j]; mu[j] = d[j]; } }
    for (int row = gw; row < nrows; row += NGW) {
        const bool lat = row < ML; const int t = lat ? (row & (SL - 1)) : ((row - ML) & (CL - 1)); const int Ls = lat ? SL : CL;
        const bf16_t* pr = PB + (size_t)row * PLD; bf16_t* yr = AY + (size_t)row * D;
        const u32x4 r_of = *(const u32x4*)(yr + c8), r_ob = *(const u32x4*)(yr + 384 + c8), r_gg = *(const u32x4*)(pr + C_GG + c8);
        const u32x4 r_nat = *(const u32x4*)(yr + 768 + 8 * (lane & 31));
        const float* lf = LOf + (size_t)row * (LOLD / 2) + c8;
        const f32x4 f0 = *(const f32x4*)lf, f1 = *(const f32x4*)(lf + 4), b0 = *(const f32x4*)(lf + 384), b1 = *(const f32x4*)(lf + 388);
        const bf16_t* pv = pr + C_RW + 768 + c8;
        const u32x4 r_v0 = *(const u32x4*)pv, r_vm = *(const u32x4*)(t > 0 ? pv - PLD : pv), r_vp = *(const u32x4*)(t < Ls - 1 ? pv + PLD : pv);
        const u32x4 r_gt = *(const u32x4*)(LOb + (size_t)row * LOLD + 1536 + c8);
        const float bon = BON[(size_t)row * 12 + h] + BON[(size_t)row * 12 + 6 + h];
        const float mm = t > 0 ? 0.5f : 0.f, mp = t < Ls - 1 ? 0.5f : 0.f;
        float of[8], ob[8], gg[8], v0[8], vm[8], vp[8], gt[8];
        cvt8(r_of, of); cvt8(r_ob, ob); cvt8(r_gg, gg); cvt8(r_v0, v0); cvt8(r_vm, vm); cvt8(r_vp, vp); cvt8(r_gt, gt);
        float og[8], orw[8]; float ss = 0.f, sm = 0.f;
#pragma unroll
        for (int j = 0; j < 8; ++j) { og[j] = of[j] + ob[j]; ss += og[j] * og[j]; orw[j] = (j < 4 ? f0[j & 3] : f1[j & 3]) + (j < 4 ? b0[j & 3] : b1[j & 3]); sm += orw[j]; }
        ss = sum8(ss); sm = sum8(sm);
        const float mean = sm * (1.f / 64.f); float sq = 0.f;
#pragma unroll
        for (int j = 0; j < 8; ++j) { orw[j] -= mean; sq += orw[j] * orw[j]; }
        sq = sum8(sq);
        float e1 = 1e-5f, e2 = 64e-5f; asm volatile("" : "+v"(e1), "+v"(e2));
        const float rg = rsqrtf(ss * (1.f / 64.f) + e1), rn = rsqrtf(sq * (1.f / 64.f) + e2);
        float yg[8], yw[8];
#pragma unroll
        for (int j = 0; j < 8; ++j) { yg[j] = og[j] * rg * nw[j] * (gg[j] * sigm(gg[j]));
            const float vs = v0[j] + ((mm * vm[j] + mp * vp[j]) - v0[j]) * mu[j];
            yw[j] = (orw[j] * rn * gnw[j] + gnb[j] + bon * vs) * gt[j]; }
        asm volatile("s_waitcnt vmcnt(0)" ::: "memory");
        const bool okst = !dry || yg[0] == 1.2345e37f;
        if (act && okst) { u32x4 o; o.x = cvtpk(yg[0], yg[1]); o.y = cvtpk(yg[2], yg[3]); o.z = cvtpk(yg[4], yg[5]); o.w = cvtpk(yg[6], yg[7]); *(u32x4*)(yr + c8) = o;
            u32x4 w; w.x = cvtpk(yw[0], yw[1]); w.y = cvtpk(yw[2], yw[3]); w.z = cvtpk(yw[4], yw[5]); w.w = cvtpk(yw[6], yw[7]); *(u32x4*)(yr + 640 + c8) = w; }
        if (lane < 32 && okst) *(u32x4*)(yr + 384 + 8 * lane) = r_nat;
    }
}

#define XB_TMO      128
#define XB_XCNT(j)  (256  + 64 * (j))
#define XB_XSUB(j)  (1280 + 64 * (j))
#define XB_XGEN(j)  (2304 + 64 * (j))
#define XB_TOP      3328
#define XB_TOPGEN   3392
#define XCD_BAR_WORDS 3456
#define XB_SPIN_CAP (1u << 18)

__device__ __forceinline__ unsigned xb_ld(unsigned* p)              { return __hip_atomic_load(p, __ATOMIC_RELAXED, __HIP_MEMORY_SCOPE_AGENT); }
__device__ __forceinline__ unsigned xb_add(unsigned* p, unsigned v) { return __hip_atomic_fetch_add(p, v, __ATOMIC_RELAXED, __HIP_MEMORY_SCOPE_AGENT); }
__device__ __forceinline__ unsigned xb_xcc_id() { return (unsigned)__builtin_amdgcn_s_getreg((3 << 11) | 20) & 0xFu; }
#define XB_SPIN(cond, bar) do { unsigned _sp = 0; while (cond) { __builtin_amdgcn_s_sleep(1); \
    if ((++_sp & 255u) == 0u) { if (xb_ld(&(bar)[XB_TMO])) break; if (_sp > XB_SPIN_CAP) { atomicAdd(&(bar)[XB_TMO], 1u); break; } } } } while (0)

struct XcdBarrier {
    unsigned* bar; unsigned x;
    volatile LAS unsigned* st;
};

__device__ __forceinline__ XcdBarrier xcd_barrier_post(unsigned* bar, volatile LAS unsigned* st, int tid) {
    XcdBarrier b; b.bar = bar; b.x = xb_xcc_id(); b.st = st;
    if (tid == 0) (void)xb_add(&bar[XB_XCNT(b.x)], 1u);
    return b;
}
__device__ __forceinline__ void xcd_barrier_complete(unsigned* bar, unsigned x, unsigned& nloc, unsigned& nx) {
    const unsigned G = gridDim.x * gridDim.y * gridDim.z;
    unsigned sum, cnt, mine, sp = 0u;
    for (;;) {
        sum = 0u; cnt = 0u; mine = 0u;
#pragma unroll
        for (unsigned j = 0; j < 16; ++j) { const unsigned c = xb_ld(&bar[XB_XCNT(j)]); sum += c; cnt += (c > 0u) ? 1u : 0u; mine = (j == x) ? c : mine; }
        if (sum == G) break;
        __builtin_amdgcn_s_sleep(1);
        if ((++sp & 255u) == 0u) { if (xb_ld(&bar[XB_TMO])) break; if (sp > XB_SPIN_CAP) { atomicAdd(&bar[XB_TMO], 1u); break; } }
    }
    nloc = mine > 0u ? mine : 1u; nx = cnt > 0u ? cnt : 1u;
}

__device__ __forceinline__ void xcd_barrier(const XcdBarrier& b, int tid) {
    asm volatile("s_waitcnt vmcnt(0)" ::: "memory");
    __syncthreads();
    if (tid == 0) {
        unsigned* bar = b.bar;
        __builtin_amdgcn_s_waitcnt(0);
        unsigned nloc = b.st[0], nx = b.st[1];
        if (nloc == 0u) { xcd_barrier_complete(bar, b.x, nloc, nx); b.st[0] = nloc; b.st[1] = nx; }
        const unsigned old = xb_add(&bar[XB_XSUB(b.x)], 1u);
        const unsigned gen = old / nloc;
        if (old + 1u == (gen + 1u) * nloc) {
            __builtin_amdgcn_fence(__ATOMIC_RELEASE, "agent");
            asm volatile("s_waitcnt vmcnt(0)" ::: "memory");
            const unsigned og = xb_add(&bar[XB_TOP], 1u);
            const unsigned tg = og / nx;
            if (og + 1u == (tg + 1u) * nx) xb_add(&bar[XB_TOPGEN], 1u);
            else XB_SPIN(xb_ld(&bar[XB_TOPGEN]) == tg, bar);
            __builtin_amdgcn_fence(__ATOMIC_ACQUIRE, "agent");
            xb_add(&bar[XB_XGEN(b.x)], 1u);
            asm volatile("s_waitcnt vmcnt(0)" ::: "memory");
        } else {
            XB_SPIN(xb_ld(&bar[XB_XGEN(b.x)]) == gen, bar);
            __builtin_amdgcn_fence(__ATOMIC_ACQUIRE, "agent");
            asm volatile("s_waitcnt vmcnt(0)" ::: "memory");
        }
    }
    __syncthreads();
}


DI void grid_sync_probe() { cg::this_grid().sync(); }
DI void run_step(const Params& p, const int step, LAS unsigned char* lds, int tid, int lane, int wave, bool dry = false) {
    const int G = gridDim.x, bx = blockIdx.x;
    unsigned char* ws = p.ws;
    const float* MOD = (const float*)(ws + WS_MOD);
    float* TC = (float*)(ws + WS_VT);
    {
        const int l = step < 2 ? 0 : (step - 2) / 10, st = step < 2 ? -1 : (step - 2) % 10;
        unsigned char* wl = ws + (size_t)l * WLB;
        const float* modl = MOD + (size_t)l * 33 * 6144;
        const int Mff = l == 0 ? MT : ML;
        if (st == 0 || st == 2 || st == 5 || st == 7 || st == 8) {
            const bf16_t* gA = (const bf16_t*)(ws + WS_AY); const bf16_t* gB; int gM = Mff, gN = 1024, gK = 1024, mode = 2;
            bf16_t* eO = (bf16_t*)(ws + WS_PB); const float* ex = (const float*)p.out; const float* exc = (const float*)TC; int gofs = 2 * 1024;
            if (st == 0) { gB = (const bf16_t*)(wl + OFF_WIN); gM = MT; gN = PLD; mode = 0; }
            else if (st == 2) { gB = (const bf16_t*)(wl + OFF_BT2); gM = MT; gN = 2048; gK = 384; mode = 1; eO = (bf16_t*)(ws + WS_LO); }
            else if (st == 5) { gB = (const bf16_t*)(wl + OFF_WOUT); if (l == 0) { ex = pin(p, I_X); exc = pin(p, I_CTX); } }
            else if (st == 7) { gB = (const bf16_t*)(wl + OFF_W13); gN = 2 * FH; mode = 3; }
            else { gA = (const bf16_t*)(ws + WS_PB); gB = (const bf16_t*)(wl + OFF_W2); gK = FH; gofs = 5 * 1024; }
            asm volatile("" : "+s"(gK), "+s"(gM), "+s"(gN), "+s"(mode), "+s"(gofs));
            asm volatile("" : "+s"(gA), "+s"(gB), "+s"(eO), "+s"(ex), "+s"(exc));
            const pg8::Gemm g{gA, gB, gM, gN, gK};
            const pg8::EpiAny E{mode, pg8::EpiStoreBf16{eO, PLD}, pg8::EpiLora{eO, pin(p, I_W0) + (size_t)l * 768, pin(p, I_A0) + (size_t)l * 768},
                                pg8::EpiRes{ex, exc, p.out, TC, modl, gofs}, pg8::EpiSwiglu{eO}};
            pg8::StaticOrder S; S.init(g.M, g.N, G, bx);
#if defined(PROBE_GEMM)
            int nrep = (st == 0 || st == 2 || st == 7) ? 2 : 1; asm volatile("" : "+s"(nrep));
#pragma unroll 1
            for (int rep = 0; rep < nrep; ++rep) { pg8::gemm_phase<pg8::EpiAny, pg8::StaticOrder, true, true>(lds, g, S, E, tid); __syncthreads(); }
#else
            pg8::gemm_phase<pg8::EpiAny, pg8::StaticOrder, true, true>(lds, g, S, E, tid);
#endif
        }
#ifndef ONLYGEMM
        else if (step == 0) phase_prologue(p, lds, tid, lane, wave);
        else if (step == 1) phase_modulate0(p, lane, wave);
        else if (st == 1) phase_prep(p, l, lds, lane, wave);
#if defined(PROBE_MIX)
        else if (st == 3) { int nrep = 2; asm volatile("" : "+s"(nrep));
#pragma unroll 1
            for (int rep = 0; rep < nrep; ++rep) { phase_mixers(p, l, lds, tid, lane, wave, rep + 1 < nrep, rep + 1 < nrep ? PROBE_MIX : 3); __syncthreads(); grid_sync_probe(); } }
#else
        else if (st == 3) phase_mixers(p, l, lds, tid, lane, wave);
#endif
        else if (st == 4) phase_readout(p, l, Mff, lane, wave, dry);
        else if (st == 6) phase_ln(p, lane, wave, Mff, pin(p, I_LN1W) + l * 1024, pin(p, I_LN1B) + l * 1024, modl, 3 * 1024, 4 * 1024, true, true, dry);
        else {
            if (l == 0) phase_ln(p, lane, wave, MT, pin(p, I_LN2W), pin(p, I_LN2B), MOD + (size_t)33 * 6144, 0, 1024, true, true, dry);
            else phase_ln(p, lane, wave, ML, pin(p, I_LN2W) + 1024, pin(p, I_LN2B) + 1024, modl, 0, 1024, true, false, dry);
        }
#endif
    }
}
#ifdef MULTI_LAUNCH
template <int STEP> __global__ void __launch_bounds__(NTHR, 2) k_step(Params p) {
    extern __shared__ __attribute__((aligned(16))) unsigned char smem[];
    const int tid = threadIdx.x, lane = tid & 63, wave = __builtin_amdgcn_readfirstlane(tid >> 6);
    run_step(p, STEP, (LAS unsigned char*)smem, tid, lane, wave);
}
template <int STEP> static void launch_steps(const Params& p, int grid, hipStream_t stream) {
    static bool attr_done = false;
    if (!attr_done) { (void)hipFuncSetAttribute((const void*)k_step<STEP>, hipFuncAttributeMaxDynamicSharedMemorySize, LDS_BYTES); attr_done = true; }
    hipLaunchKernelGGL(k_step<STEP>, dim3(grid), dim3(NTHR), LDS_BYTES, stream, p);
    if constexpr (STEP + 1 < 22) launch_steps<STEP + 1>(p, grid, stream);
}
#else
__global__ void __launch_bounds__(NTHR, 2) hybrid_fwd(Params p) {
    extern __shared__ __attribute__((aligned(16))) unsigned char smem[];
    LAS unsigned char* lds = (LAS unsigned char*)smem;
    cg::grid_group grid = cg::this_grid();
    const int wave0 = __builtin_amdgcn_readfirstlane((int)threadIdx.x >> 6);
    volatile LAS unsigned* MISC = (volatile LAS unsigned*)(lds + LDS_BYTES - 64);
#if defined(PROBE_REPEAT) || defined(PROBE_DRY)
    bool repeated = false;
#endif
#pragma unroll 1
    for (int step = 0; step < 22; ++step) {
        unsigned msk = ~0u; int wave_ = wave0;
        asm volatile("" : "+s"(msk), "+s"(wave_));
        const int lane_ = (int)__builtin_amdgcn_mbcnt_hi(msk, __builtin_amdgcn_mbcnt_lo(msk, 0u));
        const int tid_ = wave_ * 64 + lane_;
        const int stepu = __builtin_amdgcn_readfirstlane(step);
#if defined(PROBE_DRY)
        const int sd_ = stepu < 2 ? -1 : (stepu - 2) % 10; const bool wantdry = ((PROBE_DRY & 1) && (sd_ == 6 || sd_ == 9)) || ((PROBE_DRY & 2) && sd_ == 4);
        run_step(p, stepu, lds, tid_, lane_, wave_, wantdry && !repeated);
#else
        run_step(p, stepu, lds, tid_, lane_, wave_);
#endif
        XcdBarrier bar; bar.bar = (unsigned*)(p.ws + WS_BAR); bar.x = xb_xcc_id(); bar.st = MISC;
        if (stepu == 0) {
            if (tid_ < 2) MISC[tid_] = 0u;
            if (tid_ == 0) (void)xb_add(&bar.bar[XB_XCNT(bar.x)], 1u);
            grid.sync();
        } else if (stepu != 21) xcd_barrier(bar, tid_);
#if defined(PROBE_DRY)
        if (wantdry && !repeated) { repeated = true; --step; } else repeated = false;
#endif
#if defined(PROBE_REPEAT)
        { const int st_ = step < 2 ? -1 : (step - 2) % 10; const bool rep_ok = ((PROBE_REPEAT & 1) && (st_ == 0 || st_ == 2 || st_ == 7)) || ((PROBE_REPEAT & 2) && st_ == 1) || ((PROBE_REPEAT & 4) && step == 0) || ((PROBE_REPEAT & 8) && step == 1);
          if (rep_ok && !repeated) { repeated = true; --step; } else repeated = false; }
#endif
    }
}
#endif

extern "C" void kernel_launch(void* const* d_in, const int* in_sizes, int n_in, void* d_out, int out_size, void* d_ws, size_t ws_size, hipStream_t stream) {
    static int grid = 0;
    if (grid == 0) {
        int dev = 0, cus = 0, per_cu = 0;
        if (n_in != 29 || ws_size < WS_END) { fprintf(stderr, "kernel_launch: unexpected n_in %d / ws_size %zu (need %zu)\n", n_in, ws_size, (size_t)WS_END); }
        hipGetDevice(&dev);
        hipDeviceGetAttribute(&cus, hipDeviceAttributeMultiprocessorCount, dev);
#ifndef MULTI_LAUNCH
        if (hipFuncSetAttribute((const void*)hybrid_fwd, hipFuncAttributeMaxDynamicSharedMemorySize, LDS_BYTES) != hipSuccess) fprintf(stderr, "kernel_launch: hipFuncSetAttribute failed\n");
        if (hipOccupancyMaxActiveBlocksPerMultiprocessor(&per_cu, (const void*)hybrid_fwd, NTHR, LDS_BYTES) != hipSuccess || per_cu < 1) { fprintf(stderr, "kernel_launch: occupancy query gave %d\n", per_cu); per_cu = 1; }
#endif
        (void)hipGetLastError();
        grid = cus > 0 ? cus : 256;
    }
    Params p{};
    for (int i = 0; i < 29; ++i) p.in[i] = (const float*)d_in[i];
    p.out = (float*)d_out; p.ws = (unsigned char*)d_ws;
#ifdef MULTI_LAUNCH
    launch_steps<0>(p, grid, stream);
#else
    (void)hipMemsetAsync((unsigned char*)d_ws + WS_BAR, 0, 16384, stream);
    void* args[] = {&p};
    hipError_t e = hipLaunchCooperativeKernel((const void*)hybrid_fwd, dim3(grid), dim3(NTHR), args, LDS_BYTES, stream);
    if (e != hipSuccess) fprintf(stderr, "kernel_launch: cooperative launch failed: %s (grid %d)\n", hipGetErrorString(e), grid);
#endif
}
```

```cpp
#include <hip/hip_runtime.h>
#include <hip/hip_cooperative_groups.h>
#include <cstdio>
#include <cstdint>
namespace cg = cooperative_groups;
namespace pg8 {
#define PG8_LAS __attribute__((address_space(3)))
typedef unsigned short bf16_t;
typedef short bf16x8 __attribute__((ext_vector_type(8)));
typedef float f32x4 __attribute__((ext_vector_type(4)));
typedef unsigned u32x4 __attribute__((ext_vector_type(4)));
constexpr int BM = 256, BK = 64, HALF = 128, HTB = HALF * BK * 2  , STAGE_BYTES = 8 * HTB, NXCD = 8, WGM = 8;

__host__ __device__ __forceinline__ int lds_byte(int r, int c) { const int st = (r >> 4) * 2 + (c >> 5), rr = r & 15, cc = c & 31, ob = rr * 64 + cc * 2; return st * 1024 + (ob ^ (((ob >> 9) & 1) << 5)); }
__host__ __device__ __forceinline__ void stage_rc(int b, int& R, int& C) { const int st = b / 1024, sb = b % 1024, swz = sb ^ (((sb >> 9) & 1) << 5); R = (st >> 1) * 16 + swz / 64; C = (st & 1) * 32 + (swz % 64) / 2; }
__host__ __device__ __forceinline__ int perm32(int rho) { const int n = rho >> 4, i = rho & 15; return 8 * (i >> 2) + 4 * n + (i & 3); }

struct Unit { int pm, pn; };
struct Gemm { const bf16_t* A; const bf16_t* Bt; int M, N, K; };

struct StaticOrder {
    int nM, nN, nwg, G, c;
    __host__ __device__ void init(int M, int N, int G_, int c_) { nM = M / BM; nN = N / BM; nwg = nM * nN; G = G_; c = c_; }
    __host__ __device__ bool next(int i, Unit& u) const {
        const long L = (long)i * G + c; if (L >= nwg) return false;
        int wgid = (int)L; { const int q = nwg / NXCD, r = nwg % NXCD, xcd = wgid % NXCD, off = wgid / NXCD; wgid = (xcd < r ? xcd * (q + 1) : r * (q + 1) + (xcd - r) * q) + off; }
        const int nig = WGM * nN, gid = wgid / nig, fm = gid * WGM, gsz = (nM - fm) < WGM ? (nM - fm) : WGM;
        u.pm = fm + ((wgid % nig) % gsz); u.pn = (wgid % nig) / gsz; return true;
    }
    __device__ __forceinline__ void a_ready(const Unit&) const {}
    __device__ __forceinline__ void done(const Unit&) const {}
};
__device__ __forceinline__ unsigned cvtpk(float lo, float hi) { typedef float v2f __attribute__((ext_vector_type(2))); typedef __bf16 v2b __attribute__((ext_vector_type(2))); v2f v = {lo, hi}; v2b b = __builtin_convertvector(v, v2b); return __builtin_bit_cast(unsigned, b); }
__device__ __forceinline__ float sigm(float x) { return 1.0f / (1.0f + __expf(-x)); }
struct EpiStoreBf16 {
    static constexpr bool PERM = true, AFTER_DRAIN = false;
    bf16_t* O; int ldc;
    __device__ __forceinline__ void operator()(const f32x4 (&acc)[2][2][4][2], const Unit& u, int wr, int wc, int fr, int fq) const {
        const int row0 = u.pm * BM + wr * 64 + fr, col0 = u.pn * BM + wc * 32 + 8 * fq;
#pragma unroll
        for (int ai = 0; ai < 2; ++ai)
#pragma unroll
            for (int m = 0; m < 4; ++m) { bf16_t* rowp = O + (size_t)(row0 + ai * HALF + m * 16) * ldc + col0;
#pragma unroll
                for (int bj = 0; bj < 2; ++bj) { const f32x4 v0 = acc[ai][bj][m][0], v1 = acc[ai][bj][m][1];
                    u32x4 w; w.x = cvtpk(v0[0], v0[1]); w.y = cvtpk(v0[2], v0[3]); w.z = cvtpk(v1[0], v1[1]); w.w = cvtpk(v1[2], v1[3]);
                    *(u32x4*)(rowp + bj * HALF) = w; } }
    }
};
struct EpiLora {
    static constexpr bool PERM = true, AFTER_DRAIN = false;
    bf16_t* O; const float* w0; const float* a0;
    __device__ __forceinline__ void operator()(const f32x4 (&acc)[2][2][4][2], const Unit& u, int wr, int wc, int fr, int fq) const {
        const int row0 = u.pm * BM + wr * 64 + fr;
#pragma unroll
        for (int bj = 0; bj < 2; ++bj) {
            const int cb = u.pn * 2 + bj;
            if (cb < 15) {
                const int c0 = cb * 128 + wc * 32 + 8 * fq;
                if (cb >= 12) {
#pragma unroll
                    for (int ai = 0; ai < 2; ++ai)
#pragma unroll
                        for (int m = 0; m < 4; ++m) { const f32x4 v0 = acc[ai][bj][m][0], v1 = acc[ai][bj][m][1];
                            u32x4 w; w.x = cvtpk(v0[0], v0[1]); w.y = cvtpk(v0[2], v0[3]); w.z = cvtpk(v1[0], v1[1]); w.w = cvtpk(v1[2], v1[3]);
                            *(u32x4*)(O + (size_t)(row0 + ai * HALF + m * 16) * 1920 + c0) = w; }
                } else {
                    const int kind = wc >> 1, g = cb / 6, h = cb % 6;
                    const float* a0v = a0; const float* w0v = w0; asm volatile("" : "+s"(a0v), "+s"(w0v));
                    const float* bp = (kind ? a0v : w0v) + g * 384 + h * 64 + (wc & 1) * 32 + 8 * fq;
                    const f32x4 b0 = *(const f32x4*)bp, b1 = *(const f32x4*)(bp + 4);
                    const float mul = kind == 0 ? 0.60653065971263342f : 1.f;
#pragma unroll
                    for (int ai = 0; ai < 2; ++ai)
#pragma unroll
                        for (int m = 0; m < 4; ++m) { const f32x4 v0 = acc[ai][bj][m][0] + b0, v1 = acc[ai][bj][m][1] + b1;
                            u32x4 w; w.x = cvtpk(mul * sigm(v0[0]), mul * sigm(v0[1])); w.y = cvtpk(mul * sigm(v0[2]), mul * sigm(v0[3]));
                            w.z = cvtpk(mul * sigm(v1[0]), mul * sigm(v1[1])); w.w = cvtpk(mul * sigm(v1[2]), mul * sigm(v1[3]));
                            *(u32x4*)(O + (size_t)(row0 + ai * HALF + m * 16) * 1920 + c0) = w; }
                }
            }
        }
    }
};
struct EpiRes {
    static constexpr bool PERM = true, AFTER_DRAIN = false;
    const float* xl; const float* xc; float* ol; float* oc; const float* mod; int gofs;
    __device__ __forceinline__ void operator()(const f32x4 (&acc)[2][2][4][2], const Unit& u, int wr, int wc, int fr, int fq) const {
        const bool lat = u.pm < 256; const int bi = lat ? (u.pm >> 3) : 32;
        const size_t rbase = (size_t)(lat ? u.pm : u.pm - 256) * BM;
        const float* xlv = xl; const float* xcv = xc; float* olv = ol; float* ocv = oc; asm volatile("" : "+s"(xlv), "+s"(xcv), "+s"(olv), "+s"(ocv));
        const float* xin = (lat ? xlv : xcv) + rbase * 1024; float* out = (lat ? olv : ocv) + rbase * 1024;
        const float* gp = mod + (size_t)bi * 6144 + gofs;
        const int col0 = u.pn * BM + wc * 32 + 8 * fq, row0 = wr * 64 + fr;
#pragma unroll
        for (int bj = 0; bj < 2; ++bj)
#pragma unroll
            for (int n = 0; n < 2; ++n) { const int c = col0 + bj * HALF + 4 * n; const f32x4 gt = *(const f32x4*)(gp + c);
#pragma unroll
                for (int ai = 0; ai < 2; ++ai)
#pragma unroll
                    for (int m = 0; m < 4; ++m) { const size_t o = (size_t)(row0 + ai * HALF + m * 16) * 1024 + c;
                        const f32x4 xv = *(const f32x4*)(xin + o); const f32x4 a = acc[ai][bj][m][n];
                        f32x4 r; r[0] = 1.41421356237f * xv[0] + gt[0] * a[0]; r[1] = 1.41421356237f * xv[1] + gt[1] * a[1]; r[2] = 1.41421356237f * xv[2] + gt[2] * a[2]; r[3] = 1.41421356237f * xv[3] + gt[3] * a[3];
                        *(f32x4*)(out + o) = r; } }
    }
};
struct EpiSwiglu {
    static constexpr bool PERM = true, AFTER_DRAIN = false;
    bf16_t* O;
    __device__ __forceinline__ void operator()(const f32x4 (&acc)[2][2][4][2], const Unit& u, int wr, int wc, int fr, int fq) const {
        const int row0 = u.pm * BM + wr * 64 + fr, col0 = u.pn * HALF + wc * 32 + 8 * fq;
#pragma unroll
        for (int ai = 0; ai < 2; ++ai)
#pragma unroll
            for (int m = 0; m < 4; ++m) { float v[8];
#pragma unroll
                for (int i = 0; i < 8; ++i) { const float g = acc[ai][0][m][i >> 2][i & 3], up = acc[ai][1][m][i >> 2][i & 3]; v[i] = g * sigm(g) * up; }
                u32x4 w; w.x = cvtpk(v[0], v[1]); w.y = cvtpk(v[2], v[3]); w.z = cvtpk(v[4], v[5]); w.w = cvtpk(v[6], v[7]);
                *(u32x4*)(O + (size_t)(row0 + ai * HALF + m * 16) * 2816 + col0) = w; }
    }
};
struct EpiAny {
    static constexpr bool PERM = true, AFTER_DRAIN = false;
    int mode; EpiStoreBf16 e0; EpiLora e1; EpiRes e2; EpiSwiglu e3;
    __device__ __forceinline__ void operator()(const f32x4 (&acc)[2][2][4][2], const Unit& u, int wr, int wc, int fr, int fq) const {
        if (mode == 0) e0(acc, u, wr, wc, fr, fq); else if (mode == 1) e1(acc, u, wr, wc, fr, fq); else if (mode == 2) e2(acc, u, wr, wc, fr, fq); else e3(acc, u, wr, wc, fr, fq);
    }
};
template <class Epi, class Sched, bool ALIGN_EPI = false, bool SP2 = false>
__device__ __forceinline__ void gemm_phase(PG8_LAS unsigned char* lds, const Gemm g, const Sched& S, const Epi& E, const int tid) {
    const int wid = __builtin_amdgcn_readfirstlane(tid >> 6), lane = tid & 63, wr = wid >> 2, wc = wid & 3, fr = lane & 15, fq = lane >> 4;
    const int K = g.K, nt = K / BK;
    unsigned voffA[2], voffB[2];
#pragma unroll
    for (int i = 0; i < 2; ++i) { int R, C; stage_rc(tid * 16 + i * 8192, R, C); const int Rb = Epi::PERM ? ((R & ~31) + perm32(R & 31)) : R;
        voffA[i] = (unsigned)(R * K + C) * 2u; voffB[i] = (unsigned)(Rb * K + C) * 2u; }
    const size_t kstep = (size_t)(BK * 2);
    const size_t hstep = (size_t)HALF * K * 2;
    const size_t tstep = 2 * hstep;
    const unsigned ldsw = (unsigned)wid * 1024u;
    const int aoff = lds_byte(wr * 64 + fr, fq * 8), boff = lds_byte(wc * 32 + fr, fq * 8);
#define PG8_SA(b, h) (((b) * 2 + (h)) * HTB)
#define PG8_SB(b, h) ((4 + (b) * 2 + (h)) * HTB)
#define PG8_STAGE(bufoff, gbase, voff) do { _Pragma("unroll") for (int _i = 0; _i < 2; ++_i) \
        __builtin_amdgcn_global_load_lds((const unsigned*)((const char*)(gbase) + (voff)[_i]), (PG8_LAS unsigned*)(lds + (bufoff) + ldsw + _i * 8192), 16, 0, 0); } while (0)
#define PG8_LDA(dst, b, h) do { _Pragma("unroll") for (int m = 0; m < 4; ++m) _Pragma("unroll") for (int k = 0; k < 2; ++k) dst[m][k] = *(const PG8_LAS bf16x8*)(lds + PG8_SA(b, h) + aoff + m * 2048 + k * 1024); } while (0)
#define PG8_LDB(dst, b, h) do { _Pragma("unroll") for (int n = 0; n < 2; ++n) _Pragma("unroll") for (int k = 0; k < 2; ++k) dst[n][k] = *(const PG8_LAS bf16x8*)(lds + PG8_SB(b, h) + boff + n * 2048 + k * 1024); } while (0)
#define PG8_MMA(ai, bj, At, Bt) do { __builtin_amdgcn_s_setprio(1); _Pragma("unroll") for (int m = 0; m < 4; ++m) _Pragma("unroll") for (int n = 0; n < 2; ++n) _Pragma("unroll") for (int k = 0; k < 2; ++k) \
        acc[ai][bj][m][n] = __builtin_amdgcn_mfma_f32_16x16x32_bf16(Bt[n][k], At[m][k], acc[ai][bj][m][n], 0, 0, 0); __builtin_amdgcn_s_setprio(0); } while (0)
#define PG8_WAIT_V(n) asm volatile("s_waitcnt vmcnt(" #n ")" ::: "memory")
#define PG8_WAIT_L(n) asm volatile("s_waitcnt lgkmcnt(" #n ")" ::: "memory")
#define PG8_BAR __builtin_amdgcn_s_barrier()
#define PG8_SCHED __builtin_amdgcn_sched_barrier(0)
    Unit cur, nxt; int ui = 0;
    if (!S.next(0, cur)) return;
    f32x4 acc[2][2][4][2];
#pragma unroll
    for (int a = 0; a < 2; ++a)
#pragma unroll
        for (int b = 0; b < 2; ++b)
#pragma unroll
            for (int m = 0; m < 4; ++m)
#pragma unroll
                for (int n = 0; n < 2; ++n) acc[a][b][m][n] = (f32x4){0.f, 0.f, 0.f, 0.f};
    bf16x8 At[4][2], B0[2][2], B1[2][2];
    const char* cA = (const char*)g.A + (size_t)cur.pm * tstep; const char* cB = (const char*)g.Bt + (size_t)cur.pn * tstep;
    S.a_ready(cur);
    if constexpr (SP2) {
        PG8_STAGE(PG8_SB(0, 0), cB, voffB); PG8_STAGE(PG8_SB(0, 1), cB + hstep, voffB); PG8_STAGE(PG8_SA(0, 0), cA, voffA); PG8_STAGE(PG8_SA(0, 1), cA + hstep, voffA);
        if (wr == 1) PG8_BAR;
        PG8_WAIT_V(2); PG8_BAR;
        PG8_STAGE(PG8_SB(1, 0), cB + kstep, voffB); PG8_STAGE(PG8_SA(1, 0), cA + kstep, voffA); PG8_STAGE(PG8_SB(1, 1), cB + hstep + kstep, voffB);
        PG8_WAIT_V(6); PG8_BAR;
    } else {
        PG8_STAGE(PG8_SB(0, 0), cB, voffB); PG8_STAGE(PG8_SA(0, 0), cA, voffA); PG8_STAGE(PG8_SB(0, 1), cB + hstep, voffB); PG8_STAGE(PG8_SA(0, 1), cA + hstep, voffA);
        if (wr == 1) PG8_BAR;
        PG8_WAIT_V(4); PG8_BAR;
        PG8_STAGE(PG8_SB(1, 0), cB + kstep, voffB); PG8_STAGE(PG8_SA(1, 0), cA + kstep, voffA); PG8_STAGE(PG8_SB(1, 1), cB + hstep + kstep, voffB);
        PG8_WAIT_V(6); PG8_BAR;
    }
    for (;;) {
        const bool has_next = S.next(ui + 1, nxt);
        const char* nA = has_next ? (const char*)g.A + (size_t)nxt.pm * tstep : cA; const char* nB = has_next ? (const char*)g.Bt + (size_t)nxt.pn * tstep : cB;
        for (int t = 0; t < nt; t += 2) {
            const bool last = (t == nt - 2);
            const char* a1 = cA + (size_t)(t + 1) * kstep;
            const char* a2 = last ? nA : cA + (size_t)(t + 2) * kstep; const char* b2 = last ? nB : cB + (size_t)(t + 2) * kstep;
            const char* a3 = a2 + kstep; const char* b3 = b2 + kstep;
            if (last && has_next) S.a_ready(nxt);
            if constexpr (SP2) {
            PG8_LDB(B0, 0, 0); PG8_LDB(B1, 0, 1); PG8_SCHED; PG8_LDA(At, 0, 0); PG8_STAGE(PG8_SA(1, 1), a1 + hstep, voffA);
            PG8_WAIT_V(8); PG8_WAIT_L(0); PG8_BAR; PG8_MMA(0, 0, At, B0); PG8_MMA(0, 1, At, B1); PG8_BAR; PG8_SCHED;
            PG8_LDA(At, 0, 1); PG8_STAGE(PG8_SB(0, 0), b2, voffB); PG8_STAGE(PG8_SB(0, 1), b2 + hstep, voffB); PG8_STAGE(PG8_SA(0, 0), a2, voffA);
            PG8_WAIT_V(8); PG8_WAIT_L(0); PG8_BAR; PG8_MMA(1, 0, At, B0); PG8_MMA(1, 1, At, B1); PG8_BAR; PG8_SCHED;
            PG8_LDB(B0, 1, 0); PG8_LDB(B1, 1, 1); PG8_SCHED; PG8_LDA(At, 1, 0); PG8_STAGE(PG8_SA(0, 1), a2 + hstep, voffA);
            PG8_WAIT_V(8); PG8_WAIT_L(0); PG8_BAR; PG8_MMA(0, 0, At, B0); PG8_MMA(0, 1, At, B1); PG8_BAR; PG8_SCHED;
            PG8_LDA(At, 1, 1); PG8_STAGE(PG8_SB(1, 0), b3, voffB); PG8_STAGE(PG8_SB(1, 1), b3 + hstep, voffB); PG8_STAGE(PG8_SA(1, 0), a3, voffA);
            PG8_WAIT_V(8); PG8_WAIT_L(0); PG8_BAR; PG8_MMA(1, 0, At, B0); PG8_MMA(1, 1, At, B1); PG8_BAR; PG8_SCHED;
            } else {
            PG8_LDB(B0, 0, 0); PG8_SCHED; PG8_LDA(At, 0, 0); PG8_STAGE(PG8_SA(1, 1), a1 + hstep, voffA);
            PG8_WAIT_L(8); PG8_BAR; PG8_WAIT_L(0); PG8_MMA(0, 0, At, B0); PG8_BAR; PG8_SCHED;
            PG8_LDB(B1, 0, 1); PG8_STAGE(PG8_SB(0, 0), b2, voffB);
            PG8_BAR; PG8_WAIT_L(0); PG8_MMA(0, 1, At, B1); PG8_BAR;
            PG8_LDA(At, 0, 1); PG8_STAGE(PG8_SA(0, 0), a2, voffA);
            PG8_BAR; PG8_WAIT_L(0); PG8_MMA(1, 0, At, B0); PG8_BAR; PG8_SCHED;
            PG8_STAGE(PG8_SB(0, 1), b2 + hstep, voffB);
            PG8_WAIT_V(6); PG8_BAR; PG8_MMA(1, 1, At, B1); PG8_BAR;
            PG8_LDB(B0, 1, 0); PG8_SCHED; PG8_LDA(At, 1, 0); PG8_STAGE(PG8_SA(0, 1), a2 + hstep, voffA);
            PG8_WAIT_L(8); PG8_BAR; PG8_WAIT_L(0); PG8_MMA(0, 0, At, B0); PG8_BAR; PG8_SCHED;
            PG8_LDB(B1, 1, 1); PG8_STAGE(PG8_SB(1, 0), b3, voffB);
            PG8_BAR; PG8_WAIT_L(0); PG8_MMA(0, 1, At, B1); PG8_BAR;
            PG8_LDA(At, 1, 1); PG8_STAGE(PG8_SA(1, 0), a3, voffA);
            PG8_BAR; PG8_WAIT_L(0); PG8_MMA(1, 0, At, B0); PG8_BAR; PG8_SCHED;
            PG8_STAGE(PG8_SB(1, 1), b3 + hstep, voffB);
            PG8_WAIT_V(6); PG8_BAR; PG8_MMA(1, 1, At, B1); PG8_BAR;
            }
        }
        if constexpr (ALIGN_EPI) { if (wr == 0) PG8_BAR; }
        if constexpr (!Epi::AFTER_DRAIN) { E(acc, cur, wr, wc, fr, fq); S.done(cur); }
        if (!has_next) break;
#pragma unroll
        for (int a = 0; a < 2; ++a)
#pragma unroll
            for (int b = 0; b < 2; ++b)
#pragma unroll
                for (int m = 0; m < 4; ++m)
#pragma unroll
                    for (int n = 0; n < 2; ++n) acc[a][b][m][n] = (f32x4){0.f, 0.f, 0.f, 0.f};
        cur = nxt; cA = nA; cB = nB; ++ui;
        if constexpr (ALIGN_EPI) { if (wr == 1) PG8_BAR; }
    }
    PG8_WAIT_V(0);
    if constexpr (!ALIGN_EPI) { if (wr == 0) PG8_BAR; }
    PG8_BAR;
    if constexpr (Epi::AFTER_DRAIN) { E.fused(acc, cur, wr, wc, fr, fq, lds, wid, lane); S.done(cur); }
#undef PG8_SA
#undef PG8_SB
#undef PG8_STAGE
#undef PG8_LDA
#undef PG8_LDB
#undef PG8_MMA
#undef PG8_WAIT_V
#undef PG8_WAIT_L
#undef PG8_BAR
#undef PG8_SCHED
}
}

#define DI __device__ __forceinline__
#define LAS __attribute__((address_space(3)))
using pg8::bf16_t; using pg8::bf16x8; using pg8::f32x4; using pg8::u32x4; using pg8::cvtpk; using pg8::sigm;
typedef float f32x2 __attribute__((ext_vector_type(2)));
typedef unsigned u32x2 __attribute__((ext_vector_type(2)));

#ifndef NAT_IN
#define NAT_IN 46
#endif
#ifndef MIXMASK
#define MIXMASK 3
#endif
#ifndef ROLEMASK
#define ROLEMASK 15
#endif
#ifndef PHMASK
#define PHMASK 0xffff
#endif
constexpr int NTHR = 512, NWAVE = 8, LDS_BYTES = 147456;
constexpr int D = 1024, NB = 32, SL = 2048, CL = 256, ML = NB * SL, MC = NB * CL, MT = ML + MC;
constexpr int INC = 3488, PLD = 3584, FH = 2816, LOLD = 1920;
constexpr int C_NQ = 0, C_NK = 256, C_NV = 512;
constexpr int C_GQ = 768, C_GK = 960, C_GV = 1152, C_GG = 1536, C_GDN = 1920;
constexpr int C_RW = 1952;
constexpr size_t OFF_WIN = 0, OFF_WOUT = 7340032, OFF_W13 = 9437184, OFF_W2 = 20971520, OFF_BT2 = 26738688, WLB = 28311552;
constexpr size_t WS_MOD = 2 * WLB, WS_ROPE = WS_MOD + 1622016, WS_BON = WS_ROPE + 262144, WS_VT = WS_BON + 3538944, WS_AY = WS_VT + 37748736,
                 WS_PB = WS_AY + 150994944, WS_LO = WS_PB + 528482304, WS_BAR = WS_LO + 283115520, WS_END = WS_BAR + 16384;

struct Params { const float* in[29]; float* out; unsigned char* ws; };
enum { I_X = 0, I_C, I_CTX, I_CCTX, I_WMOD, I_BMOD, I_WIN, I_GUP, I_GB, I_GNW, I_RPB, I_MU, I_W0, I_WD2, I_A0, I_WA2, I_WG2, I_KK, I_KA, I_RK, I_GNWT, I_GNB,
       I_WOUT, I_LN1W, I_LN1B, I_W13, I_W2, I_LN2W, I_LN2B };

DI const float* pin(const Params& p, int i) { asm volatile("" : "+s"(i)); return p.in[i]; }
DI float bf2f(bf16_t h) { return __uint_as_float(((unsigned)h) << 16); }
DI float bflo(unsigned u) { return __uint_as_float(u << 16); }
DI float bfhi(unsigned u) { return __uint_as_float(u & 0xffff0000u); }
DI bf16_t f2bf(float f) { return (bf16_t)(cvtpk(f, 0.f) & 0xffffu); }
DI float shx(float v, int m, int lane) { return __int_as_float(__builtin_amdgcn_ds_bpermute((lane ^ m) << 2, __float_as_int(v))); }
#define DPPF(v, ctrl) __int_as_float(__builtin_amdgcn_mov_dpp(__float_as_int(v), (ctrl), 0xf, 0xf, true))
DI float sum4(float v) { v += DPPF(v, 0xB1); v += DPPF(v, 0x4E); return v; }
DI float sum8(float v) { v = sum4(v); v += DPPF(v, 0x141); return v; }
DI float sum16(float v) { v = sum8(v); v += DPPF(v, 0x140); return v; }
DI float x16_sum(float x) { const auto r = __builtin_amdgcn_permlane16_swap(__float_as_uint(x), __float_as_uint(x), false, false); return __uint_as_float(r[0]) + __uint_as_float(r[1]); }
DI float x32_sum(float x) { const auto r = __builtin_amdgcn_permlane32_swap(__float_as_uint(x), __float_as_uint(x), false, false); return __uint_as_float(r[0]) + __uint_as_float(r[1]); }
DI float x16_max(float x) { const auto r = __builtin_amdgcn_permlane16_swap(__float_as_uint(x), __float_as_uint(x), false, false); return fmaxf(__uint_as_float(r[0]), __uint_as_float(r[1])); }
DI float x32_max(float x) { const auto r = __builtin_amdgcn_permlane32_swap(__float_as_uint(x), __float_as_uint(x), false, false); return fmaxf(__uint_as_float(r[0]), __uint_as_float(r[1])); }
DI float wave_sum(float v, int) { return x32_sum(x16_sum(sum16(v))); }
DI void cvt8(const u32x4 u, float* o) { o[0] = bflo(u.x); o[1] = bfhi(u.x); o[2] = bflo(u.y); o[3] = bfhi(u.y); o[4] = bflo(u.z); o[5] = bfhi(u.z); o[6] = bflo(u.w); o[7] = bfhi(u.w); }
DI void load8(const bf16_t* p, float* o) { const u32x4 u = *(const u32x4*)p; o[0] = bflo(u.x); o[1] = bfhi(u.x); o[2] = bflo(u.y); o[3] = bfhi(u.y); o[4] = bflo(u.z); o[5] = bfhi(u.z); o[6] = bflo(u.w); o[7] = bfhi(u.w); }
DI void load16(const bf16_t* p, float (&o)[16]) { load8(p, &o[0]); load8(p + 8, &o[8]); }
DI void shift16(const bf16_t* prow, bool hasm, bool hasp, const float* mu, float (&y)[16]) {
    float c0[16], cm[16], cp[16];
    load16(prow, c0);
    if (hasm) load16(prow - PLD, cm); else {
#pragma unroll
        for (int j = 0; j < 16; ++j) cm[j] = 0.f; }
    if (hasp) load16(prow + PLD, cp); else {
#pragma unroll
        for (int j = 0; j < 16; ++j) cp[j] = 0.f; }
#pragma unroll
    for (int j = 0; j < 16; ++j) y[j] = c0[j] + (0.5f * (cm[j] + cp[j]) - c0[j]) * mu[j];
}
DI void step_row(int s, int g, int b, int& row, int& ts, int& Ls) {
    if (s < CL) { ts = g ? (CL - 1 - s) : s; row = ML + b * CL + ts; Ls = CL; }
    else { const int u = s - CL; ts = g ? (SL - 1 - u) : u; row = b * SL + ts; Ls = SL; }
}

DI void transpose_item(const float* W, int N, bf16_t* WT, int Kd, size_t dst_row0, int k0, int n0, LAS float* scr, int lane) {
#pragma unroll 8
    for (int i = 0; i < 32; ++i) { const int kk = 2 * i + (lane >> 5); scr[kk * 33 + (lane & 31)] = W[(size_t)(k0 + kk) * N + n0 + (lane & 31)]; }
    asm volatile("s_waitcnt lgkmcnt(0)" ::: "memory");
    const int c = lane & 7;
#pragma unroll
    for (int j = 0; j < 4; ++j) { const int n = (lane >> 3) + 8 * j; const LAS float* s = scr + (8 * c) * 33 + n;
        u32x4 o; o.x = cvtpk(s[0 * 33], s[1 * 33]); o.y = cvtpk(s[2 * 33], s[3 * 33]); o.z = cvtpk(s[4 * 33], s[5 * 33]); o.w = cvtpk(s[6 * 33], s[7 * 33]);
        *(u32x4*)(WT + (dst_row0 + n) * Kd + k0 + 8 * c) = o; }
    asm volatile("s_waitcnt lgkmcnt(0)" ::: "memory");
}

DI void phase_prologue(const Params& p, LAS unsigned char* lds, int tid, int lane, int wave) {
    unsigned char* ws = p.ws;
    float* MOD = (float*)(ws + WS_MOD);
    {
        LAS float* sc = (LAS float*)lds;
        LAS float* part = (LAS float*)(lds + 135168);
        for (int i = tid; i < 33 * 1024; i += NTHR) { const int bi = i >> 10, k = i & 1023; const float cv = bi < 32 ? pin(p, I_C)[bi * 1024 + k] : pin(p, I_CCTX)[k]; sc[k * 33 + bi] = cv * sigm(cv); }
        __syncthreads();
        for (int u = blockIdx.x; u < 192; u += gridDim.x) {
            const int l = u / 96, n0 = (u % 96) * 64;
            float acc[33];
#pragma unroll
            for (int bi = 0; bi < 33; ++bi) acc[bi] = 0.f;
            const float* wp = pin(p, I_WMOD) + (size_t)l * 1024 * 6144 + n0 + lane;
#pragma unroll 8
            for (int kk = 0; kk < 128; ++kk) { const int k = wave * 128 + kk; const float w = wp[(size_t)k * 6144];
#pragma unroll
                for (int bi = 0; bi < 33; ++bi) acc[bi] += sc[k * 33 + bi] * w; }
            for (int w = 0; w < NWAVE; ++w) {
                if (wave == w) {
#pragma unroll
                    for (int bi = 0; bi < 33; ++bi) { if (w == 0) part[bi * 64 + lane] = acc[bi]; else part[bi * 64 + lane] += acc[bi]; } }
                __syncthreads();
            }
            for (int i = tid; i < 33 * 64; i += NTHR) { const int bi = i >> 6, n = i & 63; MOD[(size_t)(l * 33 + bi) * 6144 + n0 + n] = part[i] + pin(p, I_BMOD)[l * 6144 + n0 + n]; }
            __syncthreads();
        }
        __syncthreads();
    }
    const int gw = blockIdx.x * NWAVE + wave, NGW = gridDim.x * NWAVE;
    const int gt = blockIdx.x * NTHR + tid, NGT = gridDim.x * NTHR;
    {
        LAS float* scr = (LAS float*)(lds + wave * 8448);
        constexpr int IT_IN = 16 * 109, IT_OUT = 16 * 32, IT_13 = 16 * 176, IT_2 = 44 * 32, IT_L = IT_IN + IT_OUT + IT_13 + IT_2;
        for (int it = gw; it < 2 * IT_L; it += NGW) {
            const int l = it / IT_L; int r = it % IT_L;
            unsigned char* wl = ws + (size_t)l * WLB;
            if (r < IT_IN) { const int kb = r / 109, nb = r % 109;
                const int n0 = nb * 32; const int drow = n0 < 1184 ? n0 + 768 : (n0 < 1952 ? n0 - 1184 : n0);
                transpose_item(pin(p, I_WIN) + (size_t)l * 1024 * INC, INC, (bf16_t*)(wl + OFF_WIN), 1024, (size_t)drow, kb * 64, n0, scr, lane); continue; }
            r -= IT_IN;
            if (r < IT_OUT) { const int kb = r / 32, nb = r % 32;
                transpose_item(pin(p, I_WOUT) + (size_t)l * 1024 * 1024, 1024, (bf16_t*)(wl + OFF_WOUT), 1024, (size_t)nb * 32, kb * 64, nb * 32, scr, lane); continue; }
            r -= IT_OUT;
            if (r < IT_13) { const int kb = r / 176, nb = r % 176; const int n0 = nb * 32;
                const int j = n0 < FH ? n0 : n0 - FH; const size_t drow = (size_t)(256 * (j / 128) + (n0 < FH ? 0 : 128) + (j % 128));
                transpose_item(pin(p, I_W13) + (size_t)l * 1024 * 2 * FH, 2 * FH, (bf16_t*)(wl + OFF_W13), 1024, drow, kb * 64, n0, scr, lane); continue; }
            r -= IT_13;
            { const int kb = r / 32, nb = r % 32;
                transpose_item(pin(p, I_W2) + (size_t)l * FH * 1024, 1024, (bf16_t*)(wl + OFF_W2), FH, (size_t)nb * 32, kb * 64, nb * 32, scr, lane); }
        }
    }
    for (int i = gt; i < 2 * 96 * 1024; i += NGT) { const int l = i / (96 * 1024), r = i % (96 * 1024); ((bf16_t*)(ws + (size_t)l * WLB + OFF_WIN))[(size_t)INC * 1024 + r] = 0; }
    for (int i = gt; i < 2 * 2048 * 384; i += NGT) {
        const int l = i / (2048 * 384), r = i % (2048 * 384), n = r / 384, k = r % 384;
        float v = 0.f;
        if (n < 1536) { const int g = n / 768, h = (n % 768) / 128, which = (n % 128) / 64, ch = n % 64, c = h * 64 + ch;
            const int kb = which ? 128 + 64 * g : 64 * g;
            if (k >= kb && k < kb + 64) v = (which ? pin(p, I_WA2) : pin(p, I_WD2))[((size_t)(l * 2 + g) * 64 + (k - kb)) * 384 + c]; }
        else if (n < 1920) { if (k >= 256) v = pin(p, I_WG2)[((size_t)l * 128 + (k - 256)) * 384 + (n - 1536)]; }
        ((bf16_t*)(ws + (size_t)l * WLB + OFF_BT2))[r] = f2bf(v);
    }
    for (int i = gt; i < SL * 16; i += NGT) { const int t = i >> 4, pi = i & 15; const float pos = (float)(pi < 8 ? (t >> 6) : (t & 63));
        const float inv = powf(10000.0f, -(float)(pi & 7) * 0.125f); const float ang = pos * inv;
        float* rt = (float*)(ws + WS_ROPE) + (size_t)i * 2; rt[0] = cosf(ang); rt[1] = sinf(ang); }
}

DI void phase_modulate0(const Params& p, int lane, int wave) {
    const int gw = blockIdx.x * NWAVE + wave, NGW = gridDim.x * NWAVE;
    const float* MOD = (const float*)(p.ws + WS_MOD); bf16_t* A = (bf16_t*)(p.ws + WS_AY);
    for (int row = gw; row < MT; row += NGW) {
        const float* src = row < ML ? pin(p, I_X) + (size_t)row * D : pin(p, I_CTX) + (size_t)(row - ML) * D;
        const int bi = row < ML ? (row >> 11) : 32; const float* md = MOD + (size_t)bi * 6144;
#pragma unroll
        for (int j = 0; j < 4; ++j) { const int c = 4 * (lane + 64 * j); const f32x4 v = *(const f32x4*)(src + c), sh = *(const f32x4*)(md + c), sc = *(const f32x4*)(md + 1024 + c);
            u32x2 o; o.x = cvtpk(v[0] * (1.f + sc[0]) + sh[0], v[1] * (1.f + sc[1]) + sh[1]); o.y = cvtpk(v[2] * (1.f + sc[2]) + sh[2], v[3] * (1.f + sc[3]) + sh[3]);
            *(u32x2*)(A + (size_t)row * D + c) = o; }
    }
}
DI void phase_ln(const Params& p, int lane, int wave, int nrows, const float* lnw, const float* lnb, const float* modl, int sh_ofs, int sc_ofs, bool write_x, bool write_A, bool dry = false) {
    const int gw = blockIdx.x * NWAVE + wave, NGW = gridDim.x * NWAVE;
    bf16_t* A = (bf16_t*)(p.ws + WS_AY); float* tc = (float*)(p.ws + WS_VT);
    f32x4 nx[4];
    if (gw < nrows) { const float* t0 = gw < ML ? p.out + (size_t)gw * D : tc + (size_t)(gw - ML) * D;
#pragma unroll
        for (int j = 0; j < 4; ++j) nx[j] = *(const f32x4*)(t0 + 4 * (lane + 64 * j)); }
    for (int row = gw; row < nrows; row += NGW) {
        const bool lat = row < ML;
        float* t = lat ? p.out + (size_t)row * D : tc + (size_t)(row - ML) * D;
        const int bi = lat ? (row >> 11) : 32;
        f32x4 v[4]; float s = 0.f;
#pragma unroll
        for (int j = 0; j < 4; ++j) { v[j] = nx[j]; s += (v[j][0] + v[j][1]) + (v[j][2] + v[j][3]); }
        { const int rn = row + NGW; if (rn < nrows) { const float* tn = rn < ML ? p.out + (size_t)rn * D : tc + (size_t)(rn - ML) * D;
#pragma unroll
            for (int j = 0; j < 4; ++j) nx[j] = *(const f32x4*)(tn + 4 * (lane + 64 * j)); } }
        const float mean = wave_sum(s, lane) * (1.f / D); float s2 = 0.f;
#pragma unroll
        for (int j = 0; j < 4; ++j) { v[j] = v[j] - mean; s2 += (v[j][0] * v[j][0] + v[j][1] * v[j][1]) + (v[j][2] * v[j][2] + v[j][3] * v[j][3]); }
        const float rstd = rsqrtf(wave_sum(s2, lane) * (1.f / D) + 1e-5f);
        const float* md = modl + (size_t)bi * 6144;
#pragma unroll
        for (int j = 0; j < 4; ++j) { const int c = 4 * (lane + 64 * j); const f32x4 w = *(const f32x4*)(lnw + c), b = *(const f32x4*)(lnb + c);
            f32x4 y; y[0] = v[j][0] * rstd * w[0] + b[0]; y[1] = v[j][1] * rstd * w[1] + b[1]; y[2] = v[j][2] * rstd * w[2] + b[2]; y[3] = v[j][3] * rstd * w[3] + b[3];
            const bool okst = !dry || y[0] == 1.2345e37f;
            if (write_x && okst) *(f32x4*)(t + c) = y;
            if (write_A && okst) { const f32x4 sh = *(const f32x4*)(md + sh_ofs + c), sc = *(const f32x4*)(md + sc_ofs + c);
                u32x2 o; o.x = cvtpk(y[0] * (1.f + sc[0]) + sh[0], y[1] * (1.f + sc[1]) + sh[1]); o.y = cvtpk(y[2] * (1.f + sc[2]) + sh[2], y[3] * (1.f + sc[3]) + sh[3]);
                *(u32x2*)(A + (size_t)row * D + c) = o; } }
    }
}

DI void phase_prep(const Params& p, int l, LAS unsigned char* lds, int lane, int wave) {
    const int gw = blockIdx.x * NWAVE + wave, NGW = gridDim.x * NWAVE;
    const bf16_t* PB = (const bf16_t*)(p.ws + WS_PB); bf16_t* A2 = (bf16_t*)(p.ws + WS_AY); bf16_t* VT = (bf16_t*)(p.ws + WS_VT);
    {
        const int j8 = lane < 48 ? 8 * lane : 0, kind = j8 >> 7;
        float mu[8];
        { const float* m = pin(p, I_MU) + (size_t)l * 1536 + 1152 + j8;
#pragma unroll
          for (int j = 0; j < 8; ++j) mu[j] = m[j]; }
        for (int row = gw; row < MT; row += NGW) {
            const bool lat = row < ML; const int t = lat ? (row & (SL - 1)) : ((row - ML) & (CL - 1)); const int Ls = lat ? SL : CL;
            const bf16_t* pr = PB + (size_t)row * PLD + C_RW + 1152 + j8;
            const u32x4 r0 = *(const u32x4*)pr, rm = *(const u32x4*)(t > 0 ? pr - PLD : pr), rp = *(const u32x4*)(t < Ls - 1 ? pr + PLD : pr);
            const float mm = t > 0 ? 0.5f : 0.f, mp = t < Ls - 1 ? 0.5f : 0.f;
            float c0[8], cm[8], cp[8], o[8];
            cvt8(r0, c0); cvt8(rm, cm); cvt8(rp, cp);
#pragma unroll
            for (int j = 0; j < 8; ++j) { const float y = c0[j] + ((mm * cm[j] + mp * cp[j]) - c0[j]) * mu[j];
                o[j] = kind == 0 ? 1.f - 2.f / (1.f + __expf(2.f * y)) : (kind == 1 ? y : sigm(y)); }
            if (lane < 48) { u32x4 w; w.x = cvtpk(o[0], o[1]); w.y = cvtpk(o[2], o[3]); w.z = cvtpk(o[4], o[5]); w.w = cvtpk(o[6], o[7]); *(u32x4*)(A2 + (size_t)row * 384 + j8) = w; }
        }
    }
    LAS bf16_t* T = (LAS bf16_t*)(lds + wave * 8448);
    for (int it = gw; it < NB * 4 * 36; it += NGW) {
        const int tb = it % 36, h = (it / 36) & 3, b = it / 144;
        const int row0 = tb < 32 ? b * SL + tb * 64 : ML + b * CL + (tb - 32) * 64;
        const bf16_t* src = PB + (size_t)(row0 + (lane >> 3)) * PLD + C_NV + h * 64 + 8 * (lane & 7);
#pragma unroll
        for (int i = 0; i < 8; ++i) { const u32x4 v = *(const u32x4*)(src + (size_t)(8 * i) * PLD);
            LAS unsigned* d = (LAS unsigned*)(T + (8 * i + (lane >> 3)) * 66 + 8 * (lane & 7)); d[0] = v.x; d[1] = v.y; d[2] = v.z; d[3] = v.w; }
        asm volatile("s_waitcnt vmcnt(0) lgkmcnt(0)" ::: "memory");
        bf16_t* dst = VT + ((size_t)(b * 4 + h) * 144 + tb * 4) * 1024;
#pragma unroll
        for (int k = 0; k < 16; ++k) { const int u = k * 64 + lane, q = u >> 8, d = (u >> 2) & 63, kg = u & 3;
            const LAS bf16_t* tp = T + (16 * q + 4 * kg) * 66 + d;
            u32x2 o; o.x = (unsigned)tp[0] | ((unsigned)tp[66] << 16); o.y = (unsigned)tp[132] | ((unsigned)tp[198] << 16);
            *(u32x2*)(dst + (size_t)(q * 64 + d) * 16 + 4 * kg) = o; }
        asm volatile("s_waitcnt lgkmcnt(0)" ::: "memory");
    }
}

#define MFMA16(a, b, c) __builtin_amdgcn_mfma_f32_16x16x32_bf16((a), (b), (c), 0, 0, 0)
DI u32x4 vload16(const bf16_t* p) { const volatile unsigned* q = (const volatile unsigned*)p; u32x4 r; r.x = q[0]; r.y = q[1]; r.z = q[2]; r.w = q[3]; return r; }
DI u32x2 vload8(const bf16_t* p) { const volatile unsigned* q = (const volatile unsigned*)p; u32x2 r; r.x = q[0]; r.y = q[1]; return r; }
struct NatPair { bf16x8 k[2][2]; u32x2 v[4][2]; u32x2 bias[2]; };
DI void nat_unit(const Params& p, int l, int id, bool isctx, int lane) {
    const bf16_t* PB = (const bf16_t*)(p.ws + WS_PB); const bf16_t* VT = (const bf16_t*)(p.ws + WS_VT); bf16_t* AY = (bf16_t*)(p.ws + WS_AY);
    const int l15 = lane & 15, g = lane >> 4;
    int b, h, r = 0, qt, qrow;
    if (!isctx) { qt = id & 3; r = (id >> 2) & 31; h = (id >> 7) & 3; b = id >> 9; qrow = b * SL + r * 64 + 16 * qt + l15; }
    else { qt = id & 15; h = (id >> 4) & 3; b = id >> 6; qrow = ML + b * CL + 16 * qt + l15; }
    const bf16_t* qp = PB + (size_t)qrow * PLD + C_NQ + h * 64 + 8 * g;
    const bf16x8 qf0 = *(const bf16x8*)qp, qf1 = *(const bf16x8*)(qp + 32);
    const int rs = min(max(r - 4, 0), 24);
    int ct_lo = 0, nct = 1;
    if (!isctx) { const int lo = min(max(16 * qt - 8, 0), 48), hi = min(max(16 * qt + 7, 0), 48) + 16; ct_lo = lo >> 4; nct = ((hi - 1) >> 4) - ct_lo + 1; }
    const int nloc = isctx ? 0 : 8 * nct, npairs = nloc / 2 + 8;
    const int qc = 16 * qt + l15, cs = min(max(qc - 8, 0), 48);
    float m = -1e30f, lsum = 0.f;
    f32x4 oacc[4];
#pragma unroll
    for (int dt = 0; dt < 4; ++dt) oacc[dt] = (f32x4){0.f, 0.f, 0.f, 0.f};
    const bf16_t* vt = VT + (size_t)(b * 4 + h) * 144 * 1024 + l15 * 16 + 4 * g;
    const bf16_t* kbase = PB + (size_t)l15 * PLD + C_NK + h * 64 + 8 * g;
    const float* rp = pin(p, I_RPB) + (size_t)((l * 4 + h) * 15) * 31;
    NatPair ring[4];
    int iti = 0, ikr = 0, icj = 0;
#define NAT_ISSUE(slot) do { __builtin_amdgcn_sched_barrier(0); _Pragma("unroll") for (int e = 0; e < 2; ++e) { int tk, keyrow; f32x4 bs = (f32x4){0.f, 0.f, 0.f, 0.f}; \
        if (iti < nloc) { const int ct = ct_lo + icj; tk = (rs + ikr) * 64 + 16 * ct; keyrow = b * SL + tk; const float* rpr = rp + (rs + ikr - r + 7) * 31; \
            _Pragma("unroll") for (int rg = 0; rg < 4; ++rg) { const int kc = 16 * ct + 4 * g + rg; const bool vis = (kc >= cs) && (kc < cs + 16); const float bv = rpr[min(max(kc - qc + 15, 0), 30)]; bs[rg] = vis ? bv : -1e30f; } \
            if (++icj == nct) { icj = 0; ++ikr; } } \
        else { const int j = (iti - nloc) * 16; tk = SL + j; keyrow = ML + b * CL + j; } \
        ++iti; ring[slot].bias[e] = (u32x2){cvtpk(bs[0], bs[1]), cvtpk(bs[2], bs[3])}; \
        const bf16_t* kp = kbase + (size_t)keyrow * PLD; ring[slot].k[e][0] = *(const bf16x8*)kp; ring[slot].k[e][1] = *(const bf16x8*)(kp + 32); \
        _Pragma("unroll") for (int dt = 0; dt < 4; ++dt) ring[slot].v[dt][e] = *(const u32x2*)(vt + (size_t)(tk >> 4) * 1024 + dt * 256); } __builtin_amdgcn_sched_barrier(0); } while (0)
#pragma unroll
    for (int j = 0; j < 4; ++j) NAT_ISSUE(j);
    for (int pi0 = 0; pi0 < npairs; pi0 += 4) {
#pragma unroll
        for (int j = 0; j < 4; ++j) {
            const int pi = pi0 + j;
            f32x4 s[2];
#pragma unroll
            for (int e = 0; e < 2; ++e) {
                f32x4 a = (f32x4){0.f, 0.f, 0.f, 0.f};
                a = MFMA16(ring[j].k[e][0], qf0, a); a = MFMA16(ring[j].k[e][1], qf1, a);
                const u32x2 bb = ring[j].bias[e];
                s[e] = a * 0.125f + (f32x4){bflo(bb.x), bfhi(bb.x), bflo(bb.y), bfhi(bb.y)};
            }
            float tmax = fmaxf(fmaxf(fmaxf(s[0][0], s[0][1]), fmaxf(s[0][2], s[0][3])), fmaxf(fmaxf(s[1][0], s[1][1]), fmaxf(s[1][2], s[1][3])));
            tmax = x32_max(x16_max(tmax));
            const float mn = fmaxf(m, tmax), corr = __expf(m - mn); m = mn;
            float pv[8]; float ps = 0.f;
#pragma unroll
            for (int i = 0; i < 8; ++i) { const float sv = s[i >> 2][i & 3]; pv[i] = sv > -1e29f ? __expf(sv - mn) : 0.f; ps += pv[i]; }
            lsum = lsum * corr + ps;
            u32x4 pk; pk.x = cvtpk(pv[0], pv[1]); pk.y = cvtpk(pv[2], pv[3]); pk.z = cvtpk(pv[4], pv[5]); pk.w = cvtpk(pv[6], pv[7]);
            const bf16x8 pf = __builtin_bit_cast(bf16x8, pk);
#pragma unroll
            for (int dt = 0; dt < 4; ++dt) {
                u32x4 vv; vv.x = ring[j].v[dt][0].x; vv.y = ring[j].v[dt][0].y; vv.z = ring[j].v[dt][1].x; vv.w = ring[j].v[dt][1].y;
                oacc[dt] = oacc[dt] * corr;
                oacc[dt] = MFMA16(__builtin_bit_cast(bf16x8, vv), pf, oacc[dt]);
            }
            if (pi + 4 < npairs) NAT_ISSUE(j);
        }
    }
#undef NAT_ISSUE
    lsum = x32_sum(x16_sum(lsum));
    const float inv = 1.0f / lsum;
    bf16_t* yp = AY + (size_t)qrow * D + 768 + h * 64 + 4 * g;
#pragma unroll
    for (int dt = 0; dt < 4; ++dt) { u32x2 o; o.x = cvtpk(oacc[dt][0] * inv, oacc[dt][1] * inv); o.y = cvtpk(oacc[dt][2] * inv, oacc[dt][3] * inv); *(u32x2*)(yp + 16 * dt) = o; }
}

constexpr int RW_STEP = 384, RW_BUF = 16 * RW_STEP, GL_STEP = 160, GL_BUF = 16 * GL_STEP, NCHUNK = (CL + SL) / 16;
struct RwRaw { u32x4 d[3][3][2]; u32x4 lo[4]; };
DI void rwkv_load(const Params& p, int item, int c, RwRaw& R, int lane) {
    const int g = item & 1, h = (item >> 1) % 6, b = item / 12;
    const int ti = lane >> 2, cg = lane & 3;
    int row, ts, Ls; step_row(16 * c + ti, g, b, row, ts, Ls);
    const int rm = ts > 0 ? row - 1 : row, rp = ts < Ls - 1 ? row + 1 : row;
    const bf16_t* PB = (const bf16_t*)(p.ws + WS_PB) + C_RW + h * 64 + 16 * cg;
    const bf16_t* p0 = PB + (size_t)row * PLD; const bf16_t* pm = PB + (size_t)rm * PLD; const bf16_t* pp = PB + (size_t)rp * PLD;
#pragma unroll
    for (int a = 0; a < 3; ++a)
#pragma unroll
        for (int hf = 0; hf < 2; ++hf) { R.d[a][0][hf] = *(const u32x4*)(pm + a * 384 + 8 * hf); R.d[a][1][hf] = *(const u32x4*)(p0 + a * 384 + 8 * hf); R.d[a][2][hf] = *(const u32x4*)(pp + a * 384 + 8 * hf); }
    const bf16_t* lo = (const bf16_t*)(p.ws + WS_LO) + (size_t)row * LOLD + (g * 6 + h) * 128 + 16 * cg;
    R.lo[0] = *(const u32x4*)lo; R.lo[1] = *(const u32x4*)(lo + 8); R.lo[2] = *(const u32x4*)(lo + 64); R.lo[3] = *(const u32x4*)(lo + 72);
}
DI void rwkv_compute(const Params& p, int item, int c, const RwRaw& R, LAS float* buf, const LAS float* CST, int lane) {
    const int g = item & 1, h = (item >> 1) % 6, b = item / 12;
    const int ti = lane >> 2, cg = lane & 3;
    int row, ts, Ls; step_row(16 * c + ti, g, b, row, ts, Ls);
    const float mm = ts > 0 ? 0.5f : 0.f, mp = ts < Ls - 1 ? 0.5f : 0.f;
    float y[3][16];
#pragma unroll
    for (int a = 0; a < 3; ++a) {
        float c0[16], cm[16], cp[16];
        cvt8(R.d[a][0][0], &cm[0]); cvt8(R.d[a][0][1], &cm[8]); cvt8(R.d[a][1][0], &c0[0]); cvt8(R.d[a][1][1], &c0[8]); cvt8(R.d[a][2][0], &cp[0]); cvt8(R.d[a][2][1], &cp[8]);
#pragma unroll
        for (int j4 = 0; j4 < 4; ++j4) { const f32x4 mu = *(const LAS f32x4*)(CST + a * 64 + 16 * cg + 4 * j4);
#pragma unroll
            for (int jj = 0; jj < 4; ++jj) { const int j = 4 * j4 + jj; y[a][j] = c0[j] + ((mm * cm[j] + mp * cp[j]) - c0[j]) * mu[jj]; } }
    }
    float lw[16], a[16];
    cvt8(R.lo[0], &lw[0]); cvt8(R.lo[1], &lw[8]); cvt8(R.lo[2], &a[0]); cvt8(R.lo[3], &a[8]);
    float kkv[16]; float ss = 0.f;
#pragma unroll
    for (int j4 = 0; j4 < 4; ++j4) { const f32x4 kc = *(const LAS f32x4*)(CST + 3 * 64 + 16 * cg + 4 * j4);
#pragma unroll
        for (int jj = 0; jj < 4; ++jj) { const int j = 4 * j4 + jj; kkv[j] = y[1][j] * kc[jj]; ss += kkv[j] * kkv[j]; } }
    ss = sum4(ss);
    const float inv = rsqrtf(ss + 1e-12f);
    float bon = 0.f;
    LAS float* o = buf + ti * RW_STEP + 16 * cg;
#pragma unroll
    for (int j4 = 0; j4 < 4; ++j4) {
        const f32x4 kac = *(const LAS f32x4*)(CST + 4 * 64 + 16 * cg + 4 * j4), rkc = *(const LAS f32x4*)(CST + 5 * 64 + 16 * cg + 4 * j4);
        f32x4 w4, b4, km4, r4, kk4, v4;
#pragma unroll
        for (int jj = 0; jj < 4; ++jj) { const int j = 4 * j4 + jj;
            const float kkn = kkv[j] * inv, aj = a[j];
            const float km = y[1][j] * (1.f + (aj - 1.f) * kac[jj]);
            w4[jj] = __expf(-lw[j]); b4[jj] = kkn * aj; km4[jj] = km; r4[jj] = y[0][j]; kk4[jj] = kkn; v4[jj] = y[2][j];
            bon += y[0][j] * km * rkc[jj]; }
        *(LAS f32x4*)(o + 0 * 64 + 4 * j4) = w4; *(LAS f32x4*)(o + 1 * 64 + 4 * j4) = b4; *(LAS f32x4*)(o + 2 * 64 + 4 * j4) = km4;
        *(LAS f32x4*)(o + 3 * 64 + 4 * j4) = r4; *(LAS f32x4*)(o + 4 * 64 + 4 * j4) = kk4; *(LAS f32x4*)(o + 5 * 64 + 4 * j4) = v4;
    }
    bon = sum4(bon);
    if (cg == 0) ((float*)(p.ws + WS_BON))[(size_t)row * 12 + g * 6 + h] = bon;
}
DI float xhalf_sum(float x) {
    const auto r = __builtin_amdgcn_permlane32_swap(__float_as_uint(x), __float_as_uint(x), false, false);
    return __uint_as_float(r[0]) + __uint_as_float(r[1]);
}
DI void rwkv_scan_chunk(const Params& p, int item, int c, const LAS float* buf, f32x2 (&S)[16], int lane, int hf, bool dry) {
    const int g = item & 1, h = (item >> 1) % 6, b = item / 12;
    float* LOf = (float*)(p.ws + WS_LO);
    const int kh = lane >> 5, rowi = 32 * hf + (lane & 31);
    const LAS float* bk = buf + 32 * kh;
    f32x4 KK[8];
#pragma unroll
    for (int i = 0; i < 8; ++i) KK[i] = *(const LAS f32x4*)(bk + 256 + 4 * i);
    float vv = buf[320 + rowi];
    for (int st = 0; st < 16; ++st) {
        const LAS float* W = bk + st * RW_STEP;
        const LAS float* Wn = bk + (st < 15 ? st + 1 : st) * RW_STEP;
        f32x4 U[2][8];
#pragma unroll
        for (int j = 0; j < 2; ++j) { U[0][4 * j] = *(const LAS f32x4*)(W + 4 * j); U[0][4 * j + 1] = *(const LAS f32x4*)(W + 64 + 4 * j); U[0][4 * j + 2] = *(const LAS f32x4*)(W + 128 + 4 * j); U[0][4 * j + 3] = *(const LAS f32x4*)(W + 192 + 4 * j); }
        f32x2 sacc[4];
#pragma unroll
        for (int i = 0; i < 4; ++i) sacc[i] = (f32x2){0.f, 0.f};
#pragma unroll
        for (int i = 0; i < 8; ++i) { sacc[(2 * i) & 3] += S[2 * i] * (f32x2){KK[i][0], KK[i][1]}; sacc[(2 * i + 1) & 3] += S[2 * i + 1] * (f32x2){KK[i][2], KK[i][3]}; }
        const f32x2 st2 = (sacc[0] + sacc[1]) + (sacc[2] + sacc[3]);
        const float sa = -xhalf_sum(st2[0] + st2[1]);
        const f32x2 sa2 = (f32x2){sa, sa}, vv2 = (f32x2){vv, vv};
        f32x2 oacc[4];
#pragma unroll
        for (int i = 0; i < 4; ++i) oacc[i] = (f32x2){0.f, 0.f};
        asm volatile("" : "+v"(oacc[0]), "+v"(oacc[1]) :: "memory");
#pragma unroll
        for (int gi = 0; gi < 4; ++gi) {
            const int cu = gi & 1, nx = cu ^ 1;
            if (gi < 3) {
#pragma unroll
                for (int j = 0; j < 2; ++j) { const int i = 2 * (gi + 1) + j; U[nx][4 * j] = *(const LAS f32x4*)(W + 4 * i); U[nx][4 * j + 1] = *(const LAS f32x4*)(W + 64 + 4 * i);
                    U[nx][4 * j + 2] = *(const LAS f32x4*)(W + 128 + 4 * i); U[nx][4 * j + 3] = *(const LAS f32x4*)(W + 192 + 4 * i); }
            }
            if (gi >= 2) {
#pragma unroll
                for (int j = 0; j < 4; ++j) KK[4 * (gi - 2) + j] = *(const LAS f32x4*)(Wn + 256 + 4 * (4 * (gi - 2) + j));
            }
#pragma unroll
            for (int j = 0; j < 2; ++j) { const int i = 2 * gi + j; const f32x4 w4 = U[cu][4 * j], b4 = U[cu][4 * j + 1], km4 = U[cu][4 * j + 2], r4 = U[cu][4 * j + 3];
                f32x2 t0 = vv2 * (f32x2){km4[0], km4[1]}; t0 = sa2 * (f32x2){b4[0], b4[1]} + t0; S[2 * i] = S[2 * i] * (f32x2){w4[0], w4[1]} + t0;
                f32x2 t1 = vv2 * (f32x2){km4[2], km4[3]}; t1 = sa2 * (f32x2){b4[2], b4[3]} + t1; S[2 * i + 1] = S[2 * i + 1] * (f32x2){w4[2], w4[3]} + t1;
                oacc[(2 * i) & 3] += S[2 * i] * (f32x2){r4[0], r4[1]}; oacc[(2 * i + 1) & 3] += S[2 * i + 1] * (f32x2){r4[2], r4[3]}; }
            asm volatile("" : "+v"(oacc[0]), "+v"(oacc[1]), "+v"(oacc[2]), "+v"(oacc[3]) :: "memory");
        }
        vv = buf[(st < 15 ? st + 1 : st) * RW_STEP + 320 + rowi];
        const f32x2 o2 = (oacc[0] + oacc[1]) + (oacc[2] + oacc[3]);
        const float ov = xhalf_sum(o2[0] + o2[1]);
        int row, ts, Ls; step_row(16 * c + st, g, b, row, ts, Ls);
        if (kh == 0 && (!dry || ov == 1.2345e37f)) LOf[(size_t)row * (LOLD / 2) + (g * 6 + h) * 64 + rowi] = ov;
    }
}
struct GlRaw { u32x4 q, k, v[2], dn[2]; f32x4 rt[2]; };
DI void gla_load(const Params& p, int item, int c, GlRaw& R, int lane) {
    const int g = item & 1, h = (item >> 1) % 6, b = item / 12;
    const int ti = lane >> 2, cg = lane & 3;
    int row, ts, Ls; step_row(16 * c + ti, g, b, row, ts, Ls);
    const bf16_t* pr = (const bf16_t*)(p.ws + WS_PB) + (size_t)row * PLD;
    R.q = *(const u32x4*)(pr + C_GQ + h * 32 + 8 * cg); R.k = *(const u32x4*)(pr + C_GK + h * 32 + 8 * cg);
    R.v[0] = *(const u32x4*)(pr + C_GV + h * 64 + 16 * cg); R.v[1] = *(const u32x4*)(pr + C_GV + h * 64 + 16 * cg + 8);
    R.dn[0] = *(const u32x4*)(pr + C_GDN + 16 * g); R.dn[1] = *(const u32x4*)(pr + C_GDN + 16 * g + 8);
    const float* rt = (const float*)(p.ws + WS_ROPE) + (size_t)((Ls == SL ? ts : 0) * 16 + 4 * cg) * 2;
    R.rt[0] = *(const f32x4*)rt; R.rt[1] = *(const f32x4*)(rt + 4);
}
DI void gla_compute(const Params& p, int item, int c, const GlRaw& R, LAS float* buf, const LAS float* GU, int lane) {
    const int g = item & 1, b = item / 12;
    const int ti = lane >> 2, cg = lane & 3;
    int row, ts, Ls; step_row(16 * c + ti, g, b, row, ts, Ls);
    float q[8], k[8], v[16], dn[16];
    cvt8(R.q, q); cvt8(R.k, k); cvt8(R.v[0], &v[0]); cvt8(R.v[1], &v[8]); cvt8(R.dn[0], &dn[0]); cvt8(R.dn[1], &dn[8]);
    float al[8];
    {
        f32x4 z0 = *(const LAS f32x4*)(GU + 512 + 8 * cg), z1 = *(const LAS f32x4*)(GU + 512 + 8 * cg + 4);
#pragma unroll
        for (int rr = 0; rr < 16; ++rr) {
            if ((rr & 3) == 0) asm volatile("" : "+v"(z0), "+v"(z1) :: "memory");
            const f32x4 g0 = *(const LAS f32x4*)(GU + rr * 32 + 8 * cg), g1 = *(const LAS f32x4*)(GU + rr * 32 + 8 * cg + 4);
            z0 = z0 + g0 * dn[rr]; z1 = z1 + g1 * dn[rr]; }
#pragma unroll
        for (int j = 0; j < 8; ++j) { const float z = j < 4 ? z0[j & 3] : z1[j & 3];
            const float ls = fminf(z, 0.f) - __logf(1.f + __expf(-fabsf(z)));
            al[j] = __expf(ls * 0.0625f); }
    }
    if (Ls == SL) {
#pragma unroll
        for (int jj = 0; jj < 4; ++jj) { const float cc = R.rt[jj >> 1][2 * (jj & 1)], sn = R.rt[jj >> 1][2 * (jj & 1) + 1];
            const float q1 = q[2 * jj], q2 = q[2 * jj + 1]; q[2 * jj] = q1 * cc - q2 * sn; q[2 * jj + 1] = q1 * sn + q2 * cc;
            const float k1 = k[2 * jj], k2 = k[2 * jj + 1]; k[2 * jj] = k1 * cc - k2 * sn; k[2 * jj + 1] = k1 * sn + k2 * cc; }
    }
    LAS float* o = buf + ti * GL_STEP;
#pragma unroll
    for (int j4 = 0; j4 < 2; ++j4) {
        *(LAS f32x4*)(o + 8 * cg + 4 * j4) = (f32x4){al[4 * j4], al[4 * j4 + 1], al[4 * j4 + 2], al[4 * j4 + 3]};
        *(LAS f32x4*)(o + 32 + 8 * cg + 4 * j4) = (f32x4){k[4 * j4], k[4 * j4 + 1], k[4 * j4 + 2], k[4 * j4 + 3]};
        *(LAS f32x4*)(o + 64 + 8 * cg + 4 * j4) = (f32x4){q[4 * j4], q[4 * j4 + 1], q[4 * j4 + 2], q[4 * j4 + 3]} * 0.17677669529663687f; }
#pragma unroll
    for (int j4 = 0; j4 < 4; ++j4) *(LAS f32x4*)(o + 96 + 16 * cg + 4 * j4) = (f32x4){v[4 * j4], v[4 * j4 + 1], v[4 * j4 + 2], v[4 * j4 + 3]};
}
DI void gla_scan_chunk(const Params& p, int item, int c, const LAS float* buf, f32x2 (&S)[16], int lane, bool dry = false) {
    const int g = item & 1, h = (item >> 1) % 6, b = item / 12;
    bf16_t* AY = (bf16_t*)(p.ws + WS_AY);
    f32x4 U[2][12];
#pragma unroll
    for (int j = 0; j < 4; ++j) { U[0][3 * j] = ((const LAS f32x4*)buf)[j]; U[0][3 * j + 1] = ((const LAS f32x4*)buf)[8 + j]; U[0][3 * j + 2] = ((const LAS f32x4*)buf)[16 + j]; }
    float vv = buf[96 + lane];
    for (int st = 0; st < 16; ++st) {
        const LAS f32x4* W = (const LAS f32x4*)(buf + st * GL_STEP);
        const LAS float* bn = buf + (st < 15 ? st + 1 : st) * GL_STEP;
        const LAS f32x4* Wn = (const LAS f32x4*)bn;
        const f32x2 vv2 = (f32x2){vv, vv};
        f32x2 oacc[4];
#pragma unroll
        for (int i = 0; i < 4; ++i) oacc[i] = (f32x2){0.f, 0.f};
#pragma unroll
        for (int gi = 0; gi < 2; ++gi) {
            const int cu = gi, nx = gi ^ 1;
#pragma unroll
            for (int j = 0; j < 4; ++j) { const LAS f32x4* Wx = gi == 0 ? W : Wn; const int i = gi == 0 ? 4 + j : j;
                U[nx][3 * j] = Wx[i]; U[nx][3 * j + 1] = Wx[8 + i]; U[nx][3 * j + 2] = Wx[16 + i]; }
            if (gi == 1) vv = bn[96 + lane];
#pragma unroll
            for (int j = 0; j < 4; ++j) { const int i = 4 * gi + j; const f32x4 a4 = U[cu][3 * j], k4 = U[cu][3 * j + 1], q4 = U[cu][3 * j + 2];
                S[2 * i] = S[2 * i] * (f32x2){a4[0], a4[1]} + vv2 * (f32x2){k4[0], k4[1]}; S[2 * i + 1] = S[2 * i + 1] * (f32x2){a4[2], a4[3]} + vv2 * (f32x2){k4[2], k4[3]};
                oacc[(2 * i) & 3] += S[2 * i] * (f32x2){q4[0], q4[1]}; oacc[(2 * i + 1) & 3] += S[2 * i + 1] * (f32x2){q4[2], q4[3]}; }
            asm volatile("" : "+v"(oacc[0]), "+v"(oacc[1]), "+v"(oacc[2]), "+v"(oacc[3]) :: "memory");
        }
        const f32x2 o2 = (oacc[0] + oacc[1]) + (oacc[2] + oacc[3]);
        int row, ts, Ls; step_row(16 * c + st, g, b, row, ts, Ls);
        { const float ov = o2[0] + o2[1]; if (!dry || ov == 1.2345e37f) AY[(size_t)row * D + g * 384 + h * 64 + lane] = f2bf(ov); }
    }
}
DI void lds_wait_ge(volatile LAS unsigned* f, unsigned v) { while (*f < v) __builtin_amdgcn_s_sleep(1); }
DI void scan_unit_rw(const Params& p, int l, int su, LAS unsigned char* lds, int tid, int lane, int wave, bool dry, int nat_lo, int nat_hi, int nat_stride, int nnat) {
    LAS float* RWB = (LAS float*)lds; LAS float* CSB = (LAS float*)(lds + 143616);
    volatile LAS unsigned* FLG = (volatile LAS unsigned*)(lds + 146688);
    __syncthreads();
    for (int i = tid; i < 2 * 384; i += NTHR) { const int sl = i / 384, r = i % 384, a = r >> 6, ch = r & 63; const int it = 2 * su + sl, hh = (it >> 1) % 6;
        float v;
        if (a < 3) v = pin(p, I_MU)[(size_t)l * 1536 + a * 384 + hh * 64 + ch];
        else v = (a == 3 ? pin(p, I_KK) : (a == 4 ? pin(p, I_KA) : pin(p, I_RK)))[(size_t)l * 384 + hh * 64 + ch];
        CSB[i] = v; }
    if (tid < 8) FLG[tid] = 0u;
    __syncthreads();
    if (wave < 4) {
        asm volatile("" : "+v"(lane));
        const int slot = wave >> 1, hf = wave & 1, item = 2 * su + slot;
        f32x2 S[16];
#pragma unroll
        for (int i = 0; i < 16; ++i) S[i] = (f32x2){0.f, 0.f};
        for (int c = 0; c < NCHUNK; ++c) {
            lds_wait_ge(FLG + slot, (unsigned)(c + 1));
            asm volatile("" ::: "memory");
            rwkv_scan_chunk(p, item, c, RWB + (slot * 2 + (c & 1)) * RW_BUF, S, lane, hf, dry);
            asm volatile("s_waitcnt lgkmcnt(0)" ::: "memory");
            FLG[2 + slot * 2 + hf] = (unsigned)(c + 1);
        }
    } else if (wave < 6) {
        asm volatile("" : "+v"(lane));
        const int slot = wave & 1, item = 2 * su + slot;
        RwRaw R; rwkv_load(p, item, 0, R, lane);
        for (int c = 0; c < NCHUNK; ++c) {
            if (c >= 2) { lds_wait_ge(FLG + 2 + slot * 2, (unsigned)(c - 1)); lds_wait_ge(FLG + 3 + slot * 2, (unsigned)(c - 1)); }
            asm volatile("" ::: "memory");
            rwkv_compute(p, item, c, R, RWB + (slot * 2 + (c & 1)) * RW_BUF, CSB + slot * 384, lane);
            if (c + 1 < NCHUNK) rwkv_load(p, item, c + 1, R, lane);
            asm volatile("s_waitcnt lgkmcnt(0)" ::: "memory");
            FLG[slot] = (unsigned)(c + 1);
        }
    } else {
        asm volatile("" : "+v"(lane));
        for (int id = nat_lo + su * 2 + (wave - 6); id < nat_hi; id += nat_stride) { if (id < nnat) nat_unit(p, l, id, false, lane); else nat_unit(p, l, id - nnat, true, lane); }
    }
}
DI void scan_unit_gl(const Params& p, int l, int gu, LAS unsigned char* lds, int tid, int lane, int wave, bool dry) {
    LAS float* GLB = (LAS float*)lds; LAS float* GUB = (LAS float*)(lds + 122880);
    __syncthreads();
    for (int i = tid; i < 6 * 544; i += NTHR) { const int sl = i / 544, r = i % 544; const int it = 6 * gu + sl, gg = it & 1, hh = (it >> 1) % 6;
        GUB[i] = r < 512 ? pin(p, I_GUP)[((size_t)(l * 2 + gg) * 16 + (r >> 5)) * 192 + hh * 32 + (r & 31)] : pin(p, I_GB)[(size_t)(l * 2 + gg) * 192 + hh * 32 + (r - 512)]; }
    __syncthreads();
    if (wave < 6) {
        asm volatile("" : "+v"(lane));
        const int item = 6 * gu + wave;
        f32x2 Sg[16];
#pragma unroll
        for (int i = 0; i < 16; ++i) Sg[i] = (f32x2){0.f, 0.f};
        __syncthreads();
        for (int c = 0; c < NCHUNK; ++c) { gla_scan_chunk(p, item, c, GLB + (wave * 2 + (c & 1)) * GL_BUF, Sg, lane, dry); __syncthreads(); }
    } else {
        asm volatile("" : "+v"(lane));
        const int s0 = (wave - 6) * 3;
        GlRaw R0, R1, R2;
        gla_load(p, 6 * gu + s0, 0, R0, lane); gla_load(p, 6 * gu + s0 + 1, 0, R1, lane); gla_load(p, 6 * gu + s0 + 2, 0, R2, lane);
        gla_compute(p, 6 * gu + s0, 0, R0, GLB + ((s0) * 2) * GL_BUF, GUB + (s0) * 544, lane);
        gla_compute(p, 6 * gu + s0 + 1, 0, R1, GLB + ((s0 + 1) * 2) * GL_BUF, GUB + (s0 + 1) * 544, lane);
        gla_compute(p, 6 * gu + s0 + 2, 0, R2, GLB + ((s0 + 2) * 2) * GL_BUF, GUB + (s0 + 2) * 544, lane);
        gla_load(p, 6 * gu + s0, 1, R0, lane); gla_load(p, 6 * gu + s0 + 1, 1, R1, lane); gla_load(p, 6 * gu + s0 + 2, 1, R2, lane);
        __syncthreads();
        for (int c = 0; c < NCHUNK; ++c) {
            if (c + 1 < NCHUNK) { const int nb = (c + 1) & 1;
                gla_compute(p, 6 * gu + s0, c + 1, R0, GLB + ((s0) * 2 + nb) * GL_BUF, GUB + (s0) * 544, lane);
                gla_compute(p, 6 * gu + s0 + 1, c + 1, R1, GLB + ((s0 + 1) * 2 + nb) * GL_BUF, GUB + (s0 + 1) * 544, lane);
                gla_compute(p, 6 * gu + s0 + 2, c + 1, R2, GLB + ((s0 + 2) * 2 + nb) * GL_BUF, GUB + (s0 + 2) * 544, lane);
                if (c + 2 < NCHUNK) { gla_load(p, 6 * gu + s0, c + 2, R0, lane); gla_load(p, 6 * gu + s0 + 1, c + 2, R1, lane); gla_load(p, 6 * gu + s0 + 2, c + 2, R2, lane); } }
            __syncthreads(); }
    }
}
DI void phase_mixers(const Params& p, int l, LAS unsigned char* lds, int tid, int lane, int wave, bool dry = false, int which = 3) {
    const int G = gridDim.x, bx = blockIdx.x;
    const int nnat = NB * 4 * 32 * 4, nnatc = l == 0 ? NB * 4 * 16 : 0, ntot = nnat + nnatc;
    const int n_in = (G == 256 && (which & 2)) ? min(ntot, 384 * NAT_IN) : 0;
    if (which & 1) for (int u = bx; u < 256; u += G) { if (u < 192) scan_unit_rw(p, l, u, lds, tid, lane, wave, dry, 0, n_in, 384, nnat); else scan_unit_gl(p, l, u - 192, lds, tid, lane, wave, dry); }
    if (which & 2) for (int id = n_in + bx * NWAVE + wave; id < ntot; id += G * NWAVE) { if (id < nnat) nat_unit(p, l, id, false, lane); else nat_unit(p, l, id - nnat, true, lane); }
}

DI void phase_readout(const Params& p, int l, int nrows, int lane, int wave, bool dry = false) {
    const int gw = blockIdx.x * NWAVE + wave, NGW = gridDim.x * NWAVE;
    const bf16_t* PB = (const bf16_t*)(p.ws + WS_PB); bf16_t* AY = (bf16_t*)(p.ws + WS_AY);
    const float* LOf = (const float*)(p.ws + WS_LO); const bf16_t* LOb = (const bf16_t*)(p.ws + WS_LO); const float* BON = (const float*)(p.ws + WS_BON);
    const bool act = lane < 48; const int c8 = act ? 8 * lane : 0, h = c8 >> 6;
    float nw[8], gnw[8], gnb[8], mu[8];
    { const float* a = pin(p, I_GNW) + l * 64 + (c8 & 63); const float* b = pin(p, I_GNWT) + l * 384 + c8; const float* c = pin(p, I_GNB) + l * 384 + c8; const float* d = pin(p, I_MU) + (size_t)l * 1536 + 768 + c8;
#pragma unroll
      for (int j = 0; j < 8; ++j) { nw[j] = a[j]; gnw[j] = b[j]; gnb[j] = c[j]; mu[j] = d[j]; } }
    for (int row = gw; row < nrows; row += NGW) {
        const bool lat = row < ML; const int t = lat ? (row & (SL - 1)) : ((row - ML) & (CL - 1)); const int Ls = lat ? SL : CL;
        const bf16_t* pr = PB + (size_t)row * PLD; bf16_t* yr = AY + (size_t)row * D;
        const u32x4 r_of = *(const u32x4*)(yr + c8), r_ob = *(const u32x4*)(yr + 384 + c8), r_gg = *(const u32x4*)(pr + C_GG + c8);
        const u32x4 r_nat = *(const u32x4*)(yr + 768 + 8 * (lane & 31));
        const float* lf = LOf + (size_t)row * (LOLD / 2) + c8;
        const f32x4 f0 = *(const f32x4*)lf, f1 = *(const f32x4*)(lf + 4), b0 = *(const f32x4*)(lf + 384), b1 = *(const f32x4*)(lf + 388);
        const bf16_t* pv = pr + C_RW + 768 + c8;
        const u32x4 r_v0 = *(const u32x4*)pv, r_vm = *(const u32x4*)(t > 0 ? pv - PLD : pv), r_vp = *(const u32x4*)(t < Ls - 1 ? pv + PLD : pv);
        const u32x4 r_gt = *(const u32x4*)(LOb + (size_t)row * LOLD + 1536 + c8);
        const float bon = BON[(size_t)row * 12 + h] + BON[(size_t)row * 12 + 6 + h];
        const float mm = t > 0 ? 0.5f : 0.f, mp = t < Ls - 1 ? 0.5f : 0.f;
        float of[8], ob[8], gg[8], v0[8], vm[8], vp[8], gt[8];
        cvt8(r_of, of); cvt8(r_ob, ob); cvt8(r_gg, gg); cvt8(r_v0, v0); cvt8(r_vm, vm); cvt8(r_vp, vp); cvt8(r_gt, gt);
        float og[8], orw[8]; float ss = 0.f, sm = 0.f;
#pragma unroll
        for (int j = 0; j < 8; ++j) { og[j] = of[j] + ob[j]; ss += og[j] * og[j]; orw[j] = (j < 4 ? f0[j & 3] : f1[j & 3]) + (j < 4 ? b0[j & 3] : b1[j & 3]); sm += orw[j]; }
        ss = sum8(ss); sm = sum8(sm);
        const float mean = sm * (1.f / 64.f); float sq = 0.f;
#pragma unroll
        for (int j = 0; j < 8; ++j) { orw[j] -= mean; sq += orw[j] * orw[j]; }
        sq = sum8(sq);
        float e1 = 1e-5f, e2 = 64e-5f; asm volatile("" : "+v"(e1), "+v"(e2));
        const float rg = rsqrtf(ss * (1.f / 64.f) + e1), rn = rsqrtf(sq * (1.f / 64.f) + e2);
        float yg[8], yw[8];
#pragma unroll
        for (int j = 0; j < 8; ++j) { yg[j] = og[j] * rg * nw[j] * (gg[j] * sigm(gg[j]));
            const float vs = v0[j] + ((mm * vm[j] + mp * vp[j]) - v0[j]) * mu[j];
            yw[j] = (orw[j] * rn * gnw[j] + gnb[j] + bon * vs) * gt[j]; }
        asm volatile("s_waitcnt vmcnt(0)" ::: "memory");
        const bool okst = !dry || yg[0] == 1.2345e37f;
        if (act && okst) { u32x4 o; o.x = cvtpk(yg[0], yg[1]); o.y = cvtpk(yg[2], yg[3]); o.z = cvtpk(yg[4], yg[5]); o.w = cvtpk(yg[6], yg[7]); *(u32x4*)(yr + c8) = o;
            u32x4 w; w.x = cvtpk(yw[0], yw[1]); w.y = cvtpk(yw[2], yw[3]); w.z = cvtpk(yw[4], yw[5]); w.w = cvtpk(yw[6], yw[7]); *(u32x4*)(yr + 640 + c8) = w; }
        if (lane < 32 && okst) *(u32x4*)(yr + 384 + 8 * lane) = r_nat;
    }
}

#define XB_TMO      128
#define XB_XCNT(j)  (256  + 64 * (j))
#define XB_XSUB(j)  (1280 + 64 * (j))
#define XB_XGEN(j)  (2304 + 64 * (j))
#define XB_TOP      3328
#define XB_TOPGEN   3392
#define XCD_BAR_WORDS 3456
#define XB_SPIN_CAP (1u << 18)

__device__ __forceinline__ unsigned xb_ld(unsigned* p)              { return __hip_atomic_load(p, __ATOMIC_RELAXED, __HIP_MEMORY_SCOPE_AGENT); }
__device__ __forceinline__ unsigned xb_add(unsigned* p, unsigned v) { return __hip_atomic_fetch_add(p, v, __ATOMIC_RELAXED, __HIP_MEMORY_SCOPE_AGENT); }
__device__ __forceinline__ unsigned xb_xcc_id() { return (unsigned)__builtin_amdgcn_s_getreg((3 << 11) | 20) & 0xFu; }
#define XB_SPIN(cond, bar) do { unsigned _sp = 0; while (cond) { __builtin_amdgcn_s_sleep(1); \
    if ((++_sp & 255u) == 0u) { if (xb_ld(&(bar)[XB_TMO])) break; if (_sp > XB_SPIN_CAP) { atomicAdd(&(bar)[XB_TMO], 1u); break; } } } } while (0)

struct XcdBarrier {
    unsigned* bar; unsigned x;
    volatile LAS unsigned* st;
};

__device__ __forceinline__ XcdBarrier xcd_barrier_post(unsigned* bar, volatile LAS unsigned* st, int tid) {
    XcdBarrier b; b.bar = bar; b.x = xb_xcc_id(); b.st = st;
    if (tid == 0) (void)xb_add(&bar[XB_XCNT(b.x)], 1u);
    return b;
}
__device__ __forceinline__ void xcd_barrier_complete(unsigned* bar, unsigned x, unsigned& nloc, unsigned& nx) {
    const unsigned G = gridDim.x * gridDim.y * gridDim.z;
    unsigned sum, cnt, mine, sp = 0u;
    for (;;) {
        sum = 0u; cnt = 0u; mine = 0u;
#pragma unroll
        for (unsigned j = 0; j < 16; ++j) { const unsigned c = xb_ld(&bar[XB_XCNT(j)]); sum += c; cnt += (c > 0u) ? 1u : 0u; mine = (j == x) ? c : mine; }
        if (sum == G) break;
        __builtin_amdgcn_s_sleep(1);
        if ((++sp & 255u) == 0u) { if (xb_ld(&bar[XB_TMO])) break; if (sp > XB_SPIN_CAP) { atomicAdd(&bar[XB_TMO], 1u); break; } }
    }
    nloc = mine > 0u ? mine : 1u; nx = cnt > 0u ? cnt : 1u;
}

__device__ __forceinline__ void xcd_barrier(const XcdBarrier& b, int tid) {
    asm volatile("s_waitcnt vmcnt(0)" ::: "memory");
    __syncthreads();
    if (tid == 0) {
        unsigned* bar = b.bar;
        __builtin_amdgcn_s_waitcnt(0);
        unsigned nloc = b.st[0], nx = b.st[1];
        if (nloc == 0u) { xcd_barrier_complete(bar, b.x, nloc, nx); b.st[0] = nloc; b.st[1] = nx; }
        const unsigned old = xb_add(&bar[XB_XSUB(b.x)], 1u);
        const unsigned gen = old / nloc;
        if (old + 1u == (gen + 1u) * nloc) {
            __builtin_amdgcn_fence(__ATOMIC_RELEASE, "agent");
            asm volatile("s_waitcnt vmcnt(0)" ::: "memory");
            const unsigned og = xb_add(&bar[XB_TOP], 1u);
            const unsigned tg = og / nx;
            if (og + 1u == (tg + 1u) * nx) xb_add(&bar[XB_TOPGEN], 1u);
            else XB_SPIN(xb_ld(&bar[XB_TOPGEN]) == tg, bar);
            __builtin_amdgcn_fence(__ATOMIC_ACQUIRE, "agent");
            xb_add(&bar[XB_XGEN(b.x)], 1u);
            asm volatile("s_waitcnt vmcnt(0)" ::: "memory");
        } else {
            XB_SPIN(xb_ld(&bar[XB_XGEN(b.x)]) == gen, bar);
            __builtin_amdgcn_fence(__ATOMIC_ACQUIRE, "agent");
            asm volatile("s_waitcnt vmcnt(0)" ::: "memory");
        }
    }
    __syncthreads();
}


DI void grid_sync_probe() { cg::this_grid().sync(); }
DI void run_step(const Params& p, const int step, LAS unsigned char* lds, int tid, int lane, int wave, bool dry = false) {
    const int G = gridDim.x, bx = blockIdx.x;
    unsigned char* ws = p.ws;
    const float* MOD = (const float*)(ws + WS_MOD);
    float* TC = (float*)(ws + WS_VT);
    {
        const int l = step < 2 ? 0 : (step - 2) / 10, st = step < 2 ? -1 : (step - 2) % 10;
        unsigned char* wl = ws + (size_t)l * WLB;
        const float* modl = MOD + (size_t)l * 33 * 6144;
        const int Mff = l == 0 ? MT : ML;
        if (st == 0 || st == 2 || st == 5 || st == 7 || st == 8) {
            const bf16_t* gA = (const bf16_t*)(ws + WS_AY); const bf16_t* gB; int gM = Mff, gN = 1024, gK = 1024, mode = 2;
            bf16_t* eO = (bf16_t*)(ws + WS_PB); const float* ex = (const float*)p.out; const float* exc = (const float*)TC; int gofs = 2 * 1024;
            if (st == 0) { gB = (const bf16_t*)(wl + OFF_WIN); gM = MT; gN = PLD; mode = 0; }
            else if (st == 2) { gB = (const bf16_t*)(wl + OFF_BT2); gM = MT; gN = 2048; gK = 384; mode = 1; eO = (bf16_t*)(ws + WS_LO); }
            else if (st == 5) { gB = (const bf16_t*)(wl + OFF_WOUT); if (l == 0) { ex = pin(p, I_X); exc = pin(p, I_CTX); } }
            else if (st == 7) { gB = (const bf16_t*)(wl + OFF_W13); gN = 2 * FH; mode = 3; }
            else { gA = (const bf16_t*)(ws + WS_PB); gB = (const bf16_t*)(wl + OFF_W2); gK = FH; gofs = 5 * 1024; }
            asm volatile("" : "+s"(gK), "+s"(gM), "+s"(gN), "+s"(mode), "+s"(gofs));
            asm volatile("" : "+s"(gA), "+s"(gB), "+s"(eO), "+s"(ex), "+s"(exc));
            const pg8::Gemm g{gA, gB, gM, gN, gK};
            const pg8::EpiAny E{mode, pg8::EpiStoreBf16{eO, PLD}, pg8::EpiLora{eO, pin(p, I_W0) + (size_t)l * 768, pin(p, I_A0) + (size_t)l * 768},
                                pg8::EpiRes{ex, exc, p.out, TC, modl, gofs}, pg8::EpiSwiglu{eO}};
            pg8::StaticOrder S; S.init(g.M, g.N, G, bx);
#if defined(PROBE_GEMM)
            int nrep = (st == 0 || st == 2 || st == 7) ? 2 : 1; asm volatile("" : "+s"(nrep));
#pragma unroll 1
            for (int rep = 0; rep < nrep; ++rep) { pg8::gemm_phase<pg8::EpiAny, pg8::StaticOrder, true, true>(lds, g, S, E, tid); __syncthreads(); }
#else
            pg8::gemm_phase<pg8::EpiAny, pg8::StaticOrder, true, true>(lds, g, S, E, tid);
#endif
        }
#ifndef ONLYGEMM
        else if (step == 0) phase_prologue(p, lds, tid, lane, wave);
        else if (step == 1) phase_modulate0(p, lane, wave);
        else if (st == 1) phase_prep(p, l, lds, lane, wave);
#if defined(PROBE_MIX)
        else if (st == 3) { int nrep = 2; asm volatile("" : "+s"(nrep));
#pragma unroll 1
            for (int rep = 0; rep < nrep; ++rep) { phase_mixers(p, l, lds, tid, lane, wave, rep + 1 < nrep, rep + 1 < nrep ? PROBE_MIX : 3); __syncthreads(); grid_sync_probe(); } }
#else
        else if (st == 3) phase_mixers(p, l, lds, tid, lane, wave);
#endif
        else if (st == 4) phase_readout(p, l, Mff, lane, wave, dry);
        else if (st == 6) phase_ln(p, lane, wave, Mff, pin(p, I_LN1W) + l * 1024, pin(p, I_LN1B) + l * 1024, modl, 3 * 1024, 4 * 1024, true, true, dry);
        else {
            if (l == 0) phase_ln(p, lane, wave, MT, pin(p, I_LN2W), pin(p, I_LN2B), MOD + (size_t)33 * 6144, 0, 1024, true, true, dry);
            else phase_ln(p, lane, wave, ML, pin(p, I_LN2W) + 1024, pin(p, I_LN2B) + 1024, modl, 0, 1024, true, false, dry);
        }
#endif
    }
}
#ifdef MULTI_LAUNCH
template <int STEP> __global__ void __launch_bounds__(NTHR, 2) k_step(Params p) {
    extern __shared__ __attribute__((aligned(16))) unsigned char smem[];
    const int tid = threadIdx.x, lane = tid & 63, wave = __builtin_amdgcn_readfirstlane(tid >> 6);
    run_step(p, STEP, (LAS unsigned char*)smem, tid, lane, wave);
}
template <int STEP> static void launch_steps(const Params& p, int grid, hipStream_t stream) {
    static bool attr_done = false;
    if (!attr_done) { (void)hipFuncSetAttribute((const void*)k_step<STEP>, hipFuncAttributeMaxDynamicSharedMemorySize, LDS_BYTES); attr_done = true; }
    hipLaunchKernelGGL(k_step<STEP>, dim3(grid), dim3(NTHR), LDS_BYTES, stream, p);
    if constexpr (STEP + 1 < 22) launch_steps<STEP + 1>(p, grid, stream);
}
#else
__global__ void __launch_bounds__(NTHR, 2) hybrid_fwd(Params p) {
    extern __shared__ __attribute__((aligned(16))) unsigned char smem[];
    LAS unsigned char* lds = (LAS unsigned char*)smem;
    cg::grid_group grid = cg::this_grid();
    const int wave0 = __builtin_amdgcn_readfirstlane((int)threadIdx.x >> 6);
    volatile LAS unsigned* MISC = (volatile LAS unsigned*)(lds + LDS_BYTES - 64);
#if defined(PROBE_REPEAT) || defined(PROBE_DRY)
    bool repeated = false;
#endif
#pragma unroll 1
    for (int step = 0; step < 22; ++step) {
        unsigned msk = ~0u; int wave_ = wave0;
        asm volatile("" : "+s"(msk), "+s"(wave_));
        const int lane_ = (int)__builtin_amdgcn_mbcnt_hi(msk, __builtin_amdgcn_mbcnt_lo(msk, 0u));
        const int tid_ = wave_ * 64 + lane_;
        const int stepu = __builtin_amdgcn_readfirstlane(step);
#if defined(PROBE_DRY)
        const int sd_ = stepu < 2 ? -1 : (stepu - 2) % 10; const bool wantdry = ((PROBE_DRY & 1) && (sd_ == 6 || sd_ == 9)) || ((PROBE_DRY & 2) && sd_ == 4);
        run_step(p, stepu, lds, tid_, lane_, wave_, wantdry && !repeated);
#else
        run_step(p, stepu, lds, tid_, lane_, wave_);
#endif
        XcdBarrier bar; bar.bar = (unsigned*)(p.ws + WS_BAR); bar.x = xb_xcc_id(); bar.st = MISC;
        if (stepu == 0) {
            if (tid_ < 2) MISC[tid_] = 0u;
            if (tid_ == 0) (void)xb_add(&bar.bar[XB_XCNT(bar.x)], 1u);
            grid.sync();
        } else if (stepu != 21) xcd_barrier(bar, tid_);
#if defined(PROBE_DRY)
        if (wantdry && !repeated) { repeated = true; --step; } else repeated = false;
#endif
#if defined(PROBE_REPEAT)
        { const int st_ = step < 2 ? -1 : (step - 2) % 10; const bool rep_ok = ((PROBE_REPEAT & 1) && (st_ == 0 || st_ == 2 || st_ == 7)) || ((PROBE_REPEAT & 2) && st_ == 1) || ((PROBE_REPEAT & 4) && step == 0) || ((PROBE_REPEAT & 8) && step == 1);
          if (rep_ok && !repeated) { repeated = true; --step; } else repeated = false; }
#endif
    }
}
#endif

extern "C" void kernel_launch(void* const* d_in, const int* in_sizes, int n_in, void* d_out, int out_size, void* d_ws, size_t ws_size, hipStream_t stream) {
    static int grid = 0;
    if (grid == 0) {
        int dev = 0, cus = 0, per_cu = 0;
        if (n_in != 29 || ws_size < WS_END) { fprintf(stderr, "kernel_launch: unexpected n_in %d / ws_size %zu (need %zu)\n", n_in, ws_size, (size_t)WS_END); }
        hipGetDevice(&dev);
        hipDeviceGetAttribute(&cus, hipDeviceAttributeMultiprocessorCount, dev);
#ifndef MULTI_LAUNCH
        if (hipFuncSetAttribute((const void*)hybrid_fwd, hipFuncAttributeMaxDynamicSharedMemorySize, LDS_BYTES) != hipSuccess) fprintf(stderr, "kernel_launch: hipFuncSetAttribute failed\n");
        if (hipOccupancyMaxActiveBlocksPerMultiprocessor(&per_cu, (const void*)hybrid_fwd, NTHR, LDS_BYTES) != hipSuccess || per_cu < 1) { fprintf(stderr, "kernel_launch: occupancy query gave %d\n", per_cu); per_cu = 1; }
#endif
        (void)hipGetLastError();
        grid = cus > 0 ? cus : 256;
    }
    Params p{};
    for (int i = 0; i < 29; ++i) p.in[i] = (const float*)d_in[i];
    p.out = (float*)d_out; p.ws = (unsigned char*)d_ws;
#ifdef MULTI_LAUNCH
    launch_steps<0>(p, grid, stream);
#else
    (void)hipMemsetAsync((unsigned char*)d_ws + WS_BAR, 0, 16384, stream);
    void* args[] = {&p};
    hipError_t e = hipLaunchCooperativeKernel((const void*)hybrid_fwd, dim3(grid), dim3(NTHR), args, LDS_BYTES, stream);
    if (e != hipSuccess) fprintf(stderr, "kernel_launch: cooperative launch failed: %s (grid %d)\n", hipGetErrorString(e), grid);
#endif
}
```

```cpp
#include <hip/hip_runtime.h>
#include <hip/hip_cooperative_groups.h>
#include <cstdio>
#include <cstdint>
namespace cg = cooperative_groups;
namespace pg8 {
#define PG8_LAS __attribute__((address_space(3)))
typedef unsigned short bf16_t;
typedef short bf16x8 __attribute__((ext_vector_type(8)));
typedef float f32x4 __attribute__((ext_vector_type(4)));
typedef unsigned u32x4 __attribute__((ext_vector_type(4)));
constexpr int BM = 256, BK = 64, HALF = 128, HTB = HALF * BK * 2  , STAGE_BYTES = 8 * HTB, NXCD = 8, WGM = 8;

__host__ __device__ __forceinline__ int lds_byte(int r, int c) { const int st = (r >> 4) * 2 + (c >> 5), rr = r & 15, cc = c & 31, ob = rr * 64 + cc * 2; return st * 1024 + (ob ^ (((ob >> 9) & 1) << 5)); }
__host__ __device__ __forceinline__ void stage_rc(int b, int& R, int& C) { const int st = b / 1024, sb = b % 1024, swz = sb ^ (((sb >> 9) & 1) << 5); R = (st >> 1) * 16 + swz / 64; C = (st & 1) * 32 + (swz % 64) / 2; }
__host__ __device__ __forceinline__ int perm32(int rho) { const int n = rho >> 4, i = rho & 15; return 8 * (i >> 2) + 4 * n + (i & 3); }

struct Unit { int pm, pn; };
struct Gemm { const bf16_t* A; const bf16_t* Bt; int M, N, K; };

struct StaticOrder {
    int nM, nN, nwg, G, c;
    __host__ __device__ void init(int M, int N, int G_, int c_) { nM = M / BM; nN = N / BM; nwg = nM * nN; G = G_; c = c_; }
    __host__ __device__ bool next(int i, Unit& u) const {
        const long L = (long)i * G + c; if (L >= nwg) return false;
        int wgid = (int)L; { const int q = nwg / NXCD, r = nwg % NXCD, xcd = wgid % NXCD, off = wgid / NXCD; wgid = (xcd < r ? xcd * (q + 1) : r * (q + 1) + (xcd - r) * q) + off; }
        const int nig = WGM * nN, gid = wgid / nig, fm = gid * WGM, gsz = (nM - fm) < WGM ? (nM - fm) : WGM;
        u.pm = fm + ((wgid % nig) % gsz); u.pn = (wgid % nig) / gsz; return true;
    }
    __device__ __forceinline__ void a_ready(const Unit&) const {}
    __device__ __forceinline__ void done(const Unit&) const {}
};
__device__ __forceinline__ unsigned cvtpk(float lo, float hi) { typedef float v2f __attribute__((ext_vector_type(2))); typedef __bf16 v2b __attribute__((ext_vector_type(2))); v2f v = {lo, hi}; v2b b = __builtin_convertvector(v, v2b); return __builtin_bit_cast(unsigned, b); }
__device__ __forceinline__ float sigm(float x) { return 1.0f / (1.0f + __expf(-x)); }
struct EpiStoreBf16 {
    static constexpr bool PERM = true, AFTER_DRAIN = false;
    bf16_t* O; int ldc;
    __device__ __forceinline__ void operator()(const f32x4 (&acc)[2][2][4][2], const Unit& u, int wr, int wc, int fr, int fq) const {
        const int row0 = u.pm * BM + wr * 64 + fr, col0 = u.pn * BM + wc * 32 + 8 * fq;
#pragma unroll
        for (int ai = 0; ai < 2; ++ai)
#pragma unroll
            for (int m = 0; m < 4; ++m) { bf16_t* rowp = O + (size_t)(row0 + ai * HALF + m * 16) * ldc + col0;
#pragma unroll
                for (int bj = 0; bj < 2; ++bj) { const f32x4 v0 = acc[ai][bj][m][0], v1 = acc[ai][bj][m][1];
                    u32x4 w; w.x = cvtpk(v0[0], v0[1]); w.y = cvtpk(v0[2], v0[3]); w.z = cvtpk(v1[0], v1[1]); w.w = cvtpk(v1[2], v1[3]);
                    *(u32x4*)(rowp + bj * HALF) = w; } }
    }
};
struct EpiLora {
    static constexpr bool PERM = true, AFTER_DRAIN = false;
    bf16_t* O; const float* w0; const float* a0;
    __device__ __forceinline__ void operator()(const f32x4 (&acc)[2][2][4][2], const Unit& u, int wr, int wc, int fr, int fq) const {
        const int row0 = u.pm * BM + wr * 64 + fr;
#pragma unroll
        for (int bj = 0; bj < 2; ++bj) {
            const int cb = u.pn * 2 + bj;
            if (cb < 15) {
                const int c0 = cb * 128 + wc * 32 + 8 * fq;
                if (cb >= 12) {
#pragma unroll
                    for (int ai = 0; ai < 2; ++ai)
#pragma unroll
                        for (int m = 0; m < 4; ++m) { const f32x4 v0 = acc[ai][bj][m][0], v1 = acc[ai][bj][m][1];
                            u32x4 w; w.x = cvtpk(v0[0], v0[1]); w.y = cvtpk(v0[2], v0[3]); w.z = cvtpk(v1[0], v1[1]); w.w = cvtpk(v1[2], v1[3]);
                            *(u32x4*)(O + (size_t)(row0 + ai * HALF + m * 16) * 1920 + c0) = w; }
                } else {
                    const int kind = wc >> 1, g = cb / 6, h = cb % 6;
                    const float* a0v = a0; const float* w0v = w0; asm volatile("" : "+s"(a0v), "+s"(w0v));
                    const float* bp = (kind ? a0v : w0v) + g * 384 + h * 64 + (wc & 1) * 32 + 8 * fq;
                    const f32x4 b0 = *(const f32x4*)bp, b1 = *(const f32x4*)(bp + 4);
                    const float mul = kind == 0 ? 0.60653065971263342f : 1.f;
#pragma unroll
                    for (int ai = 0; ai < 2; ++ai)
#pragma unroll
                        for (int m = 0; m < 4; ++m) { const f32x4 v0 = acc[ai][bj][m][0] + b0, v1 = acc[ai][bj][m][1] + b1;
                            u32x4 w; w.x = cvtpk(mul * sigm(v0[0]), mul * sigm(v0[1])); w.y = cvtpk(mul * sigm(v0[2]), mul * sigm(v0[3]));
                            w.z = cvtpk(mul * sigm(v1[0]), mul * sigm(v1[1])); w.w = cvtpk(mul * sigm(v1[2]), mul * sigm(v1[3]));
                            *(u32x4*)(O + (size_t)(row0 + ai * HALF + m * 16) * 1920 + c0) = w; }
                }
            }
        }
    }
};
struct EpiRes {
    static constexpr bool PERM = true, AFTER_DRAIN = false;
    const float* xl; const float* xc; float* ol; float* oc; const float* mod; int gofs;
    __device__ __forceinline__ void operator()(const f32x4 (&acc)[2][2][4][2], const Unit& u, int wr, int wc, int fr, int fq) const {
        const bool lat = u.pm < 256; const int bi = lat ? (u.pm >> 3) : 32;
        const size_t rbase = (size_t)(lat ? u.pm : u.pm - 256) * BM;
        const float* xlv = xl; const float* xcv = xc; float* olv = ol; float* ocv = oc; asm volatile("" : "+s"(xlv), "+s"(xcv), "+s"(olv), "+s"(ocv));
        const float* xin = (lat ? xlv : xcv) + rbase * 1024; float* out = (lat ? olv : ocv) + rbase * 1024;
        const float* gp = mod + (size_t)bi * 6144 + gofs;
        const int col0 = u.pn * BM + wc * 32 + 8 * fq, row0 = wr * 64 + fr;
#pragma unroll
        for (int bj = 0; bj < 2; ++bj)
#pragma unroll
            for (int n = 0; n < 2; ++n) { const int c = col0 + bj * HALF + 4 * n; const f32x4 gt = *(const f32x4*)(gp + c);
#pragma unroll
                for (int ai = 0; ai < 2; ++ai)
#pragma unroll
                    for (int m = 0; m < 4; ++m) { const size_t o = (size_t)(row0 + ai * HALF + m * 16) * 1024 + c;
                        const f32x4 xv = *(const f32x4*)(xin + o); const f32x4 a = acc[ai][bj][m][n];
                        f32x4 r; r[0] = 1.41421356237f * xv[0] + gt[0] * a[0]; r[1] = 1.41421356237f * xv[1] + gt[1] * a[1]; r[2] = 1.41421356237f * xv[2] + gt[2] * a[2]; r[3] = 1.41421356237f * xv[3] + gt[3] * a[3];
                        *(f32x4*)(out + o) = r; } }
    }
};
struct EpiSwiglu {
    static constexpr bool PERM = true, AFTER_DRAIN = false;
    bf16_t* O;
    __device__ __forceinline__ void operator()(const f32x4 (&acc)[2][2][4][2], const Unit& u, int wr, int wc, int fr, int fq) const {
        const int row0 = u.pm * BM + wr * 64 + fr, col0 = u.pn * HALF + wc * 32 + 8 * fq;
#pragma unroll
        for (int ai = 0; ai < 2; ++ai)
#pragma unroll
            for (int m = 0; m < 4; ++m) { float v[8];
#pragma unroll
                for (int i = 0; i < 8; ++i) { const float g = acc[ai][0][m][i >> 2][i & 3], up = acc[ai][1][m][i >> 2][i & 3]; v[i] = g * sigm(g) * up; }
                u32x4 w; w.x = cvtpk(v[0], v[1]); w.y = cvtpk(v[2], v[3]); w.z = cvtpk(v[4], v[5]); w.w = cvtpk(v[6], v[7]);
                *(u32x4*)(O + (size_t)(row0 + ai * HALF + m * 16) * 2816 + col0) = w; }
    }
};
struct EpiAny {
    static constexpr bool PERM = true, AFTER_DRAIN = false;
    int mode; EpiStoreBf16 e0; EpiLora e1; EpiRes e2; EpiSwiglu e3;
    __device__ __forceinline__ void operator()(const f32x4 (&acc)[2][2][4][2], const Unit& u, int wr, int wc, int fr, int fq) const {
        if (mode == 0) e0(acc, u, wr, wc, fr, fq); else if (mode == 1) e1(acc, u, wr, wc, fr, fq); else if (mode == 2) e2(acc, u, wr, wc, fr, fq); else e3(acc, u, wr, wc, fr, fq);
    }
};
template <class Epi, class Sched, bool ALIGN_EPI = false, bool SP2 = false>
__device__ __forceinline__ void gemm_phase(PG8_LAS unsigned char* lds, const Gemm g, const Sched& S, const Epi& E, const int tid) {
    const int wid = __builtin_amdgcn_readfirstlane(tid >> 6), lane = tid & 63, wr = wid >> 2, wc = wid & 3, fr = lane & 15, fq = lane >> 4;
    const int K = g.K, nt = K / BK;
    unsigned voffA[2], voffB[2];
#pragma unroll
    for (int i = 0; i < 2; ++i) { int R, C; stage_rc(tid * 16 + i * 8192, R, C); const int Rb = Epi::PERM ? ((R & ~31) + perm32(R & 31)) : R;
        voffA[i] = (unsigned)(R * K + C) * 2u; voffB[i] = (unsigned)(Rb * K + C) * 2u; }
    const size_t kstep = (size_t)(BK * 2);
    const size_t hstep = (size_t)HALF * K * 2;
    const size_t tstep = 2 * hstep;
    const unsigned ldsw = (unsigned)wid * 1024u;
    const int aoff = lds_byte(wr * 64 + fr, fq * 8), boff = lds_byte(wc * 32 + fr, fq * 8);
#define PG8_SA(b, h) (((b) * 2 + (h)) * HTB)
#define PG8_SB(b, h) ((4 + (b) * 2 + (h)) * HTB)
#define PG8_STAGE(bufoff, gbase, voff) do { _Pragma("unroll") for (int _i = 0; _i < 2; ++_i) \
        __builtin_amdgcn_global_load_lds((const unsigned*)((const char*)(gbase) + (voff)[_i]), (PG8_LAS unsigned*)(lds + (bufoff) + ldsw + _i * 8192), 16, 0, 0); } while (0)
#define PG8_LDA(dst, b, h) do { _Pragma("unroll") for (int m = 0; m < 4; ++m) _Pragma("unroll") for (int k = 0; k < 2; ++k) dst[m][k] = *(const PG8_LAS bf16x8*)(lds + PG8_SA(b, h) + aoff + m * 2048 + k * 1024); } while (0)
#define PG8_LDB(dst, b, h) do { _Pragma("unroll") for (int n = 0; n < 2; ++n) _Pragma("unroll") for (int k = 0; k < 2; ++k) dst[n][k] = *(const PG8_LAS bf16x8*)(lds + PG8_SB(b, h) + boff + n * 2048 + k * 1024); } while (0)
#define PG8_MMA(ai, bj, At, Bt) do { __builtin_amdgcn_s_setprio(1); _Pragma("unroll") for (int m = 0; m < 4; ++m) _Pragma("unroll") for (int n = 0; n < 2; ++n) _Pragma("unroll") for (int k = 0; k < 2; ++k) \
        acc[ai][bj][m][n] = __builtin_amdgcn_mfma_f32_16x16x32_bf16(Bt[n][k], At[m][k], acc[ai][bj][m][n], 0, 0, 0); __builtin_amdgcn_s_setprio(0); } while (0)
#define PG8_WAIT_V(n) asm volatile("s_waitcnt vmcnt(" #n ")" ::: "memory")
#define PG8_WAIT_L(n) asm volatile("s_waitcnt lgkmcnt(" #n ")" ::: "memory")
#define PG8_BAR __builtin_amdgcn_s_barrier()
#define PG8_SCHED __builtin_amdgcn_sched_barrier(0)
    Unit cur, nxt; int ui = 0;
    if (!S.next(0, cur)) return;
    f32x4 acc[2][2][4][2];
#pragma unroll
    for (int a = 0; a < 2; ++a)
#pragma unroll
        for (int b = 0; b < 2; ++b)
#pragma unroll
            for (int m = 0; m < 4; ++m)
#pragma unroll
                for (int n = 0; n < 2; ++n) acc[a][b][m][n] = (f32x4){0.f, 0.f, 0.f, 0.f};
    bf16x8 At[4][2], B0[2][2], B1[2][2];
    const char* cA = (const char*)g.A + (size_t)cur.pm * tstep; const char* cB = (const char*)g.Bt + (size_t)cur.pn * tstep;
    S.a_ready(cur);
    if constexpr (SP2) {
        PG8_STAGE(PG8_SB(0, 0), cB, voffB); PG8_STAGE(PG8_SB(0, 1), cB + hstep, voffB); PG8_STAGE(PG8_SA(0, 0), cA, voffA); PG8_STAGE(PG8_SA(0, 1), cA + hstep, voffA);
        if (wr == 1) PG8_BAR;
        PG8_WAIT_V(2); PG8_BAR;
        PG8_STAGE(PG8_SB(1, 0), cB + kstep, voffB); PG8_STAGE(PG8_SA(1, 0), cA + kstep, voffA); PG8_STAGE(PG8_SB(1, 1), cB + hstep + kstep, voffB);
        PG8_WAIT_V(6); PG8_BAR;
    } else {
        PG8_STAGE(PG8_SB(0, 0), cB, voffB); PG8_STAGE(PG8_SA(0, 0), cA, voffA); PG8_STAGE(PG8_SB(0, 1), cB + hstep, voffB); PG8_STAGE(PG8_SA(0, 1), cA + hstep, voffA);
        if (wr == 1) PG8_BAR;
        PG8_WAIT_V(4); PG8_BAR;
        PG8_STAGE(PG8_SB(1, 0), cB + kstep, voffB); PG8_STAGE(PG8_SA(1, 0), cA + kstep, voffA); PG8_STAGE(PG8_SB(1, 1), cB + hstep + kstep, voffB);
        PG8_WAIT_V(6); PG8_BAR;
    }
    for (;;) {
        const bool has_next = S.next(ui + 1, nxt);
        const char* nA = has_next ? (const char*)g.A + (size_t)nxt.pm * tstep : cA; const char* nB = has_next ? (const char*)g.Bt + (size_t)nxt.pn * tstep : cB;
        for (int t = 0; t < nt; t += 2) {
            const bool last = (t == nt - 2);
            const char* a1 = cA + (size_t)(t + 1) * kstep;
            const char* a2 = last ? nA : cA + (size_t)(t + 2) * kstep; const char* b2 = last ? nB : cB + (size_t)(t + 2) * kstep;
            const char* a3 = a2 + kstep; const char* b3 = b2 + kstep;
            if (last && has_next) S.a_ready(nxt);
            if constexpr (SP2) {
            PG8_LDB(B0, 0, 0); PG8_LDB(B1, 0, 1); PG8_SCHED; PG8_LDA(At, 0, 0); PG8_STAGE(PG8_SA(1, 1), a1 + hstep, voffA);
            PG8_WAIT_V(8); PG8_WAIT_L(0); PG8_BAR; PG8_MMA(0, 0, At, B0); PG8_MMA(0, 1, At, B1); PG8_BAR; PG8_SCHED;
            PG8_LDA(At, 0, 1); PG8_STAGE(PG8_SB(0, 0), b2, voffB); PG8_STAGE(PG8_SB(0, 1), b2 + hstep, voffB); PG8_STAGE(PG8_SA(0, 0), a2, voffA);
            PG8_WAIT_V(8); PG8_WAIT_L(0); PG8_BAR; PG8_MMA(1, 0, At, B0); PG8_MMA(1, 1, At, B1); PG8_BAR; PG8_SCHED;
            PG8_LDB(B0, 1, 0); PG8_LDB(B1, 1, 1); PG8_SCHED; PG8_LDA(At, 1, 0); PG8_STAGE(PG8_SA(0, 1), a2 + hstep, voffA);
            PG8_WAIT_V(8); PG8_WAIT_L(0); PG8_BAR; PG8_MMA(0, 0, At, B0); PG8_MMA(0, 1, At, B1); PG8_BAR; PG8_SCHED;
            PG8_LDA(At, 1, 1); PG8_STAGE(PG8_SB(1, 0), b3, voffB); PG8_STAGE(PG8_SB(1, 1), b3 + hstep, voffB); PG8_STAGE(PG8_SA(1, 0), a3, voffA);
            PG8_WAIT_V(8); PG8_WAIT_L(0); PG8_BAR; PG8_MMA(1, 0, At, B0); PG8_MMA(1, 1, At, B1); PG8_BAR; PG8_SCHED;
            } else {
            PG8_LDB(B0, 0, 0); PG8_SCHED; PG8_LDA(At, 0, 0); PG8_STAGE(PG8_SA(1, 1), a1 + hstep, voffA);
            PG8_WAIT_L(8); PG8_BAR; PG8_WAIT_L(0); PG8_MMA(0, 0, At, B0); PG8_BAR; PG8_SCHED;
            PG8_LDB(B1, 0, 1); PG8_STAGE(PG8_SB(0, 0), b2, voffB);
            PG8_BAR; PG8_WAIT_L(0); PG8_MMA(0, 1, At, B1); PG8_BAR;
            PG8_LDA(At, 0, 1); PG8_STAGE(PG8_SA(0, 0), a2, voffA);
            PG8_BAR; PG8_WAIT_L(0); PG8_MMA(1, 0, At, B0); PG8_BAR; PG8_SCHED;
            PG8_STAGE(PG8_SB(0, 1), b2 + hstep, voffB);
            PG8_WAIT_V(6); PG8_BAR; PG8_MMA(1, 1, At, B1); PG8_BAR;
            PG8_LDB(B0, 1, 0); PG8_SCHED; PG8_LDA(At, 1, 0); PG8_STAGE(PG8_SA(0, 1), a2 + hstep, voffA);
            PG8_WAIT_L(8); PG8_BAR; PG8_WAIT_L(0); PG8_MMA(0, 0, At, B0); PG8_BAR; PG8_SCHED;
            PG8_LDB(B1, 1, 1); PG8_STAGE(PG8_SB(1, 0), b3, voffB);
            PG8_BAR; PG8_WAIT_L(0); PG8_MMA(0, 1, At, B1); PG8_BAR;
            PG8_LDA(At, 1, 1); PG8_STAGE(PG8_SA(1, 0), a3, voffA);
            PG8_BAR; PG8_WAIT_L(0); PG8_MMA(1, 0, At, B0); PG8_BAR; PG8_SCHED;
            PG8_STAGE(PG8_SB(1, 1), b3 + hstep, voffB);
            PG8_WAIT_V(6); PG8_BAR; PG8_MMA(1, 1, At, B1); PG8_BAR;
            }
        }
        if constexpr (ALIGN_EPI) { if (wr == 0) PG8_BAR; }
        if constexpr (!Epi::AFTER_DRAIN) { E(acc, cur, wr, wc, fr, fq); S.done(cur); }
        if (!has_next) break;
#pragma unroll
        for (int a = 0; a < 2; ++a)
#pragma unroll
            for (int b = 0; b < 2; ++b)
#pragma unroll
                for (int m = 0; m < 4; ++m)
#pragma unroll
                    for (int n = 0; n < 2; ++n) acc[a][b][m][n] = (f32x4){0.f, 0.f, 0.f, 0.f};
        cur = nxt; cA = nA; cB = nB; ++ui;
        if constexpr (ALIGN_EPI) { if (wr == 1) PG8_BAR; }
    }
    PG8_WAIT_V(0);
    if constexpr (!ALIGN_EPI) { if (wr == 0) PG8_BAR; }
    PG8_BAR;
    if constexpr (Epi::AFTER_DRAIN) { E.fused(acc, cur, wr, wc, fr, fq, lds, wid, lane); S.done(cur); }
#undef PG8_SA
#undef PG8_SB
#undef PG8_STAGE
#undef PG8_LDA
#undef PG8_LDB
#undef PG8_MMA
#undef PG8_WAIT_V
#undef PG8_WAIT_L
#undef PG8_BAR
#undef PG8_SCHED
}
}

#define DI __device__ __forceinline__
#define LAS __attribute__((address_space(3)))
using pg8::bf16_t; using pg8::bf16x8; using pg8::f32x4; using pg8::u32x4; using pg8::cvtpk; using pg8::sigm;
typedef float f32x2 __attribute__((ext_vector_type(2)));
typedef unsigned u32x2 __attribute__((ext_vector_type(2)));

#ifndef SCALED_SCAN
#define SCALED_SCAN 1
#endif
#ifndef NAT_IN
#define NAT_IN 46
#endif
#ifndef MIXMASK
#define MIXMASK 3
#endif
#ifndef ROLEMASK
#define ROLEMASK 15
#endif
#ifndef PHMASK
#define PHMASK 0xffff
#endif
constexpr int NTHR = 512, NWAVE = 8, LDS_BYTES = 147456;
constexpr int D = 1024, NB = 32, SL = 2048, CL = 256, ML = NB * SL, MC = NB * CL, MT = ML + MC;
constexpr int INC = 3488, PLD = 3584, FH = 2816, LOLD = 1920;
constexpr int C_NQ = 0, C_NK = 256, C_NV = 512;
constexpr int C_GQ = 768, C_GK = 960, C_GV = 1152, C_GG = 1536, C_GDN = 1920;
constexpr int C_RW = 1952;
constexpr size_t OFF_WIN = 0, OFF_WOUT = 7340032, OFF_W13 = 9437184, OFF_W2 = 20971520, OFF_BT2 = 26738688, WLB = 28311552;
constexpr size_t WS_MOD = 2 * WLB, WS_ROPE = WS_MOD + 1622016, WS_BON = WS_ROPE + 262144, WS_VT = WS_BON + 3538944, WS_AY = WS_VT + 37748736,
                 WS_PB = WS_AY + 150994944, WS_LO = WS_PB + 528482304, WS_BAR = WS_LO + 283115520, WS_END = WS_BAR + 16384;

struct Params { const float* in[29]; float* out; unsigned char* ws; };
enum { I_X = 0, I_C, I_CTX, I_CCTX, I_WMOD, I_BMOD, I_WIN, I_GUP, I_GB, I_GNW, I_RPB, I_MU, I_W0, I_WD2, I_A0, I_WA2, I_WG2, I_KK, I_KA, I_RK, I_GNWT, I_GNB,
       I_WOUT, I_LN1W, I_LN1B, I_W13, I_W2, I_LN2W, I_LN2B };

DI const float* pin(const Params& p, int i) { asm volatile("" : "+s"(i)); return p.in[i]; }
DI float bf2f(bf16_t h) { return __uint_as_float(((unsigned)h) << 16); }
DI float bflo(unsigned u) { return __uint_as_float(u << 16); }
DI float bfhi(unsigned u) { return __uint_as_float(u & 0xffff0000u); }
DI bf16_t f2bf(float f) { return (bf16_t)(cvtpk(f, 0.f) & 0xffffu); }
DI float shx(float v, int m, int lane) { return __int_as_float(__builtin_amdgcn_ds_bpermute((lane ^ m) << 2, __float_as_int(v))); }
#define DPPF(v, ctrl) __int_as_float(__builtin_amdgcn_mov_dpp(__float_as_int(v), (ctrl), 0xf, 0xf, true))
DI float sum4(float v) { v += DPPF(v, 0xB1); v += DPPF(v, 0x4E); return v; }
DI float sum8(float v) { v = sum4(v); v += DPPF(v, 0x141); return v; }
DI float sum16(float v) { v = sum8(v); v += DPPF(v, 0x140); return v; }
DI float x16_sum(float x) { const auto r = __builtin_amdgcn_permlane16_swap(__float_as_uint(x), __float_as_uint(x), false, false); return __uint_as_float(r[0]) + __uint_as_float(r[1]); }
DI float x32_sum(float x) { const auto r = __builtin_amdgcn_permlane32_swap(__float_as_uint(x), __float_as_uint(x), false, false); return __uint_as_float(r[0]) + __uint_as_float(r[1]); }
DI float x16_max(float x) { const auto r = __builtin_amdgcn_permlane16_swap(__float_as_uint(x), __float_as_uint(x), false, false); return fmaxf(__uint_as_float(r[0]), __uint_as_float(r[1])); }
DI float x32_max(float x) { const auto r = __builtin_amdgcn_permlane32_swap(__float_as_uint(x), __float_as_uint(x), false, false); return fmaxf(__uint_as_float(r[0]), __uint_as_float(r[1])); }
DI float wave_sum(float v, int) { return x32_sum(x16_sum(sum16(v))); }
DI void cvt8(const u32x4 u, float* o) { o[0] = bflo(u.x); o[1] = bfhi(u.x); o[2] = bflo(u.y); o[3] = bfhi(u.y); o[4] = bflo(u.z); o[5] = bfhi(u.z); o[6] = bflo(u.w); o[7] = bfhi(u.w); }
DI void load8(const bf16_t* p, float* o) { const u32x4 u = *(const u32x4*)p; o[0] = bflo(u.x); o[1] = bfhi(u.x); o[2] = bflo(u.y); o[3] = bfhi(u.y); o[4] = bflo(u.z); o[5] = bfhi(u.z); o[6] = bflo(u.w); o[7] = bfhi(u.w); }
DI void load16(const bf16_t* p, float (&o)[16]) { load8(p, &o[0]); load8(p + 8, &o[8]); }
DI void shift16(const bf16_t* prow, bool hasm, bool hasp, const float* mu, float (&y)[16]) {
    float c0[16], cm[16], cp[16];
    load16(prow, c0);
    if (hasm) load16(prow - PLD, cm); else {
#pragma unroll
        for (int j = 0; j < 16; ++j) cm[j] = 0.f; }
    if (hasp) load16(prow + PLD, cp); else {
#pragma unroll
        for (int j = 0; j < 16; ++j) cp[j] = 0.f; }
#pragma unroll
    for (int j = 0; j < 16; ++j) y[j] = c0[j] + (0.5f * (cm[j] + cp[j]) - c0[j]) * mu[j];
}
DI void step_row(int s, int g, int b, int& row, int& ts, int& Ls) {
    if (s < CL) { ts = g ? (CL - 1 - s) : s; row = ML + b * CL + ts; Ls = CL; }
    else { const int u = s - CL; ts = g ? (SL - 1 - u) : u; row = b * SL + ts; Ls = SL; }
}

DI void transpose_item(const float* W, int N, bf16_t* WT, int Kd, size_t dst_row0, int k0, int n0, LAS float* scr, int lane) {
#pragma unroll 8
    for (int i = 0; i < 32; ++i) { const int kk = 2 * i + (lane >> 5); scr[kk * 33 + (lane & 31)] = W[(size_t)(k0 + kk) * N + n0 + (lane & 31)]; }
    asm volatile("s_waitcnt lgkmcnt(0)" ::: "memory");
    const int c = lane & 7;
#pragma unroll
    for (int j = 0; j < 4; ++j) { const int n = (lane >> 3) + 8 * j; const LAS float* s = scr + (8 * c) * 33 + n;
        u32x4 o; o.x = cvtpk(s[0 * 33], s[1 * 33]); o.y = cvtpk(s[2 * 33], s[3 * 33]); o.z = cvtpk(s[4 * 33], s[5 * 33]); o.w = cvtpk(s[6 * 33], s[7 * 33]);
        *(u32x4*)(WT + (dst_row0 + n) * Kd + k0 + 8 * c) = o; }
    asm volatile("s_waitcnt lgkmcnt(0)" ::: "memory");
}

DI void phase_prologue(const Params& p, LAS unsigned char* lds, int tid, int lane, int wave) {
    unsigned char* ws = p.ws;
    float* MOD = (float*)(ws + WS_MOD);
    {
        LAS float* sc = (LAS float*)lds;
        LAS float* part = (LAS float*)(lds + 135168);
        for (int i = tid; i < 33 * 1024; i += NTHR) { const int bi = i >> 10, k = i & 1023; const float cv = bi < 32 ? pin(p, I_C)[bi * 1024 + k] : pin(p, I_CCTX)[k]; sc[k * 33 + bi] = cv * sigm(cv); }
        __syncthreads();
        for (int u = blockIdx.x; u < 192; u += gridDim.x) {
            const int l = u / 96, n0 = (u % 96) * 64;
            float acc[33];
#pragma unroll
            for (int bi = 0; bi < 33; ++bi) acc[bi] = 0.f;
            const float* wp = pin(p, I_WMOD) + (size_t)l * 1024 * 6144 + n0 + lane;
#pragma unroll 8
            for (int kk = 0; kk < 128; ++kk) { const int k = wave * 128 + kk; const float w = wp[(size_t)k * 6144];
#pragma unroll
                for (int bi = 0; bi < 33; ++bi) acc[bi] += sc[k * 33 + bi] * w; }
            for (int w = 0; w < NWAVE; ++w) {
                if (wave == w) {
#pragma unroll
                    for (int bi = 0; bi < 33; ++bi) { if (w == 0) part[bi * 64 + lane] = acc[bi]; else part[bi * 64 + lane] += acc[bi]; } }
                __syncthreads();
            }
            for (int i = tid; i < 33 * 64; i += NTHR) { const int bi = i >> 6, n = i & 63; MOD[(size_t)(l * 33 + bi) * 6144 + n0 + n] = part[i] + pin(p, I_BMOD)[l * 6144 + n0 + n]; }
            __syncthreads();
        }
        __syncthreads();
    }
    const int gw = blockIdx.x * NWAVE + wave, NGW = gridDim.x * NWAVE;
    const int gt = blockIdx.x * NTHR + tid, NGT = gridDim.x * NTHR;
    {
        LAS float* scr = (LAS float*)(lds + wave * 8448);
        constexpr int IT_IN = 16 * 109, IT_OUT = 16 * 32, IT_13 = 16 * 176, IT_2 = 44 * 32, IT_L = IT_IN + IT_OUT + IT_13 + IT_2;
        for (int it = gw; it < 2 * IT_L; it += NGW) {
            const int l = it / IT_L; int r = it % IT_L;
            unsigned char* wl = ws + (size_t)l * WLB;
            if (r < IT_IN) { const int kb = r / 109, nb = r % 109;
                const int n0 = nb * 32; const int drow = n0 < 1184 ? n0 + 768 : (n0 < 1952 ? n0 - 1184 : n0);
                transpose_item(pin(p, I_WIN) + (size_t)l * 1024 * INC, INC, (bf16_t*)(wl + OFF_WIN), 1024, (size_t)drow, kb * 64, n0, scr, lane); continue; }
            r -= IT_IN;
            if (r < IT_OUT) { const int kb = r / 32, nb = r % 32;
                transpose_item(pin(p, I_WOUT) + (size_t)l * 1024 * 1024, 1024, (bf16_t*)(wl + OFF_WOUT), 1024, (size_t)nb * 32, kb * 64, nb * 32, scr, lane); continue; }
            r -= IT_OUT;
            if (r < IT_13) { const int kb = r / 176, nb = r % 176; const int n0 = nb * 32;
                const int j = n0 < FH ? n0 : n0 - FH; const size_t drow = (size_t)(256 * (j / 128) + (n0 < FH ? 0 : 128) + (j % 128));
                transpose_item(pin(p, I_W13) + (size_t)l * 1024 * 2 * FH, 2 * FH, (bf16_t*)(wl + OFF_W13), 1024, drow, kb * 64, n0, scr, lane); continue; }
            r -= IT_13;
            { const int kb = r / 32, nb = r % 32;
                transpose_item(pin(p, I_W2) + (size_t)l * FH * 1024, 1024, (bf16_t*)(wl + OFF_W2), FH, (size_t)nb * 32, kb * 64, nb * 32, scr, lane); }
        }
    }
    for (int i = gt; i < 2 * 96 * 1024; i += NGT) { const int l = i / (96 * 1024), r = i % (96 * 1024); ((bf16_t*)(ws + (size_t)l * WLB + OFF_WIN))[(size_t)INC * 1024 + r] = 0; }
    for (int i = gt; i < 2 * 2048 * 384; i += NGT) {
        const int l = i / (2048 * 384), r = i % (2048 * 384), n = r / 384, k = r % 384;
        float v = 0.f;
        if (n < 1536) { const int g = n / 768, h = (n % 768) / 128, which = (n % 128) / 64, ch = n % 64, c = h * 64 + ch;
            const int kb = which ? 128 + 64 * g : 64 * g;
            if (k >= kb && k < kb + 64) v = (which ? pin(p, I_WA2) : pin(p, I_WD2))[((size_t)(l * 2 + g) * 64 + (k - kb)) * 384 + c]; }
        else if (n < 1920) { if (k >= 256) v = pin(p, I_WG2)[((size_t)l * 128 + (k - 256)) * 384 + (n - 1536)]; }
        ((bf16_t*)(ws + (size_t)l * WLB + OFF_BT2))[r] = f2bf(v);
    }
    for (int i = gt; i < SL * 16; i += NGT) { const int t = i >> 4, pi = i & 15; const float pos = (float)(pi < 8 ? (t >> 6) : (t & 63));
        const float inv = powf(10000.0f, -(float)(pi & 7) * 0.125f); const float ang = pos * inv;
        float* rt = (float*)(ws + WS_ROPE) + (size_t)i * 2; rt[0] = cosf(ang); rt[1] = sinf(ang); }
}

DI void phase_modulate0(const Params& p, int lane, int wave) {
    const int gw = blockIdx.x * NWAVE + wave, NGW = gridDim.x * NWAVE;
    const float* MOD = (const float*)(p.ws + WS_MOD); bf16_t* A = (bf16_t*)(p.ws + WS_AY);
    for (int row = gw; row < MT; row += NGW) {
        const float* src = row < ML ? pin(p, I_X) + (size_t)row * D : pin(p, I_CTX) + (size_t)(row - ML) * D;
        const int bi = row < ML ? (row >> 11) : 32; const float* md = MOD + (size_t)bi * 6144;
#pragma unroll
        for (int j = 0; j < 4; ++j) { const int c = 4 * (lane + 64 * j); const f32x4 v = *(const f32x4*)(src + c), sh = *(const f32x4*)(md + c), sc = *(const f32x4*)(md + 1024 + c);
            u32x2 o; o.x = cvtpk(v[0] * (1.f + sc[0]) + sh[0], v[1] * (1.f + sc[1]) + sh[1]); o.y = cvtpk(v[2] * (1.f + sc[2]) + sh[2], v[3] * (1.f + sc[3]) + sh[3]);
            *(u32x2*)(A + (size_t)row * D + c) = o; }
    }
}
DI void phase_ln(const Params& p, int lane, int wave, int nrows, const float* lnw, const float* lnb, const float* modl, int sh_ofs, int sc_ofs, bool write_x, bool write_A, bool dry = false) {
    const int gw = blockIdx.x * NWAVE + wave, NGW = gridDim.x * NWAVE;
    bf16_t* A = (bf16_t*)(p.ws + WS_AY); float* tc = (float*)(p.ws + WS_VT);
    f32x4 nx[4];
    if (gw < nrows) { const float* t0 = gw < ML ? p.out + (size_t)gw * D : tc + (size_t)(gw - ML) * D;
#pragma unroll
        for (int j = 0; j < 4; ++j) nx[j] = *(const f32x4*)(t0 + 4 * (lane + 64 * j)); }
    for (int row = gw; row < nrows; row += NGW) {
        const bool lat = row < ML;
        float* t = lat ? p.out + (size_t)row * D : tc + (size_t)(row - ML) * D;
        const int bi = lat ? (row >> 11) : 32;
        f32x4 v[4]; float s = 0.f;
#pragma unroll
        for (int j = 0; j < 4; ++j) { v[j] = nx[j]; s += (v[j][0] + v[j][1]) + (v[j][2] + v[j][3]); }
        { const int rn = row + NGW; if (rn < nrows) { const float* tn = rn < ML ? p.out + (size_t)rn * D : tc + (size_t)(rn - ML) * D;
#pragma unroll
            for (int j = 0; j < 4; ++j) nx[j] = *(const f32x4*)(tn + 4 * (lane + 64 * j)); } }
        const float mean = wave_sum(s, lane) * (1.f / D); float s2 = 0.f;
#pragma unroll
        for (int j = 0; j < 4; ++j) { v[j] = v[j] - mean; s2 += (v[j][0] * v[j][0] + v[j][1] * v[j][1]) + (v[j][2] * v[j][2] + v[j][3] * v[j][3]); }
        const float rstd = rsqrtf(wave_sum(s2, lane) * (1.f / D) + 1e-5f);
        const float* md = modl + (size_t)bi * 6144;
#pragma unroll
        for (int j = 0; j < 4; ++j) { const int c = 4 * (lane + 64 * j); const f32x4 w = *(const f32x4*)(lnw + c), b = *(const f32x4*)(lnb + c);
            f32x4 y; y[0] = v[j][0] * rstd * w[0] + b[0]; y[1] = v[j][1] * rstd * w[1] + b[1]; y[2] = v[j][2] * rstd * w[2] + b[2]; y[3] = v[j][3] * rstd * w[3] + b[3];
            const bool okst = !dry || y[0] == 1.2345e37f;
            if (write_x && okst) *(f32x4*)(t + c) = y;
            if (write_A && okst) { const f32x4 sh = *(const f32x4*)(md + sh_ofs + c), sc = *(const f32x4*)(md + sc_ofs + c);
                u32x2 o; o.x = cvtpk(y[0] * (1.f + sc[0]) + sh[0], y[1] * (1.f + sc[1]) + sh[1]); o.y = cvtpk(y[2] * (1.f + sc[2]) + sh[2], y[3] * (1.f + sc[3]) + sh[3]);
                *(u32x2*)(A + (size_t)row * D + c) = o; } }
    }
}

DI void phase_prep(const Params& p, int l, LAS unsigned char* lds, int lane, int wave) {
    const int gw = blockIdx.x * NWAVE + wave, NGW = gridDim.x * NWAVE;
    const bf16_t* PB = (const bf16_t*)(p.ws + WS_PB); bf16_t* A2 = (bf16_t*)(p.ws + WS_AY); bf16_t* VT = (bf16_t*)(p.ws + WS_VT);
    {
        const int j8 = lane < 48 ? 8 * lane : 0, kind = j8 >> 7;
        float mu[8];
        { const float* m = pin(p, I_MU) + (size_t)l * 1536 + 1152 + j8;
#pragma unroll
          for (int j = 0; j < 8; ++j) mu[j] = m[j]; }
        for (int row = gw; row < MT; row += NGW) {
            const bool lat = row < ML; const int t = lat ? (row & (SL - 1)) : ((row - ML) & (CL - 1)); const int Ls = lat ? SL : CL;
            const bf16_t* pr = PB + (size_t)row * PLD + C_RW + 1152 + j8;
            const u32x4 r0 = *(const u32x4*)pr, rm = *(const u32x4*)(t > 0 ? pr - PLD : pr), rp = *(const u32x4*)(t < Ls - 1 ? pr + PLD : pr);
            const float mm = t > 0 ? 0.5f : 0.f, mp = t < Ls - 1 ? 0.5f : 0.f;
            float c0[8], cm[8], cp[8], o[8];
            cvt8(r0, c0); cvt8(rm, cm); cvt8(rp, cp);
#pragma unroll
            for (int j = 0; j < 8; ++j) { const float y = c0[j] + ((mm * cm[j] + mp * cp[j]) - c0[j]) * mu[j];
                o[j] = kind == 0 ? 1.f - 2.f / (1.f + __expf(2.f * y)) : (kind == 1 ? y : sigm(y)); }
            if (lane < 48) { u32x4 w; w.x = cvtpk(o[0], o[1]); w.y = cvtpk(o[2], o[3]); w.z = cvtpk(o[4], o[5]); w.w = cvtpk(o[6], o[7]); *(u32x4*)(A2 + (size_t)row * 384 + j8) = w; }
        }
    }
    LAS bf16_t* T = (LAS bf16_t*)(lds + wave * 8448);
    for (int it = gw; it < NB * 4 * 36; it += NGW) {
        const int tb = it % 36, h = (it / 36) & 3, b = it / 144;
        const int row0 = tb < 32 ? b * SL + tb * 64 : ML + b * CL + (tb - 32) * 64;
        const bf16_t* src = PB + (size_t)(row0 + (lane >> 3)) * PLD + C_NV + h * 64 + 8 * (lane & 7);
#pragma unroll
        for (int i = 0; i < 8; ++i) { const u32x4 v = *(const u32x4*)(src + (size_t)(8 * i) * PLD);
            LAS unsigned* d = (LAS unsigned*)(T + (8 * i + (lane >> 3)) * 66 + 8 * (lane & 7)); d[0] = v.x; d[1] = v.y; d[2] = v.z; d[3] = v.w; }
        asm volatile("s_waitcnt vmcnt(0) lgkmcnt(0)" ::: "memory");
        bf16_t* dst = VT + ((size_t)(b * 4 + h) * 144 + tb * 4) * 1024;
#pragma unroll
        for (int k = 0; k < 16; ++k) { const int u = k * 64 + lane, q = u >> 8, d = (u >> 2) & 63, kg = u & 3;
            const LAS bf16_t* tp = T + (16 * q + 4 * kg) * 66 + d;
            u32x2 o; o.x = (unsigned)tp[0] | ((unsigned)tp[66] << 16); o.y = (unsigned)tp[132] | ((unsigned)tp[198] << 16);
            *(u32x2*)(dst + (size_t)(q * 64 + d) * 16 + 4 * kg) = o; }
        asm volatile("s_waitcnt lgkmcnt(0)" ::: "memory");
    }
}

#define MFMA16(a, b, c) __builtin_amdgcn_mfma_f32_16x16x32_bf16((a), (b), (c), 0, 0, 0)
DI u32x4 vload16(const bf16_t* p) { const volatile unsigned* q = (const volatile unsigned*)p; u32x4 r; r.x = q[0]; r.y = q[1]; r.z = q[2]; r.w = q[3]; return r; }
DI u32x2 vload8(const bf16_t* p) { const volatile unsigned* q = (const volatile unsigned*)p; u32x2 r; r.x = q[0]; r.y = q[1]; return r; }
struct NatPair { bf16x8 k[2][2]; u32x2 v[4][2]; u32x2 bias[2]; };
DI void nat_unit(const Params& p, int l, int id, bool isctx, int lane) {
    const bf16_t* PB = (const bf16_t*)(p.ws + WS_PB); const bf16_t* VT = (const bf16_t*)(p.ws + WS_VT); bf16_t* AY = (bf16_t*)(p.ws + WS_AY);
    const int l15 = lane & 15, g = lane >> 4;
    int b, h, r = 0, qt, qrow;
    if (!isctx) { qt = id & 3; r = (id >> 2) & 31; h = (id >> 7) & 3; b = id >> 9; qrow = b * SL + r * 64 + 16 * qt + l15; }
    else { qt = id & 15; h = (id >> 4) & 3; b = id >> 6; qrow = ML + b * CL + 16 * qt + l15; }
    const bf16_t* qp = PB + (size_t)qrow * PLD + C_NQ + h * 64 + 8 * g;
    const bf16x8 qf0 = *(const bf16x8*)qp, qf1 = *(const bf16x8*)(qp + 32);
    const int rs = min(max(r - 4, 0), 24);
    int ct_lo = 0, nct = 1;
    if (!isctx) { const int lo = min(max(16 * qt - 8, 0), 48), hi = min(max(16 * qt + 7, 0), 48) + 16; ct_lo = lo >> 4; nct = ((hi - 1) >> 4) - ct_lo + 1; }
    const int nloc = isctx ? 0 : 8 * nct, npairs = nloc / 2 + 8;
    const int qc = 16 * qt + l15, cs = min(max(qc - 8, 0), 48);
    float m = -1e30f, lsum = 0.f;
    f32x4 oacc[4];
#pragma unroll
    for (int dt = 0; dt < 4; ++dt) oacc[dt] = (f32x4){0.f, 0.f, 0.f, 0.f};
    const bf16_t* vt = VT + (size_t)(b * 4 + h) * 144 * 1024 + l15 * 16 + 4 * g;
    const bf16_t* kbase = PB + (size_t)l15 * PLD + C_NK + h * 64 + 8 * g;
    const float* rp = pin(p, I_RPB) + (size_t)((l * 4 + h) * 15) * 31;
    NatPair ring[4];
    int iti = 0, ikr = 0, icj = 0;
#define NAT_ISSUE(slot) do { __builtin_amdgcn_sched_barrier(0); _Pragma("unroll") for (int e = 0; e < 2; ++e) { int tk, keyrow; f32x4 bs = (f32x4){0.f, 0.f, 0.f, 0.f}; \
        if (iti < nloc) { const int ct = ct_lo + icj; tk = (rs + ikr) * 64 + 16 * ct; keyrow = b * SL + tk; const float* rpr = rp + (rs + ikr - r + 7) * 31; \
            _Pragma("unroll") for (int rg = 0; rg < 4; ++rg) { const int kc = 16 * ct + 4 * g + rg; const bool vis = (kc >= cs) && (kc < cs + 16); const float bv = rpr[min(max(kc - qc + 15, 0), 30)]; bs[rg] = vis ? bv : -1e30f; } \
            if (++icj == nct) { icj = 0; ++ikr; } } \
        else { const int j = (iti - nloc) * 16; tk = SL + j; keyrow = ML + b * CL + j; } \
        ++iti; ring[slot].bias[e] = (u32x2){cvtpk(bs[0], bs[1]), cvtpk(bs[2], bs[3])}; \
        const bf16_t* kp = kbase + (size_t)keyrow * PLD; ring[slot].k[e][0] = *(const bf16x8*)kp; ring[slot].k[e][1] = *(const bf16x8*)(kp + 32); \
        _Pragma("unroll") for (int dt = 0; dt < 4; ++dt) ring[slot].v[dt][e] = *(const u32x2*)(vt + (size_t)(tk >> 4) * 1024 + dt * 256); } __builtin_amdgcn_sched_barrier(0); } while (0)
#pragma unroll
    for (int j = 0; j < 4; ++j) NAT_ISSUE(j);
    for (int pi0 = 0; pi0 < npairs; pi0 += 4) {
#pragma unroll
        for (int j = 0; j < 4; ++j) {
            const int pi = pi0 + j;
            f32x4 s[2];
#pragma unroll
            for (int e = 0; e < 2; ++e) {
                f32x4 a = (f32x4){0.f, 0.f, 0.f, 0.f};
                a = MFMA16(ring[j].k[e][0], qf0, a); a = MFMA16(ring[j].k[e][1], qf1, a);
                const u32x2 bb = ring[j].bias[e];
                s[e] = a * 0.125f + (f32x4){bflo(bb.x), bfhi(bb.x), bflo(bb.y), bfhi(bb.y)};
            }
            float tmax = fmaxf(fmaxf(fmaxf(s[0][0], s[0][1]), fmaxf(s[0][2], s[0][3])), fmaxf(fmaxf(s[1][0], s[1][1]), fmaxf(s[1][2], s[1][3])));
            tmax = x32_max(x16_max(tmax));
            const float mn = fmaxf(m, tmax), corr = __expf(m - mn); m = mn;
            float pv[8]; float ps = 0.f;
#pragma unroll
            for (int i = 0; i < 8; ++i) { const float sv = s[i >> 2][i & 3]; pv[i] = sv > -1e29f ? __expf(sv - mn) : 0.f; ps += pv[i]; }
            lsum = lsum * corr + ps;
            u32x4 pk; pk.x = cvtpk(pv[0], pv[1]); pk.y = cvtpk(pv[2], pv[3]); pk.z = cvtpk(pv[4], pv[5]); pk.w = cvtpk(pv[6], pv[7]);
            const bf16x8 pf = __builtin_bit_cast(bf16x8, pk);
#pragma unroll
            for (int dt = 0; dt < 4; ++dt) {
                u32x4 vv; vv.x = ring[j].v[dt][0].x; vv.y = ring[j].v[dt][0].y; vv.z = ring[j].v[dt][1].x; vv.w = ring[j].v[dt][1].y;
                oacc[dt] = oacc[dt] * corr;
                oacc[dt] = MFMA16(__builtin_bit_cast(bf16x8, vv), pf, oacc[dt]);
            }
            if (pi + 4 < npairs) NAT_ISSUE(j);
        }
    }
#undef NAT_ISSUE
    lsum = x32_sum(x16_sum(lsum));
    const float inv = 1.0f / lsum;
    bf16_t* yp = AY + (size_t)qrow * D + 768 + h * 64 + 4 * g;
#pragma unroll
    for (int dt = 0; dt < 4; ++dt) { u32x2 o; o.x = cvtpk(oacc[dt][0] * inv, oacc[dt][1] * inv); o.y = cvtpk(oacc[dt][2] * inv, oacc[dt][3] * inv); *(u32x2*)(yp + 16 * dt) = o; }
}

constexpr int RW_STEP = 384, RW_BUF = 16 * RW_STEP, GL_STEP = 160, GL_BUF = 16 * GL_STEP, NCHUNK = (CL + SL) / 16;
DI float chunk_prefix(float x, int lane) {
#pragma unroll
    for (int d = 1; d < 16; d <<= 1) { const float t = __int_as_float(__builtin_amdgcn_ds_bpermute(((lane - 4 * d) & 63) << 2, __float_as_int(x))); x += (lane >> 2) >= d ? t : 0.f; }
    return x;
}
struct RwRaw { u32x4 d[3][3][2]; u32x4 lo[4]; };
DI void rwkv_load(const Params& p, int item, int c, RwRaw& R, int lane) {
    const int g = item & 1, h = (item >> 1) % 6, b = item / 12;
    const int ti = lane >> 2, cg = lane & 3;
    int row, ts, Ls; step_row(16 * c + ti, g, b, row, ts, Ls);
    const int rm = ts > 0 ? row - 1 : row, rp = ts < Ls - 1 ? row + 1 : row;
    const bf16_t* PB = (const bf16_t*)(p.ws + WS_PB) + C_RW + h * 64 + 16 * cg;
    const bf16_t* p0 = PB + (size_t)row * PLD; const bf16_t* pm = PB + (size_t)rm * PLD; const bf16_t* pp = PB + (size_t)rp * PLD;
#pragma unroll
    for (int a = 0; a < 3; ++a)
#pragma unroll
        for (int hf = 0; hf < 2; ++hf) { R.d[a][0][hf] = *(const u32x4*)(pm + a * 384 + 8 * hf); R.d[a][1][hf] = *(const u32x4*)(p0 + a * 384 + 8 * hf); R.d[a][2][hf] = *(const u32x4*)(pp + a * 384 + 8 * hf); }
    const bf16_t* lo = (const bf16_t*)(p.ws + WS_LO) + (size_t)row * LOLD + (g * 6 + h) * 128 + 16 * cg;
    R.lo[0] = *(const u32x4*)lo; R.lo[1] = *(const u32x4*)(lo + 8); R.lo[2] = *(const u32x4*)(lo + 64); R.lo[3] = *(const u32x4*)(lo + 72);
}
DI void rwkv_compute(const Params& p, int item, int c, const RwRaw& R, LAS float* buf, const LAS float* CST, int lane) {
    const int g = item & 1, h = (item >> 1) % 6, b = item / 12;
    const int ti = lane >> 2, cg = lane & 3;
    int row, ts, Ls; step_row(16 * c + ti, g, b, row, ts, Ls);
    const float mm = ts > 0 ? 0.5f : 0.f, mp = ts < Ls - 1 ? 0.5f : 0.f;
    float y[3][16];
#pragma unroll
    for (int a = 0; a < 3; ++a) {
        float c0[16], cm[16], cp[16];
        cvt8(R.d[a][0][0], &cm[0]); cvt8(R.d[a][0][1], &cm[8]); cvt8(R.d[a][1][0], &c0[0]); cvt8(R.d[a][1][1], &c0[8]); cvt8(R.d[a][2][0], &cp[0]); cvt8(R.d[a][2][1], &cp[8]);
#pragma unroll
        for (int j4 = 0; j4 < 4; ++j4) { const f32x4 mu = *(const LAS f32x4*)(CST + a * 64 + 16 * cg + 4 * j4);
#pragma unroll
            for (int jj = 0; jj < 4; ++jj) { const int j = 4 * j4 + jj; y[a][j] = c0[j] + ((mm * cm[j] + mp * cp[j]) - c0[j]) * mu[jj]; } }
    }
    float lw[16], a[16];
    cvt8(R.lo[0], &lw[0]); cvt8(R.lo[1], &lw[8]); cvt8(R.lo[2], &a[0]); cvt8(R.lo[3], &a[8]);
    float kkv[16]; float ss = 0.f;
#pragma unroll
    for (int j4 = 0; j4 < 4; ++j4) { const f32x4 kc = *(const LAS f32x4*)(CST + 3 * 64 + 16 * cg + 4 * j4);
#pragma unroll
        for (int jj = 0; jj < 4; ++jj) { const int j = 4 * j4 + jj; kkv[j] = y[1][j] * kc[jj]; ss += kkv[j] * kkv[j]; } }
    ss = sum4(ss);
    const float inv = rsqrtf(ss + 1e-12f);
    float bon = 0.f;
    LAS float* o = buf + ti * RW_STEP + 16 * cg;
#if SCALED_SCAN
    float P[16];
#pragma unroll
    for (int j = 0; j < 16; ++j) P[j] = chunk_prefix(lw[j], lane);
#endif
#pragma unroll
    for (int j4 = 0; j4 < 4; ++j4) {
        const f32x4 kac = *(const LAS f32x4*)(CST + 4 * 64 + 16 * cg + 4 * j4), rkc = *(const LAS f32x4*)(CST + 5 * 64 + 16 * cg + 4 * j4);
        f32x4 w4, b4, km4, r4, kk4, v4;
#pragma unroll
        for (int jj = 0; jj < 4; ++jj) { const int j = 4 * j4 + jj;
            const float kkn = kkv[j] * inv, aj = a[j];
            const float km = y[1][j] * (1.f + (aj - 1.f) * kac[jj]);
#if SCALED_SCAN
            const float eP = __expf(P[j]), eN = __expf(-P[j]), eX = __expf(lw[j] - P[j]);
            w4[jj] = eN; b4[jj] = kkn * aj * eP; km4[jj] = km * eP; r4[jj] = y[0][j] * eN; kk4[jj] = kkn * eX; v4[jj] = y[2][j];
#else
            w4[jj] = __expf(-lw[j]); b4[jj] = kkn * aj; km4[jj] = km; r4[jj] = y[0][j]; kk4[jj] = kkn; v4[jj] = y[2][j];
#endif
            bon += y[0][j] * km * rkc[jj]; }
        *(LAS f32x4*)(o + 0 * 64 + 4 * j4) = w4; *(LAS f32x4*)(o + 1 * 64 + 4 * j4) = b4; *(LAS f32x4*)(o + 2 * 64 + 4 * j4) = km4;
        *(LAS f32x4*)(o + 3 * 64 + 4 * j4) = r4; *(LAS f32x4*)(o + 4 * 64 + 4 * j4) = kk4; *(LAS f32x4*)(o + 5 * 64 + 4 * j4) = v4;
    }
    bon = sum4(bon);
    if (cg == 0) ((float*)(p.ws + WS_BON))[(size_t)row * 12 + g * 6 + h] = bon;
}
DI float xhalf_sum(float x) {
    const auto r = __builtin_amdgcn_permlane32_swap(__float_as_uint(x), __float_as_uint(x), false, false);
    return __uint_as_float(r[0]) + __uint_as_float(r[1]);
}
DI void rwkv_scan_chunk(const Params& p, int item, int c, const LAS float* buf, f32x2 (&S)[16], int lane, int hf, bool dry) {
    const int g = item & 1, h = (item >> 1) % 6, b = item / 12;
    float* LOf = (float*)(p.ws + WS_LO);
    const int kh = lane >> 5, rowi = 32 * hf + (lane & 31);
    const LAS float* bk = buf + 32 * kh;
    f32x4 KK[8];
#pragma unroll
    for (int i = 0; i < 8; ++i) KK[i] = *(const LAS f32x4*)(bk + 256 + 4 * i);
    float vv = buf[320 + rowi];
    for (int st = 0; st < 16; ++st) {
        const LAS float* W = bk + st * RW_STEP;
        const LAS float* Wn = bk + (st < 15 ? st + 1 : st) * RW_STEP;
        f32x4 U[2][8];
#pragma unroll
        for (int j = 0; j < 2; ++j) { U[0][4 * j] = *(const LAS f32x4*)(W + 4 * j); U[0][4 * j + 1] = *(const LAS f32x4*)(W + 64 + 4 * j); U[0][4 * j + 2] = *(const LAS f32x4*)(W + 128 + 4 * j); U[0][4 * j + 3] = *(const LAS f32x4*)(W + 192 + 4 * j); }
        f32x2 sacc[4];
#pragma unroll
        for (int i = 0; i < 4; ++i) sacc[i] = (f32x2){0.f, 0.f};
#pragma unroll
        for (int i = 0; i < 8; ++i) { sacc[(2 * i) & 3] += S[2 * i] * (f32x2){KK[i][0], KK[i][1]}; sacc[(2 * i + 1) & 3] += S[2 * i + 1] * (f32x2){KK[i][2], KK[i][3]}; }
        const f32x2 st2 = (sacc[0] + sacc[1]) + (sacc[2] + sacc[3]);
        const float sa = -xhalf_sum(st2[0] + st2[1]);
        const f32x2 sa2 = (f32x2){sa, sa}, vv2 = (f32x2){vv, vv};
        f32x2 oacc[4];
#pragma unroll
        for (int i = 0; i < 4; ++i) oacc[i] = (f32x2){0.f, 0.f};
        asm volatile("" : "+v"(oacc[0]), "+v"(oacc[1]) :: "memory");
#pragma unroll
        for (int gi = 0; gi < 4; ++gi) {
            const int cu = gi & 1, nx = cu ^ 1;
            if (gi < 3) {
#pragma unroll
                for (int j = 0; j < 2; ++j) { const int i = 2 * (gi + 1) + j; U[nx][4 * j] = *(const LAS f32x4*)(W + 4 * i); U[nx][4 * j + 1] = *(const LAS f32x4*)(W + 64 + 4 * i);
                    U[nx][4 * j + 2] = *(const LAS f32x4*)(W + 128 + 4 * i); U[nx][4 * j + 3] = *(const LAS f32x4*)(W + 192 + 4 * i); }
            }
            if (gi >= 2) {
#pragma unroll
                for (int j = 0; j < 4; ++j) KK[4 * (gi - 2) + j] = *(const LAS f32x4*)(Wn + 256 + 4 * (4 * (gi - 2) + j));
            }
#pragma unroll
            for (int j = 0; j < 2; ++j) { const int i = 2 * gi + j; const f32x4 w4 = U[cu][4 * j], b4 = U[cu][4 * j + 1], km4 = U[cu][4 * j + 2], r4 = U[cu][4 * j + 3];
#if SCALED_SCAN
                S[2 * i] = vv2 * (f32x2){km4[0], km4[1]} + S[2 * i]; S[2 * i] = sa2 * (f32x2){b4[0], b4[1]} + S[2 * i];
                S[2 * i + 1] = vv2 * (f32x2){km4[2], km4[3]} + S[2 * i + 1]; S[2 * i + 1] = sa2 * (f32x2){b4[2], b4[3]} + S[2 * i + 1];
                (void)w4;
#else
                f32x2 t0 = vv2 * (f32x2){km4[0], km4[1]}; t0 = sa2 * (f32x2){b4[0], b4[1]} + t0; S[2 * i] = S[2 * i] * (f32x2){w4[0], w4[1]} + t0;
                f32x2 t1 = vv2 * (f32x2){km4[2], km4[3]}; t1 = sa2 * (f32x2){b4[2], b4[3]} + t1; S[2 * i + 1] = S[2 * i + 1] * (f32x2){w4[2], w4[3]} + t1;
#endif
                oacc[(2 * i) & 3] += S[2 * i] * (f32x2){r4[0], r4[1]}; oacc[(2 * i + 1) & 3] += S[2 * i + 1] * (f32x2){r4[2], r4[3]}; }
            asm volatile("" : "+v"(oacc[0]), "+v"(oacc[1]), "+v"(oacc[2]), "+v"(oacc[3]) :: "memory");
        }
        vv = buf[(st < 15 ? st + 1 : st) * RW_STEP + 320 + rowi];
        const f32x2 o2 = (oacc[0] + oacc[1]) + (oacc[2] + oacc[3]);
        const float ov = xhalf_sum(o2[0] + o2[1]);
        int row, ts, Ls; step_row(16 * c + st, g, b, row, ts, Ls);
        if (kh == 0 && (!dry || ov == 1.2345e37f)) LOf[(size_t)row * (LOLD / 2) + (g * 6 + h) * 64 + rowi] = ov;
    }
#if SCALED_SCAN
#pragma unroll
    for (int i = 0; i < 8; ++i) { const f32x4 w4 = *(const LAS f32x4*)(bk + 15 * RW_STEP + 4 * i);
        S[2 * i] = S[2 * i] * (f32x2){w4[0], w4[1]}; S[2 * i + 1] = S[2 * i + 1] * (f32x2){w4[2], w4[3]}; }
#endif
}
struct GlRaw { u32x4 q, k, v[2], dn[2]; f32x4 rt[2]; };
DI void gla_load(const Params& p, int item, int c, GlRaw& R, int lane) {
    const int g = item & 1, h = (item >> 1) % 6, b = item / 12;
    const int ti = lane >> 2, cg = lane & 3;
    int row, ts, Ls; step_row(16 * c + ti, g, b, row, ts, Ls);
    const bf16_t* pr = (const bf16_t*)(p.ws + WS_PB) + (size_t)row * PLD;
    R.q = *(const u32x4*)(pr + C_GQ + h * 32 + 8 * cg); R.k = *(const u32x4*)(pr + C_GK + h * 32 + 8 * cg);
    R.v[0] = *(const u32x4*)(pr + C_GV + h * 64 + 16 * cg); R.v[1] = *(const u32x4*)(pr + C_GV + h * 64 + 16 * cg + 8);
    R.dn[0] = *(const u32x4*)(pr + C_GDN + 16 * g); R.dn[1] = *(const u32x4*)(pr + C_GDN + 16 * g + 8);
    const float* rt = (const float*)(p.ws + WS_ROPE) + (size_t)((Ls == SL ? ts : 0) * 16 + 4 * cg) * 2;
    R.rt[0] = *(const f32x4*)rt; R.rt[1] = *(const f32x4*)(rt + 4);
}
DI void gla_compute(const Params& p, int item, int c, const GlRaw& R, LAS float* buf, const LAS float* GU, int lane) {
    const int g = item & 1, b = item / 12;
    const int ti = lane >> 2, cg = lane & 3;
    int row, ts, Ls; step_row(16 * c + ti, g, b, row, ts, Ls);
    float q[8], k[8], v[16], dn[16];
    cvt8(R.q, q); cvt8(R.k, k); cvt8(R.v[0], &v[0]); cvt8(R.v[1], &v[8]); cvt8(R.dn[0], &dn[0]); cvt8(R.dn[1], &dn[8]);
    float al[8];
    {
        f32x4 z0 = *(const LAS f32x4*)(GU + 512 + 8 * cg), z1 = *(const LAS f32x4*)(GU + 512 + 8 * cg + 4);
#pragma unroll
        for (int rr = 0; rr < 16; ++rr) {
            if ((rr & 3) == 0) asm volatile("" : "+v"(z0), "+v"(z1) :: "memory");
            const f32x4 g0 = *(const LAS f32x4*)(GU + rr * 32 + 8 * cg), g1 = *(const LAS f32x4*)(GU + rr * 32 + 8 * cg + 4);
            z0 = z0 + g0 * dn[rr]; z1 = z1 + g1 * dn[rr]; }
#pragma unroll
        for (int j = 0; j < 8; ++j) { const float z = j < 4 ? z0[j & 3] : z1[j & 3];
            const float ls = fminf(z, 0.f) - __logf(1.f + __expf(-fabsf(z)));
#if SCALED_SCAN
            al[j] = chunk_prefix(ls * 0.0625f, lane); }
#else
            al[j] = __expf(ls * 0.0625f); }
#endif
    }
    if (Ls == SL) {
#pragma unroll
        for (int jj = 0; jj < 4; ++jj) { const float cc = R.rt[jj >> 1][2 * (jj & 1)], sn = R.rt[jj >> 1][2 * (jj & 1) + 1];
            const float q1 = q[2 * jj], q2 = q[2 * jj + 1]; q[2 * jj] = q1 * cc - q2 * sn; q[2 * jj + 1] = q1 * sn + q2 * cc;
            const float k1 = k[2 * jj], k2 = k[2 * jj + 1]; k[2 * jj] = k1 * cc - k2 * sn; k[2 * jj + 1] = k1 * sn + k2 * cc; }
    }
    LAS float* o = buf + ti * GL_STEP;
#if SCALED_SCAN
#pragma unroll
    for (int j = 0; j < 8; ++j) { const float eB = __expf(al[j]), eI = __expf(-al[j]); k[j] *= eI; q[j] *= eB; al[j] = eB; }
#endif
#pragma unroll
    for (int j4 = 0; j4 < 2; ++j4) {
        *(LAS f32x4*)(o + 8 * cg + 4 * j4) = (f32x4){al[4 * j4], al[4 * j4 + 1], al[4 * j4 + 2], al[4 * j4 + 3]};
        *(LAS f32x4*)(o + 32 + 8 * cg + 4 * j4) = (f32x4){k[4 * j4], k[4 * j4 + 1], k[4 * j4 + 2], k[4 * j4 + 3]};
        *(LAS f32x4*)(o + 64 + 8 * cg + 4 * j4) = (f32x4){q[4 * j4], q[4 * j4 + 1], q[4 * j4 + 2], q[4 * j4 + 3]} * 0.17677669529663687f; }
#pragma unroll
    for (int j4 = 0; j4 < 4; ++j4) *(LAS f32x4*)(o + 96 + 16 * cg + 4 * j4) = (f32x4){v[4 * j4], v[4 * j4 + 1], v[4 * j4 + 2], v[4 * j4 + 3]};
}
DI void gla_scan_chunk(const Params& p, int item, int c, const LAS float* buf, f32x2 (&S)[16], int lane, bool dry = false) {
    const int g = item & 1, h = (item >> 1) % 6, b = item / 12;
    bf16_t* AY = (bf16_t*)(p.ws + WS_AY);
    f32x4 U[2][12];
#pragma unroll
    for (int j = 0; j < 4; ++j) { U[0][3 * j] = ((const LAS f32x4*)buf)[j]; U[0][3 * j + 1] = ((const LAS f32x4*)buf)[8 + j]; U[0][3 * j + 2] = ((const LAS f32x4*)buf)[16 + j]; }
    float vv = buf[96 + lane];
    for (int st = 0; st < 16; ++st) {
        const LAS f32x4* W = (const LAS f32x4*)(buf + st * GL_STEP);
        const LAS float* bn = buf + (st < 15 ? st + 1 : st) * GL_STEP;
        const LAS f32x4* Wn = (const LAS f32x4*)bn;
        const f32x2 vv2 = (f32x2){vv, vv};
        f32x2 oacc[4];
#pragma unroll
        for (int i = 0; i < 4; ++i) oacc[i] = (f32x2){0.f, 0.f};
#pragma unroll
        for (int gi = 0; gi < 2; ++gi) {
            const int cu = gi, nx = gi ^ 1;
#pragma unroll
            for (int j = 0; j < 4; ++j) { const LAS f32x4* Wx = gi == 0 ? W : Wn; const int i = gi == 0 ? 4 + j : j;
                U[nx][3 * j] = Wx[i]; U[nx][3 * j + 1] = Wx[8 + i]; U[nx][3 * j + 2] = Wx[16 + i]; }
            if (gi == 1) vv = bn[96 + lane];
#pragma unroll
            for (int j = 0; j < 4; ++j) { const int i = 4 * gi + j; const f32x4 a4 = U[cu][3 * j], k4 = U[cu][3 * j + 1], q4 = U[cu][3 * j + 2];
#if SCALED_SCAN
                S[2 * i] = vv2 * (f32x2){k4[0], k4[1]} + S[2 * i]; S[2 * i + 1] = vv2 * (f32x2){k4[2], k4[3]} + S[2 * i + 1]; (void)a4;
#else
                S[2 * i] = S[2 * i] * (f32x2){a4[0], a4[1]} + vv2 * (f32x2){k4[0], k4[1]}; S[2 * i + 1] = S[2 * i + 1] * (f32x2){a4[2], a4[3]} + vv2 * (f32x2){k4[2], k4[3]};
#endif
                oacc[(2 * i) & 3] += S[2 * i] * (f32x2){q4[0], q4[1]}; oacc[(2 * i + 1) & 3] += S[2 * i + 1] * (f32x2){q4[2], q4[3]}; }
            asm volatile("" : "+v"(oacc[0]), "+v"(oacc[1]), "+v"(oacc[2]), "+v"(oacc[3]) :: "memory");
        }
        const f32x2 o2 = (oacc[0] + oacc[1]) + (oacc[2] + oacc[3]);
        int row, ts, Ls; step_row(16 * c + st, g, b, row, ts, Ls);
        { const float ov = o2[0] + o2[1]; if (!dry || ov == 1.2345e37f) AY[(size_t)row * D + g * 384 + h * 64 + lane] = f2bf(ov); }
    }
#if SCALED_SCAN
#pragma unroll
    for (int i = 0; i < 8; ++i) { const f32x4 b4 = ((const LAS f32x4*)(buf + 15 * GL_STEP))[i];
        S[2 * i] = S[2 * i] * (f32x2){b4[0], b4[1]}; S[2 * i + 1] = S[2 * i + 1] * (f32x2){b4[2], b4[3]}; }
#endif
}
DI void lds_wait_ge(volatile LAS unsigned* f, unsigned v) { while (*f < v) __builtin_amdgcn_s_sleep(1); }
DI void scan_unit_rw(const Params& p, int l, int su, LAS unsigned char* lds, int tid, int lane, int wave, bool dry, int nat_lo, int nat_hi, int nat_stride, int nnat) {
    LAS float* RWB = (LAS float*)lds; LAS float* CSB = (LAS float*)(lds + 143616);
    volatile LAS unsigned* FLG = (volatile LAS unsigned*)(lds + 146688);
    __syncthreads();
    for (int i = tid; i < 2 * 384; i += NTHR) { const int sl = i / 384, r = i % 384, a = r >> 6, ch = r & 63; const int it = 2 * su + sl, hh = (it >> 1) % 6;
        float v;
        if (a < 3) v = pin(p, I_MU)[(size_t)l * 1536 + a * 384 + hh * 64 + ch];
        else v = (a == 3 ? pin(p, I_KK) : (a == 4 ? pin(p, I_KA) : pin(p, I_RK)))[(size_t)l * 384 + hh * 64 + ch];
        CSB[i] = v; }
    if (tid < 8) FLG[tid] = 0u;
    __syncthreads();
    if (wave < 4) {
        asm volatile("" : "+v"(lane));
        const int slot = wave >> 1, hf = wave & 1, item = 2 * su + slot;
        f32x2 S[16];
#pragma unroll
        for (int i = 0; i < 16; ++i) S[i] = (f32x2){0.f, 0.f};
        for (int c = 0; c < NCHUNK; ++c) {
            lds_wait_ge(FLG + slot, (unsigned)(c + 1));
            asm volatile("" ::: "memory");
            rwkv_scan_chunk(p, item, c, RWB + (slot * 2 + (c & 1)) * RW_BUF, S, lane, hf, dry);
            asm volatile("s_waitcnt lgkmcnt(0)" ::: "memory");
            FLG[2 + slot * 2 + hf] = (unsigned)(c + 1);
        }
    } else if (wave < 6) {
        asm volatile("" : "+v"(lane));
        const int slot = wave & 1, item = 2 * su + slot;
        RwRaw R; rwkv_load(p, item, 0, R, lane);
        for (int c = 0; c < NCHUNK; ++c) {
            if (c >= 2) { lds_wait_ge(FLG + 2 + slot * 2, (unsigned)(c - 1)); lds_wait_ge(FLG + 3 + slot * 2, (unsigned)(c - 1)); }
            asm volatile("" ::: "memory");
            rwkv_compute(p, item, c, R, RWB + (slot * 2 + (c & 1)) * RW_BUF, CSB + slot * 384, lane);
            if (c + 1 < NCHUNK) rwkv_load(p, item, c + 1, R, lane);
            asm volatile("s_waitcnt lgkmcnt(0)" ::: "memory");
            FLG[slot] = (unsigned)(c + 1);
        }
    } else {
        asm volatile("" : "+v"(lane));
        for (int id = nat_lo + su * 2 + (wave - 6); id < nat_hi; id += nat_stride) { if (id < nnat) nat_unit(p, l, id, false, lane); else nat_unit(p, l, id - nnat, true, lane); }
    }
}
DI void scan_unit_gl(const Params& p, int l, int gu, LAS unsigned char* lds, int tid, int lane, int wave, bool dry) {
    LAS float* GLB = (LAS float*)lds; LAS float* GUB = (LAS float*)(lds + 122880);
    __syncthreads();
    for (int i = tid; i < 6 * 544; i += NTHR) { const int sl = i / 544, r = i % 544; const int it = 6 * gu + sl, gg = it & 1, hh = (it >> 1) % 6;
        GUB[i] = r < 512 ? pin(p, I_GUP)[((size_t)(l * 2 + gg) * 16 + (r >> 5)) * 192 + hh * 32 + (r & 31)] : pin(p, I_GB)[(size_t)(l * 2 + gg) * 192 + hh * 32 + (r - 512)]; }
    __syncthreads();
    if (wave < 6) {
        asm volatile("" : "+v"(lane));
        const int item = 6 * gu + wave;
        f32x2 Sg[16];
#pragma unroll
        for (int i = 0; i < 16; ++i) Sg[i] = (f32x2){0.f, 0.f};
        __syncthreads();
        for (int c = 0; c < NCHUNK; ++c) { gla_scan_chunk(p, item, c, GLB + (wave * 2 + (c & 1)) * GL_BUF, Sg, lane, dry); __syncthreads(); }
    } else {
        asm volatile("" : "+v"(lane));
        const int s0 = (wave - 6) * 3;
        GlRaw R0, R1, R2;
        gla_load(p, 6 * gu + s0, 0, R0, lane); gla_load(p, 6 * gu + s0 + 1, 0, R1, lane); gla_load(p, 6 * gu + s0 + 2, 0, R2, lane);
        gla_compute(p, 6 * gu + s0, 0, R0, GLB + ((s0) * 2) * GL_BUF, GUB + (s0) * 544, lane);
        gla_compute(p, 6 * gu + s0 + 1, 0, R1, GLB + ((s0 + 1) * 2) * GL_BUF, GUB + (s0 + 1) * 544, lane);
        gla_compute(p, 6 * gu + s0 + 2, 0, R2, GLB + ((s0 + 2) * 2) * GL_BUF, GUB + (s0 + 2) * 544, lane);
        gla_load(p, 6 * gu + s0, 1, R0, lane); gla_load(p, 6 * gu + s0 + 1, 1, R1, lane); gla_load(p, 6 * gu + s0 + 2, 1, R2, lane);
        __syncthreads();
        for (int c = 0; c < NCHUNK; ++c) {
            if (c + 1 < NCHUNK) { const int nb = (c + 1) & 1;
                gla_compute(p, 6 * gu + s0, c + 1, R0, GLB + ((s0) * 2 + nb) * GL_BUF, GUB + (s0) * 544, lane);
                gla_compute(p, 6 * gu + s0 + 1, c + 1, R1, GLB + ((s0 + 1) * 2 + nb) * GL_BUF, GUB + (s0 + 1) * 544, lane);
                gla_compute(p, 6 * gu + s0 + 2, c + 1, R2, GLB + ((s0 + 2) * 2 + nb) * GL_BUF, GUB + (s0 + 2) * 544, lane);
                if (c + 2 < NCHUNK) { gla_load(p, 6 * gu + s0, c + 2, R0, lane); gla_load(p, 6 * gu + s0 + 1, c + 2, R1, lane); gla_load(p, 6 * gu + s0 + 2, c + 2, R2, lane); } }
            __syncthreads(); }
    }
}
DI void phase_mixers(const Params& p, int l, LAS unsigned char* lds, int tid, int lane, int wave, bool dry = false, int which = 3) {
    const int G = gridDim.x, bx = blockIdx.x;
    const int nnat = NB * 4 * 32 * 4, nnatc = l == 0 ? NB * 4 * 16 : 0, ntot = nnat + nnatc;
    const int n_in = (G == 256 && (which & 2)) ? min(ntot, 384 * NAT_IN) : 0;
    if (which & 1) for (int u = bx; u < 256; u += G) { if (u < 192) scan_unit_rw(p, l, u, lds, tid, lane, wave, dry, 0, n_in, 384, nnat); else scan_unit_gl(p, l, u - 192, lds, tid, lane, wave, dry); }
    if (which & 2) for (int id = n_in + bx * NWAVE + wave; id < ntot; id += G * NWAVE) { if (id < nnat) nat_unit(p, l, id, false, lane); else nat_unit(p, l, id - nnat, true, lane); }
}

DI void phase_readout(const Params& p, int l, int nrows, int lane, int wave, bool dry = false) {
    const int gw = blockIdx.x * NWAVE + wave, NGW = gridDim.x * NWAVE;
    const bf16_t* PB = (const bf16_t*)(p.ws + WS_PB); bf16_t* AY = (bf16_t*)(p.ws + WS_AY);
    const float* LOf = (const float*)(p.ws + WS_LO); const bf16_t* LOb = (const bf16_t*)(p.ws + WS_LO); const float* BON = (const float*)(p.ws + WS_BON);
    const bool act = lane < 48; const int c8 = act ? 8 * lane : 0, h = c8 >> 6;
    float nw[8], gnw[8], gnb[8], mu[8];
    { const float* a = pin(p, I_GNW) + l * 64 + (c8 & 63); const float* b = pin(p, I_GNWT) + l * 384 + c8; const float* c = pin(p, I_GNB) + l * 384 + c8; const float* d = pin(p, I_MU) + (size_t)l * 1536 + 768 + c8;
#pragma unroll
      for (int j = 0; j < 8; ++j) { nw[j] = a[j]; gnw[j] = b[j]; gnb[j] = c[j]; mu[j] = d[j]; } }
    for (int row = gw; row < nrows; row += NGW) {
        const bool lat = row < ML; const int t = lat ? (row & (SL - 1)) : ((row - ML) & (CL - 1)); const int Ls = lat ? SL : CL;
        const bf16_t* pr = PB + (size_t)row * PLD; bf16_t* yr = AY + (size_t)row * D;
        const u32x4 r_of = *(const u32x4*)(yr + c8), r_ob = *(const u32x4*)(yr + 384 + c8), r_gg = *(const u32x4*)(pr + C_GG + c8);
        const u32x4 r_nat = *(const u32x4*)(yr + 768 + 8 * (lane & 31));
        const float* lf = LOf + (size_t)row * (LOLD / 2) + c8;
        const f32x4 f0 = *(const f32x4*)lf, f1 = *(const f32x4*)(lf + 4), b0 = *(const f32x4*)(lf + 384), b1 = *(const f32x4*)(lf + 388);
        const bf16_t* pv = pr + C_RW + 768 + c8;
        const u32x4 r_v0 = *(const u32x4*)pv, r_vm = *(const u32x4*)(t > 0 ? pv - PLD : pv), r_vp = *(const u32x4*)(t < Ls - 1 ? pv + PLD : pv);
        const u32x4 r_gt = *(const u32x4*)(LOb + (size_t)row * LOLD + 1536 + c8);
        const float bon = BON[(size_t)row * 12 + h] + BON[(size_t)row * 12 + 6 + h];
        const float mm = t > 0 ? 0.5f : 0.f, mp = t < Ls - 1 ? 0.5f : 0.f;
        float of[8], ob[8], gg[8], v0[8], vm[8], vp[8], gt[8];
        cvt8(r_of, of); cvt8(r_ob, ob); cvt8(r_gg, gg); cvt8(r_v0, v0); cvt8(r_vm, vm); cvt8(r_vp, vp); cvt8(r_gt, gt);
        float og[8], orw[8]; float ss = 0.f, sm = 0.f;
#pragma unroll
        for (int j = 0; j < 8; ++j) { og[j] = of[j] + ob[j]; ss += og[j] * og[j]; orw[j] = (j < 4 ? f0[j & 3] : f1[j & 3]) + (j < 4 ? b0[j & 3] : b1[j & 3]); sm += orw[j]; }
        ss = sum8(ss); sm = sum8(sm);
        const float mean = sm * (1.f / 64.f); float sq = 0.f;
#pragma unroll
        for (int j = 0; j < 8; ++j) { orw[j] -= mean; sq += orw[j] * orw[j]; }
        sq = sum8(sq);
        float e1 = 1e-5f, e2 = 64e-5f; asm volatile("" : "+v"(e1), "+v"(e2));
        const float rg = rsqrtf(ss * (1.f / 64.f) + e1), rn = rsqrtf(sq * (1.f / 64.f) + e2);
        float yg[8], yw[8];
#pragma unroll
        for (int j = 0; j < 8; ++j) { yg[j] = og[j] * rg * nw[j] * (gg[j] * sigm(gg[j]));
            const float vs = v0[j] + ((mm * vm[j] + mp * vp[j]) - v0[j]) * mu[j];
            yw[j] = (orw[j] * rn * gnw[j] + gnb[j] + bon * vs) * gt[j]; }
        asm volatile("s_waitcnt vmcnt(0)" ::: "memory");
        const bool okst = !dry || yg[0] == 1.2345e37f;
        if (act && okst) { u32x4 o; o.x = cvtpk(yg[0], yg[1]); o.y = cvtpk(yg[2], yg[3]); o.z = cvtpk(yg[4], yg[5]); o.w = cvtpk(yg[6], yg[7]); *(u32x4*)(yr + c8) = o;
            u32x4 w; w.x = cvtpk(yw[0], yw[1]); w.y = cvtpk(yw[2], yw[3]); w.z = cvtpk(yw[4], yw[5]); w.w = cvtpk(yw[6], yw[7]); *(u32x4*)(yr + 640 + c8) = w; }
        if (lane < 32 && okst) *(u32x4*)(yr + 384 + 8 * lane) = r_nat;
    }
}

#define XB_TMO      128
#define XB_XCNT(j)  (256  + 64 * (j))
#define XB_XSUB(j)  (1280 + 64 * (j))
#define XB_XGEN(j)  (2304 + 64 * (j))
#define XB_TOP      3328
#define XB_TOPGEN   3392
#define XCD_BAR_WORDS 3456
#define XB_SPIN_CAP (1u << 18)

__device__ __forceinline__ unsigned xb_ld(unsigned* p)              { return __hip_atomic_load(p, __ATOMIC_RELAXED, __HIP_MEMORY_SCOPE_AGENT); }
__device__ __forceinline__ unsigned xb_add(unsigned* p, unsigned v) { return __hip_atomic_fetch_add(p, v, __ATOMIC_RELAXED, __HIP_MEMORY_SCOPE_AGENT); }
__device__ __forceinline__ unsigned xb_xcc_id() { return (unsigned)__builtin_amdgcn_s_getreg((3 << 11) | 20) & 0xFu; }
#define XB_SPIN(cond, bar) do { unsigned _sp = 0; while (cond) { __builtin_amdgcn_s_sleep(1); \
    if ((++_sp & 255u) == 0u) { if (xb_ld(&(bar)[XB_TMO])) break; if (_sp > XB_SPIN_CAP) { atomicAdd(&(bar)[XB_TMO], 1u); break; } } } } while (0)

struct XcdBarrier {
    unsigned* bar; unsigned x;
    volatile LAS unsigned* st;
};

__device__ __forceinline__ XcdBarrier xcd_barrier_post(unsigned* bar, volatile LAS unsigned* st, int tid) {
    XcdBarrier b; b.bar = bar; b.x = xb_xcc_id(); b.st = st;
    if (tid == 0) (void)xb_add(&bar[XB_XCNT(b.x)], 1u);
    return b;
}
__device__ __forceinline__ void xcd_barrier_complete(unsigned* bar, unsigned x, unsigned& nloc, unsigned& nx) {
    const unsigned G = gridDim.x * gridDim.y * gridDim.z;
    unsigned sum, cnt, mine, sp = 0u;
    for (;;) {
        sum = 0u; cnt = 0u; mine = 0u;
#pragma unroll
        for (unsigned j = 0; j < 16; ++j) { const unsigned c = xb_ld(&bar[XB_XCNT(j)]); sum += c; cnt += (c > 0u) ? 1u : 0u; mine = (j == x) ? c : mine; }
        if (sum == G) break;
        __builtin_amdgcn_s_sleep(1);
        if ((++sp & 255u) == 0u) { if (xb_ld(&bar[XB_TMO])) break; if (sp > XB_SPIN_CAP) { atomicAdd(&bar[XB_TMO], 1u); break; } }
    }
    nloc = mine > 0u ? mine : 1u; nx = cnt > 0u ? cnt : 1u;
}

__device__ __forceinline__ void xcd_barrier(const XcdBarrier& b, int tid) {
    asm volatile("s_waitcnt vmcnt(0)" ::: "memory");
    __syncthreads();
    if (tid == 0) {
        unsigned* bar = b.bar;
        __builtin_amdgcn_s_waitcnt(0);
        unsigned nloc = b.st[0], nx = b.st[1];
        if (nloc == 0u) { xcd_barrier_complete(bar, b.x, nloc, nx); b.st[0] = nloc; b.st[1] = nx; }
        const unsigned old = xb_add(&bar[XB_XSUB(b.x)], 1u);
        const unsigned gen = old / nloc;
        if (old + 1u == (gen + 1u) * nloc) {
            __builtin_amdgcn_fence(__ATOMIC_RELEASE, "agent");
            asm volatile("s_waitcnt vmcnt(0)" ::: "memory");
            const unsigned og = xb_add(&bar[XB_TOP], 1u);
            const unsigned tg = og / nx;
            if (og + 1u == (tg + 1u) * nx) xb_add(&bar[XB_TOPGEN], 1u);
            else XB_SPIN(xb_ld(&bar[XB_TOPGEN]) == tg, bar);
            __builtin_amdgcn_fence(__ATOMIC_ACQUIRE, "agent");
            xb_add(&bar[XB_XGEN(b.x)], 1u);
            asm volatile("s_waitcnt vmcnt(0)" ::: "memory");
        } else {
            XB_SPIN(xb_ld(&bar[XB_XGEN(b.x)]) == gen, bar);
            __builtin_amdgcn_fence(__ATOMIC_ACQUIRE, "agent");
            asm volatile("s_waitcnt vmcnt(0)" ::: "memory");
        }
    }
    __syncthreads();
}


DI void grid_sync_probe() { cg::this_grid().sync(); }
DI void run_step(const Params& p, const int step, LAS unsigned char* lds, int tid, int lane, int wave, bool dry = false) {
    const int G = gridDim.x, bx = blockIdx.x;
    unsigned char* ws = p.ws;
    const float* MOD = (const float*)(ws + WS_MOD);
    float* TC = (float*)(ws + WS_VT);
    {
        const int l = step < 2 ? 0 : (step - 2) / 10, st = step < 2 ? -1 : (step - 2) % 10;
        unsigned char* wl = ws + (size_t)l * WLB;
        const float* modl = MOD + (size_t)l * 33 * 6144;
        const int Mff = l == 0 ? MT : ML;
        if (st == 0 || st == 2 || st == 5 || st == 7 || st == 8) {
            const bf16_t* gA = (const bf16_t*)(ws + WS_AY); const bf16_t* gB; int gM = Mff, gN = 1024, gK = 1024, mode = 2;
            bf16_t* eO = (bf16_t*)(ws + WS_PB); const float* ex = (const float*)p.out; const float* exc = (const float*)TC; int gofs = 2 * 1024;
            if (st == 0) { gB = (const bf16_t*)(wl + OFF_WIN); gM = MT; gN = PLD; mode = 0; }
            else if (st == 2) { gB = (const bf16_t*)(wl + OFF_BT2); gM = MT; gN = 2048; gK = 384; mode = 1; eO = (bf16_t*)(ws + WS_LO); }
            else if (st == 5) { gB = (const bf16_t*)(wl + OFF_WOUT); if (l == 0) { ex = pin(p, I_X); exc = pin(p, I_CTX); } }
            else if (st == 7) { gB = (const bf16_t*)(wl + OFF_W13); gN = 2 * FH; mode = 3; }
            else { gA = (const bf16_t*)(ws + WS_PB); gB = (const bf16_t*)(wl + OFF_W2); gK = FH; gofs = 5 * 1024; }
            asm volatile("" : "+s"(gK), "+s"(gM), "+s"(gN), "+s"(mode), "+s"(gofs));
            asm volatile("" : "+s"(gA), "+s"(gB), "+s"(eO), "+s"(ex), "+s"(exc));
            const pg8::Gemm g{gA, gB, gM, gN, gK};
            const pg8::EpiAny E{mode, pg8::EpiStoreBf16{eO, PLD}, pg8::EpiLora{eO, pin(p, I_W0) + (size_t)l * 768, pin(p, I_A0) + (size_t)l * 768},
                                pg8::EpiRes{ex, exc, p.out, TC, modl, gofs}, pg8::EpiSwiglu{eO}};
            pg8::StaticOrder S; S.init(g.M, g.N, G, bx);
#if defined(PROBE_GEMM)
            int nrep = (st == 0 || st == 2 || st == 7) ? 2 : 1; asm volatile("" : "+s"(nrep));
#pragma unroll 1
            for (int rep = 0; rep < nrep; ++rep) { pg8::gemm_phase<pg8::EpiAny, pg8::StaticOrder, true, true>(lds, g, S, E, tid); __syncthreads(); }
#else
            pg8::gemm_phase<pg8::EpiAny, pg8::StaticOrder, true, true>(lds, g, S, E, tid);
#endif
        }
#ifndef ONLYGEMM
        else if (step == 0) phase_prologue(p, lds, tid, lane, wave);
        else if (step == 1) phase_modulate0(p, lane, wave);
        else if (st == 1) phase_prep(p, l, lds, lane, wave);
#if defined(PROBE_MIX)
        else if (st == 3) { int nrep = 2; asm volatile("" : "+s"(nrep));
#pragma unroll 1
            for (int rep = 0; rep < nrep; ++rep) { phase_mixers(p, l, lds, tid, lane, wave, rep + 1 < nrep, rep + 1 < nrep ? PROBE_MIX : 3); __syncthreads(); grid_sync_probe(); } }
#else
        else if (st == 3) phase_mixers(p, l, lds, tid, lane, wave);
#endif
        else if (st == 4) phase_readout(p, l, Mff, lane, wave, dry);
        else if (st == 6) phase_ln(p, lane, wave, Mff, pin(p, I_LN1W) + l * 1024, pin(p, I_LN1B) + l * 1024, modl, 3 * 1024, 4 * 1024, true, true, dry);
        else {
            if (l == 0) phase_ln(p, lane, wave, MT, pin(p, I_LN2W), pin(p, I_LN2B), MOD + (size_t)33 * 6144, 0, 1024, true, true, dry);
            else phase_ln(p, lane, wave, ML, pin(p, I_LN2W) + 1024, pin(p, I_LN2B) + 1024, modl, 0, 1024, true, false, dry);
        }
#endif
    }
}
#ifdef MULTI_LAUNCH
template <int STEP> __global__ void __launch_bounds__(NTHR, 2) k_step(Params p) {
    extern __shared__ __attribute__((aligned(16))) unsigned char smem[];
    const int tid = threadIdx.x, lane = tid & 63, wave = __builtin_amdgcn_readfirstlane(tid >> 6);
    run_step(p, STEP, (LAS unsigned char*)smem, tid, lane, wave);
}
template <int STEP> static void launch_steps(const Params& p, int grid, hipStream_t stream) {
    static bool attr_done = false;
    if (!attr_done) { (void)hipFuncSetAttribute((const void*)k_step<STEP>, hipFuncAttributeMaxDynamicSharedMemorySize, LDS_BYTES); attr_done = true; }
    hipLaunchKernelGGL(k_step<STEP>, dim3(grid), dim3(NTHR), LDS_BYTES, stream, p);
    if constexpr (STEP + 1 < 22) launch_steps<STEP + 1>(p, grid, stream);
}
#else
__global__ void __launch_bounds__(NTHR, 2) hybrid_fwd(Params p) {
    extern __shared__ __attribute__((aligned(16))) unsigned char smem[];
    LAS unsigned char* lds = (LAS unsigned char*)smem;
    cg::grid_group grid = cg::this_grid();
    const int wave0 = __builtin_amdgcn_readfirstlane((int)threadIdx.x >> 6);
    volatile LAS unsigned* MISC = (volatile LAS unsigned*)(lds + LDS_BYTES - 64);
#if defined(PROBE_REPEAT) || defined(PROBE_DRY)
    bool repeated = false;
#endif
    bool setup_done = false;
#pragma unroll 1
    for (int step = 0; step < 22; ++step) {
        unsigned msk = ~0u; int wave_ = wave0;
        asm volatile("" : "+s"(msk), "+s"(wave_));
        const int lane_ = (int)__builtin_amdgcn_mbcnt_hi(msk, __builtin_amdgcn_mbcnt_lo(msk, 0u));
        const int tid_ = wave_ * 64 + lane_;
        const int stepu = __builtin_amdgcn_readfirstlane(step);
#if defined(PROBE_DRY)
        const int sd_ = stepu < 2 ? -1 : (stepu - 2) % 10; const bool wantdry = ((PROBE_DRY & 1) && (sd_ == 6 || sd_ == 9)) || ((PROBE_DRY & 2) && sd_ == 4);
        run_step(p, stepu, lds, tid_, lane_, wave_, wantdry && !repeated);
#else
        run_step(p, stepu, lds, tid_, lane_, wave_);
#endif
        XcdBarrier bar; bar.bar = (unsigned*)(p.ws + WS_BAR); bar.x = xb_xcc_id(); bar.st = MISC;
        if (stepu == 0) {
            if (tid_ < 2) MISC[tid_] = 0u;
            if (tid_ == 0 && !setup_done) (void)xb_add(&bar.bar[XB_XCNT(bar.x)], 1u);
            setup_done = true;
            grid.sync();
        } else if (stepu != 21) xcd_barrier(bar, tid_);
#if defined(PROBE_DRY)
        if (wantdry && !repeated) { repeated = true; --step; } else repeated = false;
#endif
#if defined(PROBE_REPEAT)
        { const int st_ = step < 2 ? -1 : (step - 2) % 10; const bool rep_ok = ((PROBE_REPEAT & 1) && (st_ == 0 || st_ == 2 || st_ == 7)) || ((PROBE_REPEAT & 2) && st_ == 1) || ((PROBE_REPEAT & 4) && step == 0) || ((PROBE_REPEAT & 8) && step == 1);
          if (rep_ok && !repeated) { repeated = true; --step; } else repeated = false; }
#endif
    }
}
#endif

extern "C" void kernel_launch(void* const* d_in, const int* in_sizes, int n_in, void* d_out, int out_size, void* d_ws, size_t ws_size, hipStream_t stream) {
    static int grid = 0;
    if (grid == 0) {
        int dev = 0, cus = 0, per_cu = 0;
        if (n_in != 29 || ws_size < WS_END) { fprintf(stderr, "kernel_launch: unexpected n_in %d / ws_size %zu (need %zu)\n", n_in, ws_size, (size_t)WS_END); }
        hipGetDevice(&dev);
        hipDeviceGetAttribute(&cus, hipDeviceAttributeMultiprocessorCount, dev);
#ifndef MULTI_LAUNCH
        if (hipFuncSetAttribute((const void*)hybrid_fwd, hipFuncAttributeMaxDynamicSharedMemorySize, LDS_BYTES) != hipSuccess) fprintf(stderr, "kernel_launch: hipFuncSetAttribute failed\n");
        if (hipOccupancyMaxActiveBlocksPerMultiprocessor(&per_cu, (const void*)hybrid_fwd, NTHR, LDS_BYTES) != hipSuccess || per_cu < 1) { fprintf(stderr, "kernel_launch: occupancy query gave %d\n", per_cu); per_cu = 1; }
#endif
        (void)hipGetLastError();
        grid = cus > 0 ? cus : 256;
    }
    Params p{};
    for (int i = 0; i < 29; ++i) p.in[i] = (const float*)d_in[i];
    p.out = (float*)d_out; p.ws = (unsigned char*)d_ws;
#ifdef MULTI_LAUNCH
    launch_steps<0>(p, grid, stream);
#else
    (void)hipMemsetAsync((unsigned char*)d_ws + WS_BAR, 0, 16384, stream);
    void* args[] = {&p};
    hipError_t e = hipLaunchCooperativeKernel((const void*)hybrid_fwd, dim3(grid), dim3(NTHR), args, LDS_BYTES, stream);
    if (e != hipSuccess) fprintf(stderr, "kernel_launch: cooperative launch failed: %s (grid %d)\n", hipGetErrorString(e), grid);
#endif
}
```

```cpp
#include <hip/hip_runtime.h>
#include <hip/hip_cooperative_groups.h>
#include <cstdio>
#include <cstdint>
namespace cg = cooperative_groups;
namespace pg8 {
#define PG8_LAS __attribute__((address_space(3)))
typedef unsigned short bf16_t;
typedef short bf16x8 __attribute__((ext_vector_type(8)));
typedef float f32x4 __attribute__((ext_vector_type(4)));
typedef unsigned u32x4 __attribute__((ext_vector_type(4)));
constexpr int BM = 256, BK = 64, HALF = 128, HTB = HALF * BK * 2  , STAGE_BYTES = 8 * HTB, NXCD = 8, WGM = 8;

__host__ __device__ __forceinline__ int lds_byte(int r, int c) { const int st = (r >> 4) * 2 + (c >> 5), rr = r & 15, cc = c & 31, ob = rr * 64 + cc * 2; return st * 1024 + (ob ^ (((ob >> 9) & 1) << 5)); }
__host__ __device__ __forceinline__ void stage_rc(int b, int& R, int& C) { const int st = b / 1024, sb = b % 1024, swz = sb ^ (((sb >> 9) & 1) << 5); R = (st >> 1) * 16 + swz / 64; C = (st & 1) * 32 + (swz % 64) / 2; }
__host__ __device__ __forceinline__ int perm32(int rho) { const int n = rho >> 4, i = rho & 15; return 8 * (i >> 2) + 4 * n + (i & 3); }

struct Unit { int pm, pn; };
struct Gemm { const bf16_t* A; const bf16_t* Bt; int M, N, K; };

struct StaticOrder {
    int nM, nN, nwg, G, c;
    __host__ __device__ void init(int M, int N, int G_, int c_) { nM = M / BM; nN = N / BM; nwg = nM * nN; G = G_; c = c_; }
    __host__ __device__ bool next(int i, Unit& u) const {
        const long L = (long)i * G + c; if (L >= nwg) return false;
        int wgid = (int)L; { const int q = nwg / NXCD, r = nwg % NXCD, xcd = wgid % NXCD, off = wgid / NXCD; wgid = (xcd < r ? xcd * (q + 1) : r * (q + 1) + (xcd - r) * q) + off; }
        const int nig = WGM * nN, gid = wgid / nig, fm = gid * WGM, gsz = (nM - fm) < WGM ? (nM - fm) : WGM;
        u.pm = fm + ((wgid % nig) % gsz); u.pn = (wgid % nig) / gsz; return true;
    }
    __device__ __forceinline__ void a_ready(const Unit&) const {}
    __device__ __forceinline__ void done(const Unit&) const {}
};
__device__ __forceinline__ unsigned cvtpk(float lo, float hi) { typedef float v2f __attribute__((ext_vector_type(2))); typedef __bf16 v2b __attribute__((ext_vector_type(2))); v2f v = {lo, hi}; v2b b = __builtin_convertvector(v, v2b); return __builtin_bit_cast(unsigned, b); }
__device__ __forceinline__ float sigm(float x) { return 1.0f / (1.0f + __expf(-x)); }
struct EpiStoreBf16 {
    static constexpr bool PERM = true, AFTER_DRAIN = false;
    bf16_t* O; int ldc;
    __device__ __forceinline__ void operator()(const f32x4 (&acc)[2][2][4][2], const Unit& u, int wr, int wc, int fr, int fq) const {
        const int row0 = u.pm * BM + wr * 64 + fr, col0 = u.pn * BM + wc * 32 + 8 * fq;
#pragma unroll
        for (int ai = 0; ai < 2; ++ai)
#pragma unroll
            for (int m = 0; m < 4; ++m) { bf16_t* rowp = O + (size_t)(row0 + ai * HALF + m * 16) * ldc + col0;
#pragma unroll
                for (int bj = 0; bj < 2; ++bj) { const f32x4 v0 = acc[ai][bj][m][0], v1 = acc[ai][bj][m][1];
                    u32x4 w; w.x = cvtpk(v0[0], v0[1]); w.y = cvtpk(v0[2], v0[3]); w.z = cvtpk(v1[0], v1[1]); w.w = cvtpk(v1[2], v1[3]);
                    *(u32x4*)(rowp + bj * HALF) = w; } }
    }
};
struct EpiLora {
    static constexpr bool PERM = true, AFTER_DRAIN = false;
    bf16_t* O; const float* w0; const float* a0;
    __device__ __forceinline__ void operator()(const f32x4 (&acc)[2][2][4][2], const Unit& u, int wr, int wc, int fr, int fq) const {
        const int row0 = u.pm * BM + wr * 64 + fr;
#pragma unroll
        for (int bj = 0; bj < 2; ++bj) {
            const int cb = u.pn * 2 + bj;
            if (cb < 15) {
                const int c0 = cb * 128 + wc * 32 + 8 * fq;
                if (cb >= 12) {
#pragma unroll
                    for (int ai = 0; ai < 2; ++ai)
#pragma unroll
                        for (int m = 0; m < 4; ++m) { const f32x4 v0 = acc[ai][bj][m][0], v1 = acc[ai][bj][m][1];
                            u32x4 w; w.x = cvtpk(v0[0], v0[1]); w.y = cvtpk(v0[2], v0[3]); w.z = cvtpk(v1[0], v1[1]); w.w = cvtpk(v1[2], v1[3]);
                            *(u32x4*)(O + (size_t)(row0 + ai * HALF + m * 16) * 1920 + c0) = w; }
                } else {
                    const int kind = wc >> 1, g = cb / 6, h = cb % 6;
                    const float* a0v = a0; const float* w0v = w0; asm volatile("" : "+s"(a0v), "+s"(w0v));
                    const float* bp = (kind ? a0v : w0v) + g * 384 + h * 64 + (wc & 1) * 32 + 8 * fq;
                    const f32x4 b0 = *(const f32x4*)bp, b1 = *(const f32x4*)(bp + 4);
                    const float mul = kind == 0 ? 0.60653065971263342f : 1.f;
#pragma unroll
                    for (int ai = 0; ai < 2; ++ai)
#pragma unroll
                        for (int m = 0; m < 4; ++m) { const f32x4 v0 = acc[ai][bj][m][0] + b0, v1 = acc[ai][bj][m][1] + b1;
                            u32x4 w; w.x = cvtpk(mul * sigm(v0[0]), mul * sigm(v0[1])); w.y = cvtpk(mul * sigm(v0[2]), mul * sigm(v0[3]));
                            w.z = cvtpk(mul * sigm(v1[0]), mul * sigm(v1[1])); w.w = cvtpk(mul * sigm(v1[2]), mul * sigm(v1[3]));
                            *(u32x4*)(O + (size_t)(row0 + ai * HALF + m * 16) * 1920 + c0) = w; }
                }
            }
        }
    }
};
struct EpiRes {
    static constexpr bool PERM = true, AFTER_DRAIN = false;
    const float* xl; const float* xc; float* ol; float* oc; const float* mod; int gofs;
    __device__ __forceinline__ void operator()(const f32x4 (&acc)[2][2][4][2], const Unit& u, int wr, int wc, int fr, int fq) const {
        const bool lat = u.pm < 256; const int bi = lat ? (u.pm >> 3) : 32;
        const size_t rbase = (size_t)(lat ? u.pm : u.pm - 256) * BM;
        const float* xlv = xl; const float* xcv = xc; float* olv = ol; float* ocv = oc; asm volatile("" : "+s"(xlv), "+s"(xcv), "+s"(olv), "+s"(ocv));
        const float* xin = (lat ? xlv : xcv) + rbase * 1024; float* out = (lat ? olv : ocv) + rbase * 1024;
        const float* gp = mod + (size_t)bi * 6144 + gofs;
        const int col0 = u.pn * BM + wc * 32 + 8 * fq, row0 = wr * 64 + fr;
#pragma unroll
        for (int bj = 0; bj < 2; ++bj)
#pragma unroll
            for (int n = 0; n < 2; ++n) { const int c = col0 + bj * HALF + 4 * n; const f32x4 gt = *(const f32x4*)(gp + c);
#pragma unroll
                for (int ai = 0; ai < 2; ++ai)
#pragma unroll
                    for (int m = 0; m < 4; ++m) { const size_t o = (size_t)(row0 + ai * HALF + m * 16) * 1024 + c;
                        const f32x4 xv = *(const f32x4*)(xin + o); const f32x4 a = acc[ai][bj][m][n];
                        f32x4 r; r[0] = 1.41421356237f * xv[0] + gt[0] * a[0]; r[1] = 1.41421356237f * xv[1] + gt[1] * a[1]; r[2] = 1.41421356237f * xv[2] + gt[2] * a[2]; r[3] = 1.41421356237f * xv[3] + gt[3] * a[3];
                        *(f32x4*)(out + o) = r; } }
    }
};
struct EpiSwiglu {
    static constexpr bool PERM = true, AFTER_DRAIN = false;
    bf16_t* O;
    __device__ __forceinline__ void operator()(const f32x4 (&acc)[2][2][4][2], const Unit& u, int wr, int wc, int fr, int fq) const {
        const int row0 = u.pm * BM + wr * 64 + fr, col0 = u.pn * HALF + wc * 32 + 8 * fq;
#pragma unroll
        for (int ai = 0; ai < 2; ++ai)
#pragma unroll
            for (int m = 0; m < 4; ++m) { float v[8];
#pragma unroll
                for (int i = 0; i < 8; ++i) { const float g = acc[ai][0][m][i >> 2][i & 3], up = acc[ai][1][m][i >> 2][i & 3]; v[i] = g * sigm(g) * up; }
                u32x4 w; w.x = cvtpk(v[0], v[1]); w.y = cvtpk(v[2], v[3]); w.z = cvtpk(v[4], v[5]); w.w = cvtpk(v[6], v[7]);
                *(u32x4*)(O + (size_t)(row0 + ai * HALF + m * 16) * 2816 + col0) = w; }
    }
};
struct EpiAny {
    static constexpr bool PERM = true, AFTER_DRAIN = false;
    int mode; EpiStoreBf16 e0; EpiLora e1; EpiRes e2; EpiSwiglu e3;
    __device__ __forceinline__ void operator()(const f32x4 (&acc)[2][2][4][2], const Unit& u, int wr, int wc, int fr, int fq) const {
        if (mode == 0) e0(acc, u, wr, wc, fr, fq); else if (mode == 1) e1(acc, u, wr, wc, fr, fq); else if (mode == 2) e2(acc, u, wr, wc, fr, fq); else e3(acc, u, wr, wc, fr, fq);
    }
};
template <class Epi, class Sched, bool ALIGN_EPI = false, bool SP2 = false>
__device__ __forceinline__ void gemm_phase(PG8_LAS unsigned char* lds, const Gemm g, const Sched& S, const Epi& E, const int tid) {
    const int wid = __builtin_amdgcn_readfirstlane(tid >> 6), lane = tid & 63, wr = wid >> 2, wc = wid & 3, fr = lane & 15, fq = lane >> 4;
    const int K = g.K, nt = K / BK;
    unsigned voffA[2], voffB[2];
#pragma unroll
    for (int i = 0; i < 2; ++i) { int R, C; stage_rc(tid * 16 + i * 8192, R, C); const int Rb = Epi::PERM ? ((R & ~31) + perm32(R & 31)) : R;
        voffA[i] = (unsigned)(R * K + C) * 2u; voffB[i] = (unsigned)(Rb * K + C) * 2u; }
    const size_t kstep = (size_t)(BK * 2);
    const size_t hstep = (size_t)HALF * K * 2;
    const size_t tstep = 2 * hstep;
    const unsigned ldsw = (unsigned)wid * 1024u;
    const int aoff = lds_byte(wr * 64 + fr, fq * 8), boff = lds_byte(wc * 32 + fr, fq * 8);
#define PG8_SA(b, h) (((b) * 2 + (h)) * HTB)
#define PG8_SB(b, h) ((4 + (b) * 2 + (h)) * HTB)
#define PG8_STAGE(bufoff, gbase, voff) do { _Pragma("unroll") for (int _i = 0; _i < 2; ++_i) \
        __builtin_amdgcn_global_load_lds((const unsigned*)((const char*)(gbase) + (voff)[_i]), (PG8_LAS unsigned*)(lds + (bufoff) + ldsw + _i * 8192), 16, 0, 0); } while (0)
#define PG8_LDA(dst, b, h) do { _Pragma("unroll") for (int m = 0; m < 4; ++m) _Pragma("unroll") for (int k = 0; k < 2; ++k) dst[m][k] = *(const PG8_LAS bf16x8*)(lds + PG8_SA(b, h) + aoff + m * 2048 + k * 1024); } while (0)
#define PG8_LDB(dst, b, h) do { _Pragma("unroll") for (int n = 0; n < 2; ++n) _Pragma("unroll") for (int k = 0; k < 2; ++k) dst[n][k] = *(const PG8_LAS bf16x8*)(lds + PG8_SB(b, h) + boff + n * 2048 + k * 1024); } while (0)
#define PG8_MMA(ai, bj, At, Bt) do { __builtin_amdgcn_s_setprio(1); _Pragma("unroll") for (int m = 0; m < 4; ++m) _Pragma("unroll") for (int n = 0; n < 2; ++n) _Pragma("unroll") for (int k = 0; k < 2; ++k) \
        acc[ai][bj][m][n] = __builtin_amdgcn_mfma_f32_16x16x32_bf16(Bt[n][k], At[m][k], acc[ai][bj][m][n], 0, 0, 0); __builtin_amdgcn_s_setprio(0); } while (0)
#define PG8_WAIT_V(n) asm volatile("s_waitcnt vmcnt(" #n ")" ::: "memory")
#define PG8_WAIT_L(n) asm volatile("s_waitcnt lgkmcnt(" #n ")" ::: "memory")
#define PG8_BAR __builtin_amdgcn_s_barrier()
#define PG8_SCHED __builtin_amdgcn_sched_barrier(0)
    Unit cur, nxt; int ui = 0;
    if (!S.next(0, cur)) return;
    f32x4 acc[2][2][4][2];
#pragma unroll
    for (int a = 0; a < 2; ++a)
#pragma unroll
        for (int b = 0; b < 2; ++b)
#pragma unroll
            for (int m = 0; m < 4; ++m)
#pragma unroll
                for (int n = 0; n < 2; ++n) acc[a][b][m][n] = (f32x4){0.f, 0.f, 0.f, 0.f};
    bf16x8 At[4][2], B0[2][2], B1[2][2];
    const char* cA = (const char*)g.A + (size_t)cur.pm * tstep; const char* cB = (const char*)g.Bt + (size_t)cur.pn * tstep;
    S.a_ready(cur);
    if constexpr (SP2) {
        PG8_STAGE(PG8_SB(0, 0), cB, voffB); PG8_STAGE(PG8_SB(0, 1), cB + hstep, voffB); PG8_STAGE(PG8_SA(0, 0), cA, voffA); PG8_STAGE(PG8_SA(0, 1), cA + hstep, voffA);
        if (wr == 1) PG8_BAR;
        PG8_WAIT_V(2); PG8_BAR;
        PG8_STAGE(PG8_SB(1, 0), cB + kstep, voffB); PG8_STAGE(PG8_SA(1, 0), cA + kstep, voffA); PG8_STAGE(PG8_SB(1, 1), cB + hstep + kstep, voffB);
        PG8_WAIT_V(6); PG8_BAR;
    } else {
        PG8_STAGE(PG8_SB(0, 0), cB, voffB); PG8_STAGE(PG8_SA(0, 0), cA, voffA); PG8_STAGE(PG8_SB(0, 1), cB + hstep, voffB); PG8_STAGE(PG8_SA(0, 1), cA + hstep, voffA);
        if (wr == 1) PG8_BAR;
        PG8_WAIT_V(4); PG8_BAR;
        PG8_STAGE(PG8_SB(1, 0), cB + kstep, voffB); PG8_STAGE(PG8_SA(1, 0), cA + kstep, voffA); PG8_STAGE(PG8_SB(1, 1), cB + hstep + kstep, voffB);
        PG8_WAIT_V(6); PG8_BAR;
    }
    for (;;) {
        const bool has_next = S.next(ui + 1, nxt);
        const char* nA = has_next ? (const char*)g.A + (size_t)nxt.pm * tstep : cA; const char* nB = has_next ? (const char*)g.Bt + (size_t)nxt.pn * tstep : cB;
        for (int t = 0; t < nt; t += 2) {
            const bool last = (t == nt - 2);
            const char* a1 = cA + (size_t)(t + 1) * kstep;
            const char* a2 = last ? nA : cA + (size_t)(t + 2) * kstep; const char* b2 = last ? nB : cB + (size_t)(t + 2) * kstep;
            const char* a3 = a2 + kstep; const char* b3 = b2 + kstep;
            if (last && has_next) S.a_ready(nxt);
            if constexpr (SP2) {
            PG8_LDB(B0, 0, 0); PG8_LDB(B1, 0, 1); PG8_SCHED; PG8_LDA(At, 0, 0); PG8_STAGE(PG8_SA(1, 1), a1 + hstep, voffA);
            PG8_WAIT_V(8); PG8_WAIT_L(0); PG8_BAR; PG8_MMA(0, 0, At, B0); PG8_MMA(0, 1, At, B1); PG8_BAR; PG8_SCHED;
            PG8_LDA(At, 0, 1); PG8_STAGE(PG8_SB(0, 0), b2, voffB); PG8_STAGE(PG8_SB(0, 1), b2 + hstep, voffB); PG8_STAGE(PG8_SA(0, 0), a2, voffA);
            PG8_WAIT_V(8); PG8_WAIT_L(0); PG8_BAR; PG8_MMA(1, 0, At, B0); PG8_MMA(1, 1, At, B1); PG8_BAR; PG8_SCHED;
            PG8_LDB(B0, 1, 0); PG8_LDB(B1, 1, 1); PG8_SCHED; PG8_LDA(At, 1, 0); PG8_STAGE(PG8_SA(0, 1), a2 + hstep, voffA);
            PG8_WAIT_V(8); PG8_WAIT_L(0); PG8_BAR; PG8_MMA(0, 0, At, B0); PG8_MMA(0, 1, At, B1); PG8_BAR; PG8_SCHED;
            PG8_LDA(At, 1, 1); PG8_STAGE(PG8_SB(1, 0), b3, voffB); PG8_STAGE(PG8_SB(1, 1), b3 + hstep, voffB); PG8_STAGE(PG8_SA(1, 0), a3, voffA);
            PG8_WAIT_V(8); PG8_WAIT_L(0); PG8_BAR; PG8_MMA(1, 0, At, B0); PG8_MMA(1, 1, At, B1); PG8_BAR; PG8_SCHED;
            } else {
            PG8_LDB(B0, 0, 0); PG8_SCHED; PG8_LDA(At, 0, 0); PG8_STAGE(PG8_SA(1, 1), a1 + hstep, voffA);
            PG8_WAIT_L(8); PG8_BAR; PG8_WAIT_L(0); PG8_MMA(0, 0, At, B0); PG8_BAR; PG8_SCHED;
            PG8_LDB(B1, 0, 1); PG8_STAGE(PG8_SB(0, 0), b2, voffB);
            PG8_BAR; PG8_WAIT_L(0); PG8_MMA(0, 1, At, B1); PG8_BAR;
            PG8_LDA(At, 0, 1); PG8_STAGE(PG8_SA(0, 0), a2, voffA);
            PG8_BAR; PG8_WAIT_L(0); PG8_MMA(1, 0, At, B0); PG8_BAR; PG8_SCHED;
            PG8_STAGE(PG8_SB(0, 1), b2 + hstep, voffB);
            PG8_WAIT_V(6); PG8_BAR; PG8_MMA(1, 1, At, B1); PG8_BAR;
            PG8_LDB(B0, 1, 0); PG8_SCHED; PG8_LDA(At, 1, 0); PG8_STAGE(PG8_SA(0, 1), a2 + hstep, voffA);
            PG8_WAIT_L(8); PG8_BAR; PG8_WAIT_L(0); PG8_MMA(0, 0, At, B0); PG8_BAR; PG8_SCHED;
            PG8_LDB(B1, 1, 1); PG8_STAGE(PG8_SB(1, 0), b3, voffB);
            PG8_BAR; PG8_WAIT_L(0); PG8_MMA(0, 1, At, B1); PG8_BAR;
            PG8_LDA(At, 1, 1); PG8_STAGE(PG8_SA(1, 0), a3, voffA);
            PG8_BAR; PG8_WAIT_L(0); PG8_MMA(1, 0, At, B0); PG8_BAR; PG8_SCHED;
            PG8_STAGE(PG8_SB(1, 1), b3 + hstep, voffB);
            PG8_WAIT_V(6); PG8_BAR; PG8_MMA(1, 1, At, B1); PG8_BAR;
            }
        }
        if constexpr (ALIGN_EPI) { if (wr == 0) PG8_BAR; }
        if constexpr (!Epi::AFTER_DRAIN) { E(acc, cur, wr, wc, fr, fq); S.done(cur); }
        if (!has_next) break;
#pragma unroll
        for (int a = 0; a < 2; ++a)
#pragma unroll
            for (int b = 0; b < 2; ++b)
#pragma unroll
                for (int m = 0; m < 4; ++m)
#pragma unroll
                    for (int n = 0; n < 2; ++n) acc[a][b][m][n] = (f32x4){0.f, 0.f, 0.f, 0.f};
        cur = nxt; cA = nA; cB = nB; ++ui;
        if constexpr (ALIGN_EPI) { if (wr == 1) PG8_BAR; }
    }
    PG8_WAIT_V(0);
    if constexpr (!ALIGN_EPI) { if (wr == 0) PG8_BAR; }
    PG8_BAR;
    if constexpr (Epi::AFTER_DRAIN) { E.fused(acc, cur, wr, wc, fr, fq, lds, wid, lane); S.done(cur); }
#undef PG8_SA
#undef PG8_SB
#undef PG8_STAGE
#undef PG8_LDA
#undef PG8_LDB
#undef PG8_MMA
#undef PG8_WAIT_V
#undef PG8_WAIT_L
#undef PG8_BAR
#undef PG8_SCHED
}
}

#define DI __device__ __forceinline__
#define LAS __attribute__((address_space(3)))
using pg8::bf16_t; using pg8::bf16x8; using pg8::f32x4; using pg8::u32x4; using pg8::cvtpk; using pg8::sigm;
typedef float f32x2 __attribute__((ext_vector_type(2)));
typedef unsigned u32x2 __attribute__((ext_vector_type(2)));

#ifndef SCALED_SCAN
#define SCALED_SCAN 1
#endif
#ifndef NAT_IN
#define NAT_IN 46
#endif
#ifndef MIXMASK
#define MIXMASK 3
#endif
#ifndef ROLEMASK
#define ROLEMASK 15
#endif
#ifndef PHMASK
#define PHMASK 0xffff
#endif
constexpr int NTHR = 512, NWAVE = 8, LDS_BYTES = 147456;
constexpr int D = 1024, NB = 32, SL = 2048, CL = 256, ML = NB * SL, MC = NB * CL, MT = ML + MC;
constexpr int INC = 3488, PLD = 3584, FH = 2816, LOLD = 1920;
constexpr int C_NQ = 0, C_NK = 256, C_NV = 512;
constexpr int C_GQ = 768, C_GK = 960, C_GV = 1152, C_GG = 1536, C_GDN = 1920;
constexpr int C_RW = 1952;
constexpr size_t OFF_WIN = 0, OFF_WOUT = 7340032, OFF_W13 = 9437184, OFF_W2 = 20971520, OFF_BT2 = 26738688, WLB = 28311552;
constexpr size_t WS_MOD = 2 * WLB, WS_ROPE = WS_MOD + 1622016, WS_BON = WS_ROPE + 262144, WS_VT = WS_BON + 3538944, WS_AY = WS_VT + 37748736,
                 WS_PB = WS_AY + 150994944, WS_LO = WS_PB + 528482304, WS_BAR = WS_LO + 283115520, WS_END = WS_BAR + 16384;

struct Params { const float* in[29]; float* out; unsigned char* ws; };
enum { I_X = 0, I_C, I_CTX, I_CCTX, I_WMOD, I_BMOD, I_WIN, I_GUP, I_GB, I_GNW, I_RPB, I_MU, I_W0, I_WD2, I_A0, I_WA2, I_WG2, I_KK, I_KA, I_RK, I_GNWT, I_GNB,
       I_WOUT, I_LN1W, I_LN1B, I_W13, I_W2, I_LN2W, I_LN2B };

DI const float* pin(const Params& p, int i) { asm volatile("" : "+s"(i)); return p.in[i]; }
DI float bf2f(bf16_t h) { return __uint_as_float(((unsigned)h) << 16); }
DI float bflo(unsigned u) { return __uint_as_float(u << 16); }
DI float bfhi(unsigned u) { return __uint_as_float(u & 0xffff0000u); }
DI bf16_t f2bf(float f) { return (bf16_t)(cvtpk(f, 0.f) & 0xffffu); }
DI float shx(float v, int m, int lane) { return __int_as_float(__builtin_amdgcn_ds_bpermute((lane ^ m) << 2, __float_as_int(v))); }
#define DPPF(v, ctrl) __int_as_float(__builtin_amdgcn_mov_dpp(__float_as_int(v), (ctrl), 0xf, 0xf, true))
DI float sum4(float v) { v += DPPF(v, 0xB1); v += DPPF(v, 0x4E); return v; }
DI float sum8(float v) { v = sum4(v); v += DPPF(v, 0x141); return v; }
DI float sum16(float v) { v = sum8(v); v += DPPF(v, 0x140); return v; }
DI float x16_sum(float x) { const auto r = __builtin_amdgcn_permlane16_swap(__float_as_uint(x), __float_as_uint(x), false, false); return __uint_as_float(r[0]) + __uint_as_float(r[1]); }
DI float x32_sum(float x) { const auto r = __builtin_amdgcn_permlane32_swap(__float_as_uint(x), __float_as_uint(x), false, false); return __uint_as_float(r[0]) + __uint_as_float(r[1]); }
DI float x16_max(float x) { const auto r = __builtin_amdgcn_permlane16_swap(__float_as_uint(x), __float_as_uint(x), false, false); return fmaxf(__uint_as_float(r[0]), __uint_as_float(r[1])); }
DI float x32_max(float x) { const auto r = __builtin_amdgcn_permlane32_swap(__float_as_uint(x), __float_as_uint(x), false, false); return fmaxf(__uint_as_float(r[0]), __uint_as_float(r[1])); }
DI float wave_sum(float v, int) { return x32_sum(x16_sum(sum16(v))); }
DI void cvt8(const u32x4 u, float* o) { o[0] = bflo(u.x); o[1] = bfhi(u.x); o[2] = bflo(u.y); o[3] = bfhi(u.y); o[4] = bflo(u.z); o[5] = bfhi(u.z); o[6] = bflo(u.w); o[7] = bfhi(u.w); }
DI void load8(const bf16_t* p, float* o) { const u32x4 u = *(const u32x4*)p; o[0] = bflo(u.x); o[1] = bfhi(u.x); o[2] = bflo(u.y); o[3] = bfhi(u.y); o[4] = bflo(u.z); o[5] = bfhi(u.z); o[6] = bflo(u.w); o[7] = bfhi(u.w); }
DI void load16(const bf16_t* p, float (&o)[16]) { load8(p, &o[0]); load8(p + 8, &o[8]); }
DI void shift16(const bf16_t* prow, bool hasm, bool hasp, const float* mu, float (&y)[16]) {
    float c0[16], cm[16], cp[16];
    load16(prow, c0);
    if (hasm) load16(prow - PLD, cm); else {
#pragma unroll
        for (int j = 0; j < 16; ++j) cm[j] = 0.f; }
    if (hasp) load16(prow + PLD, cp); else {
#pragma unroll
        for (int j = 0; j < 16; ++j) cp[j] = 0.f; }
#pragma unroll
    for (int j = 0; j < 16; ++j) y[j] = c0[j] + (0.5f * (cm[j] + cp[j]) - c0[j]) * mu[j];
}
DI void step_row(int s, int g, int b, int& row, int& ts, int& Ls) {
    if (s < CL) { ts = g ? (CL - 1 - s) : s; row = ML + b * CL + ts; Ls = CL; }
    else { const int u = s - CL; ts = g ? (SL - 1 - u) : u; row = b * SL + ts; Ls = SL; }
}

DI void transpose_item(const float* W, int N, bf16_t* WT, int Kd, size_t dst_row0, int k0, int n0, LAS float* scr, int lane) {
#pragma unroll 8
    for (int i = 0; i < 32; ++i) { const int kk = 2 * i + (lane >> 5); scr[kk * 33 + (lane & 31)] = W[(size_t)(k0 + kk) * N + n0 + (lane & 31)]; }
    asm volatile("s_waitcnt lgkmcnt(0)" ::: "memory");
    const int c = lane & 7;
#pragma unroll
    for (int j = 0; j < 4; ++j) { const int n = (lane >> 3) + 8 * j; const LAS float* s = scr + (8 * c) * 33 + n;
        u32x4 o; o.x = cvtpk(s[0 * 33], s[1 * 33]); o.y = cvtpk(s[2 * 33], s[3 * 33]); o.z = cvtpk(s[4 * 33], s[5 * 33]); o.w = cvtpk(s[6 * 33], s[7 * 33]);
        *(u32x4*)(WT + (dst_row0 + n) * Kd + k0 + 8 * c) = o; }
    asm volatile("s_waitcnt lgkmcnt(0)" ::: "memory");
}

DI void phase_prologue(const Params& p, LAS unsigned char* lds, int tid, int lane, int wave) {
    unsigned char* ws = p.ws;
    float* MOD = (float*)(ws + WS_MOD);
    {
        LAS float* sc = (LAS float*)lds;
        LAS float* part = (LAS float*)(lds + 135168);
        for (int i = tid; i < 33 * 1024; i += NTHR) { const int bi = i >> 10, k = i & 1023; const float cv = bi < 32 ? pin(p, I_C)[bi * 1024 + k] : pin(p, I_CCTX)[k]; sc[k * 33 + bi] = cv * sigm(cv); }
        __syncthreads();
        for (int u = blockIdx.x; u < 192; u += gridDim.x) {
            const int l = u / 96, n0 = (u % 96) * 64;
            float acc[33];
#pragma unroll
            for (int bi = 0; bi < 33; ++bi) acc[bi] = 0.f;
            const float* wp = pin(p, I_WMOD) + (size_t)l * 1024 * 6144 + n0 + lane;
#pragma unroll 8
            for (int kk = 0; kk < 128; ++kk) { const int k = wave * 128 + kk; const float w = wp[(size_t)k * 6144];
#pragma unroll
                for (int bi = 0; bi < 33; ++bi) acc[bi] += sc[k * 33 + bi] * w; }
            for (int w = 0; w < NWAVE; ++w) {
                if (wave == w) {
#pragma unroll
                    for (int bi = 0; bi < 33; ++bi) { if (w == 0) part[bi * 64 + lane] = acc[bi]; else part[bi * 64 + lane] += acc[bi]; } }
                __syncthreads();
            }
            for (int i = tid; i < 33 * 64; i += NTHR) { const int bi = i >> 6, n = i & 63; MOD[(size_t)(l * 33 + bi) * 6144 + n0 + n] = part[i] + pin(p, I_BMOD)[l * 6144 + n0 + n]; }
            __syncthreads();
        }
        __syncthreads();
    }
    const int gw = blockIdx.x * NWAVE + wave, NGW = gridDim.x * NWAVE;
    const int gt = blockIdx.x * NTHR + tid, NGT = gridDim.x * NTHR;
    {
        LAS float* scr = (LAS float*)(lds + wave * 8448);
        constexpr int IT_IN = 16 * 109, IT_OUT = 16 * 32, IT_13 = 16 * 176, IT_2 = 44 * 32, IT_L = IT_IN + IT_OUT + IT_13 + IT_2;
        for (int it = gw; it < 2 * IT_L; it += NGW) {
            const int l = it / IT_L; int r = it % IT_L;
            unsigned char* wl = ws + (size_t)l * WLB;
            if (r < IT_IN) { const int kb = r / 109, nb = r % 109;
                const int n0 = nb * 32; const int drow = n0 < 1184 ? n0 + 768 : (n0 < 1952 ? n0 - 1184 : n0);
                transpose_item(pin(p, I_WIN) + (size_t)l * 1024 * INC, INC, (bf16_t*)(wl + OFF_WIN), 1024, (size_t)drow, kb * 64, n0, scr, lane); continue; }
            r -= IT_IN;
            if (r < IT_OUT) { const int kb = r / 32, nb = r % 32;
                transpose_item(pin(p, I_WOUT) + (size_t)l * 1024 * 1024, 1024, (bf16_t*)(wl + OFF_WOUT), 1024, (size_t)nb * 32, kb * 64, nb * 32, scr, lane); continue; }
            r -= IT_OUT;
            if (r < IT_13) { const int kb = r / 176, nb = r % 176; const int n0 = nb * 32;
                const int j = n0 < FH ? n0 : n0 - FH; const size_t drow = (size_t)(256 * (j / 128) + (n0 < FH ? 0 : 128) + (j % 128));
                transpose_item(pin(p, I_W13) + (size_t)l * 1024 * 2 * FH, 2 * FH, (bf16_t*)(wl + OFF_W13), 1024, drow, kb * 64, n0, scr, lane); continue; }
            r -= IT_13;
            { const int kb = r / 32, nb = r % 32;
                transpose_item(pin(p, I_W2) + (size_t)l * FH * 1024, 1024, (bf16_t*)(wl + OFF_W2), FH, (size_t)nb * 32, kb * 64, nb * 32, scr, lane); }
        }
    }
    for (int i = gt; i < 2 * 96 * 1024; i += NGT) { const int l = i / (96 * 1024), r = i % (96 * 1024); ((bf16_t*)(ws + (size_t)l * WLB + OFF_WIN))[(size_t)INC * 1024 + r] = 0; }
    for (int i = gt; i < 2 * 2048 * 384; i += NGT) {
        const int l = i / (2048 * 384), r = i % (2048 * 384), n = r / 384, k = r % 384;
        float v = 0.f;
        if (n < 1536) { const int g = n / 768, h = (n % 768) / 128, which = (n % 128) / 64, ch = n % 64, c = h * 64 + ch;
            const int kb = which ? 128 + 64 * g : 64 * g;
            if (k >= kb && k < kb + 64) v = (which ? pin(p, I_WA2) : pin(p, I_WD2))[((size_t)(l * 2 + g) * 64 + (k - kb)) * 384 + c]; }
        else if (n < 1920) { if (k >= 256) v = pin(p, I_WG2)[((size_t)l * 128 + (k - 256)) * 384 + (n - 1536)]; }
        ((bf16_t*)(ws + (size_t)l * WLB + OFF_BT2))[r] = f2bf(v);
    }
    for (int i = gt; i < SL * 16; i += NGT) { const int t = i >> 4, pi = i & 15; const float pos = (float)(pi < 8 ? (t >> 6) : (t & 63));
        const float inv = powf(10000.0f, -(float)(pi & 7) * 0.125f); const float ang = pos * inv;
        float* rt = (float*)(ws + WS_ROPE) + (size_t)i * 2; rt[0] = cosf(ang); rt[1] = sinf(ang); }
}

DI void phase_modulate0(const Params& p, int lane, int wave) {
    const int gw = blockIdx.x * NWAVE + wave, NGW = gridDim.x * NWAVE;
    const float* MOD = (const float*)(p.ws + WS_MOD); bf16_t* A = (bf16_t*)(p.ws + WS_AY);
    for (int row = gw; row < MT; row += NGW) {
        const float* src = row < ML ? pin(p, I_X) + (size_t)row * D : pin(p, I_CTX) + (size_t)(row - ML) * D;
        const int bi = row < ML ? (row >> 11) : 32; const float* md = MOD + (size_t)bi * 6144;
#pragma unroll
        for (int j = 0; j < 4; ++j) { const int c = 4 * (lane + 64 * j); const f32x4 v = *(const f32x4*)(src + c), sh = *(const f32x4*)(md + c), sc = *(const f32x4*)(md + 1024 + c);
            u32x2 o; o.x = cvtpk(v[0] * (1.f + sc[0]) + sh[0], v[1] * (1.f + sc[1]) + sh[1]); o.y = cvtpk(v[2] * (1.f + sc[2]) + sh[2], v[3] * (1.f + sc[3]) + sh[3]);
            *(u32x2*)(A + (size_t)row * D + c) = o; }
    }
}
DI void phase_ln(const Params& p, int lane, int wave, int nrows, const float* lnw, const float* lnb, const float* modl, int sh_ofs, int sc_ofs, bool write_x, bool write_A, bool dry = false) {
    const int gw = blockIdx.x * NWAVE + wave, NGW = gridDim.x * NWAVE;
    bf16_t* A = (bf16_t*)(p.ws + WS_AY); float* tc = (float*)(p.ws + WS_VT);
    f32x4 nx[4];
    if (gw < nrows) { const float* t0 = gw < ML ? p.out + (size_t)gw * D : tc + (size_t)(gw - ML) * D;
#pragma unroll
        for (int j = 0; j < 4; ++j) nx[j] = *(const f32x4*)(t0 + 4 * (lane + 64 * j)); }
    for (int row = gw; row < nrows; row += NGW) {
        const bool lat = row < ML;
        float* t = lat ? p.out + (size_t)row * D : tc + (size_t)(row - ML) * D;
        const int bi = lat ? (row >> 11) : 32;
        f32x4 v[4]; float s = 0.f;
#pragma unroll
        for (int j = 0; j < 4; ++j) { v[j] = nx[j]; s += (v[j][0] + v[j][1]) + (v[j][2] + v[j][3]); }
        { const int rn = row + NGW; if (rn < nrows) { const float* tn = rn < ML ? p.out + (size_t)rn * D : tc + (size_t)(rn - ML) * D;
#pragma unroll
            for (int j = 0; j < 4; ++j) nx[j] = *(const f32x4*)(tn + 4 * (lane + 64 * j)); } }
        const float mean = wave_sum(s, lane) * (1.f / D); float s2 = 0.f;
#pragma unroll
        for (int j = 0; j < 4; ++j) { v[j] = v[j] - mean; s2 += (v[j][0] * v[j][0] + v[j][1] * v[j][1]) + (v[j][2] * v[j][2] + v[j][3] * v[j][3]); }
        const float rstd = rsqrtf(wave_sum(s2, lane) * (1.f / D) + 1e-5f);
        const float* md = modl + (size_t)bi * 6144;
#pragma unroll
        for (int j = 0; j < 4; ++j) { const int c = 4 * (lane + 64 * j); const f32x4 w = *(const f32x4*)(lnw + c), b = *(const f32x4*)(lnb + c);
            f32x4 y; y[0] = v[j][0] * rstd * w[0] + b[0]; y[1] = v[j][1] * rstd * w[1] + b[1]; y[2] = v[j][2] * rstd * w[2] + b[2]; y[3] = v[j][3] * rstd * w[3] + b[3];
            const bool okst = !dry || y[0] == 1.2345e37f;
            if (write_x && okst) *(f32x4*)(t + c) = y;
            if (write_A && okst) { const f32x4 sh = *(const f32x4*)(md + sh_ofs + c), sc = *(const f32x4*)(md + sc_ofs + c);
                u32x2 o; o.x = cvtpk(y[0] * (1.f + sc[0]) + sh[0], y[1] * (1.f + sc[1]) + sh[1]); o.y = cvtpk(y[2] * (1.f + sc[2]) + sh[2], y[3] * (1.f + sc[3]) + sh[3]);
                *(u32x2*)(A + (size_t)row * D + c) = o; } }
    }
}

DI void phase_prep(const Params& p, int l, LAS unsigned char* lds, int lane, int wave) {
    const int gw = blockIdx.x * NWAVE + wave, NGW = gridDim.x * NWAVE;
    const bf16_t* PB = (const bf16_t*)(p.ws + WS_PB); bf16_t* A2 = (bf16_t*)(p.ws + WS_AY); bf16_t* VT = (bf16_t*)(p.ws + WS_VT);
    {
        const int j8 = lane < 48 ? 8 * lane : 0, kind = j8 >> 7;
        float mu[8];
        { const float* m = pin(p, I_MU) + (size_t)l * 1536 + 1152 + j8;
#pragma unroll
          for (int j = 0; j < 8; ++j) mu[j] = m[j]; }
        for (int row = gw; row < MT; row += NGW) {
            const bool lat = row < ML; const int t = lat ? (row & (SL - 1)) : ((row - ML) & (CL - 1)); const int Ls = lat ? SL : CL;
            const bf16_t* pr = PB + (size_t)row * PLD + C_RW + 1152 + j8;
            const u32x4 r0 = *(const u32x4*)pr, rm = *(const u32x4*)(t > 0 ? pr - PLD : pr), rp = *(const u32x4*)(t < Ls - 1 ? pr + PLD : pr);
            const float mm = t > 0 ? 0.5f : 0.f, mp = t < Ls - 1 ? 0.5f : 0.f;
            float c0[8], cm[8], cp[8], o[8];
            cvt8(r0, c0); cvt8(rm, cm); cvt8(rp, cp);
#pragma unroll
            for (int j = 0; j < 8; ++j) { const float y = c0[j] + ((mm * cm[j] + mp * cp[j]) - c0[j]) * mu[j];
                o[j] = kind == 0 ? 1.f - 2.f / (1.f + __expf(2.f * y)) : (kind == 1 ? y : sigm(y)); }
            if (lane < 48) { u32x4 w; w.x = cvtpk(o[0], o[1]); w.y = cvtpk(o[2], o[3]); w.z = cvtpk(o[4], o[5]); w.w = cvtpk(o[6], o[7]); *(u32x4*)(A2 + (size_t)row * 384 + j8) = w; }
        }
    }
    LAS bf16_t* T = (LAS bf16_t*)(lds + wave * 8448);
    for (int it = gw; it < NB * 4 * 36; it += NGW) {
        const int tb = it % 36, h = (it / 36) & 3, b = it / 144;
        const int row0 = tb < 32 ? b * SL + tb * 64 : ML + b * CL + (tb - 32) * 64;
        const bf16_t* src = PB + (size_t)(row0 + (lane >> 3)) * PLD + C_NV + h * 64 + 8 * (lane & 7);
#pragma unroll
        for (int i = 0; i < 8; ++i) { const u32x4 v = *(const u32x4*)(src + (size_t)(8 * i) * PLD);
            LAS unsigned* d = (LAS unsigned*)(T + (8 * i + (lane >> 3)) * 66 + 8 * (lane & 7)); d[0] = v.x; d[1] = v.y; d[2] = v.z; d[3] = v.w; }
        asm volatile("s_waitcnt vmcnt(0) lgkmcnt(0)" ::: "memory");
        bf16_t* dst = VT + ((size_t)(b * 4 + h) * 144 + tb * 4) * 1024;
#pragma unroll
        for (int k = 0; k < 16; ++k) { const int u = k * 64 + lane, q = u >> 8, d = (u >> 2) & 63, kg = u & 3;
            const LAS bf16_t* tp = T + (16 * q + 4 * kg) * 66 + d;
            u32x2 o; o.x = (unsigned)tp[0] | ((unsigned)tp[66] << 16); o.y = (unsigned)tp[132] | ((unsigned)tp[198] << 16);
            *(u32x2*)(dst + (size_t)(q * 64 + d) * 16 + 4 * kg) = o; }
        asm volatile("s_waitcnt lgkmcnt(0)" ::: "memory");
    }
}

#define MFMA16(a, b, c) __builtin_amdgcn_mfma_f32_16x16x32_bf16((a), (b), (c), 0, 0, 0)
DI u32x4 vload16(const bf16_t* p) { const volatile unsigned* q = (const volatile unsigned*)p; u32x4 r; r.x = q[0]; r.y = q[1]; r.z = q[2]; r.w = q[3]; return r; }
DI u32x2 vload8(const bf16_t* p) { const volatile unsigned* q = (const volatile unsigned*)p; u32x2 r; r.x = q[0]; r.y = q[1]; return r; }
struct NatPair { bf16x8 k[2][2]; u32x2 v[4][2]; u32x2 bias[2]; };
DI void nat_unit(const Params& p, int l, int id, bool isctx, int lane) {
    const bf16_t* PB = (const bf16_t*)(p.ws + WS_PB); const bf16_t* VT = (const bf16_t*)(p.ws + WS_VT); bf16_t* AY = (bf16_t*)(p.ws + WS_AY);
    const int l15 = lane & 15, g = lane >> 4;
    int b, h, r = 0, qt, qrow;
    if (!isctx) { qt = id & 3; r = (id >> 2) & 31; h = (id >> 7) & 3; b = id >> 9; qrow = b * SL + r * 64 + 16 * qt + l15; }
    else { qt = id & 15; h = (id >> 4) & 3; b = id >> 6; qrow = ML + b * CL + 16 * qt + l15; }
    const bf16_t* qp = PB + (size_t)qrow * PLD + C_NQ + h * 64 + 8 * g;
    const bf16x8 qf0 = *(const bf16x8*)qp, qf1 = *(const bf16x8*)(qp + 32);
    const int rs = min(max(r - 4, 0), 24);
    int ct_lo = 0, nct = 1;
    if (!isctx) { const int lo = min(max(16 * qt - 8, 0), 48), hi = min(max(16 * qt + 7, 0), 48) + 16; ct_lo = lo >> 4; nct = ((hi - 1) >> 4) - ct_lo + 1; }
    const int nloc = isctx ? 0 : 8 * nct, npairs = nloc / 2 + 8;
    const int qc = 16 * qt + l15, cs = min(max(qc - 8, 0), 48);
    float m = -1e30f, lsum = 0.f;
    f32x4 oacc[4];
#pragma unroll
    for (int dt = 0; dt < 4; ++dt) oacc[dt] = (f32x4){0.f, 0.f, 0.f, 0.f};
    const bf16_t* vt = VT + (size_t)(b * 4 + h) * 144 * 1024 + l15 * 16 + 4 * g;
    const bf16_t* kbase = PB + (size_t)l15 * PLD + C_NK + h * 64 + 8 * g;
    const float* rp = pin(p, I_RPB) + (size_t)((l * 4 + h) * 15) * 31;
    NatPair ring[4];
    int iti = 0, ikr = 0, icj = 0;
#define NAT_ISSUE(slot) do { __builtin_amdgcn_sched_barrier(0); _Pragma("unroll") for (int e = 0; e < 2; ++e) { int tk, keyrow; f32x4 bs = (f32x4){0.f, 0.f, 0.f, 0.f}; \
        if (iti < nloc) { const int ct = ct_lo + icj; tk = (rs + ikr) * 64 + 16 * ct; keyrow = b * SL + tk; const float* rpr = rp + (rs + ikr - r + 7) * 31; \
            _Pragma("unroll") for (int rg = 0; rg < 4; ++rg) { const int kc = 16 * ct + 4 * g + rg; const bool vis = (kc >= cs) && (kc < cs + 16); const float bv = rpr[min(max(kc - qc + 15, 0), 30)]; bs[rg] = vis ? bv : -1e30f; } \
            if (++icj == nct) { icj = 0; ++ikr; } } \
        else { const int j = (iti - nloc) * 16; tk = SL + j; keyrow = ML + b * CL + j; } \
        ++iti; ring[slot].bias[e] = (u32x2){cvtpk(bs[0], bs[1]), cvtpk(bs[2], bs[3])}; \
        const bf16_t* kp = kbase + (size_t)keyrow * PLD; ring[slot].k[e][0] = *(const bf16x8*)kp; ring[slot].k[e][1] = *(const bf16x8*)(kp + 32); \
        _Pragma("unroll") for (int dt = 0; dt < 4; ++dt) ring[slot].v[dt][e] = *(const u32x2*)(vt + (size_t)(tk >> 4) * 1024 + dt * 256); } __builtin_amdgcn_sched_barrier(0); } while (0)
#pragma unroll
    for (int j = 0; j < 4; ++j) NAT_ISSUE(j);
    for (int pi0 = 0; pi0 < npairs; pi0 += 4) {
#pragma unroll
        for (int j = 0; j < 4; ++j) {
            const int pi = pi0 + j;
            f32x4 s[2];
#pragma unroll
            for (int e = 0; e < 2; ++e) {
                f32x4 a = (f32x4){0.f, 0.f, 0.f, 0.f};
                a = MFMA16(ring[j].k[e][0], qf0, a); a = MFMA16(ring[j].k[e][1], qf1, a);
                const u32x2 bb = ring[j].bias[e];
                s[e] = a * 0.125f + (f32x4){bflo(bb.x), bfhi(bb.x), bflo(bb.y), bfhi(bb.y)};
            }
            float tmax = fmaxf(fmaxf(fmaxf(s[0][0], s[0][1]), fmaxf(s[0][2], s[0][3])), fmaxf(fmaxf(s[1][0], s[1][1]), fmaxf(s[1][2], s[1][3])));
            tmax = x32_max(x16_max(tmax));
            const float mn = fmaxf(m, tmax), corr = __expf(m - mn); m = mn;
            float pv[8]; float ps = 0.f;
#pragma unroll
            for (int i = 0; i < 8; ++i) { const float sv = s[i >> 2][i & 3]; pv[i] = sv > -1e29f ? __expf(sv - mn) : 0.f; ps += pv[i]; }
            lsum = lsum * corr + ps;
            u32x4 pk; pk.x = cvtpk(pv[0], pv[1]); pk.y = cvtpk(pv[2], pv[3]); pk.z = cvtpk(pv[4], pv[5]); pk.w = cvtpk(pv[6], pv[7]);
            const bf16x8 pf = __builtin_bit_cast(bf16x8, pk);
#pragma unroll
            for (int dt = 0; dt < 4; ++dt) {
                u32x4 vv; vv.x = ring[j].v[dt][0].x; vv.y = ring[j].v[dt][0].y; vv.z = ring[j].v[dt][1].x; vv.w = ring[j].v[dt][1].y;
                oacc[dt] = oacc[dt] * corr;
                oacc[dt] = MFMA16(__builtin_bit_cast(bf16x8, vv), pf, oacc[dt]);
            }
            if (pi + 4 < npairs) NAT_ISSUE(j);
        }
    }
#undef NAT_ISSUE
    lsum = x32_sum(x16_sum(lsum));
    const float inv = 1.0f / lsum;
    bf16_t* yp = AY + (size_t)qrow * D + 768 + h * 64 + 4 * g;
#pragma unroll
    for (int dt = 0; dt < 4; ++dt) { u32x2 o; o.x = cvtpk(oacc[dt][0] * inv, oacc[dt][1] * inv); o.y = cvtpk(oacc[dt][2] * inv, oacc[dt][3] * inv); *(u32x2*)(yp + 16 * dt) = o; }
}

constexpr int RW_STEP = 384, RW_BUF = 16 * RW_STEP, GL_STEP = 160, GL_BUF = 16 * GL_STEP, NCHUNK = (CL + SL) / 16;
DI float chunk_prefix(float x, int lane) {
#pragma unroll
    for (int d = 1; d < 16; d <<= 1) { const float t = __int_as_float(__builtin_amdgcn_ds_bpermute(((lane - 4 * d) & 63) << 2, __float_as_int(x))); x += (lane >> 2) >= d ? t : 0.f; }
    return x;
}
struct RwRaw { u32x4 d[3][3][2]; u32x4 lo[4]; };
DI void rwkv_load(const Params& p, int item, int c, RwRaw& R, int lane) {
    const int g = item & 1, h = (item >> 1) % 6, b = item / 12;
    const int ti = lane >> 2, cg = lane & 3;
    int row, ts, Ls; step_row(16 * c + ti, g, b, row, ts, Ls);
    const int rm = ts > 0 ? row - 1 : row, rp = ts < Ls - 1 ? row + 1 : row;
    const bf16_t* PB = (const bf16_t*)(p.ws + WS_PB) + C_RW + h * 64 + 16 * cg;
    const bf16_t* p0 = PB + (size_t)row * PLD; const bf16_t* pm = PB + (size_t)rm * PLD; const bf16_t* pp = PB + (size_t)rp * PLD;
#pragma unroll
    for (int a = 0; a < 3; ++a)
#pragma unroll
        for (int hf = 0; hf < 2; ++hf) { R.d[a][0][hf] = *(const u32x4*)(pm + a * 384 + 8 * hf); R.d[a][1][hf] = *(const u32x4*)(p0 + a * 384 + 8 * hf); R.d[a][2][hf] = *(const u32x4*)(pp + a * 384 + 8 * hf); }
    const bf16_t* lo = (const bf16_t*)(p.ws + WS_LO) + (size_t)row * LOLD + (g * 6 + h) * 128 + 16 * cg;
    R.lo[0] = *(const u32x4*)lo; R.lo[1] = *(const u32x4*)(lo + 8); R.lo[2] = *(const u32x4*)(lo + 64); R.lo[3] = *(const u32x4*)(lo + 72);
}
DI void rwkv_compute(const Params& p, int item, int c, const RwRaw& R, LAS float* buf, const LAS float* CST, int lane) {
    const int g = item & 1, h = (item >> 1) % 6, b = item / 12;
    const int ti = lane >> 2, cg = lane & 3;
    int row, ts, Ls; step_row(16 * c + ti, g, b, row, ts, Ls);
    const float mm = ts > 0 ? 0.5f : 0.f, mp = ts < Ls - 1 ? 0.5f : 0.f;
    float y[3][16];
#pragma unroll
    for (int a = 0; a < 3; ++a) {
        float c0[16], cm[16], cp[16];
        cvt8(R.d[a][0][0], &cm[0]); cvt8(R.d[a][0][1], &cm[8]); cvt8(R.d[a][1][0], &c0[0]); cvt8(R.d[a][1][1], &c0[8]); cvt8(R.d[a][2][0], &cp[0]); cvt8(R.d[a][2][1], &cp[8]);
#pragma unroll
        for (int j4 = 0; j4 < 4; ++j4) { const f32x4 mu = *(const LAS f32x4*)(CST + a * 64 + 16 * cg + 4 * j4);
#pragma unroll
            for (int jj = 0; jj < 4; ++jj) { const int j = 4 * j4 + jj; y[a][j] = c0[j] + ((mm * cm[j] + mp * cp[j]) - c0[j]) * mu[jj]; } }
    }
    float lw[16], a[16];
    cvt8(R.lo[0], &lw[0]); cvt8(R.lo[1], &lw[8]); cvt8(R.lo[2], &a[0]); cvt8(R.lo[3], &a[8]);
    float kkv[16]; float ss = 0.f;
#pragma unroll
    for (int j4 = 0; j4 < 4; ++j4) { const f32x4 kc = *(const LAS f32x4*)(CST + 3 * 64 + 16 * cg + 4 * j4);
#pragma unroll
        for (int jj = 0; jj < 4; ++jj) { const int j = 4 * j4 + jj; kkv[j] = y[1][j] * kc[jj]; ss += kkv[j] * kkv[j]; } }
    ss = sum4(ss);
    const float inv = rsqrtf(ss + 1e-12f);
    float bon = 0.f;
    LAS float* o = buf + ti * RW_STEP + 16 * cg;
#if SCALED_SCAN
    float P[16];
#pragma unroll
    for (int j = 0; j < 16; ++j) P[j] = chunk_prefix(lw[j], lane);
#endif
#pragma unroll
    for (int j4 = 0; j4 < 4; ++j4) {
        const f32x4 kac = *(const LAS f32x4*)(CST + 4 * 64 + 16 * cg + 4 * j4), rkc = *(const LAS f32x4*)(CST + 5 * 64 + 16 * cg + 4 * j4);
        f32x4 w4, b4, km4, r4, kk4, v4;
#pragma unroll
        for (int jj = 0; jj < 4; ++jj) { const int j = 4 * j4 + jj;
            const float kkn = kkv[j] * inv, aj = a[j];
            const float km = y[1][j] * (1.f + (aj - 1.f) * kac[jj]);
#if SCALED_SCAN
            const float eP = __expf(P[j]), eN = __expf(-P[j]), eX = __expf(lw[j] - P[j]);
            w4[jj] = eN; b4[jj] = kkn * aj * eP; km4[jj] = km * eP; r4[jj] = y[0][j] * eN; kk4[jj] = kkn * eX; v4[jj] = y[2][j];
#else
            w4[jj] = __expf(-lw[j]); b4[jj] = kkn * aj; km4[jj] = km; r4[jj] = y[0][j]; kk4[jj] = kkn; v4[jj] = y[2][j];
#endif
            bon += y[0][j] * km * rkc[jj]; }
        *(LAS f32x4*)(o + 0 * 64 + 4 * j4) = w4; *(LAS f32x4*)(o + 1 * 64 + 4 * j4) = b4; *(LAS f32x4*)(o + 2 * 64 + 4 * j4) = km4;
        *(LAS f32x4*)(o + 3 * 64 + 4 * j4) = r4; *(LAS f32x4*)(o + 4 * 64 + 4 * j4) = kk4; *(LAS f32x4*)(o + 5 * 64 + 4 * j4) = v4;
    }
    bon = sum4(bon);
    if (cg == 0) ((float*)(p.ws + WS_BON))[(size_t)row * 12 + g * 6 + h] = bon;
}
DI float xhalf_sum(float x) {
    const auto r = __builtin_amdgcn_permlane32_swap(__float_as_uint(x), __float_as_uint(x), false, false);
    return __uint_as_float(r[0]) + __uint_as_float(r[1]);
}
DI void rwkv_scan_chunk(const Params& p, int item, int c, const LAS float* buf, f32x2 (&S)[16], int lane, int hf, bool dry) {
    const int g = item & 1, h = (item >> 1) % 6, b = item / 12;
    float* LOf = (float*)(p.ws + WS_LO);
    const int kh = lane >> 5, rowi = 32 * hf + (lane & 31);
    int row0, ts0, Ls0; step_row(16 * c, g, b, row0, ts0, Ls0);
    float* op = LOf + (size_t)row0 * (LOLD / 2) + (g * 6 + h) * 64 + rowi; const long ostep = g ? -(long)(LOLD / 2) : (long)(LOLD / 2);
    const LAS float* bk = buf + 32 * kh;
    f32x4 KK[8];
#pragma unroll
    for (int i = 0; i < 8; ++i) KK[i] = *(const LAS f32x4*)(bk + 256 + 4 * i);
    float vv = buf[320 + rowi];
    for (int st = 0; st < 16; ++st) {
        const LAS float* W = bk + st * RW_STEP;
        const LAS float* Wn = bk + (st < 15 ? st + 1 : st) * RW_STEP;
        f32x4 U[2][8];
#pragma unroll
        for (int j = 0; j < 2; ++j) { U[0][4 * j] = *(const LAS f32x4*)(W + 4 * j); U[0][4 * j + 1] = *(const LAS f32x4*)(W + 64 + 4 * j); U[0][4 * j + 2] = *(const LAS f32x4*)(W + 128 + 4 * j); U[0][4 * j + 3] = *(const LAS f32x4*)(W + 192 + 4 * j); }
        f32x2 sacc[4];
#pragma unroll
        for (int i = 0; i < 4; ++i) sacc[i] = (f32x2){0.f, 0.f};
#pragma unroll
        for (int i = 0; i < 8; ++i) { sacc[(2 * i) & 3] += S[2 * i] * (f32x2){KK[i][0], KK[i][1]}; sacc[(2 * i + 1) & 3] += S[2 * i + 1] * (f32x2){KK[i][2], KK[i][3]}; }
        const f32x2 st2 = (sacc[0] + sacc[1]) + (sacc[2] + sacc[3]);
        const float sa = -xhalf_sum(st2[0] + st2[1]);
        const f32x2 sa2 = (f32x2){sa, sa}, vv2 = (f32x2){vv, vv};
        f32x2 oacc[4];
#pragma unroll
        for (int i = 0; i < 4; ++i) oacc[i] = (f32x2){0.f, 0.f};
        asm volatile("" : "+v"(oacc[0]), "+v"(oacc[1]) :: "memory");
#pragma unroll
        for (int gi = 0; gi < 4; ++gi) {
            const int cu = gi & 1, nx = cu ^ 1;
            if (gi < 3) {
#pragma unroll
                for (int j = 0; j < 2; ++j) { const int i = 2 * (gi + 1) + j; U[nx][4 * j] = *(const LAS f32x4*)(W + 4 * i); U[nx][4 * j + 1] = *(const LAS f32x4*)(W + 64 + 4 * i);
                    U[nx][4 * j + 2] = *(const LAS f32x4*)(W + 128 + 4 * i); U[nx][4 * j + 3] = *(const LAS f32x4*)(W + 192 + 4 * i); }
            }
            if (gi >= 2) {
#pragma unroll
                for (int j = 0; j < 4; ++j) KK[4 * (gi - 2) + j] = *(const LAS f32x4*)(Wn + 256 + 4 * (4 * (gi - 2) + j));
            }
#pragma unroll
            for (int j = 0; j < 2; ++j) { const int i = 2 * gi + j; const f32x4 w4 = U[cu][4 * j], b4 = U[cu][4 * j + 1], km4 = U[cu][4 * j + 2], r4 = U[cu][4 * j + 3];
#if SCALED_SCAN
                S[2 * i] = vv2 * (f32x2){km4[0], km4[1]} + S[2 * i]; S[2 * i] = sa2 * (f32x2){b4[0], b4[1]} + S[2 * i];
                S[2 * i + 1] = vv2 * (f32x2){km4[2], km4[3]} + S[2 * i + 1]; S[2 * i + 1] = sa2 * (f32x2){b4[2], b4[3]} + S[2 * i + 1];
                (void)w4;
#else
                f32x2 t0 = vv2 * (f32x2){km4[0], km4[1]}; t0 = sa2 * (f32x2){b4[0], b4[1]} + t0; S[2 * i] = S[2 * i] * (f32x2){w4[0], w4[1]} + t0;
                f32x2 t1 = vv2 * (f32x2){km4[2], km4[3]}; t1 = sa2 * (f32x2){b4[2], b4[3]} + t1; S[2 * i + 1] = S[2 * i + 1] * (f32x2){w4[2], w4[3]} + t1;
#endif
                oacc[(2 * i) & 3] += S[2 * i] * (f32x2){r4[0], r4[1]}; oacc[(2 * i + 1) & 3] += S[2 * i + 1] * (f32x2){r4[2], r4[3]}; }
            asm volatile("" : "+v"(oacc[0]), "+v"(oacc[1]), "+v"(oacc[2]), "+v"(oacc[3]) :: "memory");
        }
        vv = buf[(st < 15 ? st + 1 : st) * RW_STEP + 320 + rowi];
        const f32x2 o2 = (oacc[0] + oacc[1]) + (oacc[2] + oacc[3]);
        const float ov = xhalf_sum(o2[0] + o2[1]);
        if (kh == 0 && (!dry || ov == 1.2345e37f)) *op = ov;
        op += ostep;
    }
#if SCALED_SCAN
#pragma unroll
    for (int i = 0; i < 8; ++i) { const f32x4 w4 = *(const LAS f32x4*)(bk + 15 * RW_STEP + 4 * i);
        S[2 * i] = S[2 * i] * (f32x2){w4[0], w4[1]}; S[2 * i + 1] = S[2 * i + 1] * (f32x2){w4[2], w4[3]}; }
#endif
}
struct GlRaw { u32x4 q, k, v[2], dn[2]; f32x4 rt[2]; };
DI void gla_load(const Params& p, int item, int c, GlRaw& R, int lane) {
    const int g = item & 1, h = (item >> 1) % 6, b = item / 12;
    const int ti = lane >> 2, cg = lane & 3;
    int row, ts, Ls; step_row(16 * c + ti, g, b, row, ts, Ls);
    const bf16_t* pr = (const bf16_t*)(p.ws + WS_PB) + (size_t)row * PLD;
    R.q = *(const u32x4*)(pr + C_GQ + h * 32 + 8 * cg); R.k = *(const u32x4*)(pr + C_GK + h * 32 + 8 * cg);
    R.v[0] = *(const u32x4*)(pr + C_GV + h * 64 + 16 * cg); R.v[1] = *(const u32x4*)(pr + C_GV + h * 64 + 16 * cg + 8);
    R.dn[0] = *(const u32x4*)(pr + C_GDN + 16 * g); R.dn[1] = *(const u32x4*)(pr + C_GDN + 16 * g + 8);
    const float* rt = (const float*)(p.ws + WS_ROPE) + (size_t)((Ls == SL ? ts : 0) * 16 + 4 * cg) * 2;
    R.rt[0] = *(const f32x4*)rt; R.rt[1] = *(const f32x4*)(rt + 4);
}
DI void gla_compute(const Params& p, int item, int c, const GlRaw& R, LAS float* buf, const LAS float* GU, int lane) {
    const int g = item & 1, b = item / 12;
    const int ti = lane >> 2, cg = lane & 3;
    int row, ts, Ls; step_row(16 * c + ti, g, b, row, ts, Ls);
    float q[8], k[8], v[16], dn[16];
    cvt8(R.q, q); cvt8(R.k, k); cvt8(R.v[0], &v[0]); cvt8(R.v[1], &v[8]); cvt8(R.dn[0], &dn[0]); cvt8(R.dn[1], &dn[8]);
    float al[8];
    {
        f32x4 z0 = *(const LAS f32x4*)(GU + 512 + 8 * cg), z1 = *(const LAS f32x4*)(GU + 512 + 8 * cg + 4);
#pragma unroll
        for (int rr = 0; rr < 16; ++rr) {
            if ((rr & 3) == 0) asm volatile("" : "+v"(z0), "+v"(z1) :: "memory");
            const f32x4 g0 = *(const LAS f32x4*)(GU + rr * 32 + 8 * cg), g1 = *(const LAS f32x4*)(GU + rr * 32 + 8 * cg + 4);
            z0 = z0 + g0 * dn[rr]; z1 = z1 + g1 * dn[rr]; }
#pragma unroll
        for (int j = 0; j < 8; ++j) { const float z = j < 4 ? z0[j & 3] : z1[j & 3];
            const float ls = fminf(z, 0.f) - __logf(1.f + __expf(-fabsf(z)));
#if SCALED_SCAN
            al[j] = chunk_prefix(ls * 0.0625f, lane); }
#else
            al[j] = __expf(ls * 0.0625f); }
#endif
    }
    if (Ls == SL) {
#pragma unroll
        for (int jj = 0; jj < 4; ++jj) { const float cc = R.rt[jj >> 1][2 * (jj & 1)], sn = R.rt[jj >> 1][2 * (jj & 1) + 1];
            const float q1 = q[2 * jj], q2 = q[2 * jj + 1]; q[2 * jj] = q1 * cc - q2 * sn; q[2 * jj + 1] = q1 * sn + q2 * cc;
            const float k1 = k[2 * jj], k2 = k[2 * jj + 1]; k[2 * jj] = k1 * cc - k2 * sn; k[2 * jj + 1] = k1 * sn + k2 * cc; }
    }
    LAS float* o = buf + ti * GL_STEP;
#if SCALED_SCAN
#pragma unroll
    for (int j = 0; j < 8; ++j) { const float eB = __expf(al[j]), eI = __expf(-al[j]); k[j] *= eI; q[j] *= eB; al[j] = eB; }
#endif
#pragma unroll
    for (int j4 = 0; j4 < 2; ++j4) {
        *(LAS f32x4*)(o + 8 * cg + 4 * j4) = (f32x4){al[4 * j4], al[4 * j4 + 1], al[4 * j4 + 2], al[4 * j4 + 3]};
        *(LAS f32x4*)(o + 32 + 8 * cg + 4 * j4) = (f32x4){k[4 * j4], k[4 * j4 + 1], k[4 * j4 + 2], k[4 * j4 + 3]};
        *(LAS f32x4*)(o + 64 + 8 * cg + 4 * j4) = (f32x4){q[4 * j4], q[4 * j4 + 1], q[4 * j4 + 2], q[4 * j4 + 3]} * 0.17677669529663687f; }
#pragma unroll
    for (int j4 = 0; j4 < 4; ++j4) *(LAS f32x4*)(o + 96 + 16 * cg + 4 * j4) = (f32x4){v[4 * j4], v[4 * j4 + 1], v[4 * j4 + 2], v[4 * j4 + 3]};
}
DI void gla_scan_chunk(const Params& p, int item, int c, const LAS float* buf, f32x2 (&S)[16], int lane, bool dry = false) {
    const int g = item & 1, h = (item >> 1) % 6, b = item / 12;
    bf16_t* AY = (bf16_t*)(p.ws + WS_AY);
    int row0, ts0, Ls0; step_row(16 * c, g, b, row0, ts0, Ls0);
    bf16_t* op = AY + (size_t)row0 * D + g * 384 + h * 64 + lane; const long ostep = g ? -(long)D : (long)D;
    f32x4 U[2][12];
#pragma unroll
    for (int j = 0; j < 4; ++j) { U[0][3 * j] = ((const LAS f32x4*)buf)[j]; U[0][3 * j + 1] = ((const LAS f32x4*)buf)[8 + j]; U[0][3 * j + 2] = ((const LAS f32x4*)buf)[16 + j]; }
    float vv = buf[96 + lane];
    for (int st = 0; st < 16; ++st) {
        const LAS f32x4* W = (const LAS f32x4*)(buf + st * GL_STEP);
        const LAS float* bn = buf + (st < 15 ? st + 1 : st) * GL_STEP;
        const LAS f32x4* Wn = (const LAS f32x4*)bn;
        const f32x2 vv2 = (f32x2){vv, vv};
        f32x2 oacc[4];
#pragma unroll
        for (int i = 0; i < 4; ++i) oacc[i] = (f32x2){0.f, 0.f};
#pragma unroll
        for (int gi = 0; gi < 2; ++gi) {
            const int cu = gi, nx = gi ^ 1;
#pragma unroll
            for (int j = 0; j < 4; ++j) { const LAS f32x4* Wx = gi == 0 ? W : Wn; const int i = gi == 0 ? 4 + j : j;
                U[nx][3 * j] = Wx[i]; U[nx][3 * j + 1] = Wx[8 + i]; U[nx][3 * j + 2] = Wx[16 + i]; }
            if (gi == 1) vv = bn[96 + lane];
#pragma unroll
            for (int j = 0; j < 4; ++j) { const int i = 4 * gi + j; const f32x4 a4 = U[cu][3 * j], k4 = U[cu][3 * j + 1], q4 = U[cu][3 * j + 2];
#if SCALED_SCAN
                S[2 * i] = vv2 * (f32x2){k4[0], k4[1]} + S[2 * i]; S[2 * i + 1] = vv2 * (f32x2){k4[2], k4[3]} + S[2 * i + 1]; (void)a4;
#else
                S[2 * i] = S[2 * i] * (f32x2){a4[0], a4[1]} + vv2 * (f32x2){k4[0], k4[1]}; S[2 * i + 1] = S[2 * i + 1] * (f32x2){a4[2], a4[3]} + vv2 * (f32x2){k4[2], k4[3]};
#endif
                oacc[(2 * i) & 3] += S[2 * i] * (f32x2){q4[0], q4[1]}; oacc[(2 * i + 1) & 3] += S[2 * i + 1] * (f32x2){q4[2], q4[3]}; }
            asm volatile("" : "+v"(oacc[0]), "+v"(oacc[1]), "+v"(oacc[2]), "+v"(oacc[3]) :: "memory");
        }
        const f32x2 o2 = (oacc[0] + oacc[1]) + (oacc[2] + oacc[3]);
        { const float ov = o2[0] + o2[1]; if (!dry || ov == 1.2345e37f) *op = f2bf(ov); }
        op += ostep;
    }
#if SCALED_SCAN
#pragma unroll
    for (int i = 0; i < 8; ++i) { const f32x4 b4 = ((const LAS f32x4*)(buf + 15 * GL_STEP))[i];
        S[2 * i] = S[2 * i] * (f32x2){b4[0], b4[1]}; S[2 * i + 1] = S[2 * i + 1] * (f32x2){b4[2], b4[3]}; }
#endif
}
DI void lds_wait_ge(volatile LAS unsigned* f, unsigned v) { while (*f < v) __builtin_amdgcn_s_sleep(1); }
DI void scan_unit_rw(const Params& p, int l, int su, LAS unsigned char* lds, int tid, int lane, int wave, bool dry, int nat_lo, int nat_hi, int nat_stride, int nnat) {
    LAS float* RWB = (LAS float*)lds; LAS float* CSB = (LAS float*)(lds + 143616);
    volatile LAS unsigned* FLG = (volatile LAS unsigned*)(lds + 146688);
    __syncthreads();
    for (int i = tid; i < 2 * 384; i += NTHR) { const int sl = i / 384, r = i % 384, a = r >> 6, ch = r & 63; const int it = 2 * su + sl, hh = (it >> 1) % 6;
        float v;
        if (a < 3) v = pin(p, I_MU)[(size_t)l * 1536 + a * 384 + hh * 64 + ch];
        else v = (a == 3 ? pin(p, I_KK) : (a == 4 ? pin(p, I_KA) : pin(p, I_RK)))[(size_t)l * 384 + hh * 64 + ch];
        CSB[i] = v; }
    if (tid < 8) FLG[tid] = 0u;
    __syncthreads();
    if (wave < 4) {
        asm volatile("" : "+v"(lane));
        const int slot = wave >> 1, hf = wave & 1, item = 2 * su + slot;
        f32x2 S[16];
#pragma unroll
        for (int i = 0; i < 16; ++i) S[i] = (f32x2){0.f, 0.f};
        for (int c = 0; c < NCHUNK; ++c) {
            lds_wait_ge(FLG + slot, (unsigned)(c + 1));
            asm volatile("" ::: "memory");
            rwkv_scan_chunk(p, item, c, RWB + (slot * 2 + (c & 1)) * RW_BUF, S, lane, hf, dry);
            asm volatile("s_waitcnt lgkmcnt(0)" ::: "memory");
            FLG[2 + slot * 2 + hf] = (unsigned)(c + 1);
        }
    } else if (wave < 6) {
        asm volatile("" : "+v"(lane));
        const int slot = wave & 1, item = 2 * su + slot;
        RwRaw R; rwkv_load(p, item, 0, R, lane);
        for (int c = 0; c < NCHUNK; ++c) {
            if (c >= 2) { lds_wait_ge(FLG + 2 + slot * 2, (unsigned)(c - 1)); lds_wait_ge(FLG + 3 + slot * 2, (unsigned)(c - 1)); }
            asm volatile("" ::: "memory");
            rwkv_compute(p, item, c, R, RWB + (slot * 2 + (c & 1)) * RW_BUF, CSB + slot * 384, lane);
            if (c + 1 < NCHUNK) rwkv_load(p, item, c + 1, R, lane);
            asm volatile("s_waitcnt lgkmcnt(0)" ::: "memory");
            FLG[slot] = (unsigned)(c + 1);
        }
    } else {
        asm volatile("" : "+v"(lane));
        for (int id = nat_lo + su * 2 + (wave - 6); id < nat_hi; id += nat_stride) { if (id < nnat) nat_unit(p, l, id, false, lane); else nat_unit(p, l, id - nnat, true, lane); }
    }
}
DI void scan_unit_gl(const Params& p, int l, int gu, LAS unsigned char* lds, int tid, int lane, int wave, bool dry) {
    LAS float* GLB = (LAS float*)lds; LAS float* GUB = (LAS float*)(lds + 122880);
    volatile LAS unsigned* FLG = (volatile LAS unsigned*)(lds + 135936);
    __syncthreads();
    for (int i = tid; i < 6 * 544; i += NTHR) { const int sl = i / 544, r = i % 544; const int it = 6 * gu + sl, gg = it & 1, hh = (it >> 1) % 6;
        GUB[i] = r < 512 ? pin(p, I_GUP)[((size_t)(l * 2 + gg) * 16 + (r >> 5)) * 192 + hh * 32 + (r & 31)] : pin(p, I_GB)[(size_t)(l * 2 + gg) * 192 + hh * 32 + (r - 512)]; }
    if (tid < 12) FLG[tid] = 0u;
    __syncthreads();
    if (wave < 6) {
        asm volatile("" : "+v"(lane));
        const int item = 6 * gu + wave;
        f32x2 Sg[16];
#pragma unroll
        for (int i = 0; i < 16; ++i) Sg[i] = (f32x2){0.f, 0.f};
        for (int c = 0; c < NCHUNK; ++c) {
            lds_wait_ge(FLG + wave, (unsigned)(c + 1));
            asm volatile("" ::: "memory");
            gla_scan_chunk(p, item, c, GLB + (wave * 2 + (c & 1)) * GL_BUF, Sg, lane, dry);
            asm volatile("s_waitcnt lgkmcnt(0)" ::: "memory");
            FLG[6 + wave] = (unsigned)(c + 1);
        }
    } else {
        asm volatile("" : "+v"(lane));
        const int s0 = (wave - 6) * 3;
        GlRaw R0, R1, R2;
        gla_load(p, 6 * gu + s0, 0, R0, lane); gla_load(p, 6 * gu + s0 + 1, 0, R1, lane); gla_load(p, 6 * gu + s0 + 2, 0, R2, lane);
        for (int c = 0; c < NCHUNK; ++c) {
            const int nb = c & 1;
            if (c >= 2) lds_wait_ge(FLG + 6 + s0, (unsigned)(c - 1));
            asm volatile("" ::: "memory");
            gla_compute(p, 6 * gu + s0, c, R0, GLB + ((s0) * 2 + nb) * GL_BUF, GUB + (s0) * 544, lane);
            asm volatile("s_waitcnt lgkmcnt(0)" ::: "memory");
            FLG[s0] = (unsigned)(c + 1);
            if (c >= 2) lds_wait_ge(FLG + 6 + s0 + 1, (unsigned)(c - 1));
            asm volatile("" ::: "memory");
            gla_compute(p, 6 * gu + s0 + 1, c, R1, GLB + ((s0 + 1) * 2 + nb) * GL_BUF, GUB + (s0 + 1) * 544, lane);
            asm volatile("s_waitcnt lgkmcnt(0)" ::: "memory");
            FLG[s0 + 1] = (unsigned)(c + 1);
            if (c >= 2) lds_wait_ge(FLG + 6 + s0 + 2, (unsigned)(c - 1));
            asm volatile("" ::: "memory");
            gla_compute(p, 6 * gu + s0 + 2, c, R2, GLB + ((s0 + 2) * 2 + nb) * GL_BUF, GUB + (s0 + 2) * 544, lane);
            asm volatile("s_waitcnt lgkmcnt(0)" ::: "memory");
            FLG[s0 + 2] = (unsigned)(c + 1);
            if (c + 1 < NCHUNK) { gla_load(p, 6 * gu + s0, c + 1, R0, lane); gla_load(p, 6 * gu + s0 + 1, c + 1, R1, lane); gla_load(p, 6 * gu + s0 + 2, c + 1, R2, lane); }
        }
    }
}
DI void phase_mixers(const Params& p, int l, LAS unsigned char* lds, int tid, int lane, int wave, bool dry = false, int which = 3) {
    const int G = gridDim.x, bx = blockIdx.x;
    const int nnat = NB * 4 * 32 * 4, nnatc = l == 0 ? NB * 4 * 16 : 0, ntot = nnat + nnatc;
    const int n_in = (G == 256 && (which & 2)) ? min(ntot, 384 * NAT_IN) : 0;
    if (which & 1) for (int u = bx; u < 256; u += G) { if (u < 192) scan_unit_rw(p, l, u, lds, tid, lane, wave, dry, 0, n_in, 384, nnat); else scan_unit_gl(p, l, u - 192, lds, tid, lane, wave, dry); }
    if (which & 2) for (int id = n_in + bx * NWAVE + wave; id < ntot; id += G * NWAVE) { if (id < nnat) nat_unit(p, l, id, false, lane); else nat_unit(p, l, id - nnat, true, lane); }
}

DI void phase_readout(const Params& p, int l, int nrows, int lane, int wave, bool dry = false) {
    const int gw = blockIdx.x * NWAVE + wave, NGW = gridDim.x * NWAVE;
    const bf16_t* PB = (const bf16_t*)(p.ws + WS_PB); bf16_t* AY = (bf16_t*)(p.ws + WS_AY);
    const float* LOf = (const float*)(p.ws + WS_LO); const bf16_t* LOb = (const bf16_t*)(p.ws + WS_LO); const float* BON = (const float*)(p.ws + WS_BON);
    const bool act = lane < 48; const int c8 = act ? 8 * lane : 0, h = c8 >> 6;
    float nw[8], gnw[8], gnb[8], mu[8];
    { const float* a = pin(p, I_GNW) + l * 64 + (c8 & 63); const float* b = pin(p, I_GNWT) + l * 384 + c8; const float* c = pin(p, I_GNB) + l * 384 + c8; const float* d = pin(p, I_MU) + (size_t)l * 1536 + 768 + c8;
#pragma unroll
      for (int j = 0; j < 8; ++j) { nw[j] = a[j]; gnw[j] = b[j]; gnb[j] = c[j]; mu[j] = d[j]; } }
    for (int row = gw; row < nrows; row += NGW) {
        const bool lat = row < ML; const int t = lat ? (row & (SL - 1)) : ((row - ML) & (CL - 1)); const int Ls = lat ? SL : CL;
        const bf16_t* pr = PB + (size_t)row * PLD; bf16_t* yr = AY + (size_t)row * D;
        const u32x4 r_of = *(const u32x4*)(yr + c8), r_ob = *(const u32x4*)(yr + 384 + c8), r_gg = *(const u32x4*)(pr + C_GG + c8);
        const u32x4 r_nat = *(const u32x4*)(yr + 768 + 8 * (lane & 31));
        const float* lf = LOf + (size_t)row * (LOLD / 2) + c8;
        const f32x4 f0 = *(const f32x4*)lf, f1 = *(const f32x4*)(lf + 4), b0 = *(const f32x4*)(lf + 384), b1 = *(const f32x4*)(lf + 388);
        const bf16_t* pv = pr + C_RW + 768 + c8;
        const u32x4 r_v0 = *(const u32x4*)pv, r_vm = *(const u32x4*)(t > 0 ? pv - PLD : pv), r_vp = *(const u32x4*)(t < Ls - 1 ? pv + PLD : pv);
        const u32x4 r_gt = *(const u32x4*)(LOb + (size_t)row * LOLD + 1536 + c8);
        const float bon = BON[(size_t)row * 12 + h] + BON[(size_t)row * 12 + 6 + h];
        const float mm = t > 0 ? 0.5f : 0.f, mp = t < Ls - 1 ? 0.5f : 0.f;
        float of[8], ob[8], gg[8], v0[8], vm[8], vp[8], gt[8];
        cvt8(r_of, of); cvt8(r_ob, ob); cvt8(r_gg, gg); cvt8(r_v0, v0); cvt8(r_vm, vm); cvt8(r_vp, vp); cvt8(r_gt, gt);
        float og[8], orw[8]; float ss = 0.f, sm = 0.f;
#pragma unroll
        for (int j = 0; j < 8; ++j) { og[j] = of[j] + ob[j]; ss += og[j] * og[j]; orw[j] = (j < 4 ? f0[j & 3] : f1[j & 3]) + (j < 4 ? b0[j & 3] : b1[j & 3]); sm += orw[j]; }
        ss = sum8(ss); sm = sum8(sm);
        const float mean = sm * (1.f / 64.f); float sq = 0.f;
#pragma unroll
        for (int j = 0; j < 8; ++j) { orw[j] -= mean; sq += orw[j] * orw[j]; }
        sq = sum8(sq);
        float e1 = 1e-5f, e2 = 64e-5f; asm volatile("" : "+v"(e1), "+v"(e2));
        const float rg = rsqrtf(ss * (1.f / 64.f) + e1), rn = rsqrtf(sq * (1.f / 64.f) + e2);
        float yg[8], yw[8];
#pragma unroll
        for (int j = 0; j < 8; ++j) { yg[j] = og[j] * rg * nw[j] * (gg[j] * sigm(gg[j]));
            const float vs = v0[j] + ((mm * vm[j] + mp * vp[j]) - v0[j]) * mu[j];
            yw[j] = (orw[j] * rn * gnw[j] + gnb[j] + bon * vs) * gt[j]; }
        asm volatile("s_waitcnt vmcnt(0)" ::: "memory");
        const bool okst = !dry || yg[0] == 1.2345e37f;
        if (act && okst) { u32x4 o; o.x = cvtpk(yg[0], yg[1]); o.y = cvtpk(yg[2], yg[3]); o.z = cvtpk(yg[4], yg[5]); o.w = cvtpk(yg[6], yg[7]); *(u32x4*)(yr + c8) = o;
            u32x4 w; w.x = cvtpk(yw[0], yw[1]); w.y = cvtpk(yw[2], yw[3]); w.z = cvtpk(yw[4], yw[5]); w.w = cvtpk(yw[6], yw[7]); *(u32x4*)(yr + 640 + c8) = w; }
        if (lane < 32 && okst) *(u32x4*)(yr + 384 + 8 * lane) = r_nat;
    }
}

#define XB_TMO      128
#define XB_XCNT(j)  (256  + 64 * (j))
#define XB_XSUB(j)  (1280 + 64 * (j))
#define XB_XGEN(j)  (2304 + 64 * (j))
#define XB_TOP      3328
#define XB_TOPGEN   3392
#define XCD_BAR_WORDS 3456
#define XB_SPIN_CAP (1u << 18)

__device__ __forceinline__ unsigned xb_ld(unsigned* p)              { return __hip_atomic_load(p, __ATOMIC_RELAXED, __HIP_MEMORY_SCOPE_AGENT); }
__device__ __forceinline__ unsigned xb_add(unsigned* p, unsigned v) { return __hip_atomic_fetch_add(p, v, __ATOMIC_RELAXED, __HIP_MEMORY_SCOPE_AGENT); }
__device__ __forceinline__ unsigned xb_xcc_id() { return (unsigned)__builtin_amdgcn_s_getreg((3 << 11) | 20) & 0xFu; }
#define XB_SPIN(cond, bar) do { unsigned _sp = 0; while (cond) { __builtin_amdgcn_s_sleep(1); \
    if ((++_sp & 255u) == 0u) { if (xb_ld(&(bar)[XB_TMO])) break; if (_sp > XB_SPIN_CAP) { atomicAdd(&(bar)[XB_TMO], 1u); break; } } } } while (0)

struct XcdBarrier {
    unsigned* bar; unsigned x;
    volatile LAS unsigned* st;
};

__device__ __forceinline__ XcdBarrier xcd_barrier_post(unsigned* bar, volatile LAS unsigned* st, int tid) {
    XcdBarrier b; b.bar = bar; b.x = xb_xcc_id(); b.st = st;
    if (tid == 0) (void)xb_add(&bar[XB_XCNT(b.x)], 1u);
    return b;
}
__device__ __forceinline__ void xcd_barrier_complete(unsigned* bar, unsigned x, unsigned& nloc, unsigned& nx) {
    const unsigned G = gridDim.x * gridDim.y * gridDim.z;
    unsigned sum, cnt, mine, sp = 0u;
    for (;;) {
        sum = 0u; cnt = 0u; mine = 0u;
#pragma unroll
        for (unsigned j = 0; j < 16; ++j) { const unsigned c = xb_ld(&bar[XB_XCNT(j)]); sum += c; cnt += (c > 0u) ? 1u : 0u; mine = (j == x) ? c : mine; }
        if (sum == G) break;
        __builtin_amdgcn_s_sleep(1);
        if ((++sp & 255u) == 0u) { if (xb_ld(&bar[XB_TMO])) break; if (sp > XB_SPIN_CAP) { atomicAdd(&bar[XB_TMO], 1u); break; } }
    }
    nloc = mine > 0u ? mine : 1u; nx = cnt > 0u ? cnt : 1u;
}

__device__ __forceinline__ void xcd_barrier(const XcdBarrier& b, int tid) {
    asm volatile("s_waitcnt vmcnt(0)" ::: "memory");
    __syncthreads();
    if (tid == 0) {
        unsigned* bar = b.bar;
        __builtin_amdgcn_s_waitcnt(0);
        unsigned nloc = b.st[0], nx = b.st[1];
        if (nloc == 0u) { xcd_barrier_complete(bar, b.x, nloc, nx); b.st[0] = nloc; b.st[1] = nx; }
        const unsigned old = xb_add(&bar[XB_XSUB(b.x)], 1u);
        const unsigned gen = old / nloc;
        if (old + 1u == (gen + 1u) * nloc) {
            __builtin_amdgcn_fence(__ATOMIC_RELEASE, "agent");
            asm volatile("s_waitcnt vmcnt(0)" ::: "memory");
            const unsigned og = xb_add(&bar[XB_TOP], 1u);
            const unsigned tg = og / nx;
            if (og + 1u == (tg + 1u) * nx) xb_add(&bar[XB_TOPGEN], 1u);
            else XB_SPIN(xb_ld(&bar[XB_TOPGEN]) == tg, bar);
            __builtin_amdgcn_fence(__ATOMIC_ACQUIRE, "agent");
            xb_add(&bar[XB_XGEN(b.x)], 1u);
            asm volatile("s_waitcnt vmcnt(0)" ::: "memory");
        } else {
            XB_SPIN(xb_ld(&bar[XB_XGEN(b.x)]) == gen, bar);
            __builtin_amdgcn_fence(__ATOMIC_ACQUIRE, "agent");
            asm volatile("s_waitcnt vmcnt(0)" ::: "memory");
        }
    }
    __syncthreads();
}


DI void grid_sync_probe() { cg::this_grid().sync(); }
DI void run_step(const Params& p, const int step, LAS unsigned char* lds, int tid, int lane, int wave, bool dry = false) {
    const int G = gridDim.x, bx = blockIdx.x;
    unsigned char* ws = p.ws;
    const float* MOD = (const float*)(ws + WS_MOD);
    float* TC = (float*)(ws + WS_VT);
    {
        const int l = step < 2 ? 0 : (step - 2) / 10, st = step < 2 ? -1 : (step - 2) % 10;
        unsigned char* wl = ws + (size_t)l * WLB;
        const float* modl = MOD + (size_t)l * 33 * 6144;
        const int Mff = l == 0 ? MT : ML;
        if (st == 0 || st == 2 || st == 5 || st == 7 || st == 8) {
            const bf16_t* gA = (const bf16_t*)(ws + WS_AY); const bf16_t* gB; int gM = Mff, gN = 1024, gK = 1024, mode = 2;
            bf16_t* eO = (bf16_t*)(ws + WS_PB); const float* ex = (const float*)p.out; const float* exc = (const float*)TC; int gofs = 2 * 1024;
            if (st == 0) { gB = (const bf16_t*)(wl + OFF_WIN); gM = MT; gN = PLD; mode = 0; }
            else if (st == 2) { gB = (const bf16_t*)(wl + OFF_BT2); gM = MT; gN = 2048; gK = 384; mode = 1; eO = (bf16_t*)(ws + WS_LO); }
            else if (st == 5) { gB = (const bf16_t*)(wl + OFF_WOUT); if (l == 0) { ex = pin(p, I_X); exc = pin(p, I_CTX); } }
            else if (st == 7) { gB = (const bf16_t*)(wl + OFF_W13); gN = 2 * FH; mode = 3; }
            else { gA = (const bf16_t*)(ws + WS_PB); gB = (const bf16_t*)(wl + OFF_W2); gK = FH; gofs = 5 * 1024; }
            asm volatile("" : "+s"(gK), "+s"(gM), "+s"(gN), "+s"(mode), "+s"(gofs));
            asm volatile("" : "+s"(gA), "+s"(gB), "+s"(eO), "+s"(ex), "+s"(exc));
            const pg8::Gemm g{gA, gB, gM, gN, gK};
            const pg8::EpiAny E{mode, pg8::EpiStoreBf16{eO, PLD}, pg8::EpiLora{eO, pin(p, I_W0) + (size_t)l * 768, pin(p, I_A0) + (size_t)l * 768},
                                pg8::EpiRes{ex, exc, p.out, TC, modl, gofs}, pg8::EpiSwiglu{eO}};
            pg8::StaticOrder S; S.init(g.M, g.N, G, bx);
#if defined(PROBE_GEMM)
            int nrep = (st == 0 || st == 2 || st == 7) ? 2 : 1; asm volatile("" : "+s"(nrep));
#pragma unroll 1
            for (int rep = 0; rep < nrep; ++rep) { pg8::gemm_phase<pg8::EpiAny, pg8::StaticOrder, true, true>(lds, g, S, E, tid); __syncthreads(); }
#else
            pg8::gemm_phase<pg8::EpiAny, pg8::StaticOrder, true, true>(lds, g, S, E, tid);
#endif
        }
#ifndef ONLYGEMM
        else if (step == 0) phase_prologue(p, lds, tid, lane, wave);
        else if (step == 1) phase_modulate0(p, lane, wave);
        else if (st == 1) phase_prep(p, l, lds, lane, wave);
#if defined(PROBE_MIX)
        else if (st == 3) { int nrep = 2; asm volatile("" : "+s"(nrep));
#pragma unroll 1
            for (int rep = 0; rep < nrep; ++rep) { phase_mixers(p, l, lds, tid, lane, wave, rep + 1 < nrep, rep + 1 < nrep ? PROBE_MIX : 3); __syncthreads(); grid_sync_probe(); } }
#else
        else if (st == 3) phase_mixers(p, l, lds, tid, lane, wave);
#endif
        else if (st == 4) phase_readout(p, l, Mff, lane, wave, dry);
        else if (st == 6) phase_ln(p, lane, wave, Mff, pin(p, I_LN1W) + l * 1024, pin(p, I_LN1B) + l * 1024, modl, 3 * 1024, 4 * 1024, true, true, dry);
        else {
            if (l == 0) phase_ln(p, lane, wave, MT, pin(p, I_LN2W), pin(p, I_LN2B), MOD + (size_t)33 * 6144, 0, 1024, true, true, dry);
            else phase_ln(p, lane, wave, ML, pin(p, I_LN2W) + 1024, pin(p, I_LN2B) + 1024, modl, 0, 1024, true, false, dry);
        }
#endif
    }
}
#ifdef MULTI_LAUNCH
template <int STEP> __global__ void __launch_bounds__(NTHR, 2) k_step(Params p) {
    extern __shared__ __attribute__((aligned(16))) unsigned char smem[];
    const int tid = threadIdx.x, lane = tid & 63, wave = __builtin_amdgcn_readfirstlane(tid >> 6);
    run_step(p, STEP, (LAS unsigned char*)smem, tid, lane, wave);
}
template <int STEP> static void launch_steps(const Params& p, int grid, hipStream_t stream) {
    static bool attr_done = false;
    if (!attr_done) { (void)hipFuncSetAttribute((const void*)k_step<STEP>, hipFuncAttributeMaxDynamicSharedMemorySize, LDS_BYTES); attr_done = true; }
    hipLaunchKernelGGL(k_step<STEP>, dim3(grid), dim3(NTHR), LDS_BYTES, stream, p);
    if constexpr (STEP + 1 < 22) launch_steps<STEP + 1>(p, grid, stream);
}
#else
__global__ void __launch_bounds__(NTHR, 2) hybrid_fwd(Params p) {
    extern __shared__ __attribute__((aligned(16))) unsigned char smem[];
    LAS unsigned char* lds = (LAS unsigned char*)smem;
    cg::grid_group grid = cg::this_grid();
    const int wave0 = __builtin_amdgcn_readfirstlane((int)threadIdx.x >> 6);
    volatile LAS unsigned* MISC = (volatile LAS unsigned*)(lds + LDS_BYTES - 64);
#if defined(PROBE_REPEAT) || defined(PROBE_DRY)
    bool repeated = false;
#endif
    bool setup_done = false;
#pragma unroll 1
    for (int step = 0; step < 22; ++step) {
        unsigned msk = ~0u; int wave_ = wave0;
        asm volatile("" : "+s"(msk), "+s"(wave_));
        const int lane_ = (int)__builtin_amdgcn_mbcnt_hi(msk, __builtin_amdgcn_mbcnt_lo(msk, 0u));
        const int tid_ = wave_ * 64 + lane_;
        const int stepu = __builtin_amdgcn_readfirstlane(step);
#if defined(PROBE_DRY)
        const int sd_ = stepu < 2 ? -1 : (stepu - 2) % 10; const bool wantdry = ((PROBE_DRY & 1) && (sd_ == 6 || sd_ == 9)) || ((PROBE_DRY & 2) && sd_ == 4);
        run_step(p, stepu, lds, tid_, lane_, wave_, wantdry && !repeated);
#else
        run_step(p, stepu, lds, tid_, lane_, wave_);
#endif
        XcdBarrier bar; bar.bar = (unsigned*)(p.ws + WS_BAR); bar.x = xb_xcc_id(); bar.st = MISC;
        if (stepu == 0) {
            if (tid_ < 2) MISC[tid_] = 0u;
            if (tid_ == 0 && !setup_done) (void)xb_add(&bar.bar[XB_XCNT(bar.x)], 1u);
            setup_done = true;
            grid.sync();
        } else if (stepu != 21) xcd_barrier(bar, tid_);
#if defined(PROBE_DRY)
        if (wantdry && !repeated) { repeated = true; --step; } else repeated = false;
#endif
#if defined(PROBE_REPEAT)
        { const int st_ = step < 2 ? -1 : (step - 2) % 10; const bool rep_ok = ((PROBE_REPEAT & 1) && (st_ == 0 || st_ == 2 || st_ == 7)) || ((PROBE_REPEAT & 2) && st_ == 1) || ((PROBE_REPEAT & 4) && step == 0) || ((PROBE_REPEAT & 8) && step == 1);
          if (rep_ok && !repeated) { repeated = true; --step; } else repeated = false; }
#endif
    }
}
#endif

extern "C" void kernel_launch(void* const* d_in, const int* in_sizes, int n_in, void* d_out, int out_size, void* d_ws, size_t ws_size, hipStream_t stream) {
    static int grid = 0;
    if (grid == 0) {
        int dev = 0, cus = 0, per_cu = 0;
        if (n_in != 29 || ws_size < WS_END) { fprintf(stderr, "kernel_launch: unexpected n_in %d / ws_size %zu (need %zu)\n", n_in, ws_size, (size_t)WS_END); }
        hipGetDevice(&dev);
        hipDeviceGetAttribute(&cus, hipDeviceAttributeMultiprocessorCount, dev);
#ifndef MULTI_LAUNCH
        if (hipFuncSetAttribute((const void*)hybrid_fwd, hipFuncAttributeMaxDynamicSharedMemorySize, LDS_BYTES) != hipSuccess) fprintf(stderr, "kernel_launch: hipFuncSetAttribute failed\n");
        if (hipOccupancyMaxActiveBlocksPerMultiprocessor(&per_cu, (const void*)hybrid_fwd, NTHR, LDS_BYTES) != hipSuccess || per_cu < 1) { fprintf(stderr, "kernel_launch: occupancy query gave %d\n", per_cu); per_cu = 1; }
#endif
        (void)hipGetLastError();
        grid = cus > 0 ? cus : 256;
    }
    Params p{};
    for (int i = 0; i < 29; ++i) p.in[i] = (const float*)d_in[i];
    p.out = (float*)d_out; p.ws = (unsigned char*)d_ws;
#ifdef MULTI_LAUNCH
    launch_steps<0>(p, grid, stream);
#else
    (void)hipMemsetAsync((unsigned char*)d_ws + WS_BAR, 0, 16384, stream);
    void* args[] = {&p};
    hipError_t e = hipLaunchCooperativeKernel((const void*)hybrid_fwd, dim3(grid), dim3(NTHR), args, LDS_BYTES, stream);
    if (e != hipSuccess) fprintf(stderr, "kernel_launch: cooperative launch failed: %s (grid %d)\n", hipGetErrorString(e), grid);
#endif
}
```
